# Optimizing an MI355X kernel written in HIP

```python
import jax, jax.numpy as jnp
from jax import lax
import numpy as np

D_MODEL = 1024
BATCH = 2
SEQ = 8192
DEPTH = 1

N_HEADS = 16
HEAD_DIM = 64
N_KV_GROUPS = 4
HEADS_PER_GROUP = N_HEADS // N_KV_GROUPS
ROPE_DIM = HEAD_DIM // 4
ROPE_THETA = 500000.0
CMP_BLOCK = 32
CMP_STRIDE = 16
CMP_HIDDEN = 256
SLC_BLOCK = 64
SLC_TOPK = 16
WINDOW = 512
Q_BLOCK = 128
ATTN_Q_WIDTH = N_HEADS * HEAD_DIM
KV_WIDTH = N_KV_GROUPS * HEAD_DIM
POOL_WIDTH = D_MODEL // 2
POOL_WINDOWS = (2, 4, 8, 16)
POOL_GROUP = POOL_WIDTH // len(POOL_WINDOWS)
D_FF = ((8 * D_MODEL // 3 + 255) // 256) * 256
RMS_EPS = 1e-6
NEG_INF = -1e30

IN_SIZES = (POOL_WIDTH, ATTN_Q_WIDTH, KV_WIDTH, KV_WIDTH, KV_WIDTH, KV_WIDTH, KV_WIDTH, KV_WIDTH,
            N_HEADS * 3, D_MODEL, D_MODEL)
IN_WIDTH = sum(IN_SIZES)
SPLIT_POINTS = tuple(int(v) for v in np.cumsum(IN_SIZES)[:-1])

kernel_name = "hybrid_pool_nsa_gated_block"


def rms_norm(x, w):
    xf = x.astype(jnp.float32)
    y = xf * lax.rsqrt(jnp.mean(xf * xf, axis=-1, keepdims=True) + RMS_EPS)
    return (y * w.astype(jnp.float32)).astype(x.dtype)


def partial_rope(x, positions):
    half = ROPE_DIM // 2
    inv_freq = 1.0 / (ROPE_THETA ** (jnp.arange(0, ROPE_DIM, 2, dtype=jnp.float32) / ROPE_DIM))
    ang = positions.astype(jnp.float32)[:, None] * inv_freq[None, :]
    cos = jnp.cos(ang)[None, :, None, :]
    sin = jnp.sin(ang)[None, :, None, :]
    xf = x.astype(jnp.float32)
    x1, x2 = xf[..., :half], xf[..., half:ROPE_DIM]
    out = jnp.concatenate([x1 * cos - x2 * sin, x2 * cos + x1 * sin, xf[..., ROPE_DIM:]], axis=-1)
    return out.astype(x.dtype)


def pool_mixer(u, pool_w, pool_scale):
    B, S, _ = u.shape
    uf = u.astype(jnp.float32)
    csum = jnp.concatenate([jnp.zeros((B, 1, POOL_WIDTH), jnp.float32), jnp.cumsum(uf, axis=1)], axis=1)
    t = jnp.arange(S)
    outs = []
    for g, w in enumerate(POOL_WINDOWS):
        sl = slice(g * POOL_GROUP, (g + 1) * POOL_GROUP)
        lo = jnp.maximum(t + 1 - w, 0)
        cnt = (t + 1 - lo).astype(jnp.float32)
        mean = (csum[:, 1:, sl] - csum[:, lo, sl]) / cnt[None, :, None]
        outs.append(mean - uf[:, :, sl])
    pooled = jnp.stack(outs, axis=2)
    mixed = jnp.einsum('bsgc,gcd->bsgd', pooled, pool_w.astype(jnp.float32))
    return (mixed.reshape(B, S, POOL_WIDTH) * pool_scale.astype(jnp.float32)).astype(u.dtype)


def compress(kv, pe, w1, b1, w2):
    B, S, G, dk = kv.shape
    n_cmp = (S - CMP_BLOCK) // CMP_STRIDE + 1
    idx = jnp.arange(n_cmp)[:, None] * CMP_STRIDE + jnp.arange(CMP_BLOCK)[None, :]
    blocks = kv[:, idx] + pe[None, None, :, None, :]
    flat = blocks.transpose(0, 1, 3, 2, 4).reshape(B, n_cmp, G, CMP_BLOCK * dk)
    hid = jax.nn.gelu(flat @ w1 + b1)
    return hid @ w2


def cmp_to_slc_map(n_cmp, n_slc):
    start = np.arange(n_cmp) * CMP_STRIDE
    m = np.zeros((n_cmp, n_slc), np.float32)
    m[np.arange(n_cmp), start // SLC_BLOCK] = 1.0
    m[np.arange(n_cmp), (start + CMP_BLOCK - 1) // SLC_BLOCK] = 1.0
    return jnp.asarray(m)


def nsa_attention(q_plain, q_rope, k_cmp, v_cmp, k_slc, v_slc, k_win, v_win, gates):
    B, S, H, dk = q_plain.shape
    G, Hg = N_KV_GROUPS, HEADS_PER_GROUP
    scale = dk ** -0.5
    n_cmp = k_cmp.shape[1]
    n_slc = S // SLC_BLOCK
    n_top = min(SLC_TOPK, n_slc)
    n_qblk = S // Q_BLOCK
    qp_all = q_plain.reshape(B, S, G, Hg, dk)
    qr_all = q_rope.reshape(B, S, G, Hg, dk)
    g_all = jax.nn.sigmoid(gates.astype(jnp.float32)).reshape(B, S, G, Hg, 3)
    slc_map = cmp_to_slc_map(n_cmp, n_slc)
    cmp_end = jnp.arange(n_cmp) * CMP_STRIDE + (CMP_BLOCK - 1)

    def to_blocks(a):
        return a.reshape(B, n_slc, SLC_BLOCK, G, dk).transpose(0, 3, 1, 2, 4)

    ks_blk, vs_blk = to_blocks(k_slc), to_blocks(v_slc)
    pad = ((0, 0), (WINDOW, 0), (0, 0), (0, 0))
    kw_pad, vw_pad = jnp.pad(k_win, pad), jnp.pad(v_win, pad)
    bi = jnp.arange(B)[:, None, None, None]
    gi = jnp.arange(G)[None, :, None, None]
    blk_ids = jnp.arange(n_slc)
    in_blk = jnp.arange(SLC_BLOCK)
    win_off = jnp.arange(WINDOW + Q_BLOCK)

    def masked_softmax(s, mask):
        s = jnp.where(mask, s.astype(jnp.float32) * scale, NEG_INF)
        return jnp.where(mask, jax.nn.softmax(s, axis=-1), 0.0)

    def query_block(qb):
        t0 = qb * Q_BLOCK
        tq = t0 + jnp.arange(Q_BLOCK)
        qp = lax.dynamic_slice_in_dim(qp_all, t0, Q_BLOCK, axis=1)
        qr = lax.dynamic_slice_in_dim(qr_all, t0, Q_BLOCK, axis=1)
        g = lax.dynamic_slice_in_dim(g_all, t0, Q_BLOCK, axis=1)

        cmask = cmp_end[None, :] <= tq[:, None]
        p_cmp = masked_softmax(jnp.einsum('bqghd,bngd->bghqn', qp, k_cmp), cmask)
        o_cmp = jnp.einsum('bghqn,bngd->bqghd', p_cmp, v_cmp.astype(jnp.float32))

        jt = tq // SLC_BLOCK
        imp = jnp.einsum('bghqn,nj->bgqj', p_cmp, slc_map)
        causal = blk_ids[None, :] <= jt[:, None]
        forced = (blk_ids[None, :] == 0) | (blk_ids[None, :] == jt[:, None]) | (blk_ids[None, :] == jt[:, None] - 1)
        imp = jnp.where(forced, jnp.inf, jnp.where(causal, imp, -jnp.inf))
        _, sel = lax.top_k(imp, n_top)
        k_sel = ks_blk[bi, gi, sel]
        v_sel = vs_blk[bi, gi, sel]
        kpos = sel[..., None] * SLC_BLOCK + in_blk
        smask = (kpos <= tq[None, None, :, None, None]).reshape(B, G, 1, Q_BLOCK, n_top * SLC_BLOCK)
        s = jnp.einsum('bqghd,bgqkld->bghqkl', qr, k_sel).reshape(B, G, Hg, Q_BLOCK, n_top * SLC_BLOCK)
        p = masked_softmax(s, smask).reshape(B, G, Hg, Q_BLOCK, n_top, SLC_BLOCK)
        o_slc = jnp.einsum('bghqkl,bgqkld->bqghd', p, v_sel.astype(jnp.float32))

        kwb = lax.dynamic_slice_in_dim(kw_pad, t0, WINDOW + Q_BLOCK, axis=1)
        vwb = lax.dynamic_slice_in_dim(vw_pad, t0, WINDOW + Q_BLOCK, axis=1)
        kpos_w = t0 - WINDOW + win_off
        diff = tq[:, None] - kpos_w[None, :]
        wmask = (diff >= 0) & (diff < WINDOW) & (kpos_w[None, :] >= 0)
        p = masked_softmax(jnp.einsum('bqghd,bkgd->bghqk', qr, kwb), wmask)
        o_win = jnp.einsum('bghqk,bkgd->bqghd', p, vwb.astype(jnp.float32))

        o = g[..., 0:1] * o_cmp + g[..., 1:2] * o_slc + g[..., 2:3] * o_win
        return o.reshape(B, Q_BLOCK, H * dk)

    out = lax.map(query_block, jnp.arange(n_qblk))
    return out.transpose(1, 0, 2, 3).reshape(B, S, H * dk).astype(q_plain.dtype)


def setup_inputs(seed: int = 0) -> dict:
    key = jax.random.key(seed)
    k = jax.random.split(key, 24)
    L = DEPTH

    def nrm(kk, shape, scale):
        return jax.random.normal(kk, shape, jnp.float32) * scale

    def gain(kk, shape):
        return 1.0 + 0.05 * jax.random.normal(kk, shape, jnp.float32)

    return {
        "x": nrm(k[0], (BATCH, SEQ, D_MODEL), 1.0),
        "norm1_w": gain(k[1], (L, D_MODEL)),
        "w_in": nrm(k[2], (L, D_MODEL, IN_WIDTH), D_MODEL ** -0.5),
        "pool_w": nrm(k[3], (L, len(POOL_WINDOWS), POOL_GROUP, POOL_GROUP), POOL_GROUP ** -0.5),
        "pool_scale": gain(k[4], (L, POOL_WIDTH)),
        "cmp_pe_k": nrm(k[5], (L, CMP_BLOCK, HEAD_DIM), 0.5),
        "cmp_w1_k": nrm(k[6], (L, CMP_BLOCK * HEAD_DIM, CMP_HIDDEN), (CMP_BLOCK * HEAD_DIM) ** -0.5),
        "cmp_b1_k": nrm(k[7], (L, CMP_HIDDEN), 0.02),
        "cmp_w2_k": nrm(k[8], (L, CMP_HIDDEN, HEAD_DIM), CMP_HIDDEN ** -0.5),
        "cmp_pe_v": nrm(k[9], (L, CMP_BLOCK, HEAD_DIM), 0.5),
        "cmp_w1_v": nrm(k[10], (L, CMP_BLOCK * HEAD_DIM, CMP_HIDDEN), (CMP_BLOCK * HEAD_DIM) ** -0.5),
        "cmp_b1_v": nrm(k[11], (L, CMP_HIDDEN), 0.02),
        "cmp_w2_v": nrm(k[12], (L, CMP_HIDDEN, HEAD_DIM), CMP_HIDDEN ** -0.5),
        "w_proj_pool": nrm(k[13], (L, POOL_WIDTH, D_MODEL), POOL_WIDTH ** -0.5),
        "w_proj_attn": nrm(k[14], (L, ATTN_Q_WIDTH, D_MODEL), ATTN_Q_WIDTH ** -0.5),
        "w_out": nrm(k[15], (L, D_MODEL, D_MODEL), D_MODEL ** -0.5),
        "norm2_w": gain(k[16], (L, D_MODEL)),
        "w_ffn_gate": nrm(k[17], (L, D_MODEL, D_FF), D_MODEL ** -0.5),
        "w_ffn_up": nrm(k[18], (L, D_MODEL, D_FF), D_MODEL ** -0.5),
        "w_ffn_down": nrm(k[19], (L, D_FF, D_MODEL), D_FF ** -0.5),
        "norm_f_w": gain(k[20], (D_MODEL,)),
    }


def reference(x, norm1_w, w_in, pool_w, pool_scale, cmp_pe_k, cmp_w1_k, cmp_b1_k, cmp_w2_k,
              cmp_pe_v, cmp_w1_v, cmp_b1_v, cmp_w2_v, w_proj_pool, w_proj_attn, w_out,
              norm2_w, w_ffn_gate, w_ffn_up, w_ffn_down, norm_f_w):
    B, S, _ = x.shape
    G = N_KV_GROUPS
    positions = jnp.arange(S)

    def heads(a, n):
        return a.reshape(B, S, n, HEAD_DIM)

    for l in range(DEPTH):
        h = rms_norm(x, norm1_w[l])
        proj = h @ w_in[l]
        (u_pool, q, kc_raw, vc_raw, ks_raw, vs_raw, kw_raw, vw_raw,
         g_nsa, g_pool, g_attn) = jnp.split(proj, SPLIT_POINTS, axis=-1)
        q = heads(q, N_HEADS)
        q_rope = partial_rope(q, positions)
        k_cmp = compress(heads(kc_raw, G), cmp_pe_k[l], cmp_w1_k[l], cmp_b1_k[l], cmp_w2_k[l])
        v_cmp = compress(heads(vc_raw, G), cmp_pe_v[l], cmp_w1_v[l], cmp_b1_v[l], cmp_w2_v[l])
        k_slc = partial_rope(heads(ks_raw, G), positions)
        k_win = partial_rope(heads(kw_raw, G), positions)
        attn = nsa_attention(q, q_rope, k_cmp, v_cmp, k_slc, heads(vs_raw, G), k_win, heads(vw_raw, G),
                             g_nsa.reshape(B, S, N_HEADS, 3))
        pool = pool_mixer(u_pool, pool_w[l], pool_scale[l])
        merged = (jax.nn.sigmoid(g_pool) * (pool @ w_proj_pool[l])
                  + jax.nn.sigmoid(g_attn) * (attn @ w_proj_attn[l]))
        x = x + merged @ w_out[l]
        h = rms_norm(x, norm2_w[l])
        x = x + (jax.nn.silu(h @ w_ffn_gate[l]) * (h @ w_ffn_up[l])) @ w_ffn_down[l]
    return rms_norm(x, norm_f_w)
```

```cpp
#include <hip/hip_runtime.h>
#include <cstdint>
#include <cstdio>

typedef unsigned short bf16_t;
typedef short bf16x8 __attribute__((ext_vector_type(8)));
typedef float f32x4 __attribute__((ext_vector_type(4)));
typedef unsigned u32x4 __attribute__((ext_vector_type(4)));
typedef unsigned u32x2 __attribute__((ext_vector_type(2)));

constexpr int BATCH = 2, SEQ = 8192, T = BATCH * SEQ, DM = 1024;
constexpr int NH = 16, HD = 64, NG = 4;
constexpr int NREF = 5168, NIN = 5376;
constexpr int DFF = 2816;
constexpr int NCMP = 511, NCP = 512;
constexpr float RMS_EPS = 1e-6f;
constexpr float C2 = 0.125f * 1.4426950408889634f;

constexpr size_t MiB = 1u << 20;
constexpr size_t WS_CTL = 0;
constexpr size_t WS_PEBK = 1 * MiB, WS_PEBV = 1 * MiB + 4096, WS_RCOS = 1 * MiB + 65536, WS_RSIN = WS_RCOS + 262144;
constexpr size_t WS_RS1 = 2 * MiB, WS_RS2 = 3 * MiB;
constexpr size_t WS_KCMP = 4 * MiB, WS_VCMP = 4 * MiB + 512 * 1024;
constexpr size_t WS_W2K = 5 * MiB, WS_W2V = 5 * MiB + 65536;
constexpr size_t WS_W1K = 6 * MiB, WS_W1V = 7 * MiB;
constexpr size_t WS_WIN = 8 * MiB;
constexpr size_t WS_WM = 19 * MiB;
constexpr size_t WS_WO = 22 * MiB;
constexpr size_t WS_WGU = 24 * MiB;
constexpr size_t WS_WD = 35 * MiB;
constexpr size_t WS_GN = 41 * MiB;
constexpr size_t WS_U = 44 * MiB;
constexpr size_t WS_QP = 60 * MiB;
constexpr size_t WS_MG = 60 * MiB;
constexpr size_t WS_KC = 92 * MiB, WS_VC = 100 * MiB, WS_KS = 108 * MiB, WS_VS = 116 * MiB, WS_KW = 124 * MiB, WS_VW = 132 * MiB;
constexpr size_t WS_SA = 140 * MiB;
constexpr size_t WS_PA = 172 * MiB;
constexpr size_t WS_QR = 220 * MiB;
constexpr size_t WS_X1B = 220 * MiB;
constexpr size_t WS_TMP = 252 * MiB;
constexpr size_t WS_HIDK = 252 * MiB, WS_HIDV = 254 * MiB;
constexpr size_t WS_ACT = 44 * MiB;
constexpr size_t WS_END = 256 * MiB;
constexpr size_t DO_H = 0, DO_SP = 32 * MiB;

__device__ __forceinline__ unsigned f2bf(float f) { unsigned u = __builtin_bit_cast(unsigned, f); return (u + 0x7fffu + ((u >> 16) & 1u)) >> 16; }
__device__ __forceinline__ float bf2f(unsigned b) { return __builtin_bit_cast(float, (b & 0xffffu) << 16); }
__device__ __forceinline__ unsigned pk2(float lo, float hi) { return f2bf(lo) | (f2bf(hi) << 16); }
__device__ __forceinline__ float sigmoidf_(float v) { return 1.f / (1.f + __expf(-v)); }
__device__ __forceinline__ float wave_sum(float v) {
#pragma unroll
    for (int o = 1; o < 64; o <<= 1) v += __shfl_xor(v, o);
    return v;
}
__device__ __forceinline__ float wave_max(float v) {
#pragma unroll
    for (int o = 1; o < 64; o <<= 1) v = fmaxf(v, __shfl_xor(v, o));
    return v;
}
__host__ __device__ __forceinline__ int incol_ref(int c) {
    if (c < 3072) return c;
    if (c < 4096) return 3120 + (c - 3072);
    if (c < 5120) return 4144 + (c - 4096);
    if (c < 5168) return 3072 + (c - 5120);
    return -1;
}

struct SF_in { const float* W; __device__ float operator()(int k, int n) const { const int r = incol_ref(n); return r < 0 ? 0.f : W[(size_t)k * NREF + r]; } };
struct SF_plain { const float* W; int ldn; int pad; __device__ float operator()(int k, int n) const { return W[(size_t)k * ldn + n]; } };
struct SF_wm { const float* WF; const float* Wa; __device__ float operator()(int k, int n) const { return k < 512 ? WF[(size_t)k * 1024 + n] : Wa[(size_t)(k - 512) * 1024 + n]; } };
struct SF_gu { const float* Wg; const float* Wu; const float* nw; __device__ float operator()(int k, int n) const {
    const int tile = n >> 8, half = (n >> 7) & 1, j = n & 127, col = tile * 128 + j; return nw[k] * (half ? Wu : Wg)[(size_t)k * DFF + col]; } };

template <class SF> struct WprepArgs { SF sf; bf16_t* dst; int K; int pad; };
template <class SF> __global__ void __launch_bounds__(256) k_wprep(WprepArgs<SF> a) {
    const SF& sf = a.sf; bf16_t* dst = a.dst; const int K = a.K;
    __shared__ float tile[32][33];
    const int k0 = blockIdx.x * 32, n0 = blockIdx.y * 32, tx = threadIdx.x & 31, ty = threadIdx.x >> 5;
    for (int i = ty; i < 32; i += 8) tile[i][tx] = sf(k0 + i, n0 + tx);
    __syncthreads();
    for (int i = ty; i < 32; i += 8) dst[(size_t)(n0 + i) * K + k0 + tx] = (bf16_t)f2bf(tile[tx][i]);
}
__global__ void __launch_bounds__(256) k_wfold(const float* pool_w, const float* pool_scale, const float* Wp, float* WF) {
    const int idx = blockIdx.x * 256 + threadIdx.x, d = idx & 1023, kk = idx >> 10, g = kk >> 7;
    float s = 0.f;
    for (int dp = 0; dp < 128; ++dp) s += pool_w[(size_t)kk * 128 + dp] * pool_scale[g * 128 + dp] * Wp[(size_t)(g * 128 + dp) * 1024 + d];
    WF[idx] = s;
}
__global__ void __launch_bounds__(256) k_pebias(const float* pe, const float* w1, const float* b1, float* out) {
    const int c = threadIdx.x; float s = b1[c];
    for (int k = 0; k < 2048; ++k) s += pe[k] * w1[(size_t)k * 256 + c];
    out[c] = s;
}
__global__ void __launch_bounds__(256) k_rope_table(float* rc, float* rs) {
    const int idx = blockIdx.x * 256 + threadIdx.x, i = idx & 7, t = idx >> 3;
    const float inv_freq = (float)(1.0 / pow(500000.0, (double)i / 8.0));
    const float ang = (float)t * inv_freq;
    rc[idx] = cosf(ang); rs[idx] = sinf(ang);
}
__global__ void __launch_bounds__(256) k_rmsnorm_bf16(const float* x, const float* w, bf16_t* out) {
    const int row = blockIdx.x * 4 + (threadIdx.x >> 6), lane = threadIdx.x & 63;
    const f32x4* xr = (const f32x4*)(x + (size_t)row * DM) + lane; const f32x4* wr = (const f32x4*)w + lane;
    f32x4 v[4]; float s = 0.f;
#pragma unroll
    for (int j = 0; j < 4; ++j) { v[j] = xr[64 * j]; s += v[j].x * v[j].x + v[j].y * v[j].y + v[j].z * v[j].z + v[j].w * v[j].w; }
    const float rstd = rsqrtf(wave_sum(s) * (1.f / DM) + RMS_EPS);
    u32x2* o = (u32x2*)(out + (size_t)row * DM) + lane;
#pragma unroll
    for (int j = 0; j < 4; ++j) { const f32x4 ww = wr[64 * j]; u32x2 p; p.x = pk2(v[j].x * rstd * ww.x, v[j].y * rstd * ww.y); p.y = pk2(v[j].z * rstd * ww.z, v[j].w * rstd * ww.w); o[64 * j] = p; }
}

template <class AF, class BF, class Epi> struct GemmArgs { AF af; BF bf; Epi epi; int K; int pad; };
template <int NB, class AF, class BF, class Epi>
__global__ void __launch_bounds__(256) k_sgemm(GemmArgs<AF, BF, Epi> ga) {
    const AF& af = ga.af; const BF& bf = ga.bf; const Epi& epi = ga.epi; const int K = ga.K;
    const int lane = threadIdx.x & 63, wid = threadIdx.x >> 6, wr = wid >> 1, wc = wid & 1;
    const int m0 = blockIdx.y * 128 + wr * 64, n0 = blockIdx.x * 64 + wc * 32, fr = lane & 15, fq = lane >> 4;
    f32x4 acc[NB][4][2];
#pragma unroll
    for (int w = 0; w < NB; ++w)
#pragma unroll
        for (int mt = 0; mt < 4; ++mt)
#pragma unroll
            for (int nt = 0; nt < 2; ++nt) acc[w][mt][nt] = (f32x4){0.f, 0.f, 0.f, 0.f};
    for (int k0 = 0; k0 < K; k0 += 32) {
        bf16x8 a[4], b[NB][2];
#pragma unroll
        for (int mt = 0; mt < 4; ++mt) a[mt] = *(const bf16x8*)af(m0 + 16 * mt + fr, k0 + 8 * fq);
#pragma unroll
        for (int w = 0; w < NB; ++w)
#pragma unroll
            for (int nt = 0; nt < 2; ++nt) b[w][nt] = *(const bf16x8*)bf(w, n0 + 16 * nt + fr, k0 + 8 * fq);
#pragma unroll
        for (int w = 0; w < NB; ++w)
#pragma unroll
            for (int mt = 0; mt < 4; ++mt)
#pragma unroll
                for (int nt = 0; nt < 2; ++nt) acc[w][mt][nt] = __builtin_amdgcn_mfma_f32_16x16x32_bf16(a[mt], b[w][nt], acc[w][mt][nt], 0, 0, 0);
    }
#pragma unroll
    for (int mt = 0; mt < 4; ++mt)
#pragma unroll
        for (int nt = 0; nt < 2; ++nt)
#pragma unroll
            for (int r = 0; r < 4; ++r) {
                if constexpr (NB == 1) epi(m0 + 16 * mt + 4 * fq + r, n0 + 16 * nt + fr, acc[0][mt][nt][r]);
                else epi(m0 + 16 * mt + 4 * fq + r, n0 + 16 * nt + fr, acc[0][mt][nt][r], acc[1][mt][nt][r]);
            }
}
struct AF_plain { const bf16_t* A; int lda; int pad; __device__ const bf16_t* operator()(int row, int k) const { return A + (size_t)row * lda + k; } };
struct BF_plain { const bf16_t* B; int ldb; int pad; __device__ const bf16_t* operator()(int, int col, int k) const { return B + (size_t)col * ldb + k; } };
struct AF_cmp { const bf16_t* KV; __device__ const bf16_t* operator()(int row, int k) const {
    const int n = row & 511, bg = row >> 9, g = bg & 3, b = bg >> 2, l = k >> 6, d = k & 63; return KV + ((size_t)(b * SEQ + 16 * n + l) * 256 + g * 64 + d); } };
struct BF_gu { const bf16_t* B; __device__ const bf16_t* operator()(int w, int col, int k) const { return B + (size_t)(256 * (col >> 7) + (col & 127) + 128 * w) * DM + k; } };

struct EpiIn {
    bf16_t *U, *QP, *KC, *VC, *KS, *VS, *KW, *VW, *SP, *SA; float* GN;
    __device__ void operator()(int row, int c, float v) const {
        if (c < 512) U[(size_t)row * 512 + c] = (bf16_t)f2bf(v);
        else if (c < 1536) QP[(size_t)row * 1024 + (c - 512)] = (bf16_t)f2bf(v * C2);
        else if (c < 3072) { const int t = (c - 1536) >> 8, cc = (c - 1536) & 255; bf16_t* dst = t == 0 ? KC : t == 1 ? VC : t == 2 ? KS : t == 3 ? VS : t == 4 ? KW : VW; dst[(size_t)row * 256 + cc] = (bf16_t)f2bf(v); }
        else if (c < 4096) SP[(size_t)row * 1024 + (c - 3072)] = (bf16_t)f2bf(sigmoidf_(v));
        else if (c < 5120) SA[(size_t)row * 1024 + (c - 4096)] = (bf16_t)f2bf(sigmoidf_(v));
        else if (c < 5168) GN[(size_t)row * 48 + (c - 5120)] = sigmoidf_(v);
    }
};
__device__ __forceinline__ float gelu_tanh(float x) { const float u = 0.7978845608028654f * (x + 0.044715f * x * x * x); return 0.5f * x * (1.f + tanhf(u)); }
struct EpiHid { bf16_t* H; const float* peb; __device__ void operator()(int row, int c, float v) const { H[(size_t)row * 256 + c] = (bf16_t)f2bf(gelu_tanh(v + peb[c])); } };
struct EpiStoreBf { bf16_t* O; int ldo; int pad; __device__ void operator()(int row, int c, float v) const { O[(size_t)row * ldo + c] = (bf16_t)f2bf(v); } };
struct EpiPoolProj { bf16_t* TMP; const bf16_t* SP; __device__ void operator()(int row, int c, float v) const { TMP[(size_t)row * 1024 + c] = (bf16_t)f2bf(bf2f(SP[(size_t)row * 1024 + c]) * v); } };
struct EpiMerged { bf16_t* MG; const bf16_t* TMP; const bf16_t* SA; __device__ void operator()(int row, int c, float v) const {
    const size_t i = (size_t)row * 1024 + c; MG[i] = (bf16_t)f2bf(bf2f(TMP[i]) + bf2f(SA[i]) * v); } };
struct EpiX1 { const float* x; float* X1; bf16_t* X1B; __device__ void operator()(int row, int c, float v) const {
    const size_t i = (size_t)row * 1024 + c; const float r = x[i] + v; X1[i] = r; X1B[i] = (bf16_t)f2bf(r); } };
struct EpiAct { bf16_t* ACT; const float* RS; __device__ void operator()(int row, int c, float vg, float vu) const {
    const float rstd = rsqrtf(RS[row] * (1.f / DM) + RMS_EPS); const float g = vg * rstd, u = vu * rstd; ACT[(size_t)row * DFF + c] = (bf16_t)f2bf(g / (1.f + __expf(-g)) * u); } };
struct EpiX2 { float* X; __device__ void operator()(int row, int c, float v) const { const size_t i = (size_t)row * 1024 + c; X[i] = X[i] + v; } };

__global__ void __launch_bounds__(256) k_rope_q(const bf16_t* QP, bf16_t* QR, const float* rc, const float* rs) {
    const size_t idx = (size_t)blockIdx.x * 256 + threadIdx.x; const int c = (int)(idx & 1023), row = (int)(idx >> 10), d = c & 63, t = row & (SEQ - 1);
    if (d >= 16) { QR[idx] = QP[idx]; return; }
    const int i = d & 7; const size_t hb = idx - d;
    const float x1 = bf2f(QP[hb + i]), x2 = bf2f(QP[hb + 8 + i]), cs = rc[t * 8 + i], sn = rs[t * 8 + i];
    QR[idx] = (bf16_t)f2bf(d < 8 ? x1 * cs - x2 * sn : x2 * cs + x1 * sn);
}
__global__ void __launch_bounds__(256) k_rope_k(bf16_t* KK, const float* rc, const float* rs) {
    const int idx = blockIdx.x * 256 + threadIdx.x, i = idx & 7, g = (idx >> 3) & 3, row = idx >> 5, t = row & (SEQ - 1);
    bf16_t* p = KK + (size_t)row * 256 + g * 64;
    const float x1 = bf2f(p[i]), x2 = bf2f(p[8 + i]), cs = rc[t * 8 + i], sn = rs[t * 8 + i];
    p[i] = (bf16_t)f2bf(x1 * cs - x2 * sn); p[8 + i] = (bf16_t)f2bf(x2 * cs + x1 * sn);
}
__global__ void __launch_bounds__(256) k_pooled(const bf16_t* U, bf16_t* PA) {
    const int idx = blockIdx.x * 256 + threadIdx.x, c = idx & 511, row = idx >> 9, t = row & (SEQ - 1), w = 2 << (c >> 7);
    const int cnt = t + 1 < w ? t + 1 : w; float s = 0.f;
    for (int i = 0; i < cnt; ++i) s += bf2f(U[(size_t)(row - i) * 512 + c]);
    PA[(size_t)row * 1536 + c] = (bf16_t)f2bf(s / (float)cnt - bf2f(U[(size_t)row * 512 + c]));
}
__global__ void __launch_bounds__(256) k_rowsq(const float* X, float* RS) {
    const int row = blockIdx.x * 4 + (threadIdx.x >> 6), lane = threadIdx.x & 63;
    const f32x4* xr = (const f32x4*)(X + (size_t)row * DM) + lane; float s = 0.f;
#pragma unroll
    for (int j = 0; j < 4; ++j) { const f32x4 v = xr[64 * j]; s += v.x * v.x + v.y * v.y + v.z * v.z + v.w * v.w; }
    s = wave_sum(s); if (lane == 0) RS[row] = s;
}
__global__ void __launch_bounds__(256) k_final_norm(float* X, const float* w) {
    const int row = blockIdx.x * 4 + (threadIdx.x >> 6), lane = threadIdx.x & 63;
    f32x4* xr = (f32x4*)(X + (size_t)row * DM) + lane; const f32x4* wr = (const f32x4*)w + lane;
    f32x4 v[4]; float s = 0.f;
#pragma unroll
    for (int j = 0; j < 4; ++j) { v[j] = xr[64 * j]; s += v[j].x * v[j].x + v[j].y * v[j].y + v[j].z * v[j].z + v[j].w * v[j].w; }
    const float rstd = rsqrtf(wave_sum(s) * (1.f / DM) + RMS_EPS);
#pragma unroll
    for (int j = 0; j < 4; ++j) { const f32x4 ww = wr[64 * j]; xr[64 * j] = (f32x4){v[j].x * rstd * ww.x, v[j].y * rstd * ww.y, v[j].z * rstd * ww.z, v[j].w * rstd * ww.w}; }
}

struct AttnP { const bf16_t *QP, *QR, *KCMP, *VCMP, *KS, *VS, *KW, *VW; const float* GN; bf16_t* PA; };
__device__ __forceinline__ void dot4(const bf16_t* krow, const float (*sq)[64], float out[4]) {
    float a0 = 0.f, a1 = 0.f, a2 = 0.f, a3 = 0.f;
#pragma unroll
    for (int c = 0; c < 8; ++c) {
        const u32x4 kv = *(const u32x4*)(krow + 8 * c);
#pragma unroll
        for (int e = 0; e < 4; ++e) {
            const unsigned w = kv[e]; const float k0 = __builtin_bit_cast(float, w << 16), k1 = __builtin_bit_cast(float, w & 0xffff0000u); const int d = 8 * c + 2 * e;
            a0 += sq[0][d] * k0 + sq[0][d + 1] * k1; a1 += sq[1][d] * k0 + sq[1][d + 1] * k1; a2 += sq[2][d] * k0 + sq[2][d + 1] * k1; a3 += sq[3][d] * k0 + sq[3][d + 1] * k1;
        }
    }
    out[0] = a0; out[1] = a1; out[2] = a2; out[3] = a3;
}
__global__ void __launch_bounds__(64) k_attn_naive(AttnP P) {
    __shared__ float sq[4][64];
    __shared__ float sc[4][1024];
    __shared__ float simp[128];
    __shared__ int ssel[16];
    const int id = blockIdx.x, g = id & 3, bt = id >> 2, t = bt & (SEQ - 1), b = bt >> 13, lane = threadIdx.x;
    const float NEG = -INFINITY;
    float oc[4], os[4], ow[4];
    const int ncv = t >= 31 ? (t - 31) / 16 + 1 : 0;
    for (int h = 0; h < 4; ++h) sq[h][lane] = bf2f(P.QP[(size_t)bt * 1024 + (g * 4 + h) * 64 + lane]);
    __syncthreads();
    const bf16_t* kc = P.KCMP + (size_t)((b * 4 + g) * NCP) * 64; const bf16_t* vc = P.VCMP + (size_t)((b * 4 + g) * NCP) * 64;
    for (int n = lane; n < ncv; n += 64) { float d4[4]; dot4(kc + (size_t)n * 64, sq, d4); for (int h = 0; h < 4; ++h) sc[h][n] = d4[h]; }
    __syncthreads();
    for (int h = 0; h < 4; ++h) {
        float m = NEG; for (int n = lane; n < ncv; n += 64) m = fmaxf(m, sc[h][n]); m = wave_max(m);
        float l = 0.f; for (int n = lane; n < ncv; n += 64) l += exp2f(sc[h][n] - m); l = wave_sum(l);
        const float il = ncv > 0 ? 1.f / l : 0.f;
        for (int n = lane; n < ncv; n += 64) sc[h][n] = exp2f(sc[h][n] - m) * il;
    }
    __syncthreads();
    for (int h = 0; h < 4; ++h) oc[h] = 0.f;
    for (int n = 0; n < ncv; ++n) { const float v = bf2f(vc[(size_t)n * 64 + lane]); for (int h = 0; h < 4; ++h) oc[h] += sc[h][n] * v; }
    for (int j = lane; j < 128; j += 64) { float s = 0.f; for (int n = 4 * j - 1; n <= 4 * j + 3; ++n) if (n >= 0 && n < ncv) s += (sc[0][n] + sc[1][n]) + (sc[2][n] + sc[3][n]); simp[j] = s; }
    __syncthreads();
    const int jt = t >> 6;
    float v0, v1;
    { const int j0 = lane, j1 = lane + 64;
      v0 = (j0 == 0 || j0 == jt || j0 == jt - 1) ? INFINITY : (j0 <= jt ? simp[j0] : NEG);
      v1 = (j1 == 0 || j1 == jt || j1 == jt - 1) ? INFINITY : (j1 <= jt ? simp[j1] : NEG); }
    int i0 = lane, i1 = lane + 64;
    for (int r = 0; r < 16; ++r) {
        float bv; int bi;
        if (i0 < 999 && (i1 >= 999 || v0 >= v1)) { bv = v0; bi = i0; } else if (i1 < 999) { bv = v1; bi = i1; } else { bv = NEG; bi = 999; }
#pragma unroll
        for (int o = 1; o < 64; o <<= 1) { const float ov = __shfl_xor(bv, o); const int oi = __shfl_xor(bi, o); if (oi < 999 && (bi >= 999 || ov > bv || (ov == bv && oi < bi))) { bv = ov; bi = oi; } }
        if (i0 == bi) i0 = 999; if (i1 == bi) i1 = 999;
        if (lane == 0) ssel[r] = bi;
    }
    __syncthreads();
    for (int h = 0; h < 4; ++h) sq[h][lane] = bf2f(P.QR[(size_t)bt * 1024 + (g * 4 + h) * 64 + lane]);
    __syncthreads();
    for (int i = 0; i < 16; ++i) {
        const int kpos = ssel[i] * 64 + lane; float d4[4];
        if (kpos <= t) dot4(P.KS + (size_t)(b * SEQ + kpos) * 256 + g * 64, sq, d4); else { d4[0] = d4[1] = d4[2] = d4[3] = NEG; }
        for (int h = 0; h < 4; ++h) sc[h][i * 64 + lane] = d4[h];
    }
    __syncthreads();
    for (int h = 0; h < 4; ++h) {
        float m = NEG; for (int n = lane; n < 1024; n += 64) m = fmaxf(m, sc[h][n]); m = wave_max(m);
        float l = 0.f; for (int n = lane; n < 1024; n += 64) l += exp2f(sc[h][n] - m); l = wave_sum(l);
        const float il = 1.f / l;
        for (int n = lane; n < 1024; n += 64) sc[h][n] = exp2f(sc[h][n] - m) * il;
    }
    __syncthreads();
    for (int h = 0; h < 4; ++h) os[h] = 0.f;
    for (int i = 0; i < 16; ++i) {
        const int j = ssel[i]; const int nk = (j * 64 + 63 <= t) ? 64 : (j * 64 > t ? 0 : t - j * 64 + 1);
        const bf16_t* vb = P.VS + (size_t)(b * SEQ + j * 64) * 256 + g * 64 + lane;
        for (int k = 0; k < nk; ++k) { const float v = bf2f(vb[(size_t)k * 256]); for (int h = 0; h < 4; ++h) os[h] += sc[h][i * 64 + k] * v; }
    }
    __syncthreads();
    for (int c = 0; c < 8; ++c) {
        const int idx = c * 64 + lane, kpos = t - 511 + idx; float d4[4];
        if (kpos >= 0) dot4(P.KW + (size_t)(b * SEQ + kpos) * 256 + g * 64, sq, d4); else { d4[0] = d4[1] = d4[2] = d4[3] = NEG; }
        for (int h = 0; h < 4; ++h) sc[h][idx] = d4[h];
    }
    __syncthreads();
    for (int h = 0; h < 4; ++h) {
        float m = NEG; for (int n = lane; n < 512; n += 64) m = fmaxf(m, sc[h][n]); m = wave_max(m);
        float l = 0.f; for (int n = lane; n < 512; n += 64) l += exp2f(sc[h][n] - m); l = wave_sum(l);
        const float il = 1.f / l;
        for (int n = lane; n < 512; n += 64) sc[h][n] = exp2f(sc[h][n] - m) * il;
    }
    __syncthreads();
    for (int h = 0; h < 4; ++h) ow[h] = 0.f;
    { const int k0 = t >= 511 ? 0 : 511 - t;
      for (int idx = k0; idx < 512; ++idx) { const float v = bf2f(P.VW[(size_t)(b * SEQ + t - 511 + idx) * 256 + g * 64 + lane]); for (int h = 0; h < 4; ++h) ow[h] += sc[h][idx] * v; } }
    for (int h = 0; h < 4; ++h) {
        const float* gn = P.GN + (size_t)bt * 48 + (g * 4 + h) * 3;
        P.PA[(size_t)bt * 1536 + 512 + (g * 4 + h) * 64 + lane] = (bf16_t)f2bf(gn[0] * oc[h] + gn[1] * os[h] + gn[2] * ow[h]);
    }
}

template <int NB, class AF, class BF, class Epi>
static void launch_sgemm(dim3 grid, hipStream_t stream, AF af, BF bf, int K, Epi epi) {
    GemmArgs<AF, BF, Epi> ga{af, bf, epi, K, 0};
    k_sgemm<NB, AF, BF, Epi><<<grid, 256, 0, stream>>>(ga);
}
extern "C" void kernel_launch(void* const* d_in, const int* in_sizes, int n_in, void* d_out, int out_size, void* d_ws, size_t ws_size, hipStream_t stream) {
    if (n_in != 21 || ws_size < WS_END || out_size != T * DM) { fprintf(stderr, "kernel_launch: unexpected shapes n_in %d ws %zu out %d\n", n_in, ws_size, out_size); return; }
    const float* x = (const float*)d_in[0]; const float* norm1_w = (const float*)d_in[1]; const float* w_in = (const float*)d_in[2];
    const float* pool_w = (const float*)d_in[3]; const float* pool_scale = (const float*)d_in[4];
    const float* pe_k = (const float*)d_in[5]; const float* w1_k = (const float*)d_in[6]; const float* b1_k = (const float*)d_in[7]; const float* w2_k = (const float*)d_in[8];
    const float* pe_v = (const float*)d_in[9]; const float* w1_v = (const float*)d_in[10]; const float* b1_v = (const float*)d_in[11]; const float* w2_v = (const float*)d_in[12];
    const float* w_pp = (const float*)d_in[13]; const float* w_pa = (const float*)d_in[14]; const float* w_out = (const float*)d_in[15];
    const float* norm2_w = (const float*)d_in[16]; const float* w_g = (const float*)d_in[17]; const float* w_u = (const float*)d_in[18]; const float* w_d = (const float*)d_in[19];
    const float* normf_w = (const float*)d_in[20];
    char* ws = (char*)d_ws; char* dout = (char*)d_out;
#define WSP(T_, off) ((T_*)(ws + (off)))
    bf16_t* H = (bf16_t*)(dout + DO_H); bf16_t* SP = (bf16_t*)(dout + DO_SP);
    float* X1 = (float*)d_out;
    { WprepArgs<SF_in> a{SF_in{w_in}, WSP(bf16_t, WS_WIN), 1024, 0}; k_wprep<SF_in><<<dim3(1024 / 32, NIN / 32), 256, 0, stream>>>(a); }
    { WprepArgs<SF_plain> a{SF_plain{w1_k, 256, 0}, WSP(bf16_t, WS_W1K), 2048, 0}; k_wprep<SF_plain><<<dim3(2048 / 32, 256 / 32), 256, 0, stream>>>(a); }
    { WprepArgs<SF_plain> a{SF_plain{w1_v, 256, 0}, WSP(bf16_t, WS_W1V), 2048, 0}; k_wprep<SF_plain><<<dim3(2048 / 32, 256 / 32), 256, 0, stream>>>(a); }
    { WprepArgs<SF_plain> a{SF_plain{w2_k, 64, 0}, WSP(bf16_t, WS_W2K), 256, 0}; k_wprep<SF_plain><<<dim3(256 / 32, 64 / 32), 256, 0, stream>>>(a); }
    { WprepArgs<SF_plain> a{SF_plain{w2_v, 64, 0}, WSP(bf16_t, WS_W2V), 256, 0}; k_wprep<SF_plain><<<dim3(256 / 32, 64 / 32), 256, 0, stream>>>(a); }
    k_wfold<<<512 * 1024 / 256, 256, 0, stream>>>(pool_w, pool_scale, w_pp, WSP(float, WS_TMP));
    { WprepArgs<SF_wm> a{SF_wm{WSP(float, WS_TMP), w_pa}, WSP(bf16_t, WS_WM), 1536, 0}; k_wprep<SF_wm><<<dim3(1536 / 32, 1024 / 32), 256, 0, stream>>>(a); }
    { WprepArgs<SF_plain> a{SF_plain{w_out, 1024, 0}, WSP(bf16_t, WS_WO), 1024, 0}; k_wprep<SF_plain><<<dim3(1024 / 32, 1024 / 32), 256, 0, stream>>>(a); }
    { WprepArgs<SF_gu> a{SF_gu{w_g, w_u, norm2_w}, WSP(bf16_t, WS_WGU), 1024, 0}; k_wprep<SF_gu><<<dim3(1024 / 32, 5632 / 32), 256, 0, stream>>>(a); }
    { WprepArgs<SF_plain> a{SF_plain{w_d, 1024, 0}, WSP(bf16_t, WS_WD), 2816, 0}; k_wprep<SF_plain><<<dim3(2816 / 32, 1024 / 32), 256, 0, stream>>>(a); }
    k_pebias<<<1, 256, 0, stream>>>(pe_k, w1_k, b1_k, WSP(float, WS_PEBK));
    k_pebias<<<1, 256, 0, stream>>>(pe_v, w1_v, b1_v, WSP(float, WS_PEBV));
    k_rope_table<<<SEQ * 8 / 256, 256, 0, stream>>>(WSP(float, WS_RCOS), WSP(float, WS_RSIN));
    k_rmsnorm_bf16<<<T / 4, 256, 0, stream>>>(x, norm1_w, H);
    { EpiIn e{WSP(bf16_t, WS_U), WSP(bf16_t, WS_QP), WSP(bf16_t, WS_KC), WSP(bf16_t, WS_VC), WSP(bf16_t, WS_KS), WSP(bf16_t, WS_VS), WSP(bf16_t, WS_KW), WSP(bf16_t, WS_VW), SP, WSP(bf16_t, WS_SA), WSP(float, WS_GN)};
      launch_sgemm<1>(dim3(NIN / 64, T / 128), stream, AF_plain{H, 1024, 0}, BF_plain{WSP(bf16_t, WS_WIN), 1024, 0}, 1024, e); }
    k_rope_q<<<T * 1024 / 256, 256, 0, stream>>>(WSP(bf16_t, WS_QP), WSP(bf16_t, WS_QR), WSP(float, WS_RCOS), WSP(float, WS_RSIN));
    k_rope_k<<<T * 32 / 256, 256, 0, stream>>>(WSP(bf16_t, WS_KS), WSP(float, WS_RCOS), WSP(float, WS_RSIN));
    k_rope_k<<<T * 32 / 256, 256, 0, stream>>>(WSP(bf16_t, WS_KW), WSP(float, WS_RCOS), WSP(float, WS_RSIN));
    launch_sgemm<1>(dim3(256 / 64, 4096 / 128), stream, AF_cmp{WSP(bf16_t, WS_KC)}, BF_plain{WSP(bf16_t, WS_W1K), 2048, 0}, 2048, EpiHid{WSP(bf16_t, WS_HIDK), WSP(float, WS_PEBK)});
    launch_sgemm<1>(dim3(256 / 64, 4096 / 128), stream, AF_cmp{WSP(bf16_t, WS_VC)}, BF_plain{WSP(bf16_t, WS_W1V), 2048, 0}, 2048, EpiHid{WSP(bf16_t, WS_HIDV), WSP(float, WS_PEBV)});
    launch_sgemm<1>(dim3(1, 4096 / 128), stream, AF_plain{WSP(bf16_t, WS_HIDK), 256, 0}, BF_plain{WSP(bf16_t, WS_W2K), 256, 0}, 256, EpiStoreBf{WSP(bf16_t, WS_KCMP), 64, 0});
    launch_sgemm<1>(dim3(1, 4096 / 128), stream, AF_plain{WSP(bf16_t, WS_HIDV), 256, 0}, BF_plain{WSP(bf16_t, WS_W2V), 256, 0}, 256, EpiStoreBf{WSP(bf16_t, WS_VCMP), 64, 0});
    k_pooled<<<T * 512 / 256, 256, 0, stream>>>(WSP(bf16_t, WS_U), WSP(bf16_t, WS_PA));
    { AttnP p{WSP(bf16_t, WS_QP), WSP(bf16_t, WS_QR), WSP(bf16_t, WS_KCMP), WSP(bf16_t, WS_VCMP), WSP(bf16_t, WS_KS), WSP(bf16_t, WS_VS), WSP(bf16_t, WS_KW), WSP(bf16_t, WS_VW), WSP(float, WS_GN), WSP(bf16_t, WS_PA)};
      k_attn_naive<<<T * 4, 64, 0, stream>>>(p); }
    launch_sgemm<1>(dim3(1024 / 64, T / 128), stream, AF_plain{WSP(bf16_t, WS_PA), 1536, 0}, BF_plain{WSP(bf16_t, WS_WM), 1536, 0}, 512, EpiPoolProj{WSP(bf16_t, WS_QR), SP});
    launch_sgemm<1>(dim3(1024 / 64, T / 128), stream, AF_plain{WSP(bf16_t, WS_PA) + 512, 1536, 0}, BF_plain{WSP(bf16_t, WS_WM) + 512, 1536, 0}, 1024, EpiMerged{WSP(bf16_t, WS_MG), WSP(bf16_t, WS_QR), WSP(bf16_t, WS_SA)});
    launch_sgemm<1>(dim3(1024 / 64, T / 128), stream, AF_plain{WSP(bf16_t, WS_MG), 1024, 0}, BF_plain{WSP(bf16_t, WS_WO), 1024, 0}, 1024, EpiX1{x, X1, WSP(bf16_t, WS_X1B)});
    k_rowsq<<<T / 4, 256, 0, stream>>>(X1, WSP(float, WS_RS1));
    launch_sgemm<2>(dim3(DFF / 64, T / 128), stream, AF_plain{WSP(bf16_t, WS_X1B), 1024, 0}, BF_gu{WSP(bf16_t, WS_WGU)}, 1024, EpiAct{WSP(bf16_t, WS_ACT), WSP(float, WS_RS1)});
    launch_sgemm<1>(dim3(1024 / 64, T / 128), stream, AF_plain{WSP(bf16_t, WS_ACT), DFF, 0}, BF_plain{WSP(bf16_t, WS_WD), DFF, 0}, DFF, EpiX2{X1});
    k_final_norm<<<T / 4, 256, 0, stream>>>(X1, normf_w);
#undef WSP
}
```

```cpp
#include <hip/hip_runtime.h>
#include <hip/hip_cooperative_groups.h>
#include <cstdint>
#include <cstdio>
namespace cg = cooperative_groups;
#ifndef MK_PROBE
#define MK_PROBE -1
#endif
#define SUBREP(k) for (int srep_ = 0; srep_ < ((MK_PROBE) == (k) ? 2 : 1); ++srep_)

#define LAS __attribute__((address_space(3)))
typedef unsigned short bf16_t;
typedef short bf16x8 __attribute__((ext_vector_type(8)));
typedef float f32x4 __attribute__((ext_vector_type(4)));
typedef unsigned u32x4 __attribute__((ext_vector_type(4)));
typedef unsigned u32x2 __attribute__((ext_vector_type(2)));

constexpr int BATCH = 2, SEQ = 8192, T = BATCH * SEQ, DM = 1024;
constexpr int NREF = 5168, NIN = 5376;
constexpr int DFF = 2816;
constexpr int NCP = 512;
constexpr float RMS_EPS = 1e-6f;
constexpr float C2 = 0.125f * 1.4426950408889634f;
constexpr int NWAVES = 8, NTHREADS = 512;

constexpr size_t MiB = 1u << 20;
constexpr size_t WS_CTL = 0;
constexpr size_t WS_PEBK = 1 * MiB, WS_PEBV = 1 * MiB + 4096, WS_RCOS = 1 * MiB + 65536, WS_RSIN = WS_RCOS + 262144;
constexpr size_t WS_RS1 = 2 * MiB;
constexpr size_t WS_SEL = 3 * MiB;
constexpr size_t WS_KCMP = 4 * MiB, WS_VCMP = 4 * MiB + 512 * 1024;
constexpr size_t WS_W2K = 5 * MiB, WS_W2V = 5 * MiB + 65536;
constexpr size_t WS_W1K = 6 * MiB, WS_W1V = 7 * MiB;
constexpr size_t WS_WIN = 8 * MiB;
constexpr size_t WS_WM = 19 * MiB;
constexpr size_t WS_WO = 22 * MiB;
constexpr size_t WS_WGU = 24 * MiB;
constexpr size_t WS_WD = 35 * MiB;
constexpr size_t WS_GN = 41 * MiB;
constexpr size_t WS_U = 44 * MiB;
constexpr size_t WS_QP = 60 * MiB;
constexpr size_t WS_MG = 60 * MiB;
constexpr size_t WS_KC = 92 * MiB, WS_VC = 100 * MiB, WS_KS = 108 * MiB, WS_VS = 116 * MiB, WS_KW = 124 * MiB, WS_VW = 132 * MiB;
constexpr size_t WS_SA = 140 * MiB;
constexpr size_t WS_PA = 172 * MiB;
constexpr size_t WS_QR = 220 * MiB;
constexpr size_t WS_X1B = 220 * MiB;
constexpr size_t WS_HIDK = 252 * MiB, WS_HIDV = 254 * MiB;
constexpr size_t WS_ACT = 44 * MiB;
constexpr size_t WS_END = 256 * MiB;
constexpr size_t DO_H = 0, DO_SP = 32 * MiB;

constexpr int RING_BYTES = 131072;
constexpr int MISC_OFF = 147456 - 256;
constexpr int LDS_BYTES = 147456;

__device__ __forceinline__ unsigned f2bf(float f) { unsigned u = __builtin_bit_cast(unsigned, f); return (u + 0x7fffu + ((u >> 16) & 1u)) >> 16; }
__device__ __forceinline__ float bf2f(unsigned b) { return __builtin_bit_cast(float, (b & 0xffffu) << 16); }
__device__ __forceinline__ unsigned pk2(float lo, float hi) { return f2bf(lo) | (f2bf(hi) << 16); }
typedef float f32x2_t __attribute__((ext_vector_type(2))); typedef __bf16 bf16x2_t __attribute__((ext_vector_type(2)));
__device__ __forceinline__ unsigned cvt_pk_bf16(float lo, float hi) { f32x2_t v = {lo, hi}; bf16x2_t b = __builtin_convertvector(v, bf16x2_t); return __builtin_bit_cast(unsigned, b); }
__device__ __forceinline__ u32x4 pack8(const f32x4& a, const f32x4& b) { u32x4 w; w.x = cvt_pk_bf16(a[0], a[1]); w.y = cvt_pk_bf16(a[2], a[3]); w.z = cvt_pk_bf16(b[0], b[1]); w.w = cvt_pk_bf16(b[2], b[3]); return w; }
__device__ __forceinline__ void unpack8(const u32x4& w, f32x4& a, f32x4& b) {
    a[0] = __builtin_bit_cast(float, w.x << 16); a[1] = __builtin_bit_cast(float, w.x & 0xffff0000u); a[2] = __builtin_bit_cast(float, w.y << 16); a[3] = __builtin_bit_cast(float, w.y & 0xffff0000u);
    b[0] = __builtin_bit_cast(float, w.z << 16); b[1] = __builtin_bit_cast(float, w.z & 0xffff0000u); b[2] = __builtin_bit_cast(float, w.w << 16); b[3] = __builtin_bit_cast(float, w.w & 0xffff0000u); }
__device__ __forceinline__ float sigmoidf_(float v) { return __builtin_amdgcn_rcpf(1.f + __expf(-v)); }
__device__ __forceinline__ float wave_sum(float v) {
#pragma unroll
    for (int o = 1; o < 64; o <<= 1) v += __shfl_xor(v, o);
    return v;
}
__device__ __forceinline__ float wave_max(float v) {
#pragma unroll
    for (int o = 1; o < 64; o <<= 1) v = fmaxf(v, __shfl_xor(v, o));
    return v;
}
#define WSYNC() asm volatile("s_waitcnt lgkmcnt(0)" ::: "memory")
__device__ __forceinline__ int lane_id() { int r; asm volatile("v_mbcnt_lo_u32_b32 %0, -1, 0\n\tv_mbcnt_hi_u32_b32 %0, -1, %0" : "=v"(r)); return r; }
#define TID_(wv) (64 * (wv) + lane_id())
#define OPAQUE(x) asm volatile("" : "+v"(x))
__host__ __device__ __forceinline__ int incol_ref(int c) {
    if (c < 3072) return c;
    if (c < 4096) return 3120 + (c - 3072);
    if (c < 5120) return 4144 + (c - 4096);
    if (c < 5168) return 3072 + (c - 5120);
    return -1;
}

struct Params {
    const float *x, *norm1_w, *w_in, *pool_w, *pool_scale, *pe_k, *w1_k, *b1_k, *w2_k, *pe_v, *w1_v, *b1_v, *w2_v, *w_pp, *w_pa, *w_out, *norm2_w, *w_g, *w_u, *w_d, *normf_w;
    float* out; unsigned char* ws;
    int ph_lo, ph_hi;
};

typedef const __attribute__((address_space(4))) Params* KParams;
namespace pg8 {
constexpr int BM = 256, BK = 64, HALF = 128, HTB = HALF * BK * 2, STAGE_BYTES = 8 * HTB, NXCD = 8, WGM = 8;
__host__ __device__ __forceinline__ int lds_byte(int r, int c) { const int st = (r >> 4) * 2 + (c >> 5), rr = r & 15, cc = c & 31, ob = rr * 64 + cc * 2; return st * 1024 + (ob ^ (((ob >> 9) & 1) << 5)); }
__host__ __device__ __forceinline__ void stage_rc(int b, int& R, int& C) { const int st = b / 1024, sb = b % 1024, swz = sb ^ (((sb >> 9) & 1) << 5); R = (st >> 1) * 16 + swz / 64; C = (st & 1) * 32 + (swz % 64) / 2; }
__host__ __device__ __forceinline__ int perm32(int rho) { const int n = rho >> 4, i = rho & 15; return 8 * (i >> 2) + 4 * n + (i & 3); }

struct Unit { int pm, pn; const char* A; const char* B; };
struct Gemm { int lda, ldb, ksA, ksB, nt, hsA; };

struct StaticOrder {
    int nM, nN, nwg, G, c;
    __device__ void init(int M, int N, int G_, int c_) { nM = M / BM; nN = N / BM; nwg = nM * nN; G = G_; c = c_; }
    __device__ bool next(int i, int& pm, int& pn) const {
        const long L = (long)i * G + c; if (L >= nwg) return false;
        int wgid = (int)L; { const int q = nwg / NXCD, r = nwg % NXCD, xcd = wgid % NXCD, off = wgid / NXCD; wgid = (xcd < r ? xcd * (q + 1) : r * (q + 1) + (xcd - r) * q) + off; }
        const int nig = WGM * nN, gid = wgid / nig, fm = gid * WGM, gsz = (nM - fm) < WGM ? (nM - fm) : WGM;
        pm = fm + ((wgid % nig) % gsz); pn = (wgid % nig) / gsz; return true;
    }
};
struct StdSched {
    StaticOrder so; const char* A; const char* B; size_t tA, tB;
    __device__ void init(const void* A_, const void* B_, int M, int N, int lda_bytes, int ldb_bytes, int G, int c) { so.init(M, N, G, c); A = (const char*)A_; B = (const char*)B_; tA = (size_t)256 * lda_bytes; tB = (size_t)256 * ldb_bytes; }
    __device__ bool next(int i, Unit& u) const { if (!so.next(i, u.pm, u.pn)) return false; u.A = A + u.pm * tA; u.B = B + u.pn * tB; return true; }
};

template <class Epi, class Sched, bool ALIGN_EPI>
__device__ __forceinline__ void gemm_phase(LAS unsigned char* lds, const Gemm g, const Sched& S, const Epi& E, int wave_k) {
    int tid = TID_(wave_k); asm volatile("" : "+v"(tid));
    const int wid = __builtin_amdgcn_readfirstlane(tid >> 6), lane = tid & 63, wr = wid >> 2, wc = wid & 3, fr = lane & 15, fq = lane >> 4;
    const int nt = g.nt;
    unsigned voffA[2], voffB[2];
#pragma unroll
    for (int i = 0; i < 2; ++i) { int R, C; stage_rc(tid * 16 + i * 8192, R, C); const int Rb = (R & ~31) + perm32(R & 31);
        voffA[i] = (unsigned)(R * g.lda + C * 2); voffB[i] = (unsigned)(Rb * g.ldb + C * 2); }
    const size_t kstepA = (size_t)g.ksA, kstepB = (size_t)g.ksB;
    const ptrdiff_t hstepA = g.hsA ? (ptrdiff_t)g.hsA : (ptrdiff_t)HALF * g.lda; const size_t hstepB = (size_t)HALF * g.ldb;
    const unsigned ldsw = (unsigned)wid * 1024u;
    const int aoff = lds_byte(wr * 64 + fr, fq * 8), boff = lds_byte(wc * 32 + fr, fq * 8);
#define PG8_SA(b, h) (((b) * 2 + (h)) * HTB)
#define PG8_SB(b, h) ((4 + (b) * 2 + (h)) * HTB)
#define PG8_STAGE(bufoff, gbase, voff) do { _Pragma("unroll") for (int _i = 0; _i < 2; ++_i) \
        __builtin_amdgcn_global_load_lds((const unsigned*)((const char*)(gbase) + (voff)[_i]), (LAS unsigned*)(lds + (bufoff) + ldsw + _i * 8192), 16, 0, 0); } while (0)
#define PG8_LDA(dst, b, h) do { _Pragma("unroll") for (int m = 0; m < 4; ++m) _Pragma("unroll") for (int k = 0; k < 2; ++k) dst[m][k] = *(const LAS bf16x8*)(lds + PG8_SA(b, h) + aoff + m * 2048 + k * 1024); } while (0)
#define PG8_LDB(dst, b, h) do { _Pragma("unroll") for (int n = 0; n < 2; ++n) _Pragma("unroll") for (int k = 0; k < 2; ++k) dst[n][k] = *(const LAS bf16x8*)(lds + PG8_SB(b, h) + boff + n * 2048 + k * 1024); } while (0)
#define PG8_MMA(ai, bj, At, Bt) do { __builtin_amdgcn_s_setprio(1); _Pragma("unroll") for (int m = 0; m < 4; ++m) _Pragma("unroll") for (int n = 0; n < 2; ++n) _Pragma("unroll") for (int k = 0; k < 2; ++k) \
        acc[ai][bj][m][n] = __builtin_amdgcn_mfma_f32_16x16x32_bf16(Bt[n][k], At[m][k], acc[ai][bj][m][n], 0, 0, 0); __builtin_amdgcn_s_setprio(0); } while (0)
#define PG8_WAIT_V(n) asm volatile("s_waitcnt vmcnt(" #n ")" ::: "memory")
#define PG8_WAIT_L(n) asm volatile("s_waitcnt lgkmcnt(" #n ")" ::: "memory")
#define PG8_BAR __builtin_amdgcn_s_barrier()
#define PG8_SCHED __builtin_amdgcn_sched_barrier(0)
    Unit cur, nxt; int ui = 0;
    if (!S.next(0, cur)) return;
    f32x4 acc[2][2][4][2];
#pragma unroll
    for (int a = 0; a < 2; ++a)
#pragma unroll
        for (int b = 0; b < 2; ++b)
#pragma unroll
            for (int m = 0; m < 4; ++m)
#pragma unroll
                for (int n = 0; n < 2; ++n) acc[a][b][m][n] = (f32x4){0.f, 0.f, 0.f, 0.f};
    bf16x8 At[4][2], B0[2][2], B1[2][2];
    const char* cA = cur.A; const char* cB = cur.B;
    PG8_STAGE(PG8_SB(0, 0), cB, voffB); PG8_STAGE(PG8_SB(0, 1), cB + hstepB, voffB); PG8_STAGE(PG8_SA(0, 0), cA, voffA); PG8_STAGE(PG8_SA(0, 1), cA + hstepA, voffA);
    if (wr == 1) PG8_BAR;
    PG8_WAIT_V(2); PG8_BAR;
    PG8_STAGE(PG8_SB(1, 0), cB + kstepB, voffB); PG8_STAGE(PG8_SA(1, 0), cA + kstepA, voffA); PG8_STAGE(PG8_SB(1, 1), cB + hstepB + kstepB, voffB);
    PG8_WAIT_V(6); PG8_BAR;
    for (;;) {
        const bool has_next = S.next(ui + 1, nxt);
        const char* nA = has_next ? nxt.A : cA; const char* nB = has_next ? nxt.B : cB;
        for (int t = 0; t < nt; t += 2) {
            const bool last = (t == nt - 2);
            const char* a1 = cA + (size_t)(t + 1) * kstepA;
            const char* a2 = last ? nA : cA + (size_t)(t + 2) * kstepA; const char* b2 = last ? nB : cB + (size_t)(t + 2) * kstepB;
            const char* a3 = a2 + kstepA; const char* b3 = b2 + kstepB;
            PG8_LDB(B0, 0, 0); PG8_LDB(B1, 0, 1); PG8_SCHED; PG8_LDA(At, 0, 0); PG8_STAGE(PG8_SA(1, 1), a1 + hstepA, voffA);
            PG8_WAIT_V(8); PG8_WAIT_L(0); PG8_BAR; PG8_MMA(0, 0, At, B0); PG8_MMA(0, 1, At, B1); PG8_BAR; PG8_SCHED;
            PG8_LDA(At, 0, 1); PG8_STAGE(PG8_SB(0, 0), b2, voffB); PG8_STAGE(PG8_SB(0, 1), b2 + hstepB, voffB); PG8_STAGE(PG8_SA(0, 0), a2, voffA);
            PG8_WAIT_V(8); PG8_WAIT_L(0); PG8_BAR; PG8_MMA(1, 0, At, B0); PG8_MMA(1, 1, At, B1); PG8_BAR; PG8_SCHED;
            PG8_LDB(B0, 1, 0); PG8_LDB(B1, 1, 1); PG8_SCHED; PG8_LDA(At, 1, 0); PG8_STAGE(PG8_SA(0, 1), a2 + hstepA, voffA);
            PG8_WAIT_V(8); PG8_WAIT_L(0); PG8_BAR; PG8_MMA(0, 0, At, B0); PG8_MMA(0, 1, At, B1); PG8_BAR; PG8_SCHED;
            PG8_LDA(At, 1, 1); PG8_STAGE(PG8_SB(1, 0), b3, voffB); PG8_STAGE(PG8_SB(1, 1), b3 + hstepB, voffB); PG8_STAGE(PG8_SA(1, 0), a3, voffA);
            PG8_WAIT_V(8); PG8_WAIT_L(0); PG8_BAR; PG8_MMA(1, 0, At, B0); PG8_MMA(1, 1, At, B1); PG8_BAR; PG8_SCHED;
            if constexpr (Epi::HOOK_KT > 0) { if (t + 2 == Epi::HOOK_KT) { E.hook(acc, cur, wr, wc, fr, fq); PG8_WAIT_V(0); PG8_SCHED; } }
        }
        if constexpr (ALIGN_EPI) { if (wr == 0) PG8_BAR; }
        if constexpr (!Epi::AFTER_DRAIN) { E(acc, cur, wr, wc, fr, fq); }
        if (!has_next) break;
#pragma unroll
        for (int a = 0; a < 2; ++a)
#pragma unroll
            for (int b = 0; b < 2; ++b)
#pragma unroll
                for (int m = 0; m < 4; ++m)
#pragma unroll
                    for (int n = 0; n < 2; ++n) acc[a][b][m][n] = (f32x4){0.f, 0.f, 0.f, 0.f};
        cur = nxt; cA = nA; cB = nB; ++ui;
        if constexpr (ALIGN_EPI) { if (wr == 1) PG8_BAR; }
    }
    PG8_WAIT_V(0);
    if constexpr (!ALIGN_EPI) { if (wr == 0) PG8_BAR; }
    PG8_BAR;
    if constexpr (Epi::AFTER_DRAIN) { E.fused(acc, cur, wr, wc, fr, fq, wid, lane, lds); }
#undef PG8_SA
#undef PG8_SB
#undef PG8_STAGE
#undef PG8_LDA
#undef PG8_LDB
#undef PG8_MMA
#undef PG8_WAIT_V
#undef PG8_WAIT_L
#undef PG8_BAR
#undef PG8_SCHED
}
}
using pg8::Unit;
typedef f32x4 Acc[2][2][4][2];
#define EPI_ROW(u, ai, wr, m, fr) ((u).pm * 256 + (ai) * 128 + (wr) * 64 + (m) * 16 + (fr))
#define EPI_LC(bj, wc, fq) ((bj) * 128 + (wc) * 32 + (fq) * 8)

constexpr int CW_XC = 14600;
struct EpiIn {
    static constexpr bool AFTER_DRAIN = false; static constexpr int HOOK_KT = 0;
    bf16_t *U, *QP, *QR, *KV0, *SP, *SA; float* GN; const float* RC; const float* RS;
    __device__ __forceinline__ void rope8(f32x4& v0, f32x4& v1, int t, bool apply, int fq) const {
        f32x4 p0, p1;
#pragma unroll
        for (int e = 0; e < 4; ++e) { p0[e] = __shfl_xor(v0[e], 16); p1[e] = __shfl_xor(v1[e], 16); }
        if (apply) {
            const f32x4 c0 = *(const f32x4*)(RC + t * 8), c1 = *(const f32x4*)(RC + t * 8 + 4), s0 = *(const f32x4*)(RS + t * 8), s1 = *(const f32x4*)(RS + t * 8 + 4);
            const float sg = (fq & 1) ? 1.f : -1.f;
            v0 = v0 * c0 + (p0 * s0) * sg; v1 = v1 * c1 + (p1 * s1) * sg;
        }
    }
    __device__ __forceinline__ void operator()(const Acc& acc, const Unit& u, int wr, int wc, int fr, int fq) const {
        OPAQUE(fr); OPAQUE(fq);
        const int pn = u.pn; const bool ropel = ((wc & 1) == 0) && fq < 2;
#pragma unroll
        for (int ai = 0; ai < 2; ++ai)
#pragma unroll
            for (int m = 0; m < 4; ++m) {
                const int r = EPI_ROW(u, ai, wr, m, fr), t = r & (SEQ - 1);
#pragma unroll
                for (int bj = 0; bj < 2; ++bj) {
                    const int lc = EPI_LC(bj, wc, fq); f32x4 v0 = acc[ai][bj][m][0], v1 = acc[ai][bj][m][1];
                    if (pn < 2) { *(u32x4*)(U + (size_t)r * 512 + pn * 256 + lc) = pack8(v0, v1); }
                    else if (pn < 6) {
                        v0 = v0 * C2; v1 = v1 * C2; const size_t o = (size_t)r * 1024 + (pn - 2) * 256 + lc;
                        *(u32x4*)(QP + o) = pack8(v0, v1);
                        if ((wc & 1) == 0) rope8(v0, v1, t, ropel, fq);
                        *(u32x4*)(QR + o) = pack8(v0, v1);
                    } else if (pn < 12) {
                        const int ty = pn - 6; bf16_t* dst = KV0 + (size_t)ty * (size_t)(4u << 20);
                        if ((ty == 2 || ty == 4) && (wc & 1) == 0) rope8(v0, v1, t, ropel, fq);
                        *(u32x4*)(dst + (size_t)r * 256 + lc) = pack8(v0, v1);
                    } else if (pn < 20) {
                        bf16_t* dst = pn < 16 ? SP : SA; const int cb = ((pn - 12) & 3) * 256 + lc;
#pragma unroll
                        for (int e = 0; e < 4; ++e) { v0[e] = sigmoidf_(v0[e]); v1[e] = sigmoidf_(v1[e]); }
                        *(u32x4*)(dst + (size_t)r * 1024 + cb) = pack8(v0, v1);
                    } else if (lc < 48) {
#pragma unroll
                        for (int e = 0; e < 4; ++e) { v0[e] = sigmoidf_(v0[e]); v1[e] = sigmoidf_(v1[e]); }
                        *(f32x4*)(GN + (size_t)r * 48 + lc) = v0; *(f32x4*)(GN + (size_t)r * 48 + lc + 4) = v1;
                    }
                }
            }
    }
};
__device__ __forceinline__ float gelu_tanh(float x) { const float u = 0.7978845608028654f * (x + 0.044715f * x * x * x); const float e = __expf(2.f * u); return 0.5f * x * (1.f + (1.f - 2.f * __builtin_amdgcn_rcpf(e + 1.f))); }
struct EpiCmp {
    static constexpr bool AFTER_DRAIN = true; static constexpr int HOOK_KT = 0;
    bf16_t *HIDK, *HIDV; const float *PEBK, *PEBV; const bf16_t *W2K, *W2V; bf16_t *KCMP, *VCMP; unsigned char* wsb; int split;
    template <int AI> __device__ __forceinline__ void gelu_half(const Acc& acc, bf16_t* HID, const float* peb, int rbase, int wr, int wc, int fr, int fq) const {
#pragma unroll
        for (int bj = 0; bj < 2; ++bj) {
            const int lc = EPI_LC(bj, wc, fq); const f32x4 b0 = *(const f32x4*)(peb + lc), b1 = *(const f32x4*)(peb + lc + 4);
#pragma unroll
            for (int m = 0; m < 4; ++m) {
                const int r = rbase + wr * 64 + m * 16 + fr; f32x4 v0 = acc[AI][bj][m][0] + b0, v1 = acc[AI][bj][m][1] + b1;
#pragma unroll
                for (int e = 0; e < 4; ++e) { v0[e] = gelu_tanh(v0[e]); v1[e] = gelu_tanh(v1[e]); }
                *(u32x4*)(HID + (size_t)r * 256 + lc) = pack8(v0, v1);
            }
        }
    }
    __device__ __forceinline__ void fused(Acc& acc, const Unit& u, int wr, int wc, int fr, int fq, int wid, int lane, LAS unsigned char*) const {
        OPAQUE(fr); OPAQUE(fq);
        const int h = u.pn, which = u.pm >> 4, rt = u.pm & 15; bf16_t* HID = which ? HIDV : HIDK; const float* peb = which ? PEBV : PEBK;
        if (split) {
            float* slabs = (float*)(wsb + (u.pm < 16 ? WS_WM : WS_WD)) + (size_t)((u.pm & 15) * 2) * (128 * 256);
            unsigned* cnt = (unsigned*)(wsb + WS_CTL) + CW_XC + (u.pm * 2) * 16;
            float* mine = slabs + (size_t)h * (128 * 256); const float* theirs = slabs + (size_t)(h ^ 1) * (128 * 256);
#pragma unroll
            for (int bj = 0; bj < 2; ++bj)
#pragma unroll
                for (int m = 0; m < 4; ++m) { float* p = mine + (size_t)(wr * 64 + m * 16 + fr) * 256 + EPI_LC(bj, wc, fq);
                    asm volatile("global_store_dwordx4 %0, %1, off sc0 sc1" :: "v"(p), "v"(acc[1][bj][m][0]) : "memory");
                    asm volatile("global_store_dwordx4 %0, %1, off offset:16 sc0 sc1" :: "v"(p), "v"(acc[1][bj][m][1]) : "memory"); }
            asm volatile("s_waitcnt vmcnt(0)" ::: "memory");
            if (lane == 0) __hip_atomic_fetch_add(cnt + 16 * h, 1u, __ATOMIC_RELAXED, __HIP_MEMORY_SCOPE_AGENT);
            if (wid == 0) {
                unsigned sp = 0; while ((unsigned)__builtin_amdgcn_readfirstlane((int)__hip_atomic_load(cnt + 16 * (h ^ 1), __ATOMIC_RELAXED, __HIP_MEMORY_SCOPE_AGENT)) < 8u && ++sp < (1u << 22)) __builtin_amdgcn_s_sleep(2);
            }
            asm volatile("s_waitcnt vmcnt(0) lgkmcnt(0)" ::: "memory"); __builtin_amdgcn_s_barrier(); asm volatile("" ::: "memory");
            __builtin_amdgcn_fence(__ATOMIC_ACQUIRE, "agent");
#pragma unroll
            for (int bj = 0; bj < 2; ++bj)
#pragma unroll
                for (int m = 0; m < 4; ++m) { const float* p = theirs + (size_t)(wr * 64 + m * 16 + fr) * 256 + EPI_LC(bj, wc, fq); acc[0][bj][m][0] += *(const f32x4*)p; acc[0][bj][m][1] += *(const f32x4*)(p + 4); }
        }
        gelu_half<0>(acc, HID, peb, rt * 256 + (split ? h * 128 : 0), wr, wc, fr, fq);
        if (!split) gelu_half<1>(acc, HID, peb, rt * 256 + 128, wr, wc, fr, fq);
        asm volatile("s_waitcnt vmcnt(0)" ::: "memory"); __syncthreads();
        const bf16_t* W2 = which ? W2V : W2K; bf16_t* OUT = which ? VCMP : KCMP; const int r0 = rt * 256 + (split ? h * 128 + wid * 16 : wid * 32);
        f32x4 c2[2][4];
#pragma unroll
        for (int mt = 0; mt < 2; ++mt)
#pragma unroll
            for (int nt = 0; nt < 4; ++nt) c2[mt][nt] = (f32x4){0.f, 0.f, 0.f, 0.f};
        for (int k0 = 0; k0 < 256; k0 += 32) {
            bf16x8 a[2], b[4];
#pragma unroll
            for (int mt = 0; mt < 2; ++mt) a[mt] = *(const bf16x8*)(HID + (size_t)(r0 + (split ? 0 : 16 * mt) + fr) * 256 + k0 + 8 * fq);
#pragma unroll
            for (int nt = 0; nt < 4; ++nt) b[nt] = *(const bf16x8*)(W2 + (size_t)(16 * nt + fr) * 256 + k0 + 8 * fq);
#pragma unroll
            for (int mt = 0; mt < 2; ++mt)
#pragma unroll
                for (int nt = 0; nt < 4; ++nt) c2[mt][nt] = __builtin_amdgcn_mfma_f32_16x16x32_bf16(a[mt], b[nt], c2[mt][nt], 0, 0, 0);
        }
#pragma unroll
        for (int mt = 0; mt < 2; ++mt) {
            if (mt == 0 || !split) {
#pragma unroll
            for (int nt = 0; nt < 4; ++nt)
#pragma unroll
                for (int r = 0; r < 4; ++r) OUT[(size_t)(r0 + 16 * mt + 4 * fq + r) * 64 + 16 * nt + fr] = (bf16_t)f2bf(c2[mt][nt][r]);
            }
        }
    }
};
struct EpiMerged {
    static constexpr bool AFTER_DRAIN = false; static constexpr int HOOK_KT = 8;
    bf16_t* MG; const bf16_t* SP; const bf16_t* SA;
    __device__ __forceinline__ void hook(Acc& acc, const Unit& u, int wr, int wc, int fr, int fq) const {
        OPAQUE(fr); OPAQUE(fq);
#pragma unroll
        for (int ai = 0; ai < 2; ++ai)
#pragma unroll
            for (int m = 0; m < 4; ++m) {
                const int r = EPI_ROW(u, ai, wr, m, fr);
#pragma unroll
                for (int bj = 0; bj < 2; ++bj) {
                    const size_t o = (size_t)r * 1024 + u.pn * 256 + EPI_LC(bj, wc, fq);
                    const u32x4 wp = *(const u32x4*)(SP + o), wa = *(const u32x4*)(SA + o); f32x4 p0, p1, a0, a1; unpack8(wp, p0, p1); unpack8(wa, a0, a1);
#pragma unroll
                    for (int e = 0; e < 4; ++e) { acc[ai][bj][m][0][e] *= p0[e] * __builtin_amdgcn_rcpf(a0[e]); acc[ai][bj][m][1][e] *= p1[e] * __builtin_amdgcn_rcpf(a1[e]); }
                }
            }
    }
    __device__ __forceinline__ void operator()(const Acc& acc, const Unit& u, int wr, int wc, int fr, int fq) const {
        OPAQUE(fr); OPAQUE(fq);
#pragma unroll
        for (int ai = 0; ai < 2; ++ai)
#pragma unroll
            for (int m = 0; m < 4; ++m) {
                const int r = EPI_ROW(u, ai, wr, m, fr);
#pragma unroll
                for (int bj = 0; bj < 2; ++bj) {
                    const size_t o = (size_t)r * 1024 + u.pn * 256 + EPI_LC(bj, wc, fq);
                    const u32x4 wa = *(const u32x4*)(SA + o); f32x4 a0, a1; unpack8(wa, a0, a1);
                    *(u32x4*)(MG + o) = pack8(acc[ai][bj][m][0] * a0, acc[ai][bj][m][1] * a1);
                }
            }
    }
};
struct EpiX1 {
    static constexpr bool AFTER_DRAIN = false; static constexpr int HOOK_KT = 0;
    const float* x; float* X1; bf16_t* X1B; float* RSP;
    __device__ __forceinline__ void operator()(const Acc& acc, const Unit& u, int wr, int wc, int fr, int fq) const {
        OPAQUE(fr); OPAQUE(fq);
#pragma unroll
        for (int ai = 0; ai < 2; ++ai)
#pragma unroll
            for (int m = 0; m < 4; ++m) {
                const int r = EPI_ROW(u, ai, wr, m, fr); float s = 0.f;
#pragma unroll
                for (int bj = 0; bj < 2; ++bj) {
                    const size_t o = (size_t)r * 1024 + u.pn * 256 + EPI_LC(bj, wc, fq);
                    const f32x4 o0 = *(const f32x4*)(x + o) + acc[ai][bj][m][0], o1 = *(const f32x4*)(x + o + 4) + acc[ai][bj][m][1];
                    *(u32x4*)(X1B + o) = pack8(o0, o1);
                    s += (o0[0] * o0[0] + o0[1] * o0[1]) + (o0[2] * o0[2] + o0[3] * o0[3]) + (o1[0] * o1[0] + o1[1] * o1[1]) + (o1[2] * o1[2] + o1[3] * o1[3]);
                }
                s += __shfl_xor(s, 16); s += __shfl_xor(s, 32);
                if (fq == 0) RSP[(size_t)r * 16 + u.pn * 4 + wc] = s;
            }
    }
};
struct EpiAct {
    static constexpr bool AFTER_DRAIN = false; static constexpr int HOOK_KT = 0;
    bf16_t* ACT; const float* RSP;
    __device__ __forceinline__ void operator()(const Acc& acc, const Unit& u, int wr, int wc, int fr, int fq) const {
        OPAQUE(fr); OPAQUE(fq);
#pragma unroll
        for (int ai = 0; ai < 2; ++ai)
#pragma unroll
            for (int m = 0; m < 4; ++m) {
                const int r = EPI_ROW(u, ai, wr, m, fr); const f32x4* rp = (const f32x4*)(RSP + (size_t)r * 16);
                const f32x4 q0 = rp[0], q1 = rp[1], q2 = rp[2], q3 = rp[3];
                const float ss = ((q0[0] + q0[1]) + (q0[2] + q0[3])) + ((q1[0] + q1[1]) + (q1[2] + q1[3])) + ((q2[0] + q2[1]) + (q2[2] + q2[3])) + ((q3[0] + q3[1]) + (q3[2] + q3[3]));
                const float rstd = rsqrtf(ss * (1.f / DM) + RMS_EPS);
                f32x4 o[2];
#pragma unroll
                for (int n = 0; n < 2; ++n)
#pragma unroll
                    for (int e = 0; e < 4; ++e) { const float gg = acc[ai][0][m][n][e] * rstd, uu = acc[ai][1][m][n][e] * rstd; o[n][e] = gg * sigmoidf_(gg) * uu; }
                *(u32x4*)(ACT + (size_t)r * DFF + u.pn * 128 + wc * 32 + fq * 8) = pack8(o[0], o[1]);
            }
    }
};
struct EpiX2 {
    static constexpr bool AFTER_DRAIN = false; static constexpr int HOOK_KT = 0;
    float* X; const bf16_t* X1B;
    __device__ __forceinline__ void operator()(const Acc& acc, const Unit& u, int wr, int wc, int fr, int fq) const {
        OPAQUE(fr); OPAQUE(fq);
#pragma unroll
        for (int ai = 0; ai < 2; ++ai)
#pragma unroll
            for (int m = 0; m < 4; ++m) {
                const int r = EPI_ROW(u, ai, wr, m, fr);
#pragma unroll
                for (int bj = 0; bj < 2; ++bj) {
                    const size_t o = (size_t)r * 1024 + u.pn * 256 + EPI_LC(bj, wc, fq); float* p = X + o;
                    const u32x4 xw = *(const u32x4*)(X1B + o); f32x4 x0, x1v; unpack8(xw, x0, x1v);
                    *(f32x4*)p = x0 + acc[ai][bj][m][0]; *(f32x4*)(p + 4) = x1v + acc[ai][bj][m][1];
                }
            }
    }
};
struct EpiFinal {
    static constexpr bool AFTER_DRAIN = true; static constexpr int HOOK_KT = 0;
    float* X; const bf16_t* X1B; const float* nw; float* slots; unsigned* cnt;
    __device__ __forceinline__ void fused(Acc& acc, const Unit& u, int wr, int wc, int fr, int fq, int wid, int lane, LAS unsigned char* lds) const {
        OPAQUE(fr); OPAQUE(fq);
        LAS float* Pl = (LAS float*)lds;
        LAS float* Sr = (LAS float*)(lds + 4096);
#pragma unroll
        for (int ai = 0; ai < 2; ++ai)
#pragma unroll
            for (int m = 0; m < 4; ++m) {
                const int r = EPI_ROW(u, ai, wr, m, fr); float sq = 0.f;
#pragma unroll
                for (int bj = 0; bj < 2; ++bj) {
                    { const u32x4 xw = *(const u32x4*)(X1B + (size_t)r * 1024 + u.pn * 256 + EPI_LC(bj, wc, fq)); f32x4 x0, x1v; unpack8(xw, x0, x1v); acc[ai][bj][m][0] += x0; acc[ai][bj][m][1] += x1v; }
                    const f32x4 a = acc[ai][bj][m][0], b = acc[ai][bj][m][1];
                    sq += ((a[0] * a[0] + a[1] * a[1]) + (a[2] * a[2] + a[3] * a[3])) + ((b[0] * b[0] + b[1] * b[1]) + (b[2] * b[2] + b[3] * b[3]));
                }
                sq += __shfl_xor(sq, 16); sq += __shfl_xor(sq, 32);
                if (fq == 0) Pl[(ai * 128 + wr * 64 + m * 16 + fr) * 4 + wc] = sq;
            }
        asm volatile("s_waitcnt lgkmcnt(0)" ::: "memory"); __builtin_amdgcn_s_barrier(); asm volatile("" ::: "memory");
        const int row = wid * 32 + (lane & 31);
        if (lane < 32) { const f32x4 q4 = *(const LAS f32x4*)(Pl + row * 4);
            __hip_atomic_store(slots + (size_t)(u.pm * 256 + row) * 4 + u.pn, (q4[0] + q4[1]) + (q4[2] + q4[3]), __ATOMIC_RELAXED, __HIP_MEMORY_SCOPE_AGENT); }
        asm volatile("s_waitcnt vmcnt(0)" ::: "memory");
        if (lane == 0) __hip_atomic_fetch_add(cnt + 64 * u.pm, 1u, __ATOMIC_RELAXED, __HIP_MEMORY_SCOPE_AGENT);
        if (wid == 0) {
            unsigned sp = 0; while ((unsigned)__builtin_amdgcn_readfirstlane((int)__hip_atomic_load(cnt + 64 * u.pm, __ATOMIC_RELAXED, __HIP_MEMORY_SCOPE_AGENT)) < 32u && ++sp < (1u << 22)) __builtin_amdgcn_s_sleep(2);
            __builtin_amdgcn_fence(__ATOMIC_ACQUIRE, "agent");
        }
        asm volatile("s_waitcnt vmcnt(0) lgkmcnt(0)" ::: "memory"); __builtin_amdgcn_s_barrier(); asm volatile("" ::: "memory");
        if (lane < 32) { const float* sl = slots + (size_t)(u.pm * 256 + row) * 4; float t = 0.f;
#pragma unroll
            for (int k = 0; k < 4; ++k) t += __hip_atomic_load(sl + k, __ATOMIC_RELAXED, __HIP_MEMORY_SCOPE_AGENT);
            Sr[row] = rsqrtf(t * (1.f / DM) + RMS_EPS); }
        asm volatile("s_waitcnt lgkmcnt(0)" ::: "memory"); __builtin_amdgcn_s_barrier(); asm volatile("" ::: "memory");
#pragma unroll
        for (int bj = 0; bj < 2; ++bj) {
            const int c0 = u.pn * 256 + EPI_LC(bj, wc, fq); const f32x4 w0 = *(const f32x4*)(nw + c0), w1 = *(const f32x4*)(nw + c0 + 4);
#pragma unroll
            for (int ai = 0; ai < 2; ++ai)
#pragma unroll
                for (int m = 0; m < 4; ++m) {
                    const int rl = ai * 128 + wr * 64 + m * 16 + fr; const float rs = Sr[rl]; float* p = X + (size_t)(u.pm * 256 + rl) * 1024 + c0;
                    *(f32x4*)p = acc[ai][bj][m][0] * w0 * rs; *(f32x4*)(p + 4) = acc[ai][bj][m][1] * w1 * rs;
                }
        }
    }
};
struct CmpSched {
    const char *KC, *VC, *W1K, *W1V; int c, split;
    __device__ bool next(int i, Unit& u) const {
        if (i > 0 || c >= (split ? 64 : 32)) return false;
        const int un = split ? c >> 1 : c, hk = split ? c & 1 : 0;
        const int which = un >> 4, rt = un & 15, bg = rt >> 1, half = rt & 1, b = bg >> 2, g = bg & 3;
        u.pm = un; u.pn = hk; u.A = (which ? VC : KC) + ((size_t)(b * SEQ + 16 * 256 * half + 16 * hk + (hk ? 16 * 128 : 0)) * 256 + g * 64) * 2; u.B = (which ? W1V : W1K) + (size_t)hk * 2048; return true;
    }
};

struct SF_in { const float* W; __device__ __forceinline__ float operator()(int k, int n) const { const int r = incol_ref(n); return r < 0 ? 0.f : W[(size_t)k * NREF + r]; } };
struct SF_plain { const float* W; int ldn; __device__ __forceinline__ float operator()(int k, int n) const { return W[(size_t)k * ldn + n]; } };
struct SF_gu { const float *Wg, *Wu, *nw; __device__ __forceinline__ float operator()(int k, int n) const {
    const int tile = n >> 8, half = (n >> 7) & 1, j = n & 127, col = tile * 128 + j; const ptrdiff_t d = Wu - Wg; return nw[k] * Wg[(ptrdiff_t)half * d + (ptrdiff_t)k * DFF + col]; } };
__device__ __forceinline__ void p0_tile_out(int K, bf16_t* WT, LAS float* scr, int k0, int n0, int lane) {
    WSYNC();
    const int c = lane & 7;
#pragma unroll
    for (int j = 0; j < 4; ++j) { const int n = (lane >> 3) + 8 * j; const LAS float* s = scr + (8 * c) * 33 + n;
        u32x4 o; o.x = pk2(s[0 * 33], s[1 * 33]); o.y = pk2(s[2 * 33], s[3 * 33]); o.z = pk2(s[4 * 33], s[5 * 33]); o.w = pk2(s[6 * 33], s[7 * 33]);
        *(u32x4*)(WT + (size_t)(n0 + n) * K + k0 + 8 * c) = o; }
    WSYNC();
}
template <class SF> __device__ __forceinline__ void p0_transpose_item(const SF& sf, int K, int N, bf16_t* WT, LAS float* scr, int item, int lane) {
    const int nblk = N / 32, kb = item / nblk, nb = item % nblk, k0 = 64 * kb, n0 = 32 * nb;
    float v[32];
#pragma unroll
    for (int i = 0; i < 32; ++i) v[i] = sf(k0 + 2 * i + (lane >> 5), n0 + (lane & 31));
#pragma unroll
    for (int i = 0; i < 32; ++i) scr[(2 * i + (lane >> 5)) * 33 + (lane & 31)] = v[i];
    p0_tile_out(K, WT, scr, k0, n0, lane);
}
__device__ __forceinline__ void p0_fold_item(const float* pool_w, const float* pool_scale, const float* Wp, bf16_t* WT, int f, int wave, int lane) {
    const int k0 = 64 * (f >> 5), n0 = 32 * (f & 31) + 4 * wave, g = k0 >> 7;
    f32x4 acc = (f32x4){0.f, 0.f, 0.f, 0.f};
    const float* arow = pool_w + (size_t)(k0 + lane) * 128;
#pragma unroll 4
    for (int dp = 0; dp < 128; dp += 4) {
        const f32x4 a = *(const f32x4*)(arow + dp); const f32x4 sc = *(const f32x4*)(pool_scale + g * 128 + dp);
#pragma unroll
        for (int e = 0; e < 4; ++e) { const f32x4 w4 = *(const f32x4*)(Wp + (size_t)(g * 128 + dp + e) * 1024 + n0); acc += w4 * (a[e] * sc[e]); }
    }
#pragma unroll
    for (int j = 0; j < 4; ++j) WT[(size_t)(n0 + j) * 1536 + k0 + lane] = (bf16_t)f2bf(acc[j]);
}
template <int PART> __device__ __forceinline__ void p0_prologue(KParams P, LAS unsigned char* lds, int gw, int NGW, int wave, int lane) {
    unsigned char* ws = P->ws;
    LAS float* scr = (LAS float*)(lds + wave * 16384);
    constexpr int I_IN = (1024 / 64) * (NIN / 32), I_W1 = (2048 / 64) * (256 / 32), I_W2 = (256 / 64) * (64 / 32), I_WM = (1024 / 64) * (1024 / 32), I_WO = (1024 / 64) * (1024 / 32),
                  I_GU = (1024 / 64) * (5632 / 32), I_WD = (2816 / 64) * (1024 / 32);
    if constexpr (PART == 1) {
        constexpr int NITEMS = I_WM + I_WO + I_WD;
        for (int f = gw >> 3; f < 256; f += NGW >> 3) p0_fold_item(P->pool_w, P->pool_scale, P->w_pp, (bf16_t*)(ws + WS_WM), f, wave, lane);
        for (int it = gw; it < NITEMS; it += NGW) {
            int r = it;
            if (r < I_WM) { p0_transpose_item(SF_plain{P->w_pa, 1024}, 1536, 1024, (bf16_t*)(ws + WS_WM) + 512, scr, r, lane); continue; } r -= I_WM;
            if (r < I_WO) { p0_transpose_item(SF_plain{P->w_out, 1024}, 1024, 1024, (bf16_t*)(ws + WS_WO), scr, r, lane); continue; } r -= I_WO;
            p0_transpose_item(SF_plain{P->w_d, 1024}, 2816, 1024, (bf16_t*)(ws + WS_WD), scr, r, lane);
        }
        return;
    }
    constexpr int NITEMS = I_IN + 2 * I_W1 + 2 * I_W2 + I_GU;
    for (int it = gw; it < NITEMS; it += NGW) {
        int r = it;
        if (r < I_GU) { p0_transpose_item(SF_gu{P->w_g, P->w_u, P->norm2_w}, 1024, 5632, (bf16_t*)(ws + WS_WGU), scr, r, lane); continue; } r -= I_GU;
        if (r < I_IN) { p0_transpose_item(SF_in{P->w_in}, 1024, NIN, (bf16_t*)(ws + WS_WIN), scr, r, lane); continue; } r -= I_IN;
        if (r < I_W1) { p0_transpose_item(SF_plain{P->w1_k, 256}, 2048, 256, (bf16_t*)(ws + WS_W1K), scr, r, lane); continue; } r -= I_W1;
        if (r < I_W1) { p0_transpose_item(SF_plain{P->w1_v, 256}, 2048, 256, (bf16_t*)(ws + WS_W1V), scr, r, lane); continue; } r -= I_W1;
        if (r < I_W2) { p0_transpose_item(SF_plain{P->w2_k, 64}, 256, 64, (bf16_t*)(ws + WS_W2K), scr, r, lane); continue; } r -= I_W2;
        p0_transpose_item(SF_plain{P->w2_v, 64}, 256, 64, (bf16_t*)(ws + WS_W2V), scr, r, lane);
    }
    for (int it = (gw & 31) ? 64 : (gw >> 5); it < 64; it += NGW >> 5) {
        const int which = it >> 5, c0 = (it & 31) * 8; const float* pe = which ? P->pe_v : P->pe_k; const float* w1 = which ? P->w1_v : P->w1_k; const float* b1 = which ? P->b1_v : P->b1_k;
        f32x4 s0 = (f32x4){0.f, 0.f, 0.f, 0.f}, s1 = s0;
#pragma unroll 8
        for (int j = 0; j < 32; ++j) { const int k = lane + 64 * j; const float p = pe[k]; s0 += *(const f32x4*)(w1 + (size_t)k * 256 + c0) * p; s1 += *(const f32x4*)(w1 + (size_t)k * 256 + c0 + 4) * p; }
#pragma unroll
        for (int e = 0; e < 4; ++e) { s0[e] = wave_sum(s0[e]); s1[e] = wave_sum(s1[e]); }
        if (lane == 0) { float* o = (float*)(ws + (which ? WS_PEBV : WS_PEBK)) + c0; *(f32x4*)o = s0 + *(const f32x4*)(b1 + c0); *(f32x4*)(o + 4) = s1 + *(const f32x4*)(b1 + c0 + 4); }
    }
    for (int it = gw; it < SEQ * 8 / 64; it += NGW) {
        const int idx = it * 64 + lane, i = idx & 7, t = idx >> 3;
        const float inv_freq = i == 0 ? 1.0f : i == 1 ? 0.193922758102417f : i == 2 ? 0.03760603070259094f : i == 3 ? 0.00729266507551074f : i == 4 ? 0.001414213445968926f : i == 5 ? 0.00027424818836152554f : i == 6 ? 5.318296462064609e-05f : 1.0313385246263351e-05f;
        const float ang = (float)t * inv_freq;
        ((float*)(ws + WS_RCOS))[idx] = cosf(ang); ((float*)(ws + WS_RSIN))[idx] = sinf(ang);
    }
    bf16_t* H = (bf16_t*)((char*)P->out + DO_H);
#pragma unroll 1
    for (int row = gw; row < T; row += NGW) {
        const f32x4* xr = (const f32x4*)(P->x + (size_t)row * DM) + lane; const f32x4* wr = (const f32x4*)P->norm1_w + lane;
        f32x4 v[4]; float s = 0.f;
#pragma unroll
        for (int j = 0; j < 4; ++j) { v[j] = xr[64 * j]; s += (v[j].x * v[j].x + v[j].y * v[j].y) + (v[j].z * v[j].z + v[j].w * v[j].w); }
        const float rstd = rsqrtf(wave_sum(s) * (1.f / DM) + RMS_EPS);
        u32x2* o = (u32x2*)(H + (size_t)row * DM) + lane;
#pragma unroll
        for (int j = 0; j < 4; ++j) { const f32x4 ww = wr[64 * j]; u32x2 p; p.x = pk2(v[j].x * rstd * ww.x, v[j].y * rstd * ww.y); p.y = pk2(v[j].z * rstd * ww.z, v[j].w * rstd * ww.w); o[64 * j] = p; }
    }
}
template <int W> __device__ __forceinline__ void pooled_item(const bf16_t* U, bf16_t* PA, int g, int rb, int lane) {
    const int row = rb * 4 + (lane >> 4), c0 = g * 128 + (lane & 15) * 8, t = row & (SEQ - 1), cnt = t + 1 < W ? t + 1 : W;
    u32x4 q[W];
#pragma unroll
    for (int i = 0; i < W; ++i) q[i] = *(const u32x4*)(U + (size_t)(row - (i < cnt ? i : 0)) * 512 + c0);
    f32x4 u0, u1; unpack8(q[0], u0, u1); f32x4 s0 = u0, s1 = u1;
#pragma unroll
    for (int i = 1; i < W; ++i) { f32x4 a, b; unpack8(q[i], a, b); if (i < cnt) { s0 += a; s1 += b; } }
    const float ic = 1.f / (float)cnt;
    *(u32x4*)(PA + (size_t)row * 1536 + c0) = pack8(s0 * ic - u0, s1 * ic - u1);
}
template <int W> __device__ __forceinline__ void pooled_load(const bf16_t* U, int g, int rb, int lane, u32x4 (&q)[W]) {
    const int row = rb * 4 + (lane >> 4), c0 = g * 128 + (lane & 15) * 8, t = row & (SEQ - 1), cnt = t + 1 < W ? t + 1 : W;
#pragma unroll
    for (int i = 0; i < W; ++i) q[i] = *(const u32x4*)(U + (size_t)(row - (i < cnt ? i : 0)) * 512 + c0);
}
template <int W> __device__ __forceinline__ void pooled_store(bf16_t* PA, int g, int rb, int lane, const u32x4 (&q)[W]) {
    const int row = rb * 4 + (lane >> 4), c0 = g * 128 + (lane & 15) * 8, t = row & (SEQ - 1), cnt = t + 1 < W ? t + 1 : W;
    f32x4 u0, u1; unpack8(q[0], u0, u1); f32x4 s0 = u0, s1 = u1;
#pragma unroll
    for (int i = 1; i < W; ++i) { f32x4 a, b; unpack8(q[i], a, b); if (i < cnt) { s0 += a; s1 += b; } }
    const float ic = 1.f / (float)cnt;
    *(u32x4*)(PA + (size_t)row * 1536 + c0) = pack8(s0 * ic - u0, s1 * ic - u1);
}
__device__ __forceinline__ void p2_pooled(const bf16_t* U, bf16_t* PA, int gw, int NGW, int lane) {
#pragma unroll 1
    for (int rb = gw; rb < T / 4; rb += NGW) {
        { u32x4 q16[16]; pooled_load<16>(U, 3, rb, lane, q16); pooled_store<16>(PA, 3, rb, lane, q16); }
        { u32x4 q2[2], q4[4], q8[8]; pooled_load<8>(U, 2, rb, lane, q8); pooled_load<4>(U, 1, rb, lane, q4); pooled_load<2>(U, 0, rb, lane, q2);
          pooled_store<2>(PA, 0, rb, lane, q2); pooled_store<4>(PA, 1, rb, lane, q4); pooled_store<8>(PA, 2, rb, lane, q8); }
    }
}

namespace nsa {
constexpr int NS = 4, SLOT = 16384, RING = NS * SLOT, WSCR = 8704;
constexpr float THR = 8.f;
typedef short v4i16_t __attribute__((ext_vector_type(4)));
__device__ __forceinline__ float xor1_add(float v) { return v + __builtin_bit_cast(float, __builtin_amdgcn_mov_dpp(__builtin_bit_cast(int, v), 0xB1, 0xF, 0xF, true)); }
__device__ __forceinline__ float xor2_add(float v) { return v + __builtin_bit_cast(float, __builtin_amdgcn_mov_dpp(__builtin_bit_cast(int, v), 0x4E, 0xF, 0xF, true)); }
__device__ __forceinline__ float gmax(float m) {
    auto a = __builtin_amdgcn_permlane16_swap(__float_as_uint(m), __float_as_uint(m), false, false); m = fmaxf(__uint_as_float(a[0]), __uint_as_float(a[1]));
    auto b = __builtin_amdgcn_permlane32_swap(__float_as_uint(m), __float_as_uint(m), false, false); return fmaxf(__uint_as_float(b[0]), __uint_as_float(b[1])); }
__device__ __forceinline__ float gsum(float m) {
    auto a = __builtin_amdgcn_permlane16_swap(__float_as_uint(m), __float_as_uint(m), false, false); m = __uint_as_float(a[0]) + __uint_as_float(a[1]);
    auto b = __builtin_amdgcn_permlane32_swap(__float_as_uint(m), __float_as_uint(m), false, false); return __uint_as_float(b[0]) + __uint_as_float(b[1]); }
struct Lane {
    int wave, lane, g, c; unsigned kbase, vbase; unsigned lds0;
    __device__ __forceinline__ void init(int tid, LAS unsigned char* lds) {
        lane = tid & 63; wave = __builtin_amdgcn_readfirstlane(tid >> 6); g = lane >> 4; c = lane & 15; lds0 = (unsigned)(size_t)lds;
        kbase = (unsigned)(c * 128 + ((g ^ (lane & 7)) << 4));
        const int q = (lane >> 2) & 3, p = lane & 3, rx = 4 * (g & 1) + q;
        vbase = (unsigned)((4 * g + q) * 128 + (((p >> 1) ^ rx) << 4) + (p & 1) * 8);
    }
};
struct Src { const char* k; const char* v; unsigned loff, tstride; };
__device__ __forceinline__ Src make_src(const bf16_t* K, const bf16_t* V, size_t row0, int stride_el, int col0, const Lane& L) {
    Src s; s.k = (const char*)(K + row0 * stride_el + col0); s.v = (const char*)(V + row0 * stride_el + col0);
    const int R = 8 * L.wave + (L.lane >> 3), ch = (L.lane & 7) ^ ((L.lane >> 3) & 7);
    s.loff = (unsigned)((R * stride_el + ch * 8) * 2); s.tstride = (unsigned)(64 * stride_el * 2); return s;
}
__device__ __forceinline__ void glds16(const void* gsrc, unsigned lds_dst) { unsigned keep;
    asm volatile("s_mov_b32 %0, m0\n\ts_mov_b32 m0, %2\n\ts_nop 0\n\tglobal_load_lds_dwordx4 %1, off\n\ts_mov_b32 m0, %0" : "=&s"(keep) : "v"(gsrc), "s"(lds_dst) : "memory"); }
__device__ __forceinline__ void issue(const Lane& L, const Src& S, int tile, int slot) {
    const char* gk = S.k + (size_t)tile * S.tstride + S.loff; const char* gv = S.v + (size_t)tile * S.tstride + S.loff;
    const unsigned d = (unsigned)__builtin_amdgcn_readfirstlane((int)(L.lds0 + slot * SLOT + L.wave * 1024));
    glds16(gk, d); glds16(gv, d + 8192);
}
struct Frags { unsigned k0, k1, v0, v1, v2, v3; };
typedef Frags TileAddr;
template <bool WITH_V> __device__ __forceinline__ void load_frags(const TileAddr& A, const Lane& L, Frags& F) { F = A; }
__device__ __forceinline__ void load_k(const Frags& F, const Lane& L, bf16x8 (&kf)[4][2]) {
#pragma unroll
    for (int mt = 0; mt < 4; ++mt) {
        kf[mt][0] = *(const LAS bf16x8*)((const LAS unsigned char*)(size_t)F.k0 + mt * 2048);
        kf[mt][1] = *(const LAS bf16x8*)((const LAS unsigned char*)(size_t)F.k1 + mt * 2048);
    }
}
__device__ __forceinline__ void load_vdt(unsigned va, bf16x8 (&vf)[2]) {
#pragma unroll
    for (int ks = 0; ks < 2; ++ks) {
        const v4i16_t lo = __builtin_amdgcn_ds_read_tr16_b64_v4i16((LAS v4i16_t*)((LAS unsigned char*)(size_t)va + ks * 4096));
        const v4i16_t hi = __builtin_amdgcn_ds_read_tr16_b64_v4i16((LAS v4i16_t*)((LAS unsigned char*)(size_t)va + ks * 4096 + 2048));
        vf[ks] = (bf16x8){lo[0], lo[1], lo[2], lo[3], hi[0], hi[1], hi[2], hi[3]};
    }
}
__device__ __forceinline__ void load_v(const Frags& F, const Lane& L, bf16x8 (&vf)[4][2]) { load_vdt(F.v0, vf[0]); load_vdt(F.v1, vf[1]); load_vdt(F.v2, vf[2]); load_vdt(F.v3, vf[3]); }
template <bool WITH_V, bool MASKED, class MaskFn>
__device__ __forceinline__ void visit_slow(const Frags& F, const Lane& L, const bf16x8 (&q)[2], f32x4 (&o)[4], float& mref, float& lsum, bool colsel, const MaskFn& valid) {
    const bool seen = mref != -INFINITY;
    const float c0 = colsel ? (seen ? -mref : 0.f) : -INFINITY;
    const f32x4 ci = (f32x4){c0, c0, c0, c0};
    f32x4 s[4];
    { bf16x8 kf[4][2]; load_k(F, L, kf);
#pragma unroll
    for (int mt = 0; mt < 4; ++mt) {
        s[mt] = __builtin_amdgcn_mfma_f32_16x16x32_bf16(kf[mt][0], q[0], ci, 0, 0, 0);
        s[mt] = __builtin_amdgcn_mfma_f32_16x16x32_bf16(kf[mt][1], q[1], s[mt], 0, 0, 0);
    } }
    __builtin_amdgcn_sched_barrier(0);
    bf16x8 vf[4][2]; if constexpr (WITH_V) load_v(F, L, vf);
    if constexpr (MASKED) {
#pragma unroll
        for (int mt = 0; mt < 4; ++mt)
#pragma unroll
            for (int r = 0; r < 4; ++r) if (!valid(16 * mt + 4 * L.g + r)) s[mt][r] = -INFINITY;
    }
    float mx = fmaxf(fmaxf(s[0][0], s[0][1]), fmaxf(s[0][2], s[0][3]));
#pragma unroll
    for (int mt = 1; mt < 4; ++mt) mx = fmaxf(mx, fmaxf(fmaxf(s[mt][0], s[mt][1]), fmaxf(s[mt][2], s[mt][3])));
    if (__any((mx > THR) || (!seen && mx > -INFINITY))) {
        const float mxr = gmax(mx);
        const float d = (mxr == -INFINITY) ? 0.f : (seen ? fmaxf(mxr, 0.f) : mxr);
        const float f = __builtin_amdgcn_exp2f(-d);
        if (mxr != -INFINITY) mref = (seen ? mref : 0.f) + d;
#pragma unroll
        for (int mt = 0; mt < 4; ++mt) s[mt] = s[mt] - d;
        lsum *= f;
        if constexpr (WITH_V) {
#pragma unroll
            for (int dt = 0; dt < 4; ++dt) o[dt] = o[dt] * f;
        }
    }
#pragma unroll
    for (int mt = 0; mt < 4; ++mt)
#pragma unroll
        for (int r = 0; r < 4; ++r) s[mt][r] = __builtin_amdgcn_exp2f(s[mt][r]);
    bf16x8 pf[2];
#pragma unroll
    for (int ks = 0; ks < 2; ++ks) { const u32x4 w = pack8(s[2 * ks], s[2 * ks + 1]); pf[ks] = __builtin_bit_cast(bf16x8, w); }
    { const f32x4 t4 = (s[0] + s[1]) + (s[2] + s[3]); lsum += (t4[0] + t4[1]) + (t4[2] + t4[3]); }
    if constexpr (WITH_V) {
#pragma unroll
        for (int dt = 0; dt < 4; ++dt)
#pragma unroll
            for (int ks = 0; ks < 2; ++ks) o[dt] = __builtin_amdgcn_mfma_f32_16x16x32_bf16(vf[dt][ks], pf[ks], o[dt], 0, 0, 0);
    }
}
template <bool MASKED, class MaskA, class MaskB>
__device__ __forceinline__ void visitB2(const Frags& F, const Lane& L, const bf16x8 (&qA)[2], const bf16x8 (&qB)[2], f32x4 (&oA)[4], f32x4 (&oB)[4], float msA, float msB, float invA, float invB,
                                        const MaskA& validA, const MaskB& validB, LAS float* impA, LAS float* impB, int jb) {
    const float cA = -msA, cB = -msB; const f32x4 ciA = (f32x4){cA, cA, cA, cA}, ciB = (f32x4){cB, cB, cB, cB};
    f32x4 sA[4], sB[4];
    { bf16x8 kf[4][2]; load_k(F, L, kf);
#pragma unroll
    for (int mt = 0; mt < 4; ++mt) {
        sA[mt] = __builtin_amdgcn_mfma_f32_16x16x32_bf16(kf[mt][0], qA[0], ciA, 0, 0, 0);
        sB[mt] = __builtin_amdgcn_mfma_f32_16x16x32_bf16(kf[mt][0], qB[0], ciB, 0, 0, 0);
        sA[mt] = __builtin_amdgcn_mfma_f32_16x16x32_bf16(kf[mt][1], qA[1], sA[mt], 0, 0, 0);
        sB[mt] = __builtin_amdgcn_mfma_f32_16x16x32_bf16(kf[mt][1], qB[1], sB[mt], 0, 0, 0);
    } }

    bf16x8 vf[4][2]; load_v(F, L, vf);
#pragma unroll
    for (int mt = 0; mt < 4; ++mt) {
#pragma unroll
        for (int r = 0; r < 4; ++r) {
            sA[mt][r] = (!MASKED || validA(16 * mt + 4 * L.g + r)) ? __builtin_amdgcn_exp2f(sA[mt][r]) * invA : 0.f;
            sB[mt][r] = (!MASKED || validB(16 * mt + 4 * L.g + r)) ? __builtin_amdgcn_exp2f(sB[mt][r]) * invB : 0.f;
        }
        float va = (sA[mt][0] + sA[mt][1]) + (sA[mt][2] + sA[mt][3]), va3 = sA[mt][3], vb = (sB[mt][0] + sB[mt][1]) + (sB[mt][2] + sB[mt][3]), vb3 = sB[mt][3];
        va = xor2_add(xor1_add(va)); va3 = xor2_add(xor1_add(va3)); vb = xor2_add(xor1_add(vb)); vb3 = xor2_add(xor1_add(vb3));
        if ((L.c & 3) == 0) { const int j = jb + 4 * mt + L.g;
            __hip_atomic_fetch_add(impA + j, va, __ATOMIC_RELAXED, __HIP_MEMORY_SCOPE_WORKGROUP); __hip_atomic_fetch_add(impB + j, vb, __ATOMIC_RELAXED, __HIP_MEMORY_SCOPE_WORKGROUP);
            if (j + 1 < 128) { __hip_atomic_fetch_add(impA + j + 1, va3, __ATOMIC_RELAXED, __HIP_MEMORY_SCOPE_WORKGROUP); __hip_atomic_fetch_add(impB + j + 1, vb3, __ATOMIC_RELAXED, __HIP_MEMORY_SCOPE_WORKGROUP); } }
    }
    bf16x8 pA[2], pB[2];
#pragma unroll
    for (int ks = 0; ks < 2; ++ks) { const u32x4 wa = pack8(sA[2 * ks], sA[2 * ks + 1]), wb = pack8(sB[2 * ks], sB[2 * ks + 1]); pA[ks] = __builtin_bit_cast(bf16x8, wa); pB[ks] = __builtin_bit_cast(bf16x8, wb); }
#pragma unroll
    for (int dt = 0; dt < 4; ++dt)
#pragma unroll
        for (int ks = 0; ks < 2; ++ks) { oA[dt] = __builtin_amdgcn_mfma_f32_16x16x32_bf16(vf[dt][ks], pA[ks], oA[dt], 0, 0, 0); oB[dt] = __builtin_amdgcn_mfma_f32_16x16x32_bf16(vf[dt][ks], pB[ks], oB[dt], 0, 0, 0); }
}
constexpr float PLIM = 1.8446744e19f;
template <bool WITH_V, bool MASKED, class MaskFn>
__device__ __forceinline__ void visit_fast(const Frags& F, const Lane& L, const bf16x8 (&q)[2], f32x4 (&o)[4], float mref, float& lsum, float& badv, bool colsel, const MaskFn& valid) {
    const float c0 = colsel ? -mref : -INFINITY;
    const f32x4 ci = (f32x4){c0, c0, c0, c0};
    f32x4 s[4];
    { bf16x8 kf[4][2]; load_k(F, L, kf);
#pragma unroll
    for (int mt = 0; mt < 4; ++mt) {
        s[mt] = __builtin_amdgcn_mfma_f32_16x16x32_bf16(kf[mt][0], q[0], ci, 0, 0, 0);
        s[mt] = __builtin_amdgcn_mfma_f32_16x16x32_bf16(kf[mt][1], q[1], s[mt], 0, 0, 0);
    } }

    bf16x8 vf[4][2]; if constexpr (WITH_V) load_v(F, L, vf);
#pragma unroll
    for (int mt = 0; mt < 4; ++mt)
#pragma unroll
        for (int r = 0; r < 4; ++r) { const float e = __builtin_amdgcn_exp2f(s[mt][r]); s[mt][r] = (!MASKED || valid(16 * mt + 4 * L.g + r)) ? e : 0.f; }
    float ps; { const f32x4 t4 = (s[0] + s[1]) + (s[2] + s[3]); ps = (t4[0] + t4[1]) + (t4[2] + t4[3]); }
    lsum += ps; badv = fmaxf(badv, ps);
    if constexpr (WITH_V) {
        bf16x8 pf[2];
#pragma unroll
        for (int ks = 0; ks < 2; ++ks) { const u32x4 w = pack8(s[2 * ks], s[2 * ks + 1]); pf[ks] = __builtin_bit_cast(bf16x8, w); }
#pragma unroll
        for (int dt = 0; dt < 4; ++dt)
#pragma unroll
            for (int ks = 0; ks < 2; ++ks) o[dt] = __builtin_amdgcn_mfma_f32_16x16x32_bf16(vf[dt][ks], pf[ks], o[dt], 0, 0, 0);
    }
}
template <bool MASKED, bool WITH_V = true, class MaskA, class MaskB>
__device__ __forceinline__ void visit_fast2(const Frags& F, const Lane& L, const bf16x8 (&qA)[2], const bf16x8 (&qB)[2], f32x4 (&oA)[4], f32x4 (&oB)[4], float mrefA, float mrefB,
                                            float& lsumA, float& lsumB, float& badv, bool colA, bool colB, const MaskA& validA, const MaskB& validB) {
    const float cA = colA ? -mrefA : -INFINITY, cB = colB ? -mrefB : -INFINITY;
    const f32x4 ciA = (f32x4){cA, cA, cA, cA}, ciB = (f32x4){cB, cB, cB, cB};
    f32x4 sA[4], sB[4];
    { bf16x8 kf[4][2]; load_k(F, L, kf);
#pragma unroll
    for (int mt = 0; mt < 4; ++mt) {
        sA[mt] = __builtin_amdgcn_mfma_f32_16x16x32_bf16(kf[mt][0], qA[0], ciA, 0, 0, 0);
        sB[mt] = __builtin_amdgcn_mfma_f32_16x16x32_bf16(kf[mt][0], qB[0], ciB, 0, 0, 0);
        sA[mt] = __builtin_amdgcn_mfma_f32_16x16x32_bf16(kf[mt][1], qA[1], sA[mt], 0, 0, 0);
        sB[mt] = __builtin_amdgcn_mfma_f32_16x16x32_bf16(kf[mt][1], qB[1], sB[mt], 0, 0, 0);
    } }
    bf16x8 vf[4][2]; if constexpr (WITH_V) load_v(F, L, vf);
#pragma unroll
    for (int mt = 0; mt < 4; ++mt)
#pragma unroll
        for (int r = 0; r < 4; ++r) {
            const float ea = __builtin_amdgcn_exp2f(sA[mt][r]), eb = __builtin_amdgcn_exp2f(sB[mt][r]);
            sA[mt][r] = (!MASKED || validA(16 * mt + 4 * L.g + r)) ? ea : 0.f; sB[mt][r] = (!MASKED || validB(16 * mt + 4 * L.g + r)) ? eb : 0.f;
        }
    { const f32x4 t4 = (sA[0] + sA[1]) + (sA[2] + sA[3]); const float ps = (t4[0] + t4[1]) + (t4[2] + t4[3]); lsumA += ps; badv = fmaxf(badv, ps); }
    { const f32x4 t4 = (sB[0] + sB[1]) + (sB[2] + sB[3]); const float ps = (t4[0] + t4[1]) + (t4[2] + t4[3]); lsumB += ps; badv = fmaxf(badv, ps); }
    if constexpr (!WITH_V) return;
    bf16x8 pA[2], pB[2];
#pragma unroll
    for (int ks = 0; ks < 2; ++ks) { const u32x4 wa = pack8(sA[2 * ks], sA[2 * ks + 1]), wb = pack8(sB[2 * ks], sB[2 * ks + 1]); pA[ks] = __builtin_bit_cast(bf16x8, wa); pB[ks] = __builtin_bit_cast(bf16x8, wb); }
#pragma unroll
    for (int dt = 0; dt < 4; ++dt)
#pragma unroll
        for (int ks = 0; ks < 2; ++ks) { oA[dt] = __builtin_amdgcn_mfma_f32_16x16x32_bf16(vf[dt][ks], pA[ks], oA[dt], 0, 0, 0); oB[dt] = __builtin_amdgcn_mfma_f32_16x16x32_bf16(vf[dt][ks], pB[ks], oB[dt], 0, 0, 0); }
}
template <bool WITH_V, class MaskFn>
__device__ __forceinline__ void visit_init(const Frags& F, const Lane& L, const bf16x8 (&q)[2], f32x4 (&o)[4], float& mref, float& lsum, float& badv, bool colsel, const MaskFn& valid) {
    const bool seen = mref != -INFINITY;
    const float c0 = colsel ? (seen ? -mref : 0.f) : -INFINITY;
    const f32x4 ci = (f32x4){c0, c0, c0, c0};
    f32x4 s[4];
    { bf16x8 kf[4][2]; load_k(F, L, kf);
#pragma unroll
    for (int mt = 0; mt < 4; ++mt) {
        s[mt] = __builtin_amdgcn_mfma_f32_16x16x32_bf16(kf[mt][0], q[0], ci, 0, 0, 0);
        s[mt] = __builtin_amdgcn_mfma_f32_16x16x32_bf16(kf[mt][1], q[1], s[mt], 0, 0, 0);
    } }

    bf16x8 vf[4][2]; if constexpr (WITH_V) load_v(F, L, vf);
#pragma unroll
    for (int mt = 0; mt < 4; ++mt)
#pragma unroll
        for (int r = 0; r < 4; ++r) if (!valid(16 * mt + 4 * L.g + r)) s[mt][r] = -INFINITY;
    float mx = fmaxf(fmaxf(s[0][0], s[0][1]), fmaxf(s[0][2], s[0][3]));
#pragma unroll
    for (int mt = 1; mt < 4; ++mt) mx = fmaxf(mx, fmaxf(fmaxf(s[mt][0], s[mt][1]), fmaxf(s[mt][2], s[mt][3])));
    const float mxr = gmax(mx);
    const float d = (!seen && mxr != -INFINITY) ? mxr : 0.f;
    if (!seen && mxr != -INFINITY) mref = mxr;
#pragma unroll
    for (int mt = 0; mt < 4; ++mt)
#pragma unroll
        for (int r = 0; r < 4; ++r) s[mt][r] = __builtin_amdgcn_exp2f(s[mt][r] - d);
    float ps; { const f32x4 t4 = (s[0] + s[1]) + (s[2] + s[3]); ps = (t4[0] + t4[1]) + (t4[2] + t4[3]); }
    lsum += ps; badv = fmaxf(badv, ps);
    if constexpr (WITH_V) {
        bf16x8 pf[2];
#pragma unroll
        for (int ks = 0; ks < 2; ++ks) { const u32x4 w = pack8(s[2 * ks], s[2 * ks + 1]); pf[ks] = __builtin_bit_cast(bf16x8, w); }
#pragma unroll
        for (int dt = 0; dt < 4; ++dt)
#pragma unroll
            for (int ks = 0; ks < 2; ++ks) o[dt] = __builtin_amdgcn_mfma_f32_16x16x32_bf16(vf[dt][ks], pf[ks], o[dt], 0, 0, 0);
    }
}
template <bool MASKED, class MaskFn>
__device__ __forceinline__ void visitB(const Frags& F, const Lane& L, const bf16x8 (&q)[2], f32x4 (&o)[4], float ms, float inv_l, const MaskFn& valid, LAS float* imp_row, int jb) {
    const float c0 = -ms; const f32x4 ci = (f32x4){c0, c0, c0, c0};
    f32x4 s[4];
    { bf16x8 kf[4][2]; load_k(F, L, kf);
#pragma unroll
    for (int mt = 0; mt < 4; ++mt) {
        s[mt] = __builtin_amdgcn_mfma_f32_16x16x32_bf16(kf[mt][0], q[0], ci, 0, 0, 0);
        s[mt] = __builtin_amdgcn_mfma_f32_16x16x32_bf16(kf[mt][1], q[1], s[mt], 0, 0, 0);
    } }

    bf16x8 vf[4][2]; load_v(F, L, vf);
#pragma unroll
    for (int mt = 0; mt < 4; ++mt) {
#pragma unroll
        for (int r = 0; r < 4; ++r) s[mt][r] = (!MASKED || valid(16 * mt + 4 * L.g + r)) ? __builtin_amdgcn_exp2f(s[mt][r]) * inv_l : 0.f;
        float val = (s[mt][0] + s[mt][1]) + (s[mt][2] + s[mt][3]), v3 = s[mt][3];
        val = xor2_add(xor1_add(val)); v3 = xor2_add(xor1_add(v3));
        if ((L.c & 3) == 0) { const int j = jb + 4 * mt + L.g; __hip_atomic_fetch_add(imp_row + j, val, __ATOMIC_RELAXED, __HIP_MEMORY_SCOPE_WORKGROUP);
            if (j + 1 < 128) __hip_atomic_fetch_add(imp_row + j + 1, v3, __ATOMIC_RELAXED, __HIP_MEMORY_SCOPE_WORKGROUP); }
    }
    bf16x8 pf[2];
#pragma unroll
    for (int ks = 0; ks < 2; ++ks) { const u32x4 w = pack8(s[2 * ks], s[2 * ks + 1]); pf[ks] = __builtin_bit_cast(bf16x8, w); }
#pragma unroll
    for (int dt = 0; dt < 4; ++dt)
#pragma unroll
        for (int ks = 0; ks < 2; ++ks) o[dt] = __builtin_amdgcn_mfma_f32_16x16x32_bf16(vf[dt][ks], pf[ks], o[dt], 0, 0, 0);
}
struct HiMask { int hi; __device__ __forceinline__ bool operator()(int key) const { return key <= hi; } };
struct RangeMask { int lo, hi; __device__ __forceinline__ bool operator()(int key) const { return key >= lo && key <= hi; } };
struct LoMask { int lo; __device__ __forceinline__ bool operator()(int key) const { return key >= lo; } };
struct NoMask { __device__ __forceinline__ bool operator()(int) const { return true; } };
__device__ __forceinline__ unsigned ctr_load(LAS unsigned* p) { return (unsigned)__builtin_amdgcn_readfirstlane((int)__hip_atomic_load(p, __ATOMIC_RELAXED, __HIP_MEMORY_SCOPE_WORKGROUP)); }
template <class Body>
__device__ __forceinline__ void stream(LAS unsigned char* lds, const Lane& L, const Src& S, int tile0, int NT, const Body& body) {
    LAS unsigned* ready = (LAS unsigned*)(lds + MISC_OFF + 64);
    LAS unsigned* done = ready + NS;
    __builtin_amdgcn_s_barrier();
    if (L.wave == 0 && L.lane < 2 * NS) ready[L.lane] = 0u;
    asm volatile("s_waitcnt lgkmcnt(0)" ::: "memory");
    __builtin_amdgcn_s_barrier();
    asm volatile("" ::: "memory");
    int issued = 0, published = 0;
    TileAddr A; A.k0 = L.lds0 + L.kbase; A.k1 = L.lds0 + (L.kbase ^ 64u); A.v0 = L.lds0 + 8192u + L.vbase; A.v1 = L.lds0 + 8192u + (L.vbase ^ 32u); A.v2 = L.lds0 + 8192u + (L.vbase ^ 64u); A.v3 = L.lds0 + 8192u + (L.vbase ^ 96u);
    for (int i = 0; i < NT; ++i) {
        asm volatile("s_waitcnt vmcnt(0)" ::: "memory");
        for (; published < issued; ++published) if (L.lane == 0) __hip_atomic_fetch_add(ready + (published & (NS - 1)), 1u, __ATOMIC_RELAXED, __HIP_MEMORY_SCOPE_WORKGROUP);
        for (;;) {
            if (issued >= NT || issued >= i + NS) break;
            const bool must = issued <= i;
            if (issued >= NS) {
                const unsigned want = 8u * (unsigned)(issued / NS);
                if (ctr_load(done + (issued & (NS - 1))) < want) { if (!must) break; while (ctr_load(done + (issued & (NS - 1))) < want) __builtin_amdgcn_s_sleep(1); }
            }
            issue(L, S, tile0 + issued, issued & (NS - 1)); ++issued;
            if (must) { asm volatile("s_waitcnt vmcnt(0)" ::: "memory"); for (; published < issued; ++published) if (L.lane == 0) __hip_atomic_fetch_add(ready + (published & (NS - 1)), 1u, __ATOMIC_RELAXED, __HIP_MEMORY_SCOPE_WORKGROUP); }
        }
        { const unsigned want = 8u * (unsigned)(i / NS + 1); LAS unsigned* rp = ready + (i & (NS - 1)); while (ctr_load(rp) < want) __builtin_amdgcn_s_sleep(1); }
        asm volatile("" ::: "memory");
        body(i, A);
        { const unsigned d = ((i + 1) & (NS - 1)) ? (unsigned)SLOT : (unsigned)(-(NS - 1) * SLOT); A.k0 += d; A.k1 += d; A.v0 += d; A.v1 += d; A.v2 += d; A.v3 += d; }
        asm volatile("s_waitcnt lgkmcnt(0)" ::: "memory");
        if (L.lane == 0) __hip_atomic_fetch_add(done + (i & (NS - 1)), 1u, __ATOMIC_RELAXED, __HIP_MEMORY_SCOPE_WORKGROUP);
    }
    asm volatile("s_waitcnt vmcnt(0) lgkmcnt(0)" ::: "memory");
}
struct Tensors { unsigned char* ws;
    __device__ __forceinline__ const bf16_t* QP_() const { return (const bf16_t*)(ws + WS_QP); }   __device__ __forceinline__ const bf16_t* QR_() const { return (const bf16_t*)(ws + WS_QR); }
    __device__ __forceinline__ const bf16_t* KCMP_() const { return (const bf16_t*)(ws + WS_KCMP); } __device__ __forceinline__ const bf16_t* VCMP_() const { return (const bf16_t*)(ws + WS_VCMP); }
    __device__ __forceinline__ const bf16_t* KS_() const { return (const bf16_t*)(ws + WS_KS); }   __device__ __forceinline__ const bf16_t* VS_() const { return (const bf16_t*)(ws + WS_VS); }
    __device__ __forceinline__ const bf16_t* KW_() const { return (const bf16_t*)(ws + WS_KW); }   __device__ __forceinline__ const bf16_t* VW_() const { return (const bf16_t*)(ws + WS_VW); }
    __device__ __forceinline__ const float* GN_() const { return (const float*)(ws + WS_GN); }     __device__ __forceinline__ bf16_t* PA_() const { return (bf16_t*)(ws + WS_PA); }
};
__device__ __forceinline__ void unit(LAS unsigned char* lds, const Tensors& X, int b, int gk, int u, int wave_s) {
    const int t0 = 128 * u;
    bf16x8 q[4][2]; f32x4 o[4][4]; float m[4], l[4]; float badv;
#define NSA_STAGE() Lane L; { const int ln_ = lane_id(); L.init(ln_ + 64 * wave_s, lds); } \
    const int tw0 = t0 + 16 * L.wave, tl = L.c >> 2; (void)tl; \
    LAS unsigned char* wscr = lds + RING + L.wave * WSCR; (void)wscr; \
    LAS float* impw = (LAS float*)wscr; (void)impw;                   \
    LAS unsigned* bmask = (LAS unsigned*)(wscr + 8192); (void)bmask;     \
    const int qrow32 = (b * SEQ + tw0 + (L.c >> 2)) * 1024 + (gk * 4 + (L.c & 3)) * 64 + 8 * L.g; (void)qrow32;        \
    const int gnrow = (b * SEQ + tw0 + (L.c >> 2)) * 48 + (gk * 4 + (L.c & 3)) * 3; (void)gnrow;                         \
    LAS unsigned char* park = wscr + ((size_t)L.c * 64 + 4 * L.g) * 2; (void)park
#define NSA_LOADQ(Qp) do { int qo_ = qrow32; OPAQUE(qo_); const bf16_t* qp_ = (Qp) + (size_t)qo_; _Pragma("unroll") for (int rt = 0; rt < 4; ++rt) _Pragma("unroll") for (int dk = 0; dk < 2; ++dk) q[rt][dk] = *(const bf16x8*)(qp_ + rt * 4096 + 32 * dk); \
        _Pragma("unroll") for (int rt = 0; rt < 4; ++rt) _Pragma("unroll") for (int dk = 0; dk < 2; ++dk) asm volatile("" : "+v"(q[rt][dk]));     \
        } while (0)
#define NSA_BAD() (__any(!(badv <= PLIM)))
#define NSA_RESET() do { float z_ = 0.f; OPAQUE(z_); badv = z_; _Pragma("unroll") for (int rt = 0; rt < 4; ++rt) { m[rt] = -INFINITY; l[rt] = z_; _Pragma("unroll") for (int dt = 0; dt < 4; ++dt) o[rt][dt] = (f32x4){z_, z_, z_, z_}; } } while (0)
    {
        NSA_STAGE();
        { float z_ = 0.f; OPAQUE(z_); const f32x4 z4 = (f32x4){z_, z_, z_, z_};
#pragma unroll
        for (int i = 0; i < 8; ++i) *(LAS f32x4*)(impw + (i * 64 + L.lane) * 4) = z4; }
        NSA_LOADQ(X.QP_()); NSA_RESET();
        const int nct = ((8 * u + 6) >> 6) + 1;
        const Src S = make_src(X.KCMP_(), X.VCMP_(), (size_t)(b * 4 + gk) * NCP, 64, 0, L);
        stream(lds, L, S, 0, nct, [&](int i, const TileAddr& Ks) {
            const int nb = 64 * i;
            if (tw0 + 15 >= 31 && nb <= ((tw0 + 15 - 31) >> 4)) {
                Frags F; load_frags<false>(Ks, L, F);
#pragma unroll
                for (int pr = 0; pr < 2; ++pr) {
                    const int rA = 2 * pr, rB = rA + 1, twA = tw0 + 4 * rA, twB = twA + 4;
                    const bool nA = twA + 3 >= 31 && nb <= ((twA + 3 - 31) >> 4), nB = twB + 3 >= 31 && nb <= ((twB + 3 - 31) >> 4);
                    const bool inter = twA >= 31 && nb + 63 <= ((twA - 31) >> 4);
                    const int tA = twA + tl, tB = twB + tl;
                    const HiMask hA{(tA >= 31 ? ((tA - 31) >> 4) : -1) - nb}, hB{(tB >= 31 ? ((tB - 31) >> 4) : -1) - nb};
                    (void)inter;
                    if (i == 0) { if (nA) visit_init<false>(F, L, q[rA], o[rA], m[rA], l[rA], badv, true, hA); if (nB) visit_init<false>(F, L, q[rB], o[rB], m[rB], l[rB], badv, true, hB); }
                    else if (nA && nB) visit_fast2<true, false>(F, L, q[rA], q[rB], o[rA], o[rB], m[rA], m[rB], l[rA], l[rB], badv, true, true, hA, hB);
                    else { if (nA) visit_fast<false, true>(F, L, q[rA], o[rA], m[rA], l[rA], badv, true, hA); if (nB) visit_fast<false, true>(F, L, q[rB], o[rB], m[rB], l[rB], badv, true, hB); }
                }
            }
        });
        if (NSA_BAD()) {
            NSA_RESET();
            stream(lds, L, S, 0, nct, [&](int i, const TileAddr& Ks) {
                const int nb = 64 * i;
                if (tw0 + 15 >= 31 && nb <= ((tw0 + 15 - 31) >> 4)) {
                    Frags F; load_frags<false>(Ks, L, F);
#pragma unroll
                    for (int rt = 0; rt < 4; ++rt) {
                        const int twA = tw0 + 4 * rt, tA = twA + tl;
                        if (twA + 3 >= 31 && nb <= ((twA + 3 - 31) >> 4)) visit_slow<false, true>(F, L, q[rt], o[rt], m[rt], l[rt], true, HiMask{(tA >= 31 ? ((tA - 31) >> 4) : -1) - nb});
                    }
                }
            });
        }
        float inv[4], msf[4];
#pragma unroll
        for (int rt = 0; rt < 4; ++rt) { const float lt = gsum(l[rt]); inv[rt] = lt > 0.f ? __builtin_amdgcn_rcpf(lt) : 0.f; msf[rt] = (m[rt] == -INFINITY) ? 0.f : m[rt]; }
        NSA_RESET();
        stream(lds, L, S, 0, nct, [&](int i, const TileAddr& Ks) {
            const int nb = 64 * i;
            if (tw0 + 15 >= 31 && nb <= ((tw0 + 15 - 31) >> 4)) {
                Frags F; load_frags<true>(Ks, L, F);
#pragma unroll
                for (int pr = 0; pr < 2; ++pr) {
                    const int rA = 2 * pr, rB = rA + 1, twA = tw0 + 4 * rA, twB = twA + 4;
                    const bool nA = twA + 3 >= 31 && nb <= ((twA + 3 - 31) >> 4), nB = twB + 3 >= 31 && nb <= ((twB + 3 - 31) >> 4);
                    const bool inter = twA >= 31 && nb + 63 <= ((twA - 31) >> 4);
                    const int tA = twA + tl, tB = twB + tl;
                    const HiMask hA{(tA >= 31 ? ((tA - 31) >> 4) : -1) - nb}, hB{(tB >= 31 ? ((tB - 31) >> 4) : -1) - nb};
                    LAS float* iA = impw + (4 * rA + tl) * 128; LAS float* iB = impw + (4 * rB + tl) * 128;
                    (void)inter;
                    if (nA && nB) visitB2<true>(F, L, q[rA], q[rB], o[rA], o[rB], msf[rA], msf[rB], inv[rA], inv[rB], hA, hB, iA, iB, 16 * i);
                    else { if (nA) visitB<true>(F, L, q[rA], o[rA], msf[rA], inv[rA], hA, iA, 16 * i);
                           if (nB) visitB<true>(F, L, q[rB], o[rB], msf[rB], inv[rB], hB, iB, 16 * i); }
                }
            }
        });
    }
    asm volatile("s_waitcnt lgkmcnt(0)" ::: "memory");
    {
        NSA_STAGE();
        unsigned bm0 = 0u, bm1 = 0u;
#pragma unroll 1
        for (int tau = 0; tau < 16; ++tau) {
            const int t = tw0 + tau, jt = t >> 6; bool s0, s1;
            if (jt <= 15) { s0 = L.lane <= jt; s1 = false; }
            else {
                const float v0 = impw[tau * 128 + L.lane], v1 = impw[tau * 128 + 64 + L.lane];
                const int j0 = L.lane, j1 = L.lane + 64;
                const unsigned long long k0 = (j0 >= 1 && j0 <= jt - 2) ? ((1ull << 39) | ((unsigned long long)__float_as_uint(v0) << 7) | (unsigned long long)(127 - j0)) : 0ull;
                const unsigned long long k1 = (j1 <= jt - 2) ? ((1ull << 39) | ((unsigned long long)__float_as_uint(v1) << 7) | (unsigned long long)(127 - j1)) : 0ull;
                unsigned long long Tk = 0ull;
#pragma unroll 1
                for (int bit = 39; bit >= 0; --bit) {
                    const unsigned long long C = Tk | (1ull << bit);
                    const int cnt = __popcll(__ballot(k0 >= C)) + __popcll(__ballot(k1 >= C));
                    if (cnt >= 13) Tk = C;
                }
                s0 = (k0 >= Tk && k0 != 0ull) || j0 == 0 || j0 == jt || j0 == jt - 1;
                s1 = (k1 >= Tk && k1 != 0ull) || j1 == jt || j1 == jt - 1;
            }
            bm0 |= (s0 ? 1u : 0u) << tau; bm1 |= (s1 ? 1u : 0u) << tau;
        }
        bmask[L.lane] = bm0; bmask[64 + L.lane] = bm1;
    }
    asm volatile("s_waitcnt lgkmcnt(0)" ::: "memory");
    {
        NSA_STAGE();
#pragma unroll
        for (int rt = 0; rt < 4; ++rt) {
            int gi_ = gnrow + rt * 192; OPAQUE(gi_); const float gc = X.GN_()[gi_];
#pragma unroll
            for (int dt = 0; dt < 4; ++dt) { const f32x4 v = o[rt][dt] * gc; u32x2 w; w.x = cvt_pk_bf16(v[0], v[1]); w.y = cvt_pk_bf16(v[2], v[3]); *(LAS u32x2*)(park + rt * 2048 + dt * 32) = w; }
        }
    }
    {
        NSA_STAGE();
        NSA_LOADQ(X.QR_());
        const int kt_lo = (2 * u - 8) > 0 ? (2 * u - 8) : 0, kt_hi = 2 * u + 1;
        const Src S = make_src(X.KW_(), X.VW_(), (size_t)b * SEQ, 256, gk * 64, L);
        SUBREP(32) { NSA_RESET();
        stream(lds, L, S, kt_lo, kt_hi - kt_lo + 1, [&](int i, const TileAddr& Ks) {
            const int kbase = 64 * (kt_lo + i);
            if (kbase <= tw0 + 15 && kbase + 63 >= tw0 - 511) {
                Frags F; load_frags<true>(Ks, L, F);
#pragma unroll
                for (int pr = 0; pr < 2; ++pr) {
                    const int rA = 2 * pr, rB = rA + 1, twA = tw0 + 4 * rA, twB = twA + 4;
                    const bool nA = kbase <= twA + 3 && kbase + 63 >= twA - 511, nB = kbase <= twB + 3 && kbase + 63 >= twB - 511;
                    const bool inter = kbase + 63 <= twA && kbase >= twB + 3 - 511;
                    const int tA = twA + tl, tB = twB + tl;
                    const bool init = kbase <= (twB + 3 - 511 > 0 ? twB + 3 - 511 : 0);
                    if (init) { if (nA) visit_init<true>(F, L, q[rA], o[rA], m[rA], l[rA], badv, true, RangeMask{tA - 511 - kbase, tA - kbase}); if (nB) visit_init<true>(F, L, q[rB], o[rB], m[rB], l[rB], badv, true, RangeMask{tB - 511 - kbase, tB - kbase}); }
                    else if (nA && nB) { if (inter) visit_fast2<false>(F, L, q[rA], q[rB], o[rA], o[rB], m[rA], m[rB], l[rA], l[rB], badv, true, true, NoMask{}, NoMask{});
                                         else visit_fast2<true>(F, L, q[rA], q[rB], o[rA], o[rB], m[rA], m[rB], l[rA], l[rB], badv, true, true, HiMask{tA - kbase}, HiMask{tB - kbase}); }
                    else if (inter) { if (nA) visit_fast<true, false>(F, L, q[rA], o[rA], m[rA], l[rA], badv, true, NoMask{}); if (nB) visit_fast<true, false>(F, L, q[rB], o[rB], m[rB], l[rB], badv, true, NoMask{}); }
                    else { if (nA) visit_fast<true, true>(F, L, q[rA], o[rA], m[rA], l[rA], badv, true, HiMask{tA - kbase}); if (nB) visit_fast<true, true>(F, L, q[rB], o[rB], m[rB], l[rB], badv, true, HiMask{tB - kbase}); }
                }
            }
        });
        if (NSA_BAD()) {
            NSA_RESET();
            stream(lds, L, S, kt_lo, kt_hi - kt_lo + 1, [&](int i, const TileAddr& Ks) {
                const int kbase = 64 * (kt_lo + i);
                if (kbase <= tw0 + 15 && kbase + 63 >= tw0 - 511) {
                    Frags F; load_frags<true>(Ks, L, F);
#pragma unroll
                    for (int rt = 0; rt < 4; ++rt) {
                        const int twA = tw0 + 4 * rt, tA = twA + tl;
                        if (kbase <= twA + 3 && kbase + 63 >= twA - 511) visit_slow<true, true>(F, L, q[rt], o[rt], m[rt], l[rt], true, RangeMask{tA - 511 - kbase, tA - kbase});
                    }
                }
            });
        }
        }
    }
    {
        NSA_STAGE();
#pragma unroll
        for (int rt = 0; rt < 4; ++rt) {
            int gi_ = gnrow + rt * 192 + 2; OPAQUE(gi_); const float sc = X.GN_()[gi_] * __builtin_amdgcn_rcpf(gsum(l[rt]));
#pragma unroll
            for (int dt = 0; dt < 4; ++dt) {
                LAS u32x2* pp = (LAS u32x2*)(park + rt * 2048 + dt * 32); const u32x2 pw = *pp; const f32x4 v = o[rt][dt] * sc; u32x2 w;
                w.x = cvt_pk_bf16(v[0] + __builtin_bit_cast(float, pw.x << 16), v[1] + __builtin_bit_cast(float, pw.x & 0xffff0000u));
                w.y = cvt_pk_bf16(v[2] + __builtin_bit_cast(float, pw.y << 16), v[3] + __builtin_bit_cast(float, pw.y & 0xffff0000u));
                *pp = w;
            }
        }
    }
    {
        NSA_STAGE();
        const Src S = make_src(X.KS_(), X.VS_(), (size_t)b * SEQ, 256, gk * 64, L);
        if (MK_PROBE == 34) stream(lds, L, S, 0, 2 * u + 2, [&](int j, const TileAddr& Ks) { const unsigned bm = (unsigned)__builtin_amdgcn_readfirstlane((int)bmask[j]); asm volatile("" :: "s"(bm), "v"(Ks.k0)); });
        SUBREP(33) { NSA_RESET();
        stream(lds, L, S, 0, 2 * u + 2, [&](int j, const TileAddr& Ks) {
            const unsigned bm = (unsigned)__builtin_amdgcn_readfirstlane((int)bmask[j]);
            const int kbase = 64 * j; const bool j0 = (j == 0);
            if (bm & 0xffffu) {
                Frags F; load_frags<true>(Ks, L, F);
#pragma unroll
                for (int pr = 0; pr < 2; ++pr) {
                    const int rA = 2 * pr, rB = rA + 1, twA = tw0 + 4 * rA, twB = twA + 4;
                    const bool nA = (bm >> (4 * rA)) & 15u, nB = (bm >> (4 * rB)) & 15u;
                    const bool inter = kbase + 63 <= twA;
                    const bool sA = (bm >> (4 * rA + tl)) & 1u, sB = (bm >> (4 * rB + tl)) & 1u;
                    const HiMask hA{twA + tl - kbase}, hB{twB + tl - kbase};
                    if (j0) { if (nA) visit_init<true>(F, L, q[rA], o[rA], m[rA], l[rA], badv, sA, hA); if (nB) visit_init<true>(F, L, q[rB], o[rB], m[rB], l[rB], badv, sB, hB); }
                    else if (nA && nB && inter) visit_fast2<false>(F, L, q[rA], q[rB], o[rA], o[rB], m[rA], m[rB], l[rA], l[rB], badv, sA, sB, hA, hB);
                    else if (inter) { if (nA) visit_fast<true, false>(F, L, q[rA], o[rA], m[rA], l[rA], badv, sA, hA); if (nB) visit_fast<true, false>(F, L, q[rB], o[rB], m[rB], l[rB], badv, sB, hB); }
                    else { if (nA) visit_fast<true, true>(F, L, q[rA], o[rA], m[rA], l[rA], badv, sA, hA); if (nB) visit_fast<true, true>(F, L, q[rB], o[rB], m[rB], l[rB], badv, sB, hB); }
                }
            }
        });
        if (NSA_BAD()) {
            NSA_RESET();
            stream(lds, L, S, 0, 2 * u + 2, [&](int j, const TileAddr& Ks) {
                const unsigned bm = (unsigned)__builtin_amdgcn_readfirstlane((int)bmask[j]);
                const int kbase = 64 * j;
                if (bm & 0xffffu) {
                    Frags F; load_frags<true>(Ks, L, F);
#pragma unroll
                    for (int rt = 0; rt < 4; ++rt) {
                        const int twA = tw0 + 4 * rt;
                        if ((bm >> (4 * rt)) & 15u) visit_slow<true, true>(F, L, q[rt], o[rt], m[rt], l[rt], (bool)((bm >> (4 * rt + tl)) & 1u), HiMask{twA + tl - kbase});
                    }
                }
            });
        }
        }
    }
    {
        NSA_STAGE();
#pragma unroll
        for (int rt = 0; rt < 4; ++rt) {
            int gi_ = gnrow + rt * 192 + 1; OPAQUE(gi_); const float sc = X.GN_()[gi_] * __builtin_amdgcn_rcpf(gsum(l[rt]));
            int oo_ = (b * SEQ + tw0 + 4 * rt + tl) * 1536 + 512 + (gk * 4 + (L.c & 3)) * 64 + 4 * L.g; OPAQUE(oo_); bf16_t* orow = X.PA_() + (size_t)oo_;
#pragma unroll
            for (int dt = 0; dt < 4; ++dt) {
                const u32x2 pw = *(LAS u32x2*)(park + rt * 2048 + dt * 32); const f32x4 v = o[rt][dt] * sc; u32x2 w;
                w.x = cvt_pk_bf16(v[0] + __builtin_bit_cast(float, pw.x << 16), v[1] + __builtin_bit_cast(float, pw.x & 0xffff0000u));
                w.y = cvt_pk_bf16(v[2] + __builtin_bit_cast(float, pw.y << 16), v[3] + __builtin_bit_cast(float, pw.y & 0xffff0000u));
                *(u32x2*)(orow + 16 * dt) = w;
            }
        }
    }
    asm volatile("s_waitcnt vmcnt(0) lgkmcnt(0)" ::: "memory");
#undef NSA_LOADQ
#undef NSA_RESET
#undef NSA_BAD
#undef NSA_STAGE
}
}

#define XB_TMO      128
#define XB_XCNT(j)  (256  + 64 * (j))
#define XB_XSUB(j)  (1280 + 64 * (j))
#define XB_XGEN(j)  (2304 + 64 * (j))
#define XB_TOP      3328
#define XB_TOPGEN   3392
#define XCD_BAR_WORDS 3456
#define XB_SPIN_CAP (1u << 18)
constexpr int CW_FN = 10240;
constexpr int CW_BAR = 4096;
constexpr size_t CTL_ZERO_BYTES = 65536;
__device__ __forceinline__ unsigned xb_ld(unsigned* p)              { return __hip_atomic_load(p, __ATOMIC_RELAXED, __HIP_MEMORY_SCOPE_AGENT); }
__device__ __forceinline__ unsigned xb_add(unsigned* p, unsigned v) { return __hip_atomic_fetch_add(p, v, __ATOMIC_RELAXED, __HIP_MEMORY_SCOPE_AGENT); }
__device__ __forceinline__ unsigned xb_xcc_id() { return (unsigned)__builtin_amdgcn_s_getreg((3 << 11) | 20) & 0xFu; }
#define XB_SPIN(cond, bar) do { unsigned _sp = 0; while (cond) { __builtin_amdgcn_s_sleep(1); \
    if ((++_sp & 255u) == 0u) { if (xb_ld(&(bar)[XB_TMO])) break; if (_sp > XB_SPIN_CAP) { atomicAdd(&(bar)[XB_TMO], 1u); break; } } } } while (0)
struct XcdBarrier { unsigned* bar; unsigned x; volatile LAS unsigned* st; int wave; };
__device__ __forceinline__ XcdBarrier xcd_barrier_post(unsigned* bar, volatile LAS unsigned* st, int wave) {
    XcdBarrier b; b.bar = bar; b.x = xb_xcc_id(); b.st = st; b.wave = wave;
    if (wave == 0 && lane_id() == 0) (void)xb_add(&bar[XB_XCNT(b.x)], 1u);
    return b;
}
__device__ __forceinline__ void xcd_barrier_complete(unsigned* bar, unsigned x, unsigned& nloc, unsigned& nx) {
    const unsigned G = gridDim.x * gridDim.y * gridDim.z;
    unsigned sum, cnt, mine, sp = 0u;
    for (;;) {
        sum = 0u; cnt = 0u; mine = 0u;
#pragma unroll
        for (unsigned j = 0; j < 16; ++j) { const unsigned c = xb_ld(&bar[XB_XCNT(j)]); sum += c; cnt += (c > 0u) ? 1u : 0u; mine = (j == x) ? c : mine; }
        if (sum == G) break;
        __builtin_amdgcn_s_sleep(1);
        if ((++sp & 255u) == 0u) { if (xb_ld(&bar[XB_TMO])) break; if (sp > XB_SPIN_CAP) { atomicAdd(&bar[XB_TMO], 1u); break; } }
    }
    nloc = mine > 0u ? mine : 1u; nx = cnt > 0u ? cnt : 1u;
}
__device__ __forceinline__ void xcd_barrier(const XcdBarrier& b) {
    asm volatile("s_waitcnt vmcnt(0)" ::: "memory");
    __syncthreads();
    if (b.wave == 0 && lane_id() == 0) {
        unsigned* bar = b.bar;
        __builtin_amdgcn_s_waitcnt(0);
        unsigned nloc = b.st[0], nx = b.st[1];
        if (nloc == 0u) { xcd_barrier_complete(bar, b.x, nloc, nx); b.st[0] = nloc; b.st[1] = nx; }
        const unsigned old = xb_add(&bar[XB_XSUB(b.x)], 1u);
        const unsigned gen = old / nloc;
        if (old + 1u == (gen + 1u) * nloc) {
            __builtin_amdgcn_fence(__ATOMIC_RELEASE, "agent");
            asm volatile("s_waitcnt vmcnt(0)" ::: "memory");
            const unsigned og = xb_add(&bar[XB_TOP], 1u);
            const unsigned tg = og / nx;
            if (og + 1u == (tg + 1u) * nx) xb_add(&bar[XB_TOPGEN], 1u);
            else XB_SPIN(xb_ld(&bar[XB_TOPGEN]) == tg, bar);
            __builtin_amdgcn_fence(__ATOMIC_ACQUIRE, "agent");
            xb_add(&bar[XB_XGEN(b.x)], 1u);
            asm volatile("s_waitcnt vmcnt(0)" ::: "memory");
        } else {
            XB_SPIN(xb_ld(&bar[XB_XGEN(b.x)]) == gen, bar);
            __builtin_amdgcn_fence(__ATOMIC_ACQUIRE, "agent");
            asm volatile("s_waitcnt vmcnt(0)" ::: "memory");
        }
    }
    __syncthreads();
}

#ifndef MK_COOP
#define MK_COOP 1
#endif
constexpr int N_PHASES = 9;
#define REP(k) for (int rep_ = 0; rep_ < ((MK_PROBE) == (k) ? 2 : 1); ++rep_)
__device__ __forceinline__ KParams kparams() { KParams p = (KParams)__builtin_amdgcn_kernarg_segment_ptr(); asm volatile("" : "+s"(p)); return p; }
__global__ void __launch_bounds__(NTHREADS, 2) mk_fwd(Params Parg) {
    (void)Parg;
    extern __shared__ __attribute__((aligned(16))) unsigned char lds_raw[];
    LAS unsigned char* lds = (LAS unsigned char*)lds_raw;
    const int wave_k = __builtin_amdgcn_readfirstlane((int)(threadIdx.x >> 6));
    const int G = gridDim.x, bx = blockIdx.x;
    const int vcu = (G % 8 == 0) ? (bx % 8) * (G / 8) + bx / 8 : bx;
    const int NGW = G * NWAVES;
#define PHASE_IDS() int tid = TID_(wave_k); asm volatile("" : "+v"(tid)); const int lane = tid & 63, wave = __builtin_amdgcn_readfirstlane(tid >> 6), gw = vcu * NWAVES + wave; (void)lane; (void)gw
#define ws (kparams()->ws)
#define dout ((char*)kparams()->out)
    const int ph_lo = kparams()->ph_lo, ph_hi = kparams()->ph_hi;
#define WSP(T_, off) ((T_*)(ws + (off)))
#if MK_COOP
#ifndef MK_CG_SYNC
#define MK_CG_SYNC 0
#endif
#if MK_CG_SYNC
#define GRID_SYNC() cg::this_grid().sync()
#else
    volatile LAS unsigned* MISC = (volatile LAS unsigned*)(lds + MISC_OFF);
    if (wave_k == 0 && lane_id() < 32) MISC[lane_id()] = 0u;
    __syncthreads();
    const XcdBarrier xbar = xcd_barrier_post((unsigned*)(ws + WS_CTL) + CW_BAR, MISC + 8, wave_k);
#define GRID_SYNC() xcd_barrier(xbar)
#endif
#else
#define GRID_SYNC() do {} while (0)
#endif
#define IN(k) (ph_lo <= (k) && (k) < ph_hi)
#define SEAM(k) do { if (IN(k) && IN((k) + 1)) GRID_SYNC(); } while (0)
#define H ((bf16_t*)(dout + DO_H))
#define SP ((bf16_t*)(dout + DO_SP))
#define X1 ((float*)dout)

    if (IN(0)) REP(0) { PHASE_IDS(); p0_prologue<0>(kparams(), lds, gw, NGW, wave, lane); }
    SEAM(0);
    if (IN(1)) REP(1) {
        pg8::Gemm g{1024 * 2, 1024 * 2, 128, 128, 16}; pg8::StdSched S; S.init(H, WSP(bf16_t, WS_WIN), T, 5120, 2048, 2048, G, bx);
        EpiIn E{WSP(bf16_t, WS_U), WSP(bf16_t, WS_QP), WSP(bf16_t, WS_QR), WSP(bf16_t, WS_KC), SP, WSP(bf16_t, WS_SA),
                WSP(float, WS_GN), WSP(float, WS_RCOS), WSP(float, WS_RSIN)};
        pg8::gemm_phase<EpiIn, pg8::StdSched, true>(lds, g, S, E, wave_k);
    }
    SEAM(1);
    if (IN(2)) REP(2) {
        const int ncmp = (G == 256) ? 64 : 32;
        if (bx >= ncmp) {
            { PHASE_IDS(); (void)gw; p2_pooled(WSP(bf16_t, WS_U), WSP(bf16_t, WS_PA), (bx - ncmp) * NWAVES + wave, (G - ncmp) * NWAVES, lane); }
            PHASE_IDS(); (void)gw;
            const int fr = lane & 15, fq = lane >> 4; const bf16_t* Wg = WSP(bf16_t, WS_WIN) + (size_t)5120 * 1024; float* GNp = WSP(float, WS_GN);
#pragma unroll 1
            for (int it = (((bx - ncmp) * NWAVES + wave) % 3) ? T / 32 : ((bx - ncmp) * NWAVES + wave) / 3; it < T / 32; it += ((G - ncmp) * NWAVES + 2) / 3) {
                const int r0 = 32 * it; f32x4 c2[2][3];
#pragma unroll
                for (int mt = 0; mt < 2; ++mt)
#pragma unroll
                    for (int nt = 0; nt < 3; ++nt) c2[mt][nt] = (f32x4){0.f, 0.f, 0.f, 0.f};
#pragma unroll 4
                for (int k0 = 0; k0 < 1024; k0 += 32) {
                    bf16x8 a[2], b[3];
#pragma unroll
                    for (int mt = 0; mt < 2; ++mt) a[mt] = *(const bf16x8*)(H + (size_t)(r0 + 16 * mt + fr) * 1024 + k0 + 8 * fq);
#pragma unroll
                    for (int nt = 0; nt < 3; ++nt) b[nt] = *(const bf16x8*)(Wg + (size_t)(16 * nt + fr) * 1024 + k0 + 8 * fq);
#pragma unroll
                    for (int mt = 0; mt < 2; ++mt)
#pragma unroll
                        for (int nt = 0; nt < 3; ++nt) c2[mt][nt] = __builtin_amdgcn_mfma_f32_16x16x32_bf16(a[mt], b[nt], c2[mt][nt], 0, 0, 0);
                }
#pragma unroll
                for (int mt = 0; mt < 2; ++mt)
#pragma unroll
                    for (int nt = 0; nt < 3; ++nt)
#pragma unroll
                        for (int r = 0; r < 4; ++r) GNp[(size_t)(r0 + 16 * mt + 4 * fq + r) * 48 + 16 * nt + fr] = sigmoidf_(c2[mt][nt][r] + 0.f);
            }
            if (G != 256) p0_prologue<1>(kparams(), lds, (bx - ncmp) * NWAVES + wave, (G - ncmp) * NWAVES, wave, lane);
        }
        __syncthreads();
        const int split = (G == 256) ? 1 : 0;
        pg8::Gemm g{4096 * 2, 2048 * 2, 512, 128, split ? 16 : 32, (split && (bx & 1)) ? -128 * 4096 * 2 : 0};
        CmpSched S{(const char*)WSP(bf16_t, WS_KC), (const char*)WSP(bf16_t, WS_VC), (const char*)WSP(bf16_t, WS_W1K), (const char*)WSP(bf16_t, WS_W1V), bx, split};
        EpiCmp E{WSP(bf16_t, WS_HIDK), WSP(bf16_t, WS_HIDV), WSP(float, WS_PEBK), WSP(float, WS_PEBV), WSP(bf16_t, WS_W2K), WSP(bf16_t, WS_W2V), WSP(bf16_t, WS_KCMP), WSP(bf16_t, WS_VCMP), ws, split};
        pg8::gemm_phase<EpiCmp, CmpSched, false>(lds, g, S, E, wave_k);
    }
    SEAM(2);
    if (IN(3)) REP(3) {
        const nsa::Tensors X{ws};
        const int wave_s = wave_k;
#pragma unroll 1
        for (int uu = vcu; uu < 256; uu += G) { const int bg = uu >> 5, i = uu & 31;
#pragma unroll 1
            for (int hh = 0; hh < 2; ++hh) nsa::unit(lds, X, bg >> 2, bg & 3, hh ? 63 - i : i, wave_s); }
        if (G == 256 && (vcu & 31) < 8) {
            __syncthreads();
            PHASE_IDS(); (void)gw;
            p0_prologue<1>(kparams(), lds, ((vcu >> 5) * 8 + (vcu & 31)) * NWAVES + wave, 64 * NWAVES, wave, lane);
        }
    }
    SEAM(3);
    if (IN(4)) REP(4) {
        pg8::Gemm g{1536 * 2, 1536 * 2, 128, 128, 24}; pg8::StdSched S; S.init(WSP(bf16_t, WS_PA), WSP(bf16_t, WS_WM), T, 1024, 3072, 3072, G, bx);
        EpiMerged E{WSP(bf16_t, WS_MG), SP, WSP(bf16_t, WS_SA)};
        pg8::gemm_phase<EpiMerged, pg8::StdSched, false>(lds, g, S, E, wave_k);
    }
    SEAM(4);
    if (IN(5)) REP(5) {
        pg8::Gemm g{1024 * 2, 1024 * 2, 128, 128, 16}; pg8::StdSched S; S.init(WSP(bf16_t, WS_MG), WSP(bf16_t, WS_WO), T, 1024, 2048, 2048, G, bx);
        EpiX1 E{kparams()->x, X1, WSP(bf16_t, WS_X1B), WSP(float, WS_RS1)};
        pg8::gemm_phase<EpiX1, pg8::StdSched, false>(lds, g, S, E, wave_k);
    }
    SEAM(5);
    if (IN(6)) REP(6) {
        pg8::Gemm g{1024 * 2, 1024 * 2, 128, 128, 16}; pg8::StdSched S; S.init(WSP(bf16_t, WS_X1B), WSP(bf16_t, WS_WGU), T, 5632, 2048, 2048, G, bx);
        EpiAct E{WSP(bf16_t, WS_ACT), WSP(float, WS_RS1)};
        pg8::gemm_phase<EpiAct, pg8::StdSched, true>(lds, g, S, E, wave_k);
    }
    SEAM(6);
    if (IN(7)) {
        pg8::Gemm g{DFF * 2, DFF * 2, 128, 128, DFF / 64}; pg8::StdSched S; S.init(WSP(bf16_t, WS_ACT), WSP(bf16_t, WS_WD), T, 1024, DFF * 2, DFF * 2, G, bx);
        if (G == 256) {
            EpiFinal E{X1, WSP(bf16_t, WS_X1B), kparams()->normf_w, WSP(float, WS_SEL), (unsigned*)(ws + WS_CTL) + CW_FN};
            pg8::gemm_phase<EpiFinal, pg8::StdSched, false>(lds, g, S, E, wave_k);
        } else {
            EpiX2 E{X1, WSP(bf16_t, WS_X1B)};
            pg8::gemm_phase<EpiX2, pg8::StdSched, false>(lds, g, S, E, wave_k);
        }
    }
    if (G != 256) {
    SEAM(7);
    if (IN(8)) {
        PHASE_IDS();
        for (int row = gw; row < T; row += NGW) {
            f32x4* xr = (f32x4*)(X1 + (size_t)row * DM) + lane; const f32x4* wr = (const f32x4*)kparams()->normf_w + lane;
            f32x4 v[4]; float s = 0.f;
#pragma unroll
            for (int j = 0; j < 4; ++j) { v[j] = xr[64 * j]; s += (v[j].x * v[j].x + v[j].y * v[j].y) + (v[j].z * v[j].z + v[j].w * v[j].w); }
            const float rstd = rsqrtf(wave_sum(s) * (1.f / DM) + RMS_EPS);
#pragma unroll
            for (int j = 0; j < 4; ++j) { const f32x4 ww = wr[64 * j]; xr[64 * j] = (f32x4){v[j].x * rstd * ww.x, v[j].y * rstd * ww.y, v[j].z * rstd * ww.z, v[j].w * rstd * ww.w}; }
        }
    }
    }
#undef WSP
#undef ws
#undef dout
#undef H
#undef SP
#undef X1
}

extern "C" void kernel_launch(void* const* d_in, const int* in_sizes, int n_in, void* d_out, int out_size, void* d_ws, size_t ws_size, hipStream_t stream) {
    static int grid = 0;
    if (grid == 0) {
        if (n_in != 21 || ws_size < WS_END || out_size != T * DM) { fprintf(stderr, "kernel_launch: unexpected shapes n_in %d ws %zu out %d\n", n_in, ws_size, out_size); grid = -1; return; }
        int dev = 0, cus = 0, per_cu = 0;
        if (hipGetDevice(&dev) != hipSuccess || hipDeviceGetAttribute(&cus, hipDeviceAttributeMultiprocessorCount, dev) != hipSuccess) { grid = -1; return; }
        if (hipFuncSetAttribute((const void*)mk_fwd, hipFuncAttributeMaxDynamicSharedMemorySize, LDS_BYTES) != hipSuccess) { fprintf(stderr, "kernel_launch: hipFuncSetAttribute failed\n"); grid = -1; return; }
        if (hipOccupancyMaxActiveBlocksPerMultiprocessor(&per_cu, (const void*)mk_fwd, NTHREADS, LDS_BYTES) != hipSuccess || per_cu < 1) { fprintf(stderr, "kernel_launch: occupancy query says %d\n", per_cu); (void)hipGetLastError(); per_cu = 1; }
        grid = cus;
    }
    if (grid < 0) return;
    Params p{};
    const float** pin = (const float**)&p;
    for (int i = 0; i < 21; ++i) pin[i] = (const float*)d_in[i];
    p.out = (float*)d_out; p.ws = (unsigned char*)d_ws;
#if MK_COOP
    p.ph_lo = 0; p.ph_hi = N_PHASES;
    if (hipMemsetAsync((char*)d_ws + WS_CTL, 0, CTL_ZERO_BYTES, stream) != hipSuccess) { fprintf(stderr, "kernel_launch: memset failed\n"); return; }
    void* args[] = {&p};
    hipError_t e = hipLaunchCooperativeKernel((const void*)mk_fwd, dim3(grid), dim3(NTHREADS), args, LDS_BYTES, stream);
    if (e != hipSuccess) fprintf(stderr, "kernel_launch: cooperative launch failed: %s (grid %d)\n", hipGetErrorString(e), grid);
#else
    for (int ph = 0; ph < N_PHASES; ++ph) { p.ph_lo = ph; p.ph_hi = ph + 1; hipLaunchKernelGGL(mk_fwd, dim3(grid), dim3(NTHREADS), LDS_BYTES, stream, p); }
#endif
}
```

```cpp
#include <hip/hip_runtime.h>
#include <hip/hip_cooperative_groups.h>
#include <cstdint>
#include <cstdio>
namespace cg = cooperative_groups;
#ifndef MK_PROBE
#define MK_PROBE -1
#endif
#define SUBREP(k) for (int srep_ = 0; srep_ < ((MK_PROBE) == (k) ? 2 : 1); ++srep_)

#define LAS __attribute__((address_space(3)))
typedef unsigned short bf16_t;
typedef short bf16x8 __attribute__((ext_vector_type(8)));
typedef float f32x4 __attribute__((ext_vector_type(4)));
typedef unsigned u32x4 __attribute__((ext_vector_type(4)));
typedef unsigned u32x2 __attribute__((ext_vector_type(2)));

constexpr int BATCH = 2, SEQ = 8192, T = BATCH * SEQ, DM = 1024;
constexpr int NREF = 5168, NIN = 5376;
constexpr int DFF = 2816;
constexpr int NCP = 512;
constexpr float RMS_EPS = 1e-6f;
constexpr float C2 = 0.125f * 1.4426950408889634f;
constexpr int NWAVES = 8, NTHREADS = 512;

constexpr size_t MiB = 1u << 20;
constexpr size_t WS_CTL = 0;
constexpr size_t WS_PEBK = 1 * MiB, WS_PEBV = 1 * MiB + 4096, WS_RCOS = 1 * MiB + 65536, WS_RSIN = WS_RCOS + 262144;
constexpr size_t WS_RS1 = 2 * MiB;
constexpr size_t WS_SEL = 3 * MiB;
constexpr size_t WS_KCMP = 4 * MiB, WS_VCMP = 4 * MiB + 512 * 1024;
constexpr size_t WS_W2K = 5 * MiB, WS_W2V = 5 * MiB + 65536;
constexpr size_t WS_W1K = 6 * MiB, WS_W1V = 7 * MiB;
constexpr size_t WS_WIN = 8 * MiB;
constexpr size_t WS_WM = 19 * MiB;
constexpr size_t WS_WO = 22 * MiB;
constexpr size_t WS_WGU = 24 * MiB;
constexpr size_t WS_WD = 35 * MiB;
constexpr size_t WS_GN = 41 * MiB;
constexpr size_t WS_U = 44 * MiB;
constexpr size_t WS_QP = 60 * MiB;
constexpr size_t WS_MG = 60 * MiB;
constexpr size_t WS_KC = 92 * MiB, WS_VC = 100 * MiB, WS_KS = 108 * MiB, WS_VS = 116 * MiB, WS_KW = 124 * MiB, WS_VW = 132 * MiB;
constexpr size_t WS_SA = 140 * MiB;
constexpr size_t WS_PA = 172 * MiB;
constexpr size_t WS_QR = 220 * MiB;
constexpr size_t WS_X1B = 220 * MiB;
constexpr size_t WS_HIDK = 252 * MiB, WS_HIDV = 254 * MiB;
constexpr size_t WS_ACT = 44 * MiB;
constexpr size_t WS_END = 256 * MiB;
constexpr size_t DO_H = 0, DO_SP = 32 * MiB;

constexpr int RING_BYTES = 131072;
constexpr int MISC_OFF = 147456 - 256;
constexpr int LDS_BYTES = 147456;

__device__ __forceinline__ unsigned f2bf(float f) { unsigned u = __builtin_bit_cast(unsigned, f); return (u + 0x7fffu + ((u >> 16) & 1u)) >> 16; }
__device__ __forceinline__ float bf2f(unsigned b) { return __builtin_bit_cast(float, (b & 0xffffu) << 16); }
__device__ __forceinline__ unsigned pk2(float lo, float hi) { return f2bf(lo) | (f2bf(hi) << 16); }
typedef float f32x2_t __attribute__((ext_vector_type(2))); typedef __bf16 bf16x2_t __attribute__((ext_vector_type(2)));
__device__ __forceinline__ unsigned cvt_pk_bf16(float lo, float hi) { f32x2_t v = {lo, hi}; bf16x2_t b = __builtin_convertvector(v, bf16x2_t); return __builtin_bit_cast(unsigned, b); }
__device__ __forceinline__ u32x4 pack8(const f32x4& a, const f32x4& b) { u32x4 w; w.x = cvt_pk_bf16(a[0], a[1]); w.y = cvt_pk_bf16(a[2], a[3]); w.z = cvt_pk_bf16(b[0], b[1]); w.w = cvt_pk_bf16(b[2], b[3]); return w; }
__device__ __forceinline__ void unpack8(const u32x4& w, f32x4& a, f32x4& b) {
    a[0] = __builtin_bit_cast(float, w.x << 16); a[1] = __builtin_bit_cast(float, w.x & 0xffff0000u); a[2] = __builtin_bit_cast(float, w.y << 16); a[3] = __builtin_bit_cast(float, w.y & 0xffff0000u);
    b[0] = __builtin_bit_cast(float, w.z << 16); b[1] = __builtin_bit_cast(float, w.z & 0xffff0000u); b[2] = __builtin_bit_cast(float, w.w << 16); b[3] = __builtin_bit_cast(float, w.w & 0xffff0000u); }
__device__ __forceinline__ float sigmoidf_(float v) { return __builtin_amdgcn_rcpf(1.f + __expf(-v)); }
__device__ __forceinline__ float wave_sum(float v) {
#pragma unroll
    for (int o = 1; o < 64; o <<= 1) v += __shfl_xor(v, o);
    return v;
}
__device__ __forceinline__ float wave_max(float v) {
#pragma unroll
    for (int o = 1; o < 64; o <<= 1) v = fmaxf(v, __shfl_xor(v, o));
    return v;
}
#define WSYNC() asm volatile("s_waitcnt lgkmcnt(0)" ::: "memory")
__device__ __forceinline__ int lane_id() { int r; asm volatile("v_mbcnt_lo_u32_b32 %0, -1, 0\n\tv_mbcnt_hi_u32_b32 %0, -1, %0" : "=v"(r)); return r; }
#define TID_(wv) (64 * (wv) + lane_id())
#define OPAQUE(x) asm volatile("" : "+v"(x))
__host__ __device__ __forceinline__ int incol_ref(int c) {
    if (c < 3072) return c;
    if (c < 4096) return 3120 + (c - 3072);
    if (c < 5120) return 4144 + (c - 4096);
    if (c < 5168) return 3072 + (c - 5120);
    return -1;
}

struct Params {
    const float *x, *norm1_w, *w_in, *pool_w, *pool_scale, *pe_k, *w1_k, *b1_k, *w2_k, *pe_v, *w1_v, *b1_v, *w2_v, *w_pp, *w_pa, *w_out, *norm2_w, *w_g, *w_u, *w_d, *normf_w;
    float* out; unsigned char* ws;
    int ph_lo, ph_hi;
};

typedef const __attribute__((address_space(4))) Params* KParams;
namespace pg8 {
constexpr int BM = 256, BK = 64, HALF = 128, HTB = HALF * BK * 2, STAGE_BYTES = 8 * HTB, NXCD = 8, WGM = 8;
__host__ __device__ __forceinline__ int lds_byte(int r, int c) { const int st = (r >> 4) * 2 + (c >> 5), rr = r & 15, cc = c & 31, ob = rr * 64 + cc * 2; return st * 1024 + (ob ^ (((ob >> 9) & 1) << 5)); }
__host__ __device__ __forceinline__ void stage_rc(int b, int& R, int& C) { const int st = b / 1024, sb = b % 1024, swz = sb ^ (((sb >> 9) & 1) << 5); R = (st >> 1) * 16 + swz / 64; C = (st & 1) * 32 + (swz % 64) / 2; }
__host__ __device__ __forceinline__ int perm32(int rho) { const int n = rho >> 4, i = rho & 15; return 8 * (i >> 2) + 4 * n + (i & 3); }

struct Unit { int pm, pn; const char* A; const char* B; };
struct Gemm { int lda, ldb, ksA, ksB, nt, hsA; };

struct StaticOrder {
    int nM, nN, nwg, G, c;
    __device__ void init(int M, int N, int G_, int c_) { nM = M / BM; nN = N / BM; nwg = nM * nN; G = G_; c = c_; }
    __device__ bool next(int i, int& pm, int& pn) const {
        const long L = (long)i * G + c; if (L >= nwg) return false;
        int wgid = (int)L; { const int q = nwg / NXCD, r = nwg % NXCD, xcd = wgid % NXCD, off = wgid / NXCD; wgid = (xcd < r ? xcd * (q + 1) : r * (q + 1) + (xcd - r) * q) + off; }
        const int nig = WGM * nN, gid = wgid / nig, fm = gid * WGM, gsz = (nM - fm) < WGM ? (nM - fm) : WGM;
        pm = fm + ((wgid % nig) % gsz); pn = (wgid % nig) / gsz; return true;
    }
};
struct StdSched {
    StaticOrder so; const char* A; const char* B; size_t tA, tB;
    __device__ void init(const void* A_, const void* B_, int M, int N, int lda_bytes, int ldb_bytes, int G, int c) { so.init(M, N, G, c); A = (const char*)A_; B = (const char*)B_; tA = (size_t)256 * lda_bytes; tB = (size_t)256 * ldb_bytes; }
    __device__ bool next(int i, Unit& u) const { if (!so.next(i, u.pm, u.pn)) return false; u.A = A + u.pm * tA; u.B = B + u.pn * tB; return true; }
};

template <class Epi, class Sched, bool ALIGN_EPI>
__device__ __forceinline__ void gemm_phase(LAS unsigned char* lds, const Gemm g, const Sched& S, const Epi& E, int wave_k) {
    int tid = TID_(wave_k); asm volatile("" : "+v"(tid));
    const int wid = __builtin_amdgcn_readfirstlane(tid >> 6), lane = tid & 63, wr = wid >> 2, wc = wid & 3, fr = lane & 15, fq = lane >> 4;
    const int nt = g.nt;
    unsigned voffA[2], voffB[2];
#pragma unroll
    for (int i = 0; i < 2; ++i) { int R, C; stage_rc(tid * 16 + i * 8192, R, C); const int Rb = (R & ~31) + perm32(R & 31);
        voffA[i] = (unsigned)(R * g.lda + C * 2); voffB[i] = (unsigned)(Rb * g.ldb + C * 2); }
    const size_t kstepA = (size_t)g.ksA, kstepB = (size_t)g.ksB;
    const ptrdiff_t hstepA = g.hsA ? (ptrdiff_t)g.hsA : (ptrdiff_t)HALF * g.lda; const size_t hstepB = (size_t)HALF * g.ldb;
    const unsigned ldsw = (unsigned)wid * 1024u;
    const int aoff = lds_byte(wr * 64 + fr, fq * 8), boff = lds_byte(wc * 32 + fr, fq * 8);
#define PG8_SA(b, h) (((b) * 2 + (h)) * HTB)
#define PG8_SB(b, h) ((4 + (b) * 2 + (h)) * HTB)
#define PG8_STAGE(bufoff, gbase, voff) do { _Pragma("unroll") for (int _i = 0; _i < 2; ++_i) \
        __builtin_amdgcn_global_load_lds((const unsigned*)((const char*)(gbase) + (voff)[_i]), (LAS unsigned*)(lds + (bufoff) + ldsw + _i * 8192), 16, 0, 0); } while (0)
#define PG8_LDA(dst, b, h) do { _Pragma("unroll") for (int m = 0; m < 4; ++m) _Pragma("unroll") for (int k = 0; k < 2; ++k) dst[m][k] = *(const LAS bf16x8*)(lds + PG8_SA(b, h) + aoff + m * 2048 + k * 1024); } while (0)
#define PG8_LDB(dst, b, h) do { _Pragma("unroll") for (int n = 0; n < 2; ++n) _Pragma("unroll") for (int k = 0; k < 2; ++k) dst[n][k] = *(const LAS bf16x8*)(lds + PG8_SB(b, h) + boff + n * 2048 + k * 1024); } while (0)
#define PG8_MMA(ai, bj, At, Bt) do { __builtin_amdgcn_s_setprio(1); _Pragma("unroll") for (int m = 0; m < 4; ++m) _Pragma("unroll") for (int n = 0; n < 2; ++n) _Pragma("unroll") for (int k = 0; k < 2; ++k) \
        acc[ai][bj][m][n] = __builtin_amdgcn_mfma_f32_16x16x32_bf16(Bt[n][k], At[m][k], acc[ai][bj][m][n], 0, 0, 0); __builtin_amdgcn_s_setprio(0); } while (0)
#define PG8_WAIT_V(n) asm volatile("s_waitcnt vmcnt(" #n ")" ::: "memory")
#define PG8_WAIT_L(n) asm volatile("s_waitcnt lgkmcnt(" #n ")" ::: "memory")
#define PG8_BAR __builtin_amdgcn_s_barrier()
#define PG8_SCHED __builtin_amdgcn_sched_barrier(0)
    Unit cur, nxt; int ui = 0;
    if (!S.next(0, cur)) return;
    f32x4 acc[2][2][4][2];
#pragma unroll
    for (int a = 0; a < 2; ++a)
#pragma unroll
        for (int b = 0; b < 2; ++b)
#pragma unroll
            for (int m = 0; m < 4; ++m)
#pragma unroll
                for (int n = 0; n < 2; ++n) acc[a][b][m][n] = (f32x4){0.f, 0.f, 0.f, 0.f};
    bf16x8 At[4][2], B0[2][2], B1[2][2];
    const char* cA = cur.A; const char* cB = cur.B;
    PG8_STAGE(PG8_SB(0, 0), cB, voffB); PG8_STAGE(PG8_SB(0, 1), cB + hstepB, voffB); PG8_STAGE(PG8_SA(0, 0), cA, voffA); PG8_STAGE(PG8_SA(0, 1), cA + hstepA, voffA);
    if (wr == 1) PG8_BAR;
    PG8_WAIT_V(2); PG8_BAR;
    PG8_STAGE(PG8_SB(1, 0), cB + kstepB, voffB); PG8_STAGE(PG8_SA(1, 0), cA + kstepA, voffA); PG8_STAGE(PG8_SB(1, 1), cB + hstepB + kstepB, voffB);
    PG8_WAIT_V(6); PG8_BAR;
    for (;;) {
        const bool has_next = S.next(ui + 1, nxt);
        const char* nA = has_next ? nxt.A : cA; const char* nB = has_next ? nxt.B : cB;
        for (int t = 0; t < nt; t += 2) {
            const bool last = (t == nt - 2);
            const char* a1 = cA + (size_t)(t + 1) * kstepA;
            const char* a2 = last ? nA : cA + (size_t)(t + 2) * kstepA; const char* b2 = last ? nB : cB + (size_t)(t + 2) * kstepB;
            const char* a3 = a2 + kstepA; const char* b3 = b2 + kstepB;
            PG8_LDB(B0, 0, 0); PG8_LDB(B1, 0, 1); PG8_SCHED; PG8_LDA(At, 0, 0); PG8_STAGE(PG8_SA(1, 1), a1 + hstepA, voffA);
            PG8_WAIT_V(8); PG8_WAIT_L(0); PG8_BAR; PG8_MMA(0, 0, At, B0); PG8_MMA(0, 1, At, B1); PG8_BAR; PG8_SCHED;
            PG8_LDA(At, 0, 1); PG8_STAGE(PG8_SB(0, 0), b2, voffB); PG8_STAGE(PG8_SB(0, 1), b2 + hstepB, voffB); PG8_STAGE(PG8_SA(0, 0), a2, voffA);
            PG8_WAIT_V(8); PG8_WAIT_L(0); PG8_BAR; PG8_MMA(1, 0, At, B0); PG8_MMA(1, 1, At, B1); PG8_BAR; PG8_SCHED;
            PG8_LDB(B0, 1, 0); PG8_LDB(B1, 1, 1); PG8_SCHED; PG8_LDA(At, 1, 0); PG8_STAGE(PG8_SA(0, 1), a2 + hstepA, voffA);
            PG8_WAIT_V(8); PG8_WAIT_L(0); PG8_BAR; PG8_MMA(0, 0, At, B0); PG8_MMA(0, 1, At, B1); PG8_BAR; PG8_SCHED;
            PG8_LDA(At, 1, 1); PG8_STAGE(PG8_SB(1, 0), b3, voffB); PG8_STAGE(PG8_SB(1, 1), b3 + hstepB, voffB); PG8_STAGE(PG8_SA(1, 0), a3, voffA);
            PG8_WAIT_V(8); PG8_WAIT_L(0); PG8_BAR; PG8_MMA(1, 0, At, B0); PG8_MMA(1, 1, At, B1); PG8_BAR; PG8_SCHED;
            if constexpr (Epi::HOOK_KT > 0) { if (t + 2 == Epi::HOOK_KT) { E.hook(acc, cur, wr, wc, fr, fq); PG8_WAIT_V(0); PG8_SCHED; } }
        }
        if constexpr (ALIGN_EPI) { if (wr == 0) PG8_BAR; }
        if constexpr (!Epi::AFTER_DRAIN) { E(acc, cur, wr, wc, fr, fq); }
        if (!has_next) break;
#pragma unroll
        for (int a = 0; a < 2; ++a)
#pragma unroll
            for (int b = 0; b < 2; ++b)
#pragma unroll
                for (int m = 0; m < 4; ++m)
#pragma unroll
                    for (int n = 0; n < 2; ++n) acc[a][b][m][n] = (f32x4){0.f, 0.f, 0.f, 0.f};
        cur = nxt; cA = nA; cB = nB; ++ui;
        if constexpr (ALIGN_EPI) { if (wr == 1) PG8_BAR; }
    }
    PG8_WAIT_V(0);
    if constexpr (!ALIGN_EPI) { if (wr == 0) PG8_BAR; }
    PG8_BAR;
    if constexpr (Epi::AFTER_DRAIN) { E.fused(acc, cur, wr, wc, fr, fq, wid, lane, lds); }
#undef PG8_SA
#undef PG8_SB
#undef PG8_STAGE
#undef PG8_LDA
#undef PG8_LDB
#undef PG8_MMA
#undef PG8_WAIT_V
#undef PG8_WAIT_L
#undef PG8_BAR
#undef PG8_SCHED
}
}
using pg8::Unit;
typedef f32x4 Acc[2][2][4][2];
#define EPI_ROW(u, ai, wr, m, fr) ((u).pm * 256 + (ai) * 128 + (wr) * 64 + (m) * 16 + (fr))
#define EPI_LC(bj, wc, fq) ((bj) * 128 + (wc) * 32 + (fq) * 8)

constexpr int CW_XC = 14600;
struct EpiIn {
    static constexpr bool AFTER_DRAIN = false; static constexpr int HOOK_KT = 0;
    bf16_t *U, *QP, *QR, *KV0, *SP, *SA; float* GN; const float* RC; const float* RS;
    __device__ __forceinline__ void rope8(f32x4& v0, f32x4& v1, int t, bool apply, int fq) const {
        f32x4 p0, p1;
#pragma unroll
        for (int e = 0; e < 4; ++e) { p0[e] = __shfl_xor(v0[e], 16); p1[e] = __shfl_xor(v1[e], 16); }
        if (apply) {
            const f32x4 c0 = *(const f32x4*)(RC + t * 8), c1 = *(const f32x4*)(RC + t * 8 + 4), s0 = *(const f32x4*)(RS + t * 8), s1 = *(const f32x4*)(RS + t * 8 + 4);
            const float sg = (fq & 1) ? 1.f : -1.f;
            v0 = v0 * c0 + (p0 * s0) * sg; v1 = v1 * c1 + (p1 * s1) * sg;
        }
    }
    __device__ __forceinline__ void operator()(const Acc& acc, const Unit& u, int wr, int wc, int fr, int fq) const {
        OPAQUE(fr); OPAQUE(fq);
        const int pn = u.pn; const bool ropel = ((wc & 1) == 0) && fq < 2;
#pragma unroll
        for (int ai = 0; ai < 2; ++ai)
#pragma unroll
            for (int m = 0; m < 4; ++m) {
                const int r = EPI_ROW(u, ai, wr, m, fr), t = r & (SEQ - 1);
#pragma unroll
                for (int bj = 0; bj < 2; ++bj) {
                    const int lc = EPI_LC(bj, wc, fq); f32x4 v0 = acc[ai][bj][m][0], v1 = acc[ai][bj][m][1];
                    if (pn < 2) { *(u32x4*)(U + (size_t)r * 512 + pn * 256 + lc) = pack8(v0, v1); }
                    else if (pn < 6) {
                        v0 = v0 * C2; v1 = v1 * C2; const size_t o = (size_t)r * 1024 + (pn - 2) * 256 + lc;
                        *(u32x4*)(QP + o) = pack8(v0, v1);
                        if ((wc & 1) == 0) rope8(v0, v1, t, ropel, fq);
                        *(u32x4*)(QR + o) = pack8(v0, v1);
                    } else if (pn < 12) {
                        const int ty = pn - 6; bf16_t* dst = KV0 + (size_t)ty * (size_t)(4u << 20);
                        if ((ty == 2 || ty == 4) && (wc & 1) == 0) rope8(v0, v1, t, ropel, fq);
                        *(u32x4*)(dst + (size_t)r * 256 + lc) = pack8(v0, v1);
                    } else if (pn < 20) {
                        bf16_t* dst = pn < 16 ? SP : SA; const int cb = ((pn - 12) & 3) * 256 + lc;
#pragma unroll
                        for (int e = 0; e < 4; ++e) { v0[e] = sigmoidf_(v0[e]); v1[e] = sigmoidf_(v1[e]); }
                        *(u32x4*)(dst + (size_t)r * 1024 + cb) = pack8(v0, v1);
                    } else if (lc < 48) {
#pragma unroll
                        for (int e = 0; e < 4; ++e) { v0[e] = sigmoidf_(v0[e]); v1[e] = sigmoidf_(v1[e]); }
                        *(f32x4*)(GN + (size_t)r * 48 + lc) = v0; *(f32x4*)(GN + (size_t)r * 48 + lc + 4) = v1;
                    }
                }
            }
    }
};
__device__ __forceinline__ float gelu_tanh(float x) { const float u = 0.7978845608028654f * (x + 0.044715f * x * x * x); const float e = __expf(2.f * u); return 0.5f * x * (1.f + (1.f - 2.f * __builtin_amdgcn_rcpf(e + 1.f))); }
struct EpiCmp {
    static constexpr bool AFTER_DRAIN = true; static constexpr int HOOK_KT = 0;
    bf16_t *HIDK, *HIDV; const float *PEBK, *PEBV; const bf16_t *W2K, *W2V; bf16_t *KCMP, *VCMP; unsigned char* wsb; int split;
    template <int AI> __device__ __forceinline__ void gelu_half(const Acc& acc, bf16_t* HID, const float* peb, int rbase, int wr, int wc, int fr, int fq) const {
#pragma unroll
        for (int bj = 0; bj < 2; ++bj) {
            const int lc = EPI_LC(bj, wc, fq); const f32x4 b0 = *(const f32x4*)(peb + lc), b1 = *(const f32x4*)(peb + lc + 4);
#pragma unroll
            for (int m = 0; m < 4; ++m) {
                const int r = rbase + wr * 64 + m * 16 + fr; f32x4 v0 = acc[AI][bj][m][0] + b0, v1 = acc[AI][bj][m][1] + b1;
#pragma unroll
                for (int e = 0; e < 4; ++e) { v0[e] = gelu_tanh(v0[e]); v1[e] = gelu_tanh(v1[e]); }
                *(u32x4*)(HID + (size_t)r * 256 + lc) = pack8(v0, v1);
            }
        }
    }
    __device__ __forceinline__ void fused(Acc& acc, const Unit& u, int wr, int wc, int fr, int fq, int wid, int lane, LAS unsigned char*) const {
        OPAQUE(fr); OPAQUE(fq);
        const int h = u.pn, which = u.pm >> 4, rt = u.pm & 15; bf16_t* HID = which ? HIDV : HIDK; const float* peb = which ? PEBV : PEBK;
        if (split) {
            float* slabs = (float*)(wsb + (u.pm < 16 ? WS_WM : WS_WD)) + (size_t)((u.pm & 15) * 2) * (128 * 256);
            unsigned* cnt = (unsigned*)(wsb + WS_CTL) + CW_XC + (u.pm * 2) * 16;
            float* mine = slabs + (size_t)h * (128 * 256); const float* theirs = slabs + (size_t)(h ^ 1) * (128 * 256);
#pragma unroll
            for (int bj = 0; bj < 2; ++bj)
#pragma unroll
                for (int m = 0; m < 4; ++m) { float* p = mine + (size_t)(wr * 64 + m * 16 + fr) * 256 + EPI_LC(bj, wc, fq);
                    asm volatile("global_store_dwordx4 %0, %1, off sc0 sc1" :: "v"(p), "v"(acc[1][bj][m][0]) : "memory");
                    asm volatile("global_store_dwordx4 %0, %1, off offset:16 sc0 sc1" :: "v"(p), "v"(acc[1][bj][m][1]) : "memory"); }
            asm volatile("s_waitcnt vmcnt(0)" ::: "memory");
            if (lane == 0) __hip_atomic_fetch_add(cnt + 16 * h, 1u, __ATOMIC_RELAXED, __HIP_MEMORY_SCOPE_AGENT);
            if (wid == 0) {
                unsigned sp = 0; while ((unsigned)__builtin_amdgcn_readfirstlane((int)__hip_atomic_load(cnt + 16 * (h ^ 1), __ATOMIC_RELAXED, __HIP_MEMORY_SCOPE_AGENT)) < 8u && ++sp < (1u << 22)) __builtin_amdgcn_s_sleep(2);
            }
            asm volatile("s_waitcnt vmcnt(0) lgkmcnt(0)" ::: "memory"); __builtin_amdgcn_s_barrier(); asm volatile("" ::: "memory");
            __builtin_amdgcn_fence(__ATOMIC_ACQUIRE, "agent");
#pragma unroll
            for (int bj = 0; bj < 2; ++bj)
#pragma unroll
                for (int m = 0; m < 4; ++m) { const float* p = theirs + (size_t)(wr * 64 + m * 16 + fr) * 256 + EPI_LC(bj, wc, fq); acc[0][bj][m][0] += *(const f32x4*)p; acc[0][bj][m][1] += *(const f32x4*)(p + 4); }
        }
        gelu_half<0>(acc, HID, peb, rt * 256 + (split ? h * 128 : 0), wr, wc, fr, fq);
        if (!split) gelu_half<1>(acc, HID, peb, rt * 256 + 128, wr, wc, fr, fq);
        asm volatile("s_waitcnt vmcnt(0)" ::: "memory"); __syncthreads();
        const bf16_t* W2 = which ? W2V : W2K; bf16_t* OUT = which ? VCMP : KCMP; const int r0 = rt * 256 + (split ? h * 128 + wid * 16 : wid * 32);
        f32x4 c2[2][4];
#pragma unroll
        for (int mt = 0; mt < 2; ++mt)
#pragma unroll
            for (int nt = 0; nt < 4; ++nt) c2[mt][nt] = (f32x4){0.f, 0.f, 0.f, 0.f};
        for (int k0 = 0; k0 < 256; k0 += 32) {
            bf16x8 a[2], b[4];
#pragma unroll
            for (int mt = 0; mt < 2; ++mt) a[mt] = *(const bf16x8*)(HID + (size_t)(r0 + (split ? 0 : 16 * mt) + fr) * 256 + k0 + 8 * fq);
#pragma unroll
            for (int nt = 0; nt < 4; ++nt) b[nt] = *(const bf16x8*)(W2 + (size_t)(16 * nt + fr) * 256 + k0 + 8 * fq);
#pragma unroll
            for (int mt = 0; mt < 2; ++mt)
#pragma unroll
                for (int nt = 0; nt < 4; ++nt) c2[mt][nt] = __builtin_amdgcn_mfma_f32_16x16x32_bf16(a[mt], b[nt], c2[mt][nt], 0, 0, 0);
        }
#pragma unroll
        for (int mt = 0; mt < 2; ++mt) {
            if (mt == 0 || !split) {
#pragma unroll
            for (int nt = 0; nt < 4; ++nt)
#pragma unroll
                for (int r = 0; r < 4; ++r) OUT[(size_t)(r0 + 16 * mt + 4 * fq + r) * 64 + 16 * nt + fr] = (bf16_t)f2bf(c2[mt][nt][r]);
            }
        }
    }
};
struct EpiMerged {
    static constexpr bool AFTER_DRAIN = false; static constexpr int HOOK_KT = 8;
    bf16_t* MG; const bf16_t* SP; const bf16_t* SA;
    __device__ __forceinline__ void hook(Acc& acc, const Unit& u, int wr, int wc, int fr, int fq) const {
        OPAQUE(fr); OPAQUE(fq);
#pragma unroll
        for (int ai = 0; ai < 2; ++ai)
#pragma unroll
            for (int m = 0; m < 4; ++m) {
                const int r = EPI_ROW(u, ai, wr, m, fr);
#pragma unroll
                for (int bj = 0; bj < 2; ++bj) {
                    const size_t o = (size_t)r * 1024 + u.pn * 256 + EPI_LC(bj, wc, fq);
                    const u32x4 wp = *(const u32x4*)(SP + o), wa = *(const u32x4*)(SA + o); f32x4 p0, p1, a0, a1; unpack8(wp, p0, p1); unpack8(wa, a0, a1);
#pragma unroll
                    for (int e = 0; e < 4; ++e) { acc[ai][bj][m][0][e] *= p0[e] * __builtin_amdgcn_rcpf(a0[e]); acc[ai][bj][m][1][e] *= p1[e] * __builtin_amdgcn_rcpf(a1[e]); }
                }
            }
    }
    __device__ __forceinline__ void operator()(const Acc& acc, const Unit& u, int wr, int wc, int fr, int fq) const {
        OPAQUE(fr); OPAQUE(fq);
#pragma unroll
        for (int ai = 0; ai < 2; ++ai)
#pragma unroll
            for (int m = 0; m < 4; ++m) {
                const int r = EPI_ROW(u, ai, wr, m, fr);
#pragma unroll
                for (int bj = 0; bj < 2; ++bj) {
                    const size_t o = (size_t)r * 1024 + u.pn * 256 + EPI_LC(bj, wc, fq);
                    const u32x4 wa = *(const u32x4*)(SA + o); f32x4 a0, a1; unpack8(wa, a0, a1);
                    *(u32x4*)(MG + o) = pack8(acc[ai][bj][m][0] * a0, acc[ai][bj][m][1] * a1);
                }
            }
    }
};
struct EpiX1 {
    static constexpr bool AFTER_DRAIN = false; static constexpr int HOOK_KT = 0;
    const float* x; float* X1; bf16_t* X1B; float* RSP;
    __device__ __forceinline__ void operator()(const Acc& acc, const Unit& u, int wr, int wc, int fr, int fq) const {
        OPAQUE(fr); OPAQUE(fq);
#pragma unroll
        for (int ai = 0; ai < 2; ++ai)
#pragma unroll
            for (int m = 0; m < 4; ++m) {
                const int r = EPI_ROW(u, ai, wr, m, fr); float s = 0.f;
#pragma unroll
                for (int bj = 0; bj < 2; ++bj) {
                    const size_t o = (size_t)r * 1024 + u.pn * 256 + EPI_LC(bj, wc, fq);
                    const f32x4 o0 = *(const f32x4*)(x + o) + acc[ai][bj][m][0], o1 = *(const f32x4*)(x + o + 4) + acc[ai][bj][m][1];
                    *(u32x4*)(X1B + o) = pack8(o0, o1);
                    s += (o0[0] * o0[0] + o0[1] * o0[1]) + (o0[2] * o0[2] + o0[3] * o0[3]) + (o1[0] * o1[0] + o1[1] * o1[1]) + (o1[2] * o1[2] + o1[3] * o1[3]);
                }
                s += __shfl_xor(s, 16); s += __shfl_xor(s, 32);
                if (fq == 0) RSP[(size_t)r * 16 + u.pn * 4 + wc] = s;
            }
    }
};
struct EpiAct {
    static constexpr bool AFTER_DRAIN = false; static constexpr int HOOK_KT = 0;
    bf16_t* ACT; const float* RSP;
    __device__ __forceinline__ void operator()(const Acc& acc, const Unit& u, int wr, int wc, int fr, int fq) const {
        OPAQUE(fr); OPAQUE(fq);
#pragma unroll
        for (int ai = 0; ai < 2; ++ai)
#pragma unroll
            for (int m = 0; m < 4; ++m) {
                const int r = EPI_ROW(u, ai, wr, m, fr); const f32x4* rp = (const f32x4*)(RSP + (size_t)r * 16);
                const f32x4 q0 = rp[0], q1 = rp[1], q2 = rp[2], q3 = rp[3];
                const float ss = ((q0[0] + q0[1]) + (q0[2] + q0[3])) + ((q1[0] + q1[1]) + (q1[2] + q1[3])) + ((q2[0] + q2[1]) + (q2[2] + q2[3])) + ((q3[0] + q3[1]) + (q3[2] + q3[3]));
                const float rstd = rsqrtf(ss * (1.f / DM) + RMS_EPS);
                f32x4 o[2];
#pragma unroll
                for (int n = 0; n < 2; ++n)
#pragma unroll
                    for (int e = 0; e < 4; ++e) { const float gg = acc[ai][0][m][n][e] * rstd, uu = acc[ai][1][m][n][e] * rstd; o[n][e] = gg * sigmoidf_(gg) * uu; }
                *(u32x4*)(ACT + (size_t)r * DFF + u.pn * 128 + wc * 32 + fq * 8) = pack8(o[0], o[1]);
            }
    }
};
struct EpiX2 {
    static constexpr bool AFTER_DRAIN = false; static constexpr int HOOK_KT = 0;
    float* X; const bf16_t* X1B;
    __device__ __forceinline__ void operator()(const Acc& acc, const Unit& u, int wr, int wc, int fr, int fq) const {
        OPAQUE(fr); OPAQUE(fq);
#pragma unroll
        for (int ai = 0; ai < 2; ++ai)
#pragma unroll
            for (int m = 0; m < 4; ++m) {
                const int r = EPI_ROW(u, ai, wr, m, fr);
#pragma unroll
                for (int bj = 0; bj < 2; ++bj) {
                    const size_t o = (size_t)r * 1024 + u.pn * 256 + EPI_LC(bj, wc, fq); float* p = X + o;
                    const u32x4 xw = *(const u32x4*)(X1B + o); f32x4 x0, x1v; unpack8(xw, x0, x1v);
                    *(f32x4*)p = x0 + acc[ai][bj][m][0]; *(f32x4*)(p + 4) = x1v + acc[ai][bj][m][1];
                }
            }
    }
};
struct EpiFinal {
    static constexpr bool AFTER_DRAIN = true; static constexpr int HOOK_KT = 0;
    float* X; const bf16_t* X1B; const float* nw; float* slots; unsigned* cnt;
    __device__ __forceinline__ void fused(Acc& acc, const Unit& u, int wr, int wc, int fr, int fq, int wid, int lane, LAS unsigned char* lds) const {
        OPAQUE(fr); OPAQUE(fq);
        LAS float* Pl = (LAS float*)lds;
        LAS float* Sr = (LAS float*)(lds + 4096);
#pragma unroll
        for (int ai = 0; ai < 2; ++ai)
#pragma unroll
            for (int m = 0; m < 4; ++m) {
                const int r = EPI_ROW(u, ai, wr, m, fr); float sq = 0.f;
#pragma unroll
                for (int bj = 0; bj < 2; ++bj) {
                    { const u32x4 xw = *(const u32x4*)(X1B + (size_t)r * 1024 + u.pn * 256 + EPI_LC(bj, wc, fq)); f32x4 x0, x1v; unpack8(xw, x0, x1v); acc[ai][bj][m][0] += x0; acc[ai][bj][m][1] += x1v; }
                    const f32x4 a = acc[ai][bj][m][0], b = acc[ai][bj][m][1];
                    sq += ((a[0] * a[0] + a[1] * a[1]) + (a[2] * a[2] + a[3] * a[3])) + ((b[0] * b[0] + b[1] * b[1]) + (b[2] * b[2] + b[3] * b[3]));
                }
                sq += __shfl_xor(sq, 16); sq += __shfl_xor(sq, 32);
                if (fq == 0) Pl[(ai * 128 + wr * 64 + m * 16 + fr) * 4 + wc] = sq;
            }
        asm volatile("s_waitcnt lgkmcnt(0)" ::: "memory"); __builtin_amdgcn_s_barrier(); asm volatile("" ::: "memory");
        const int row = wid * 32 + (lane & 31);
        if (lane < 32) { const f32x4 q4 = *(const LAS f32x4*)(Pl + row * 4);
            __hip_atomic_store(slots + (size_t)(u.pm * 256 + row) * 4 + u.pn, (q4[0] + q4[1]) + (q4[2] + q4[3]), __ATOMIC_RELAXED, __HIP_MEMORY_SCOPE_AGENT); }
        asm volatile("s_waitcnt vmcnt(0)" ::: "memory");
        if (lane == 0) __hip_atomic_fetch_add(cnt + 64 * u.pm, 1u, __ATOMIC_RELAXED, __HIP_MEMORY_SCOPE_AGENT);
        if (wid == 0) {
            unsigned sp = 0; while ((unsigned)__builtin_amdgcn_readfirstlane((int)__hip_atomic_load(cnt + 64 * u.pm, __ATOMIC_RELAXED, __HIP_MEMORY_SCOPE_AGENT)) < 32u && ++sp < (1u << 22)) __builtin_amdgcn_s_sleep(2);
            __builtin_amdgcn_fence(__ATOMIC_ACQUIRE, "agent");
        }
        asm volatile("s_waitcnt vmcnt(0) lgkmcnt(0)" ::: "memory"); __builtin_amdgcn_s_barrier(); asm volatile("" ::: "memory");
        if (lane < 32) { const float* sl = slots + (size_t)(u.pm * 256 + row) * 4; float t = 0.f;
#pragma unroll
            for (int k = 0; k < 4; ++k) t += __hip_atomic_load(sl + k, __ATOMIC_RELAXED, __HIP_MEMORY_SCOPE_AGENT);
            Sr[row] = rsqrtf(t * (1.f / DM) + RMS_EPS); }
        asm volatile("s_waitcnt lgkmcnt(0)" ::: "memory"); __builtin_amdgcn_s_barrier(); asm volatile("" ::: "memory");
#pragma unroll
        for (int bj = 0; bj < 2; ++bj) {
            const int c0 = u.pn * 256 + EPI_LC(bj, wc, fq); const f32x4 w0 = *(const f32x4*)(nw + c0), w1 = *(const f32x4*)(nw + c0 + 4);
#pragma unroll
            for (int ai = 0; ai < 2; ++ai)
#pragma unroll
                for (int m = 0; m < 4; ++m) {
                    const int rl = ai * 128 + wr * 64 + m * 16 + fr; const float rs = Sr[rl]; float* p = X + (size_t)(u.pm * 256 + rl) * 1024 + c0;
                    *(f32x4*)p = acc[ai][bj][m][0] * w0 * rs; *(f32x4*)(p + 4) = acc[ai][bj][m][1] * w1 * rs;
                }
        }
    }
};
struct CmpSched {
    const char *KC, *VC, *W1K, *W1V; int c, split;
    __device__ bool next(int i, Unit& u) const {
        if (i > 0 || c >= (split ? 64 : 32)) return false;
        const int un = split ? c >> 1 : c, hk = split ? c & 1 : 0;
        const int which = un >> 4, rt = un & 15, bg = rt >> 1, half = rt & 1, b = bg >> 2, g = bg & 3;
        u.pm = un; u.pn = hk; u.A = (which ? VC : KC) + ((size_t)(b * SEQ + 16 * 256 * half + 16 * hk + (hk ? 16 * 128 : 0)) * 256 + g * 64) * 2; u.B = (which ? W1V : W1K) + (size_t)hk * 2048; return true;
    }
};

struct SF_in { const float* W; __device__ __forceinline__ float operator()(int k, int n) const { const int r = incol_ref(n); return r < 0 ? 0.f : W[(size_t)k * NREF + r]; } };
struct SF_plain { const float* W; int ldn; __device__ __forceinline__ float operator()(int k, int n) const { return W[(size_t)k * ldn + n]; } };
struct SF_gu { const float *Wg, *Wu, *nw; __device__ __forceinline__ float operator()(int k, int n) const {
    const int tile = n >> 8, half = (n >> 7) & 1, j = n & 127, col = tile * 128 + j; const ptrdiff_t d = Wu - Wg; return nw[k] * Wg[(ptrdiff_t)half * d + (ptrdiff_t)k * DFF + col]; } };
__device__ __forceinline__ void p0_tile_out(int K, bf16_t* WT, LAS float* scr, int k0, int n0, int lane) {
    WSYNC();
    const int c = lane & 7;
#pragma unroll
    for (int j = 0; j < 4; ++j) { const int n = (lane >> 3) + 8 * j; const LAS float* s = scr + (8 * c) * 33 + n;
        u32x4 o; o.x = pk2(s[0 * 33], s[1 * 33]); o.y = pk2(s[2 * 33], s[3 * 33]); o.z = pk2(s[4 * 33], s[5 * 33]); o.w = pk2(s[6 * 33], s[7 * 33]);
        *(u32x4*)(WT + (size_t)(n0 + n) * K + k0 + 8 * c) = o; }
    WSYNC();
}
template <class SF> __device__ __forceinline__ void p0_transpose_item(const SF& sf, int K, int N, bf16_t* WT, LAS float* scr, int item, int lane) {
    const int nblk = N / 32, kb = item / nblk, nb = item % nblk, k0 = 64 * kb, n0 = 32 * nb;
    float v[32];
#pragma unroll
    for (int i = 0; i < 32; ++i) v[i] = sf(k0 + 2 * i + (lane >> 5), n0 + (lane & 31));
#pragma unroll
    for (int i = 0; i < 32; ++i) scr[(2 * i + (lane >> 5)) * 33 + (lane & 31)] = v[i];
    p0_tile_out(K, WT, scr, k0, n0, lane);
}
__device__ __forceinline__ void p0_fold_item(const float* pool_w, const float* pool_scale, const float* Wp, bf16_t* WT, int f, int wave, int lane) {
    const int k0 = 64 * (f >> 5), n0 = 32 * (f & 31) + 4 * wave, g = k0 >> 7;
    f32x4 acc = (f32x4){0.f, 0.f, 0.f, 0.f};
    const float* arow = pool_w + (size_t)(k0 + lane) * 128;
#pragma unroll 4
    for (int dp = 0; dp < 128; dp += 4) {
        const f32x4 a = *(const f32x4*)(arow + dp); const f32x4 sc = *(const f32x4*)(pool_scale + g * 128 + dp);
#pragma unroll
        for (int e = 0; e < 4; ++e) { const f32x4 w4 = *(const f32x4*)(Wp + (size_t)(g * 128 + dp + e) * 1024 + n0); acc += w4 * (a[e] * sc[e]); }
    }
#pragma unroll
    for (int j = 0; j < 4; ++j) WT[(size_t)(n0 + j) * 1536 + k0 + lane] = (bf16_t)f2bf(acc[j]);
}
template <int PART> __device__ __forceinline__ void p0_prologue(KParams P, LAS unsigned char* lds, int gw, int NGW, int wave, int lane) {
    unsigned char* ws = P->ws;
    LAS float* scr = (LAS float*)(lds + wave * 16384);
    constexpr int I_IN = (1024 / 64) * (NIN / 32), I_W1 = (2048 / 64) * (256 / 32), I_W2 = (256 / 64) * (64 / 32), I_WM = (1024 / 64) * (1024 / 32), I_WO = (1024 / 64) * (1024 / 32),
                  I_GU = (1024 / 64) * (5632 / 32), I_WD = (2816 / 64) * (1024 / 32);
    if constexpr (PART == 1) {
        constexpr int NITEMS = I_WM + I_WO + I_WD;
        for (int f = gw >> 3; f < 256; f += NGW >> 3) p0_fold_item(P->pool_w, P->pool_scale, P->w_pp, (bf16_t*)(ws + WS_WM), f, wave, lane);
        for (int it = gw; it < NITEMS; it += NGW) {
            int r = it;
            if (r < I_WM) { p0_transpose_item(SF_plain{P->w_pa, 1024}, 1536, 1024, (bf16_t*)(ws + WS_WM) + 512, scr, r, lane); continue; } r -= I_WM;
            if (r < I_WO) { p0_transpose_item(SF_plain{P->w_out, 1024}, 1024, 1024, (bf16_t*)(ws + WS_WO), scr, r, lane); continue; } r -= I_WO;
            p0_transpose_item(SF_plain{P->w_d, 1024}, 2816, 1024, (bf16_t*)(ws + WS_WD), scr, r, lane);
        }
        return;
    }
    constexpr int NITEMS = I_IN + 2 * I_W1 + 2 * I_W2 + I_GU;
    for (int it = gw; it < NITEMS; it += NGW) {
        int r = it;
        if (r < I_GU) { p0_transpose_item(SF_gu{P->w_g, P->w_u, P->norm2_w}, 1024, 5632, (bf16_t*)(ws + WS_WGU), scr, r, lane); continue; } r -= I_GU;
        if (r < I_IN) { p0_transpose_item(SF_in{P->w_in}, 1024, NIN, (bf16_t*)(ws + WS_WIN), scr, r, lane); continue; } r -= I_IN;
        if (r < I_W1) { p0_transpose_item(SF_plain{P->w1_k, 256}, 2048, 256, (bf16_t*)(ws + WS_W1K), scr, r, lane); continue; } r -= I_W1;
        if (r < I_W1) { p0_transpose_item(SF_plain{P->w1_v, 256}, 2048, 256, (bf16_t*)(ws + WS_W1V), scr, r, lane); continue; } r -= I_W1;
        if (r < I_W2) { p0_transpose_item(SF_plain{P->w2_k, 64}, 256, 64, (bf16_t*)(ws + WS_W2K), scr, r, lane); continue; } r -= I_W2;
        p0_transpose_item(SF_plain{P->w2_v, 64}, 256, 64, (bf16_t*)(ws + WS_W2V), scr, r, lane);
    }
    for (int it = (gw & 31) ? 64 : (gw >> 5); it < 64; it += NGW >> 5) {
        const int which = it >> 5, c0 = (it & 31) * 8; const float* pe = which ? P->pe_v : P->pe_k; const float* w1 = which ? P->w1_v : P->w1_k; const float* b1 = which ? P->b1_v : P->b1_k;
        f32x4 s0 = (f32x4){0.f, 0.f, 0.f, 0.f}, s1 = s0;
#pragma unroll 8
        for (int j = 0; j < 32; ++j) { const int k = lane + 64 * j; const float p = pe[k]; s0 += *(const f32x4*)(w1 + (size_t)k * 256 + c0) * p; s1 += *(const f32x4*)(w1 + (size_t)k * 256 + c0 + 4) * p; }
#pragma unroll
        for (int e = 0; e < 4; ++e) { s0[e] = wave_sum(s0[e]); s1[e] = wave_sum(s1[e]); }
        if (lane == 0) { float* o = (float*)(ws + (which ? WS_PEBV : WS_PEBK)) + c0; *(f32x4*)o = s0 + *(const f32x4*)(b1 + c0); *(f32x4*)(o + 4) = s1 + *(const f32x4*)(b1 + c0 + 4); }
    }
    for (int it = gw; it < SEQ * 8 / 64; it += NGW) {
        const int idx = it * 64 + lane, i = idx & 7, t = idx >> 3;
        const float inv_freq = i == 0 ? 1.0f : i == 1 ? 0.193922758102417f : i == 2 ? 0.03760603070259094f : i == 3 ? 0.00729266507551074f : i == 4 ? 0.001414213445968926f : i == 5 ? 0.00027424818836152554f : i == 6 ? 5.318296462064609e-05f : 1.0313385246263351e-05f;
        const float ang = (float)t * inv_freq;
        ((float*)(ws + WS_RCOS))[idx] = cosf(ang); ((float*)(ws + WS_RSIN))[idx] = sinf(ang);
    }
    bf16_t* H = (bf16_t*)((char*)P->out + DO_H);
#pragma unroll 1
    for (int row = gw; row < T; row += NGW) {
        const f32x4* xr = (const f32x4*)(P->x + (size_t)row * DM) + lane; const f32x4* wr = (const f32x4*)P->norm1_w + lane;
        f32x4 v[4]; float s = 0.f;
#pragma unroll
        for (int j = 0; j < 4; ++j) { v[j] = xr[64 * j]; s += (v[j].x * v[j].x + v[j].y * v[j].y) + (v[j].z * v[j].z + v[j].w * v[j].w); }
        const float rstd = rsqrtf(wave_sum(s) * (1.f / DM) + RMS_EPS);
        u32x2* o = (u32x2*)(H + (size_t)row * DM) + lane;
#pragma unroll
        for (int j = 0; j < 4; ++j) { const f32x4 ww = wr[64 * j]; u32x2 p; p.x = pk2(v[j].x * rstd * ww.x, v[j].y * rstd * ww.y); p.y = pk2(v[j].z * rstd * ww.z, v[j].w * rstd * ww.w); o[64 * j] = p; }
    }
}
template <int W> __device__ __forceinline__ void pooled_item(const bf16_t* U, bf16_t* PA, int g, int rb, int lane) {
    const int row = rb * 4 + (lane >> 4), c0 = g * 128 + (lane & 15) * 8, t = row & (SEQ - 1), cnt = t + 1 < W ? t + 1 : W;
    u32x4 q[W];
#pragma unroll
    for (int i = 0; i < W; ++i) q[i] = *(const u32x4*)(U + (size_t)(row - (i < cnt ? i : 0)) * 512 + c0);
    f32x4 u0, u1; unpack8(q[0], u0, u1); f32x4 s0 = u0, s1 = u1;
#pragma unroll
    for (int i = 1; i < W; ++i) { f32x4 a, b; unpack8(q[i], a, b); if (i < cnt) { s0 += a; s1 += b; } }
    const float ic = 1.f / (float)cnt;
    *(u32x4*)(PA + (size_t)row * 1536 + c0) = pack8(s0 * ic - u0, s1 * ic - u1);
}
template <int W> __device__ __forceinline__ void pooled_load(const bf16_t* U, int g, int rb, int lane, u32x4 (&q)[W]) {
    const int row = rb * 4 + (lane >> 4), c0 = g * 128 + (lane & 15) * 8, t = row & (SEQ - 1), cnt = t + 1 < W ? t + 1 : W;
#pragma unroll
    for (int i = 0; i < W; ++i) q[i] = *(const u32x4*)(U + (size_t)(row - (i < cnt ? i : 0)) * 512 + c0);
}
template <int W> __device__ __forceinline__ void pooled_store(bf16_t* PA, int g, int rb, int lane, const u32x4 (&q)[W]) {
    const int row = rb * 4 + (lane >> 4), c0 = g * 128 + (lane & 15) * 8, t = row & (SEQ - 1), cnt = t + 1 < W ? t + 1 : W;
    f32x4 u0, u1; unpack8(q[0], u0, u1); f32x4 s0 = u0, s1 = u1;
#pragma unroll
    for (int i = 1; i < W; ++i) { f32x4 a, b; unpack8(q[i], a, b); if (i < cnt) { s0 += a; s1 += b; } }
    const float ic = 1.f / (float)cnt;
    *(u32x4*)(PA + (size_t)row * 1536 + c0) = pack8(s0 * ic - u0, s1 * ic - u1);
}
__device__ __forceinline__ void p2_pooled(const bf16_t* U, bf16_t* PA, int gw, int NGW, int lane) {
#pragma unroll 1
    for (int rb = gw; rb < T / 4; rb += NGW) {
        { u32x4 q16[16]; pooled_load<16>(U, 3, rb, lane, q16); pooled_store<16>(PA, 3, rb, lane, q16); }
        { u32x4 q2[2], q4[4], q8[8]; pooled_load<8>(U, 2, rb, lane, q8); pooled_load<4>(U, 1, rb, lane, q4); pooled_load<2>(U, 0, rb, lane, q2);
          pooled_store<2>(PA, 0, rb, lane, q2); pooled_store<4>(PA, 1, rb, lane, q4); pooled_store<8>(PA, 2, rb, lane, q8); }
    }
}

constexpr int CW_DQ = 14400;
constexpr int DQ_FOLD = 2048, DQ_I_WM = (1024 / 64) * (1024 / 32), DQ_I_WO = DQ_I_WM, DQ_I_WD = (2816 / 64) * (1024 / 32), DQ_TR = (DQ_I_WM + DQ_I_WO + DQ_I_WD) / 2, DQ_NT = DQ_FOLD + DQ_TR;
__device__ __forceinline__ void late_weights_queue(KParams P, LAS unsigned char* lds, int wave, int lane) {
    unsigned char* ws = P->ws; unsigned* ctl = (unsigned*)(ws + WS_CTL);
    LAS float* scr = (LAS float*)(lds + wave * 16384);
#pragma unroll 1
    for (;;) {
        unsigned tk = 0u;
        if (lane == 0) tk = __hip_atomic_fetch_add(ctl + CW_DQ, 1u, __ATOMIC_RELAXED, __HIP_MEMORY_SCOPE_AGENT);
        const int t = __builtin_amdgcn_readfirstlane((int)tk);
        if (t >= DQ_NT) break;
        if (t < DQ_FOLD) p0_fold_item(P->pool_w, P->pool_scale, P->w_pp, (bf16_t*)(ws + WS_WM), t >> 3, t & 7, lane);
        else {
#pragma unroll 1
            for (int q = 0; q < 2; ++q) {
                int r = (t - DQ_FOLD) * 2 + q;
                if (r < DQ_I_WD) { p0_transpose_item(SF_plain{P->w_d, 1024}, 2816, 1024, (bf16_t*)(ws + WS_WD), scr, r, lane); continue; } r -= DQ_I_WD;
                if (r < DQ_I_WM) { p0_transpose_item(SF_plain{P->w_pa, 1024}, 1536, 1024, (bf16_t*)(ws + WS_WM) + 512, scr, r, lane); continue; } r -= DQ_I_WM;
                p0_transpose_item(SF_plain{P->w_out, 1024}, 1024, 1024, (bf16_t*)(ws + WS_WO), scr, r, lane);
            }
        }
    }
}

namespace nsa {
constexpr int NS = 4, SLOT = 16384, RING = NS * SLOT, WSCR = 8704;
constexpr float THR = 8.f;
typedef short v4i16_t __attribute__((ext_vector_type(4)));
__device__ __forceinline__ float xor1_add(float v) { return v + __builtin_bit_cast(float, __builtin_amdgcn_mov_dpp(__builtin_bit_cast(int, v), 0xB1, 0xF, 0xF, true)); }
__device__ __forceinline__ float xor2_add(float v) { return v + __builtin_bit_cast(float, __builtin_amdgcn_mov_dpp(__builtin_bit_cast(int, v), 0x4E, 0xF, 0xF, true)); }
__device__ __forceinline__ float gmax(float m) {
    auto a = __builtin_amdgcn_permlane16_swap(__float_as_uint(m), __float_as_uint(m), false, false); m = fmaxf(__uint_as_float(a[0]), __uint_as_float(a[1]));
    auto b = __builtin_amdgcn_permlane32_swap(__float_as_uint(m), __float_as_uint(m), false, false); return fmaxf(__uint_as_float(b[0]), __uint_as_float(b[1])); }
__device__ __forceinline__ float gsum(float m) {
    auto a = __builtin_amdgcn_permlane16_swap(__float_as_uint(m), __float_as_uint(m), false, false); m = __uint_as_float(a[0]) + __uint_as_float(a[1]);
    auto b = __builtin_amdgcn_permlane32_swap(__float_as_uint(m), __float_as_uint(m), false, false); return __uint_as_float(b[0]) + __uint_as_float(b[1]); }
struct Lane {
    int wave, lane, g, c; unsigned kbase, vbase; unsigned lds0;
    __device__ __forceinline__ void init(int tid, LAS unsigned char* lds) {
        lane = tid & 63; wave = __builtin_amdgcn_readfirstlane(tid >> 6); g = lane >> 4; c = lane & 15; lds0 = (unsigned)(size_t)lds;
        kbase = (unsigned)(c * 128 + ((g ^ (lane & 7)) << 4));
        const int q = (lane >> 2) & 3, p = lane & 3, rx = 4 * (g & 1) + q;
        vbase = (unsigned)((4 * g + q) * 128 + (((p >> 1) ^ rx) << 4) + (p & 1) * 8);
    }
};
struct Src { const char* k; const char* v; unsigned loff, tstride; };
__device__ __forceinline__ Src make_src(const bf16_t* K, const bf16_t* V, size_t row0, int stride_el, int col0, const Lane& L) {
    Src s; s.k = (const char*)(K + row0 * stride_el + col0); s.v = (const char*)(V + row0 * stride_el + col0);
    const int R = 8 * L.wave + (L.lane >> 3), ch = (L.lane & 7) ^ ((L.lane >> 3) & 7);
    s.loff = (unsigned)((R * stride_el + ch * 8) * 2); s.tstride = (unsigned)(64 * stride_el * 2); return s;
}
__device__ __forceinline__ void glds16(const void* gsrc, unsigned lds_dst) { unsigned keep;
    asm volatile("s_mov_b32 %0, m0\n\ts_mov_b32 m0, %2\n\ts_nop 0\n\tglobal_load_lds_dwordx4 %1, off\n\ts_mov_b32 m0, %0" : "=&s"(keep) : "v"(gsrc), "s"(lds_dst) : "memory"); }
__device__ __forceinline__ void issue(const Lane& L, const Src& S, int tile, int slot) {
    const char* gk = S.k + (size_t)tile * S.tstride + S.loff; const char* gv = S.v + (size_t)tile * S.tstride + S.loff;
    const unsigned d = (unsigned)__builtin_amdgcn_readfirstlane((int)(L.lds0 + slot * SLOT + L.wave * 1024));
    glds16(gk, d); glds16(gv, d + 8192);
}
struct Frags { unsigned k0, k1, v0, v1, v2, v3; };
typedef Frags TileAddr;
template <bool WITH_V> __device__ __forceinline__ void load_frags(const TileAddr& A, const Lane& L, Frags& F) { F = A; }
__device__ __forceinline__ void load_k(const Frags& F, const Lane& L, bf16x8 (&kf)[4][2]) {
#pragma unroll
    for (int mt = 0; mt < 4; ++mt) {
        kf[mt][0] = *(const LAS bf16x8*)((const LAS unsigned char*)(size_t)F.k0 + mt * 2048);
        kf[mt][1] = *(const LAS bf16x8*)((const LAS unsigned char*)(size_t)F.k1 + mt * 2048);
    }
}
__device__ __forceinline__ void load_vdt(unsigned va, bf16x8 (&vf)[2]) {
#pragma unroll
    for (int ks = 0; ks < 2; ++ks) {
        const v4i16_t lo = __builtin_amdgcn_ds_read_tr16_b64_v4i16((LAS v4i16_t*)((LAS unsigned char*)(size_t)va + ks * 4096));
        const v4i16_t hi = __builtin_amdgcn_ds_read_tr16_b64_v4i16((LAS v4i16_t*)((LAS unsigned char*)(size_t)va + ks * 4096 + 2048));
        vf[ks] = (bf16x8){lo[0], lo[1], lo[2], lo[3], hi[0], hi[1], hi[2], hi[3]};
    }
}
__device__ __forceinline__ void load_v(const Frags& F, const Lane& L, bf16x8 (&vf)[4][2]) { load_vdt(F.v0, vf[0]); load_vdt(F.v1, vf[1]); load_vdt(F.v2, vf[2]); load_vdt(F.v3, vf[3]); }
template <bool WITH_V, bool MASKED, class MaskFn>
__device__ __forceinline__ void visit_slow(const Frags& F, const Lane& L, const bf16x8 (&q)[2], f32x4 (&o)[4], float& mref, float& lsum, bool colsel, const MaskFn& valid) {
    const bool seen = mref != -INFINITY;
    const float c0 = colsel ? (seen ? -mref : 0.f) : -INFINITY;
    const f32x4 ci = (f32x4){c0, c0, c0, c0};
    f32x4 s[4];
    { bf16x8 kf[4][2]; load_k(F, L, kf);
#pragma unroll
    for (int mt = 0; mt < 4; ++mt) {
        s[mt] = __builtin_amdgcn_mfma_f32_16x16x32_bf16(kf[mt][0], q[0], ci, 0, 0, 0);
        s[mt] = __builtin_amdgcn_mfma_f32_16x16x32_bf16(kf[mt][1], q[1], s[mt], 0, 0, 0);
    } }
    __builtin_amdgcn_sched_barrier(0);
    bf16x8 vf[4][2]; if constexpr (WITH_V) load_v(F, L, vf);
    if constexpr (MASKED) {
#pragma unroll
        for (int mt = 0; mt < 4; ++mt)
#pragma unroll
            for (int r = 0; r < 4; ++r) if (!valid(16 * mt + 4 * L.g + r)) s[mt][r] = -INFINITY;
    }
    float mx = fmaxf(fmaxf(s[0][0], s[0][1]), fmaxf(s[0][2], s[0][3]));
#pragma unroll
    for (int mt = 1; mt < 4; ++mt) mx = fmaxf(mx, fmaxf(fmaxf(s[mt][0], s[mt][1]), fmaxf(s[mt][2], s[mt][3])));
    if (__any((mx > THR) || (!seen && mx > -INFINITY))) {
        const float mxr = gmax(mx);
        const float d = (mxr == -INFINITY) ? 0.f : (seen ? fmaxf(mxr, 0.f) : mxr);
        const float f = __builtin_amdgcn_exp2f(-d);
        if (mxr != -INFINITY) mref = (seen ? mref : 0.f) + d;
#pragma unroll
        for (int mt = 0; mt < 4; ++mt) s[mt] = s[mt] - d;
        lsum *= f;
        if constexpr (WITH_V) {
#pragma unroll
            for (int dt = 0; dt < 4; ++dt) o[dt] = o[dt] * f;
        }
    }
#pragma unroll
    for (int mt = 0; mt < 4; ++mt)
#pragma unroll
        for (int r = 0; r < 4; ++r) s[mt][r] = __builtin_amdgcn_exp2f(s[mt][r]);
    bf16x8 pf[2];
#pragma unroll
    for (int ks = 0; ks < 2; ++ks) { const u32x4 w = pack8(s[2 * ks], s[2 * ks + 1]); pf[ks] = __builtin_bit_cast(bf16x8, w); }
    { const f32x4 t4 = (s[0] + s[1]) + (s[2] + s[3]); lsum += (t4[0] + t4[1]) + (t4[2] + t4[3]); }
    if constexpr (WITH_V) {
#pragma unroll
        for (int dt = 0; dt < 4; ++dt)
#pragma unroll
            for (int ks = 0; ks < 2; ++ks) o[dt] = __builtin_amdgcn_mfma_f32_16x16x32_bf16(vf[dt][ks], pf[ks], o[dt], 0, 0, 0);
    }
}
template <bool MASKED, class MaskA, class MaskB>
__device__ __forceinline__ void visitB2(const Frags& F, const Lane& L, const bf16x8 (&qA)[2], const bf16x8 (&qB)[2], f32x4 (&oA)[4], f32x4 (&oB)[4], float msA, float msB, float invA, float invB,
                                        const MaskA& validA, const MaskB& validB, LAS float* impA, LAS float* impB, int jb) {
    const float cA = -msA, cB = -msB; const f32x4 ciA = (f32x4){cA, cA, cA, cA}, ciB = (f32x4){cB, cB, cB, cB};
    f32x4 sA[4], sB[4];
    { bf16x8 kf[4][2]; load_k(F, L, kf);
#pragma unroll
    for (int mt = 0; mt < 4; ++mt) {
        sA[mt] = __builtin_amdgcn_mfma_f32_16x16x32_bf16(kf[mt][0], qA[0], ciA, 0, 0, 0);
        sB[mt] = __builtin_amdgcn_mfma_f32_16x16x32_bf16(kf[mt][0], qB[0], ciB, 0, 0, 0);
        sA[mt] = __builtin_amdgcn_mfma_f32_16x16x32_bf16(kf[mt][1], qA[1], sA[mt], 0, 0, 0);
        sB[mt] = __builtin_amdgcn_mfma_f32_16x16x32_bf16(kf[mt][1], qB[1], sB[mt], 0, 0, 0);
    } }

    bf16x8 vf[4][2]; load_v(F, L, vf);
#pragma unroll
    for (int mt = 0; mt < 4; ++mt) {
#pragma unroll
        for (int r = 0; r < 4; ++r) {
            sA[mt][r] = (!MASKED || validA(16 * mt + 4 * L.g + r)) ? __builtin_amdgcn_exp2f(sA[mt][r]) * invA : 0.f;
            sB[mt][r] = (!MASKED || validB(16 * mt + 4 * L.g + r)) ? __builtin_amdgcn_exp2f(sB[mt][r]) * invB : 0.f;
        }
        float va = (sA[mt][0] + sA[mt][1]) + (sA[mt][2] + sA[mt][3]), va3 = sA[mt][3], vb = (sB[mt][0] + sB[mt][1]) + (sB[mt][2] + sB[mt][3]), vb3 = sB[mt][3];
        va = xor2_add(xor1_add(va)); va3 = xor2_add(xor1_add(va3)); vb = xor2_add(xor1_add(vb)); vb3 = xor2_add(xor1_add(vb3));
        if ((L.c & 3) == 0) { const int j = jb + 4 * mt + L.g;
            __hip_atomic_fetch_add(impA + j, va, __ATOMIC_RELAXED, __HIP_MEMORY_SCOPE_WORKGROUP); __hip_atomic_fetch_add(impB + j, vb, __ATOMIC_RELAXED, __HIP_MEMORY_SCOPE_WORKGROUP);
            if (j + 1 < 128) { __hip_atomic_fetch_add(impA + j + 1, va3, __ATOMIC_RELAXED, __HIP_MEMORY_SCOPE_WORKGROUP); __hip_atomic_fetch_add(impB + j + 1, vb3, __ATOMIC_RELAXED, __HIP_MEMORY_SCOPE_WORKGROUP); } }
    }
    bf16x8 pA[2], pB[2];
#pragma unroll
    for (int ks = 0; ks < 2; ++ks) { const u32x4 wa = pack8(sA[2 * ks], sA[2 * ks + 1]), wb = pack8(sB[2 * ks], sB[2 * ks + 1]); pA[ks] = __builtin_bit_cast(bf16x8, wa); pB[ks] = __builtin_bit_cast(bf16x8, wb); }
#pragma unroll
    for (int dt = 0; dt < 4; ++dt)
#pragma unroll
        for (int ks = 0; ks < 2; ++ks) { oA[dt] = __builtin_amdgcn_mfma_f32_16x16x32_bf16(vf[dt][ks], pA[ks], oA[dt], 0, 0, 0); oB[dt] = __builtin_amdgcn_mfma_f32_16x16x32_bf16(vf[dt][ks], pB[ks], oB[dt], 0, 0, 0); }
}
constexpr float PLIM = 1.8446744e19f;
template <bool WITH_V, bool MASKED, class MaskFn>
__device__ __forceinline__ void visit_fast(const Frags& F, const Lane& L, const bf16x8 (&q)[2], f32x4 (&o)[4], float mref, float& lsum, float& badv, bool colsel, const MaskFn& valid) {
    const float c0 = colsel ? -mref : -INFINITY;
    const f32x4 ci = (f32x4){c0, c0, c0, c0};
    f32x4 s[4];
    { bf16x8 kf[4][2]; load_k(F, L, kf);
#pragma unroll
    for (int mt = 0; mt < 4; ++mt) {
        s[mt] = __builtin_amdgcn_mfma_f32_16x16x32_bf16(kf[mt][0], q[0], ci, 0, 0, 0);
        s[mt] = __builtin_amdgcn_mfma_f32_16x16x32_bf16(kf[mt][1], q[1], s[mt], 0, 0, 0);
    } }

    bf16x8 vf[4][2]; if constexpr (WITH_V) load_v(F, L, vf);
#pragma unroll
    for (int mt = 0; mt < 4; ++mt)
#pragma unroll
        for (int r = 0; r < 4; ++r) { const float e = __builtin_amdgcn_exp2f(s[mt][r]); s[mt][r] = (!MASKED || valid(16 * mt + 4 * L.g + r)) ? e : 0.f; }
    float ps; { const f32x4 t4 = (s[0] + s[1]) + (s[2] + s[3]); ps = (t4[0] + t4[1]) + (t4[2] + t4[3]); }
    lsum += ps; badv = fmaxf(badv, ps);
    if constexpr (WITH_V) {
        bf16x8 pf[2];
#pragma unroll
        for (int ks = 0; ks < 2; ++ks) { const u32x4 w = pack8(s[2 * ks], s[2 * ks + 1]); pf[ks] = __builtin_bit_cast(bf16x8, w); }
#pragma unroll
        for (int dt = 0; dt < 4; ++dt)
#pragma unroll
            for (int ks = 0; ks < 2; ++ks) o[dt] = __builtin_amdgcn_mfma_f32_16x16x32_bf16(vf[dt][ks], pf[ks], o[dt], 0, 0, 0);
    }
}
template <bool MASKED, bool WITH_V = true, class MaskA, class MaskB>
__device__ __forceinline__ void visit_fast2(const Frags& F, const Lane& L, const bf16x8 (&qA)[2], const bf16x8 (&qB)[2], f32x4 (&oA)[4], f32x4 (&oB)[4], float mrefA, float mrefB,
                                            float& lsumA, float& lsumB, float& badv, bool colA, bool colB, const MaskA& validA, const MaskB& validB) {
    const float cA = colA ? -mrefA : -INFINITY, cB = colB ? -mrefB : -INFINITY;
    const f32x4 ciA = (f32x4){cA, cA, cA, cA}, ciB = (f32x4){cB, cB, cB, cB};
    f32x4 sA[4], sB[4];
    { bf16x8 kf[4][2]; load_k(F, L, kf);
#pragma unroll
    for (int mt = 0; mt < 4; ++mt) {
        sA[mt] = __builtin_amdgcn_mfma_f32_16x16x32_bf16(kf[mt][0], qA[0], ciA, 0, 0, 0);
        sB[mt] = __builtin_amdgcn_mfma_f32_16x16x32_bf16(kf[mt][0], qB[0], ciB, 0, 0, 0);
        sA[mt] = __builtin_amdgcn_mfma_f32_16x16x32_bf16(kf[mt][1], qA[1], sA[mt], 0, 0, 0);
        sB[mt] = __builtin_amdgcn_mfma_f32_16x16x32_bf16(kf[mt][1], qB[1], sB[mt], 0, 0, 0);
    } }
    bf16x8 vf[4][2]; if constexpr (WITH_V) load_v(F, L, vf);
#pragma unroll
    for (int mt = 0; mt < 4; ++mt)
#pragma unroll
        for (int r = 0; r < 4; ++r) {
            const float ea = __builtin_amdgcn_exp2f(sA[mt][r]), eb = __builtin_amdgcn_exp2f(sB[mt][r]);
            sA[mt][r] = (!MASKED || validA(16 * mt + 4 * L.g + r)) ? ea : 0.f; sB[mt][r] = (!MASKED || validB(16 * mt + 4 * L.g + r)) ? eb : 0.f;
        }
    { const f32x4 t4 = (sA[0] + sA[1]) + (sA[2] + sA[3]); const float ps = (t4[0] + t4[1]) + (t4[2] + t4[3]); lsumA += ps; badv = fmaxf(badv, ps); }
    { const f32x4 t4 = (sB[0] + sB[1]) + (sB[2] + sB[3]); const float ps = (t4[0] + t4[1]) + (t4[2] + t4[3]); lsumB += ps; badv = fmaxf(badv, ps); }
    if constexpr (!WITH_V) return;
    bf16x8 pA[2], pB[2];
#pragma unroll
    for (int ks = 0; ks < 2; ++ks) { const u32x4 wa = pack8(sA[2 * ks], sA[2 * ks + 1]), wb = pack8(sB[2 * ks], sB[2 * ks + 1]); pA[ks] = __builtin_bit_cast(bf16x8, wa); pB[ks] = __builtin_bit_cast(bf16x8, wb); }
#pragma unroll
    for (int dt = 0; dt < 4; ++dt)
#pragma unroll
        for (int ks = 0; ks < 2; ++ks) { oA[dt] = __builtin_amdgcn_mfma_f32_16x16x32_bf16(vf[dt][ks], pA[ks], oA[dt], 0, 0, 0); oB[dt] = __builtin_amdgcn_mfma_f32_16x16x32_bf16(vf[dt][ks], pB[ks], oB[dt], 0, 0, 0); }
}
template <bool WITH_V, class MaskFn>
__device__ __forceinline__ void visit_init(const Frags& F, const Lane& L, const bf16x8 (&q)[2], f32x4 (&o)[4], float& mref, float& lsum, float& badv, bool colsel, const MaskFn& valid) {
    const bool seen = mref != -INFINITY;
    const float c0 = colsel ? (seen ? -mref : 0.f) : -INFINITY;
    const f32x4 ci = (f32x4){c0, c0, c0, c0};
    f32x4 s[4];
    { bf16x8 kf[4][2]; load_k(F, L, kf);
#pragma unroll
    for (int mt = 0; mt < 4; ++mt) {
        s[mt] = __builtin_amdgcn_mfma_f32_16x16x32_bf16(kf[mt][0], q[0], ci, 0, 0, 0);
        s[mt] = __builtin_amdgcn_mfma_f32_16x16x32_bf16(kf[mt][1], q[1], s[mt], 0, 0, 0);
    } }

    bf16x8 vf[4][2]; if constexpr (WITH_V) load_v(F, L, vf);
#pragma unroll
    for (int mt = 0; mt < 4; ++mt)
#pragma unroll
        for (int r = 0; r < 4; ++r) if (!valid(16 * mt + 4 * L.g + r)) s[mt][r] = -INFINITY;
    float mx = fmaxf(fmaxf(s[0][0], s[0][1]), fmaxf(s[0][2], s[0][3]));
#pragma unroll
    for (int mt = 1; mt < 4; ++mt) mx = fmaxf(mx, fmaxf(fmaxf(s[mt][0], s[mt][1]), fmaxf(s[mt][2], s[mt][3])));
    const float mxr = gmax(mx);
    const float d = (!seen && mxr != -INFINITY) ? mxr : 0.f;
    if (!seen && mxr != -INFINITY) mref = mxr;
#pragma unroll
    for (int mt = 0; mt < 4; ++mt)
#pragma unroll
        for (int r = 0; r < 4; ++r) s[mt][r] = __builtin_amdgcn_exp2f(s[mt][r] - d);
    float ps; { const f32x4 t4 = (s[0] + s[1]) + (s[2] + s[3]); ps = (t4[0] + t4[1]) + (t4[2] + t4[3]); }
    lsum += ps; badv = fmaxf(badv, ps);
    if constexpr (WITH_V) {
        bf16x8 pf[2];
#pragma unroll
        for (int ks = 0; ks < 2; ++ks) { const u32x4 w = pack8(s[2 * ks], s[2 * ks + 1]); pf[ks] = __builtin_bit_cast(bf16x8, w); }
#pragma unroll
        for (int dt = 0; dt < 4; ++dt)
#pragma unroll
            for (int ks = 0; ks < 2; ++ks) o[dt] = __builtin_amdgcn_mfma_f32_16x16x32_bf16(vf[dt][ks], pf[ks], o[dt], 0, 0, 0);
    }
}
template <bool MASKED, class MaskFn>
__device__ __forceinline__ void visitB(const Frags& F, const Lane& L, const bf16x8 (&q)[2], f32x4 (&o)[4], float ms, float inv_l, const MaskFn& valid, LAS float* imp_row, int jb) {
    const float c0 = -ms; const f32x4 ci = (f32x4){c0, c0, c0, c0};
    f32x4 s[4];
    { bf16x8 kf[4][2]; load_k(F, L, kf);
#pragma unroll
    for (int mt = 0; mt < 4; ++mt) {
        s[mt] = __builtin_amdgcn_mfma_f32_16x16x32_bf16(kf[mt][0], q[0], ci, 0, 0, 0);
        s[mt] = __builtin_amdgcn_mfma_f32_16x16x32_bf16(kf[mt][1], q[1], s[mt], 0, 0, 0);
    } }

    bf16x8 vf[4][2]; load_v(F, L, vf);
#pragma unroll
    for (int mt = 0; mt < 4; ++mt) {
#pragma unroll
        for (int r = 0; r < 4; ++r) s[mt][r] = (!MASKED || valid(16 * mt + 4 * L.g + r)) ? __builtin_amdgcn_exp2f(s[mt][r]) * inv_l : 0.f;
        float val = (s[mt][0] + s[mt][1]) + (s[mt][2] + s[mt][3]), v3 = s[mt][3];
        val = xor2_add(xor1_add(val)); v3 = xor2_add(xor1_add(v3));
        if ((L.c & 3) == 0) { const int j = jb + 4 * mt + L.g; __hip_atomic_fetch_add(imp_row + j, val, __ATOMIC_RELAXED, __HIP_MEMORY_SCOPE_WORKGROUP);
            if (j + 1 < 128) __hip_atomic_fetch_add(imp_row + j + 1, v3, __ATOMIC_RELAXED, __HIP_MEMORY_SCOPE_WORKGROUP); }
    }
    bf16x8 pf[2];
#pragma unroll
    for (int ks = 0; ks < 2; ++ks) { const u32x4 w = pack8(s[2 * ks], s[2 * ks + 1]); pf[ks] = __builtin_bit_cast(bf16x8, w); }
#pragma unroll
    for (int dt = 0; dt < 4; ++dt)
#pragma unroll
        for (int ks = 0; ks < 2; ++ks) o[dt] = __builtin_amdgcn_mfma_f32_16x16x32_bf16(vf[dt][ks], pf[ks], o[dt], 0, 0, 0);
}
struct HiMask { int hi; __device__ __forceinline__ bool operator()(int key) const { return key <= hi; } };
struct RangeMask { int lo, hi; __device__ __forceinline__ bool operator()(int key) const { return key >= lo && key <= hi; } };
struct LoMask { int lo; __device__ __forceinline__ bool operator()(int key) const { return key >= lo; } };
struct NoMask { __device__ __forceinline__ bool operator()(int) const { return true; } };
__device__ __forceinline__ unsigned ctr_load(LAS unsigned* p) { return (unsigned)__builtin_amdgcn_readfirstlane((int)__hip_atomic_load(p, __ATOMIC_RELAXED, __HIP_MEMORY_SCOPE_WORKGROUP)); }
template <class Body>
__device__ __forceinline__ void stream(LAS unsigned char* lds, const Lane& L, const Src& S, int tile0, int NT, const Body& body) {
    LAS unsigned* ready = (LAS unsigned*)(lds + MISC_OFF + 64);
    LAS unsigned* done = ready + NS;
    __builtin_amdgcn_s_barrier();
    if (L.wave == 0 && L.lane < 2 * NS) ready[L.lane] = 0u;
    asm volatile("s_waitcnt lgkmcnt(0)" ::: "memory");
    __builtin_amdgcn_s_barrier();
    asm volatile("" ::: "memory");
    int issued = 0, published = 0;
    TileAddr A; A.k0 = L.lds0 + L.kbase; A.k1 = L.lds0 + (L.kbase ^ 64u); A.v0 = L.lds0 + 8192u + L.vbase; A.v1 = L.lds0 + 8192u + (L.vbase ^ 32u); A.v2 = L.lds0 + 8192u + (L.vbase ^ 64u); A.v3 = L.lds0 + 8192u + (L.vbase ^ 96u);
    for (int i = 0; i < NT; ++i) {
        asm volatile("s_waitcnt vmcnt(0)" ::: "memory");
        for (; published < issued; ++published) if (L.lane == 0) __hip_atomic_fetch_add(ready + (published & (NS - 1)), 1u, __ATOMIC_RELAXED, __HIP_MEMORY_SCOPE_WORKGROUP);
        for (;;) {
            if (issued >= NT || issued >= i + NS) break;
            const bool must = issued <= i;
            if (issued >= NS) {
                const unsigned want = 8u * (unsigned)(issued / NS);
                if (ctr_load(done + (issued & (NS - 1))) < want) { if (!must) break; while (ctr_load(done + (issued & (NS - 1))) < want) __builtin_amdgcn_s_sleep(1); }
            }
            issue(L, S, tile0 + issued, issued & (NS - 1)); ++issued;
            if (must) { asm volatile("s_waitcnt vmcnt(0)" ::: "memory"); for (; published < issued; ++published) if (L.lane == 0) __hip_atomic_fetch_add(ready + (published & (NS - 1)), 1u, __ATOMIC_RELAXED, __HIP_MEMORY_SCOPE_WORKGROUP); }
        }
        { const unsigned want = 8u * (unsigned)(i / NS + 1); LAS unsigned* rp = ready + (i & (NS - 1)); while (ctr_load(rp) < want) __builtin_amdgcn_s_sleep(1); }
        asm volatile("" ::: "memory");
        body(i, A);
        { const unsigned d = ((i + 1) & (NS - 1)) ? (unsigned)SLOT : (unsigned)(-(NS - 1) * SLOT); A.k0 += d; A.k1 += d; A.v0 += d; A.v1 += d; A.v2 += d; A.v3 += d; }
        asm volatile("s_waitcnt lgkmcnt(0)" ::: "memory");
        if (L.lane == 0) __hip_atomic_fetch_add(done + (i & (NS - 1)), 1u, __ATOMIC_RELAXED, __HIP_MEMORY_SCOPE_WORKGROUP);
    }
    asm volatile("s_waitcnt vmcnt(0) lgkmcnt(0)" ::: "memory");
}
struct Tensors { unsigned char* ws;
    __device__ __forceinline__ const bf16_t* QP_() const { return (const bf16_t*)(ws + WS_QP); }   __device__ __forceinline__ const bf16_t* QR_() const { return (const bf16_t*)(ws + WS_QR); }
    __device__ __forceinline__ const bf16_t* KCMP_() const { return (const bf16_t*)(ws + WS_KCMP); } __device__ __forceinline__ const bf16_t* VCMP_() const { return (const bf16_t*)(ws + WS_VCMP); }
    __device__ __forceinline__ const bf16_t* KS_() const { return (const bf16_t*)(ws + WS_KS); }   __device__ __forceinline__ const bf16_t* VS_() const { return (const bf16_t*)(ws + WS_VS); }
    __device__ __forceinline__ const bf16_t* KW_() const { return (const bf16_t*)(ws + WS_KW); }   __device__ __forceinline__ const bf16_t* VW_() const { return (const bf16_t*)(ws + WS_VW); }
    __device__ __forceinline__ const float* GN_() const { return (const float*)(ws + WS_GN); }     __device__ __forceinline__ bf16_t* PA_() const { return (bf16_t*)(ws + WS_PA); }
};
__device__ __forceinline__ void unit(LAS unsigned char* lds, const Tensors& X, int b, int gk, int u, int wave_s) {
    const int t0 = 128 * u;
    bf16x8 q[4][2]; f32x4 o[4][4]; float m[4], l[4]; float badv;
#define NSA_STAGE() Lane L; { const int ln_ = lane_id(); L.init(ln_ + 64 * wave_s, lds); } \
    const int tw0 = t0 + 16 * L.wave, tl = L.c >> 2; (void)tl; \
    LAS unsigned char* wscr = lds + RING + L.wave * WSCR; (void)wscr; \
    LAS float* impw = (LAS float*)wscr; (void)impw;                   \
    LAS unsigned* bmask = (LAS unsigned*)(wscr + 8192); (void)bmask;     \
    const int qrow32 = (b * SEQ + tw0 + (L.c >> 2)) * 1024 + (gk * 4 + (L.c & 3)) * 64 + 8 * L.g; (void)qrow32;        \
    const int gnrow = (b * SEQ + tw0 + (L.c >> 2)) * 48 + (gk * 4 + (L.c & 3)) * 3; (void)gnrow;                         \
    LAS unsigned char* park = wscr + ((size_t)L.c * 64 + 4 * L.g) * 2; (void)park
#define NSA_LOADQ(Qp) do { int qo_ = qrow32; OPAQUE(qo_); const bf16_t* qp_ = (Qp) + (size_t)qo_; _Pragma("unroll") for (int rt = 0; rt < 4; ++rt) _Pragma("unroll") for (int dk = 0; dk < 2; ++dk) q[rt][dk] = *(const bf16x8*)(qp_ + rt * 4096 + 32 * dk); \
        _Pragma("unroll") for (int rt = 0; rt < 4; ++rt) _Pragma("unroll") for (int dk = 0; dk < 2; ++dk) asm volatile("" : "+v"(q[rt][dk]));     \
        } while (0)
#define NSA_BAD() (__any(!(badv <= PLIM)))
#define NSA_RESET() do { float z_ = 0.f; OPAQUE(z_); badv = z_; _Pragma("unroll") for (int rt = 0; rt < 4; ++rt) { m[rt] = -INFINITY; l[rt] = z_; _Pragma("unroll") for (int dt = 0; dt < 4; ++dt) o[rt][dt] = (f32x4){z_, z_, z_, z_}; } } while (0)
    {
        NSA_STAGE();
        { float z_ = 0.f; OPAQUE(z_); const f32x4 z4 = (f32x4){z_, z_, z_, z_};
#pragma unroll
        for (int i = 0; i < 8; ++i) *(LAS f32x4*)(impw + (i * 64 + L.lane) * 4) = z4; }
        NSA_LOADQ(X.QP_()); NSA_RESET();
        const int nct = ((8 * u + 6) >> 6) + 1;
        const Src S = make_src(X.KCMP_(), X.VCMP_(), (size_t)(b * 4 + gk) * NCP, 64, 0, L);
        stream(lds, L, S, 0, nct, [&](int i, const TileAddr& Ks) {
            const int nb = 64 * i;
            if (tw0 + 15 >= 31 && nb <= ((tw0 + 15 - 31) >> 4)) {
                Frags F; load_frags<false>(Ks, L, F);
#pragma unroll
                for (int pr = 0; pr < 2; ++pr) {
                    const int rA = 2 * pr, rB = rA + 1, twA = tw0 + 4 * rA, twB = twA + 4;
                    const bool nA = twA + 3 >= 31 && nb <= ((twA + 3 - 31) >> 4), nB = twB + 3 >= 31 && nb <= ((twB + 3 - 31) >> 4);
                    const bool inter = twA >= 31 && nb + 63 <= ((twA - 31) >> 4);
                    const int tA = twA + tl, tB = twB + tl;
                    const HiMask hA{(tA >= 31 ? ((tA - 31) >> 4) : -1) - nb}, hB{(tB >= 31 ? ((tB - 31) >> 4) : -1) - nb};
                    (void)inter;
                    if (i == 0) { if (nA) visit_init<false>(F, L, q[rA], o[rA], m[rA], l[rA], badv, true, hA); if (nB) visit_init<false>(F, L, q[rB], o[rB], m[rB], l[rB], badv, true, hB); }
                    else if (nA && nB) visit_fast2<true, false>(F, L, q[rA], q[rB], o[rA], o[rB], m[rA], m[rB], l[rA], l[rB], badv, true, true, hA, hB);
                    else { if (nA) visit_fast<false, true>(F, L, q[rA], o[rA], m[rA], l[rA], badv, true, hA); if (nB) visit_fast<false, true>(F, L, q[rB], o[rB], m[rB], l[rB], badv, true, hB); }
                }
            }
        });
        if (NSA_BAD()) {
            NSA_RESET();
            stream(lds, L, S, 0, nct, [&](int i, const TileAddr& Ks) {
                const int nb = 64 * i;
                if (tw0 + 15 >= 31 && nb <= ((tw0 + 15 - 31) >> 4)) {
                    Frags F; load_frags<false>(Ks, L, F);
#pragma unroll
                    for (int rt = 0; rt < 4; ++rt) {
                        const int twA = tw0 + 4 * rt, tA = twA + tl;
                        if (twA + 3 >= 31 && nb <= ((twA + 3 - 31) >> 4)) visit_slow<false, true>(F, L, q[rt], o[rt], m[rt], l[rt], true, HiMask{(tA >= 31 ? ((tA - 31) >> 4) : -1) - nb});
                    }
                }
            });
        }
        float inv[4], msf[4];
#pragma unroll
        for (int rt = 0; rt < 4; ++rt) { const float lt = gsum(l[rt]); inv[rt] = lt > 0.f ? __builtin_amdgcn_rcpf(lt) : 0.f; msf[rt] = (m[rt] == -INFINITY) ? 0.f : m[rt]; }
        NSA_RESET();
        stream(lds, L, S, 0, nct, [&](int i, const TileAddr& Ks) {
            const int nb = 64 * i;
            if (tw0 + 15 >= 31 && nb <= ((tw0 + 15 - 31) >> 4)) {
                Frags F; load_frags<true>(Ks, L, F);
#pragma unroll
                for (int pr = 0; pr < 2; ++pr) {
                    const int rA = 2 * pr, rB = rA + 1, twA = tw0 + 4 * rA, twB = twA + 4;
                    const bool nA = twA + 3 >= 31 && nb <= ((twA + 3 - 31) >> 4), nB = twB + 3 >= 31 && nb <= ((twB + 3 - 31) >> 4);
                    const bool inter = twA >= 31 && nb + 63 <= ((twA - 31) >> 4);
                    const int tA = twA + tl, tB = twB + tl;
                    const HiMask hA{(tA >= 31 ? ((tA - 31) >> 4) : -1) - nb}, hB{(tB >= 31 ? ((tB - 31) >> 4) : -1) - nb};
                    LAS float* iA = impw + (4 * rA + tl) * 128; LAS float* iB = impw + (4 * rB + tl) * 128;
                    (void)inter;
                    if (nA && nB) visitB2<true>(F, L, q[rA], q[rB], o[rA], o[rB], msf[rA], msf[rB], inv[rA], inv[rB], hA, hB, iA, iB, 16 * i);
                    else { if (nA) visitB<true>(F, L, q[rA], o[rA], msf[rA], inv[rA], hA, iA, 16 * i);
                           if (nB) visitB<true>(F, L, q[rB], o[rB], msf[rB], inv[rB], hB, iB, 16 * i); }
                }
            }
        });
    }
    asm volatile("s_waitcnt lgkmcnt(0)" ::: "memory");
    {
        NSA_STAGE();
        unsigned bm0 = 0u, bm1 = 0u;
#pragma unroll 1
        for (int tau = 0; tau < 16; ++tau) {
            const int t = tw0 + tau, jt = t >> 6; bool s0, s1;
            if (jt <= 15) { s0 = L.lane <= jt; s1 = false; }
            else {
                const float v0 = impw[tau * 128 + L.lane], v1 = impw[tau * 128 + 64 + L.lane];
                const int j0 = L.lane, j1 = L.lane + 64;
                const unsigned long long k0 = (j0 >= 1 && j0 <= jt - 2) ? ((1ull << 39) | ((unsigned long long)__float_as_uint(v0) << 7) | (unsigned long long)(127 - j0)) : 0ull;
                const unsigned long long k1 = (j1 <= jt - 2) ? ((1ull << 39) | ((unsigned long long)__float_as_uint(v1) << 7) | (unsigned long long)(127 - j1)) : 0ull;
                unsigned long long Tk = 0ull;
#pragma unroll 1
                for (int bit = 39; bit >= 0; --bit) {
                    const unsigned long long C = Tk | (1ull << bit);
                    const int cnt = __popcll(__ballot(k0 >= C)) + __popcll(__ballot(k1 >= C));
                    if (cnt >= 13) Tk = C;
                }
                s0 = (k0 >= Tk && k0 != 0ull) || j0 == 0 || j0 == jt || j0 == jt - 1;
                s1 = (k1 >= Tk && k1 != 0ull) || j1 == jt || j1 == jt - 1;
            }
            bm0 |= (s0 ? 1u : 0u) << tau; bm1 |= (s1 ? 1u : 0u) << tau;
        }
        bmask[L.lane] = bm0; bmask[64 + L.lane] = bm1;
    }
    asm volatile("s_waitcnt lgkmcnt(0)" ::: "memory");
    {
        NSA_STAGE();
#pragma unroll
        for (int rt = 0; rt < 4; ++rt) {
            int gi_ = gnrow + rt * 192; OPAQUE(gi_); const float gc = X.GN_()[gi_];
#pragma unroll
            for (int dt = 0; dt < 4; ++dt) { const f32x4 v = o[rt][dt] * gc; u32x2 w; w.x = cvt_pk_bf16(v[0], v[1]); w.y = cvt_pk_bf16(v[2], v[3]); *(LAS u32x2*)(park + rt * 2048 + dt * 32) = w; }
        }
    }
    {
        NSA_STAGE();
        NSA_LOADQ(X.QR_());
        const int kt_lo = (2 * u - 8) > 0 ? (2 * u - 8) : 0, kt_hi = 2 * u + 1;
        const Src S = make_src(X.KW_(), X.VW_(), (size_t)b * SEQ, 256, gk * 64, L);
        SUBREP(32) { NSA_RESET();
        stream(lds, L, S, kt_lo, kt_hi - kt_lo + 1, [&](int i, const TileAddr& Ks) {
            const int kbase = 64 * (kt_lo + i);
            if (kbase <= tw0 + 15 && kbase + 63 >= tw0 - 511) {
                Frags F; load_frags<true>(Ks, L, F);
#pragma unroll
                for (int pr = 0; pr < 2; ++pr) {
                    const int rA = 2 * pr, rB = rA + 1, twA = tw0 + 4 * rA, twB = twA + 4;
                    const bool nA = kbase <= twA + 3 && kbase + 63 >= twA - 511, nB = kbase <= twB + 3 && kbase + 63 >= twB - 511;
                    const bool inter = kbase + 63 <= twA && kbase >= twB + 3 - 511;
                    const int tA = twA + tl, tB = twB + tl;
                    const bool init = kbase <= (twB + 3 - 511 > 0 ? twB + 3 - 511 : 0);
                    if (init) { if (nA) visit_init<true>(F, L, q[rA], o[rA], m[rA], l[rA], badv, true, RangeMask{tA - 511 - kbase, tA - kbase}); if (nB) visit_init<true>(F, L, q[rB], o[rB], m[rB], l[rB], badv, true, RangeMask{tB - 511 - kbase, tB - kbase}); }
                    else if (nA && nB) { if (inter) visit_fast2<false>(F, L, q[rA], q[rB], o[rA], o[rB], m[rA], m[rB], l[rA], l[rB], badv, true, true, NoMask{}, NoMask{});
                                         else visit_fast2<true>(F, L, q[rA], q[rB], o[rA], o[rB], m[rA], m[rB], l[rA], l[rB], badv, true, true, HiMask{tA - kbase}, HiMask{tB - kbase}); }
                    else if (inter) { if (nA) visit_fast<true, false>(F, L, q[rA], o[rA], m[rA], l[rA], badv, true, NoMask{}); if (nB) visit_fast<true, false>(F, L, q[rB], o[rB], m[rB], l[rB], badv, true, NoMask{}); }
                    else { if (nA) visit_fast<true, true>(F, L, q[rA], o[rA], m[rA], l[rA], badv, true, HiMask{tA - kbase}); if (nB) visit_fast<true, true>(F, L, q[rB], o[rB], m[rB], l[rB], badv, true, HiMask{tB - kbase}); }
                }
            }
        });
        if (NSA_BAD()) {
            NSA_RESET();
            stream(lds, L, S, kt_lo, kt_hi - kt_lo + 1, [&](int i, const TileAddr& Ks) {
                const int kbase = 64 * (kt_lo + i);
                if (kbase <= tw0 + 15 && kbase + 63 >= tw0 - 511) {
                    Frags F; load_frags<true>(Ks, L, F);
#pragma unroll
                    for (int rt = 0; rt < 4; ++rt) {
                        const int twA = tw0 + 4 * rt, tA = twA + tl;
                        if (kbase <= twA + 3 && kbase + 63 >= twA - 511) visit_slow<true, true>(F, L, q[rt], o[rt], m[rt], l[rt], true, RangeMask{tA - 511 - kbase, tA - kbase});
                    }
                }
            });
        }
        }
    }
    {
        NSA_STAGE();
#pragma unroll
        for (int rt = 0; rt < 4; ++rt) {
            int gi_ = gnrow + rt * 192 + 2; OPAQUE(gi_); const float sc = X.GN_()[gi_] * __builtin_amdgcn_rcpf(gsum(l[rt]));
#pragma unroll
            for (int dt = 0; dt < 4; ++dt) {
                LAS u32x2* pp = (LAS u32x2*)(park + rt * 2048 + dt * 32); const u32x2 pw = *pp; const f32x4 v = o[rt][dt] * sc; u32x2 w;
                w.x = cvt_pk_bf16(v[0] + __builtin_bit_cast(float, pw.x << 16), v[1] + __builtin_bit_cast(float, pw.x & 0xffff0000u));
                w.y = cvt_pk_bf16(v[2] + __builtin_bit_cast(float, pw.y << 16), v[3] + __builtin_bit_cast(float, pw.y & 0xffff0000u));
                *pp = w;
            }
        }
    }
    {
        NSA_STAGE();
        const Src S = make_src(X.KS_(), X.VS_(), (size_t)b * SEQ, 256, gk * 64, L);
        if (MK_PROBE == 34) stream(lds, L, S, 0, 2 * u + 2, [&](int j, const TileAddr& Ks) { const unsigned bm = (unsigned)__builtin_amdgcn_readfirstlane((int)bmask[j]); asm volatile("" :: "s"(bm), "v"(Ks.k0)); });
        SUBREP(33) { NSA_RESET();
        stream(lds, L, S, 0, 2 * u + 2, [&](int j, const TileAddr& Ks) {
            const unsigned bm = (unsigned)__builtin_amdgcn_readfirstlane((int)bmask[j]);
            const int kbase = 64 * j; const bool j0 = (j == 0);
            if (bm & 0xffffu) {
                Frags F; load_frags<true>(Ks, L, F);
#pragma unroll
                for (int pr = 0; pr < 2; ++pr) {
                    const int rA = 2 * pr, rB = rA + 1, twA = tw0 + 4 * rA, twB = twA + 4;
                    const bool nA = (bm >> (4 * rA)) & 15u, nB = (bm >> (4 * rB)) & 15u;
                    const bool inter = kbase + 63 <= twA;
                    const bool sA = (bm >> (4 * rA + tl)) & 1u, sB = (bm >> (4 * rB + tl)) & 1u;
                    const HiMask hA{twA + tl - kbase}, hB{twB + tl - kbase};
                    if (j0) { if (nA) visit_init<true>(F, L, q[rA], o[rA], m[rA], l[rA], badv, sA, hA); if (nB) visit_init<true>(F, L, q[rB], o[rB], m[rB], l[rB], badv, sB, hB); }
                    else if (nA && nB && inter) visit_fast2<false>(F, L, q[rA], q[rB], o[rA], o[rB], m[rA], m[rB], l[rA], l[rB], badv, sA, sB, hA, hB);
                    else if (inter) { if (nA) visit_fast<true, false>(F, L, q[rA], o[rA], m[rA], l[rA], badv, sA, hA); if (nB) visit_fast<true, false>(F, L, q[rB], o[rB], m[rB], l[rB], badv, sB, hB); }
                    else { if (nA) visit_fast<true, true>(F, L, q[rA], o[rA], m[rA], l[rA], badv, sA, hA); if (nB) visit_fast<true, true>(F, L, q[rB], o[rB], m[rB], l[rB], badv, sB, hB); }
                }
            }
        });
        if (NSA_BAD()) {
            NSA_RESET();
            stream(lds, L, S, 0, 2 * u + 2, [&](int j, const TileAddr& Ks) {
                const unsigned bm = (unsigned)__builtin_amdgcn_readfirstlane((int)bmask[j]);
                const int kbase = 64 * j;
                if (bm & 0xffffu) {
                    Frags F; load_frags<true>(Ks, L, F);
#pragma unroll
                    for (int rt = 0; rt < 4; ++rt) {
                        const int twA = tw0 + 4 * rt;
                        if ((bm >> (4 * rt)) & 15u) visit_slow<true, true>(F, L, q[rt], o[rt], m[rt], l[rt], (bool)((bm >> (4 * rt + tl)) & 1u), HiMask{twA + tl - kbase});
                    }
                }
            });
        }
        }
    }
    {
        NSA_STAGE();
#pragma unroll
        for (int rt = 0; rt < 4; ++rt) {
            int gi_ = gnrow + rt * 192 + 1; OPAQUE(gi_); const float sc = X.GN_()[gi_] * __builtin_amdgcn_rcpf(gsum(l[rt]));
            int oo_ = (b * SEQ + tw0 + 4 * rt + tl) * 1536 + 512 + (gk * 4 + (L.c & 3)) * 64 + 4 * L.g; OPAQUE(oo_); bf16_t* orow = X.PA_() + (size_t)oo_;
#pragma unroll
            for (int dt = 0; dt < 4; ++dt) {
                const u32x2 pw = *(LAS u32x2*)(park + rt * 2048 + dt * 32); const f32x4 v = o[rt][dt] * sc; u32x2 w;
                w.x = cvt_pk_bf16(v[0] + __builtin_bit_cast(float, pw.x << 16), v[1] + __builtin_bit_cast(float, pw.x & 0xffff0000u));
                w.y = cvt_pk_bf16(v[2] + __builtin_bit_cast(float, pw.y << 16), v[3] + __builtin_bit_cast(float, pw.y & 0xffff0000u));
                *(u32x2*)(orow + 16 * dt) = w;
            }
        }
    }
    asm volatile("s_waitcnt vmcnt(0) lgkmcnt(0)" ::: "memory");
#undef NSA_LOADQ
#undef NSA_RESET
#undef NSA_BAD
#undef NSA_STAGE
}
}

#define XB_TMO      128
#define XB_XCNT(j)  (256  + 64 * (j))
#define XB_XSUB(j)  (1280 + 64 * (j))
#define XB_XGEN(j)  (2304 + 64 * (j))
#define XB_TOP      3328
#define XB_TOPGEN   3392
#define XCD_BAR_WORDS 3456
#define XB_SPIN_CAP (1u << 18)
constexpr int CW_FN = 10240;
constexpr int CW_BAR = 4096;
constexpr size_t CTL_ZERO_BYTES = 65536;
__device__ __forceinline__ unsigned xb_ld(unsigned* p)              { return __hip_atomic_load(p, __ATOMIC_RELAXED, __HIP_MEMORY_SCOPE_AGENT); }
__device__ __forceinline__ unsigned xb_add(unsigned* p, unsigned v) { return __hip_atomic_fetch_add(p, v, __ATOMIC_RELAXED, __HIP_MEMORY_SCOPE_AGENT); }
__device__ __forceinline__ unsigned xb_xcc_id() { return (unsigned)__builtin_amdgcn_s_getreg((3 << 11) | 20) & 0xFu; }
#define XB_SPIN(cond, bar) do { unsigned _sp = 0; while (cond) { __builtin_amdgcn_s_sleep(1); \
    if ((++_sp & 255u) == 0u) { if (xb_ld(&(bar)[XB_TMO])) break; if (_sp > XB_SPIN_CAP) { atomicAdd(&(bar)[XB_TMO], 1u); break; } } } } while (0)
struct XcdBarrier { unsigned* bar; unsigned x; volatile LAS unsigned* st; int wave; };
__device__ __forceinline__ XcdBarrier xcd_barrier_post(unsigned* bar, volatile LAS unsigned* st, int wave) {
    XcdBarrier b; b.bar = bar; b.x = xb_xcc_id(); b.st = st; b.wave = wave;
    if (wave == 0 && lane_id() == 0) (void)xb_add(&bar[XB_XCNT(b.x)], 1u);
    return b;
}
__device__ __forceinline__ void xcd_barrier_complete(unsigned* bar, unsigned x, unsigned& nloc, unsigned& nx) {
    const unsigned G = gridDim.x * gridDim.y * gridDim.z;
    unsigned sum, cnt, mine, sp = 0u;
    for (;;) {
        sum = 0u; cnt = 0u; mine = 0u;
#pragma unroll
        for (unsigned j = 0; j < 16; ++j) { const unsigned c = xb_ld(&bar[XB_XCNT(j)]); sum += c; cnt += (c > 0u) ? 1u : 0u; mine = (j == x) ? c : mine; }
        if (sum == G) break;
        __builtin_amdgcn_s_sleep(1);
        if ((++sp & 255u) == 0u) { if (xb_ld(&bar[XB_TMO])) break; if (sp > XB_SPIN_CAP) { atomicAdd(&bar[XB_TMO], 1u); break; } }
    }
    nloc = mine > 0u ? mine : 1u; nx = cnt > 0u ? cnt : 1u;
}
__device__ __forceinline__ void xcd_barrier(const XcdBarrier& b) {
    asm volatile("s_waitcnt vmcnt(0)" ::: "memory");
    __syncthreads();
    if (b.wave == 0 && lane_id() == 0) {
        unsigned* bar = b.bar;
        __builtin_amdgcn_s_waitcnt(0);
        unsigned nloc = b.st[0], nx = b.st[1];
        if (nloc == 0u) { xcd_barrier_complete(bar, b.x, nloc, nx); b.st[0] = nloc; b.st[1] = nx; }
        const unsigned old = xb_add(&bar[XB_XSUB(b.x)], 1u);
        const unsigned gen = old / nloc;
        if (old + 1u == (gen + 1u) * nloc) {
            __builtin_amdgcn_fence(__ATOMIC_RELEASE, "agent");
            asm volatile("s_waitcnt vmcnt(0)" ::: "memory");
            const unsigned og = xb_add(&bar[XB_TOP], 1u);
            const unsigned tg = og / nx;
            if (og + 1u == (tg + 1u) * nx) xb_add(&bar[XB_TOPGEN], 1u);
            else XB_SPIN(xb_ld(&bar[XB_TOPGEN]) == tg, bar);
            __builtin_amdgcn_fence(__ATOMIC_ACQUIRE, "agent");
            xb_add(&bar[XB_XGEN(b.x)], 1u);
            asm volatile("s_waitcnt vmcnt(0)" ::: "memory");
        } else {
            XB_SPIN(xb_ld(&bar[XB_XGEN(b.x)]) == gen, bar);
            __builtin_amdgcn_fence(__ATOMIC_ACQUIRE, "agent");
            asm volatile("s_waitcnt vmcnt(0)" ::: "memory");
        }
    }
    __syncthreads();
}

#ifndef MK_COOP
#define MK_COOP 1
#endif
constexpr int N_PHASES = 9;
#define REP(k) for (int rep_ = 0; rep_ < ((MK_PROBE) == (k) ? 2 : 1); ++rep_)
__device__ __forceinline__ KParams kparams() { KParams p = (KParams)__builtin_amdgcn_kernarg_segment_ptr(); asm volatile("" : "+s"(p)); return p; }
__global__ void __launch_bounds__(NTHREADS, 2) mk_fwd(Params Parg) {
    (void)Parg;
    extern __shared__ __attribute__((aligned(16))) unsigned char lds_raw[];
    LAS unsigned char* lds = (LAS unsigned char*)lds_raw;
    const int wave_k = __builtin_amdgcn_readfirstlane((int)(threadIdx.x >> 6));
    const int G = gridDim.x, bx = blockIdx.x;
    const int vcu = (G % 8 == 0) ? (bx % 8) * (G / 8) + bx / 8 : bx;
    const int NGW = G * NWAVES;
#define PHASE_IDS() int tid = TID_(wave_k); asm volatile("" : "+v"(tid)); const int lane = tid & 63, wave = __builtin_amdgcn_readfirstlane(tid >> 6), gw = vcu * NWAVES + wave; (void)lane; (void)gw
#define ws (kparams()->ws)
#define dout ((char*)kparams()->out)
    const int ph_lo = kparams()->ph_lo, ph_hi = kparams()->ph_hi;
#define WSP(T_, off) ((T_*)(ws + (off)))
#if MK_COOP
#ifndef MK_CG_SYNC
#define MK_CG_SYNC 0
#endif
#if MK_CG_SYNC
#define GRID_SYNC() cg::this_grid().sync()
#else
    volatile LAS unsigned* MISC = (volatile LAS unsigned*)(lds + MISC_OFF);
    if (wave_k == 0 && lane_id() < 32) MISC[lane_id()] = 0u;
    __syncthreads();
    const XcdBarrier xbar = xcd_barrier_post((unsigned*)(ws + WS_CTL) + CW_BAR, MISC + 8, wave_k);
#define GRID_SYNC() xcd_barrier(xbar)
#endif
#else
#define GRID_SYNC() do {} while (0)
#endif
#define IN(k) (ph_lo <= (k) && (k) < ph_hi)
#define SEAM(k) do { if (IN(k) && IN((k) + 1)) GRID_SYNC(); } while (0)
#define H ((bf16_t*)(dout + DO_H))
#define SP ((bf16_t*)(dout + DO_SP))
#define X1 ((float*)dout)

    if (IN(0)) REP(0) { PHASE_IDS(); p0_prologue<0>(kparams(), lds, gw, NGW, wave, lane); }
    SEAM(0);
    if (IN(1)) REP(1) {
        pg8::Gemm g{1024 * 2, 1024 * 2, 128, 128, 16}; pg8::StdSched S; S.init(H, WSP(bf16_t, WS_WIN), T, 5120, 2048, 2048, G, bx);
        EpiIn E{WSP(bf16_t, WS_U), WSP(bf16_t, WS_QP), WSP(bf16_t, WS_QR), WSP(bf16_t, WS_KC), SP, WSP(bf16_t, WS_SA),
                WSP(float, WS_GN), WSP(float, WS_RCOS), WSP(float, WS_RSIN)};
        pg8::gemm_phase<EpiIn, pg8::StdSched, true>(lds, g, S, E, wave_k);
    }
    SEAM(1);
    if (IN(2)) REP(2) {
        const int ncmp = (G == 256) ? 64 : 32;
        if (bx >= ncmp) {
            { PHASE_IDS(); (void)gw; p2_pooled(WSP(bf16_t, WS_U), WSP(bf16_t, WS_PA), (bx - ncmp) * NWAVES + wave, (G - ncmp) * NWAVES, lane); }
            PHASE_IDS(); (void)gw;
            const int fr = lane & 15, fq = lane >> 4; const bf16_t* Wg = WSP(bf16_t, WS_WIN) + (size_t)5120 * 1024; float* GNp = WSP(float, WS_GN);
#pragma unroll 1
            for (int it = (((bx - ncmp) * NWAVES + wave) % 3) ? T / 32 : ((bx - ncmp) * NWAVES + wave) / 3; it < T / 32; it += ((G - ncmp) * NWAVES + 2) / 3) {
                const int r0 = 32 * it; f32x4 c2[2][3];
#pragma unroll
                for (int mt = 0; mt < 2; ++mt)
#pragma unroll
                    for (int nt = 0; nt < 3; ++nt) c2[mt][nt] = (f32x4){0.f, 0.f, 0.f, 0.f};
#pragma unroll 4
                for (int k0 = 0; k0 < 1024; k0 += 32) {
                    bf16x8 a[2], b[3];
#pragma unroll
                    for (int mt = 0; mt < 2; ++mt) a[mt] = *(const bf16x8*)(H + (size_t)(r0 + 16 * mt + fr) * 1024 + k0 + 8 * fq);
#pragma unroll
                    for (int nt = 0; nt < 3; ++nt) b[nt] = *(const bf16x8*)(Wg + (size_t)(16 * nt + fr) * 1024 + k0 + 8 * fq);
#pragma unroll
                    for (int mt = 0; mt < 2; ++mt)
#pragma unroll
                        for (int nt = 0; nt < 3; ++nt) c2[mt][nt] = __builtin_amdgcn_mfma_f32_16x16x32_bf16(a[mt], b[nt], c2[mt][nt], 0, 0, 0);
                }
#pragma unroll
                for (int mt = 0; mt < 2; ++mt)
#pragma unroll
                    for (int nt = 0; nt < 3; ++nt)
#pragma unroll
                        for (int r = 0; r < 4; ++r) GNp[(size_t)(r0 + 16 * mt + 4 * fq + r) * 48 + 16 * nt + fr] = sigmoidf_(c2[mt][nt][r] + 0.f);
            }
            if (G != 256) p0_prologue<1>(kparams(), lds, (bx - ncmp) * NWAVES + wave, (G - ncmp) * NWAVES, wave, lane);
        }
        __syncthreads();
        const int split = (G == 256) ? 1 : 0;
        pg8::Gemm g{4096 * 2, 2048 * 2, 512, 128, split ? 16 : 32, (split && (bx & 1)) ? -128 * 4096 * 2 : 0};
        CmpSched S{(const char*)WSP(bf16_t, WS_KC), (const char*)WSP(bf16_t, WS_VC), (const char*)WSP(bf16_t, WS_W1K), (const char*)WSP(bf16_t, WS_W1V), bx, split};
        EpiCmp E{WSP(bf16_t, WS_HIDK), WSP(bf16_t, WS_HIDV), WSP(float, WS_PEBK), WSP(float, WS_PEBV), WSP(bf16_t, WS_W2K), WSP(bf16_t, WS_W2V), WSP(bf16_t, WS_KCMP), WSP(bf16_t, WS_VCMP), ws, split};
        pg8::gemm_phase<EpiCmp, CmpSched, false>(lds, g, S, E, wave_k);
    }
    SEAM(2);
    if (IN(3)) REP(3) {
        const nsa::Tensors X{ws};
        const int wave_s = wave_k;
#pragma unroll 1
        for (int uu = vcu; uu < 256; uu += G) { const int bg = uu >> 5, i = uu & 31;
#pragma unroll 1
            for (int hh = 0; hh < 2; ++hh) nsa::unit(lds, X, bg >> 2, bg & 3, hh ? 63 - i : i, wave_s); }
        if (G == 256) {
            __syncthreads();
            PHASE_IDS(); (void)gw;
            late_weights_queue(kparams(), lds, wave, lane);
        }
    }
    SEAM(3);
    if (IN(4)) REP(4) {
        pg8::Gemm g{1536 * 2, 1536 * 2, 128, 128, 24}; pg8::StdSched S; S.init(WSP(bf16_t, WS_PA), WSP(bf16_t, WS_WM), T, 1024, 3072, 3072, G, bx);
        EpiMerged E{WSP(bf16_t, WS_MG), SP, WSP(bf16_t, WS_SA)};
        pg8::gemm_phase<EpiMerged, pg8::StdSched, false>(lds, g, S, E, wave_k);
    }
    SEAM(4);
    if (IN(5)) REP(5) {
        pg8::Gemm g{1024 * 2, 1024 * 2, 128, 128, 16}; pg8::StdSched S; S.init(WSP(bf16_t, WS_MG), WSP(bf16_t, WS_WO), T, 1024, 2048, 2048, G, bx);
        EpiX1 E{kparams()->x, X1, WSP(bf16_t, WS_X1B), WSP(float, WS_RS1)};
        pg8::gemm_phase<EpiX1, pg8::StdSched, false>(lds, g, S, E, wave_k);
    }
    SEAM(5);
    if (IN(6)) REP(6) {
        pg8::Gemm g{1024 * 2, 1024 * 2, 128, 128, 16}; pg8::StdSched S; S.init(WSP(bf16_t, WS_X1B), WSP(bf16_t, WS_WGU), T, 5632, 2048, 2048, G, bx);
        EpiAct E{WSP(bf16_t, WS_ACT), WSP(float, WS_RS1)};
        pg8::gemm_phase<EpiAct, pg8::StdSched, true>(lds, g, S, E, wave_k);
    }
    SEAM(6);
    if (IN(7)) {
        pg8::Gemm g{DFF * 2, DFF * 2, 128, 128, DFF / 64}; pg8::StdSched S; S.init(WSP(bf16_t, WS_ACT), WSP(bf16_t, WS_WD), T, 1024, DFF * 2, DFF * 2, G, bx);
        if (G == 256) {
            EpiFinal E{X1, WSP(bf16_t, WS_X1B), kparams()->normf_w, WSP(float, WS_SEL), (unsigned*)(ws + WS_CTL) + CW_FN};
            pg8::gemm_phase<EpiFinal, pg8::StdSched, false>(lds, g, S, E, wave_k);
        } else {
            EpiX2 E{X1, WSP(bf16_t, WS_X1B)};
            pg8::gemm_phase<EpiX2, pg8::StdSched, false>(lds, g, S, E, wave_k);
        }
    }
    if (G != 256) {
    SEAM(7);
    if (IN(8)) {
        PHASE_IDS();
        for (int row = gw; row < T; row += NGW) {
            f32x4* xr = (f32x4*)(X1 + (size_t)row * DM) + lane; const f32x4* wr = (const f32x4*)kparams()->normf_w + lane;
            f32x4 v[4]; float s = 0.f;
#pragma unroll
            for (int j = 0; j < 4; ++j) { v[j] = xr[64 * j]; s += (v[j].x * v[j].x + v[j].y * v[j].y) + (v[j].z * v[j].z + v[j].w * v[j].w); }
            const float rstd = rsqrtf(wave_sum(s) * (1.f / DM) + RMS_EPS);
#pragma unroll
            for (int j = 0; j < 4; ++j) { const f32x4 ww = wr[64 * j]; xr[64 * j] = (f32x4){v[j].x * rstd * ww.x, v[j].y * rstd * ww.y, v[j].z * rstd * ww.z, v[j].w * rstd * ww.w}; }
        }
    }
    }
#undef WSP
#undef ws
#undef dout
#undef H
#undef SP
#undef X1
}

extern "C" void kernel_launch(void* const* d_in, const int* in_sizes, int n_in, void* d_out, int out_size, void* d_ws, size_t ws_size, hipStream_t stream) {
    static int grid = 0;
    if (grid == 0) {
        if (n_in != 21 || ws_size < WS_END || out_size != T * DM) { fprintf(stderr, "kernel_launch: unexpected shapes n_in %d ws %zu out %d\n", n_in, ws_size, out_size); grid = -1; return; }
        int dev = 0, cus = 0, per_cu = 0;
        if (hipGetDevice(&dev) != hipSuccess || hipDeviceGetAttribute(&cus, hipDeviceAttributeMultiprocessorCount, dev) != hipSuccess) { grid = -1; return; }
        if (hipFuncSetAttribute((const void*)mk_fwd, hipFuncAttributeMaxDynamicSharedMemorySize, LDS_BYTES) != hipSuccess) { fprintf(stderr, "kernel_launch: hipFuncSetAttribute failed\n"); grid = -1; return; }
        if (hipOccupancyMaxActiveBlocksPerMultiprocessor(&per_cu, (const void*)mk_fwd, NTHREADS, LDS_BYTES) != hipSuccess || per_cu < 1) { fprintf(stderr, "kernel_launch: occupancy query says %d\n", per_cu); (void)hipGetLastError(); per_cu = 1; }
        grid = cus;
    }
    if (grid < 0) return;
    Params p{};
    const float** pin = (const float**)&p;
    for (int i = 0; i < 21; ++i) pin[i] = (const float*)d_in[i];
    p.out = (float*)d_out; p.ws = (unsigned char*)d_ws;
#if MK_COOP
    p.ph_lo = 0; p.ph_hi = N_PHASES;
    if (hipMemsetAsync((char*)d_ws + WS_CTL, 0, CTL_ZERO_BYTES, stream) != hipSuccess) { fprintf(stderr, "kernel_launch: memset failed\n"); return; }
    void* args[] = {&p};
    hipError_t e = hipLaunchCooperativeKernel((const void*)mk_fwd, dim3(grid), dim3(NTHREADS), args, LDS_BYTES, stream);
    if (e != hipSuccess) fprintf(stderr, "kernel_launch: cooperative launch failed: %s (grid %d)\n", hipGetErrorString(e), grid);
#else
    for (int ph = 0; ph < N_PHASES; ++ph) { p.ph_lo = ph; p.ph_hi = ph + 1; hipLaunchKernelGGL(mk_fwd, dim3(grid), dim3(NTHREADS), LDS_BYTES, stream, p); }
#endif
}
```

```cpp
#include <hip/hip_runtime.h>
#include <hip/hip_cooperative_groups.h>
#include <cstdint>
#include <cstdio>
namespace cg = cooperative_groups;
#ifndef MK_PROBE
#define MK_PROBE -1
#endif
#define SUBREP(k) for (int srep_ = 0; srep_ < ((MK_PROBE) == (k) ? 2 : 1); ++srep_)

#define LAS __attribute__((address_space(3)))
typedef unsigned short bf16_t;
typedef short bf16x8 __attribute__((ext_vector_type(8)));
typedef float f32x4 __attribute__((ext_vector_type(4)));
typedef unsigned u32x4 __attribute__((ext_vector_type(4)));
typedef unsigned u32x2 __attribute__((ext_vector_type(2)));

constexpr int BATCH = 2, SEQ = 8192, T = BATCH * SEQ, DM = 1024;
constexpr int NREF = 5168, NIN = 5376;
constexpr int DFF = 2816;
constexpr int NCP = 512;
constexpr float RMS_EPS = 1e-6f;
constexpr float C2 = 0.125f * 1.4426950408889634f;
constexpr int NWAVES = 8, NTHREADS = 512;

constexpr size_t MiB = 1u << 20;
constexpr size_t WS_CTL = 0;
constexpr size_t WS_PEBK = 1 * MiB, WS_PEBV = 1 * MiB + 4096, WS_RCOS = 1 * MiB + 65536, WS_RSIN = WS_RCOS + 262144;
constexpr size_t WS_RS1 = 2 * MiB;
constexpr size_t WS_SEL = 3 * MiB;
constexpr size_t WS_KCMP = 4 * MiB, WS_VCMP = 4 * MiB + 512 * 1024;
constexpr size_t WS_W2K = 5 * MiB, WS_W2V = 5 * MiB + 65536;
constexpr size_t WS_W1K = 6 * MiB, WS_W1V = 7 * MiB;
constexpr size_t WS_WIN = 8 * MiB;
constexpr size_t WS_WM = 19 * MiB;
constexpr size_t WS_WO = 22 * MiB;
constexpr size_t WS_WGU = 24 * MiB;
constexpr size_t WS_WD = 35 * MiB;
constexpr size_t WS_GN = 41 * MiB;
constexpr size_t WS_U = 44 * MiB;
constexpr size_t WS_QP = 60 * MiB;
constexpr size_t WS_MG = 60 * MiB;
constexpr size_t WS_KC = 92 * MiB, WS_VC = 100 * MiB, WS_KS = 108 * MiB, WS_VS = 116 * MiB, WS_KW = 124 * MiB, WS_VW = 132 * MiB;
constexpr size_t WS_SA = 140 * MiB;
constexpr size_t WS_PA = 172 * MiB;
constexpr size_t WS_QR = 220 * MiB;
constexpr size_t WS_X1B = 220 * MiB;
constexpr size_t WS_HIDK = 252 * MiB, WS_HIDV = 254 * MiB;
constexpr size_t WS_ACT = 44 * MiB;
constexpr size_t WS_END = 256 * MiB;
constexpr size_t DO_H = 0, DO_SP = 32 * MiB;

constexpr int RING_BYTES = 131072;
constexpr int MISC_OFF = 147456 - 256;
constexpr int LDS_BYTES = 147456;

__device__ __forceinline__ unsigned f2bf(float f) { unsigned u = __builtin_bit_cast(unsigned, f); return (u + 0x7fffu + ((u >> 16) & 1u)) >> 16; }
__device__ __forceinline__ float bf2f(unsigned b) { return __builtin_bit_cast(float, (b & 0xffffu) << 16); }
__device__ __forceinline__ unsigned pk2(float lo, float hi) { return f2bf(lo) | (f2bf(hi) << 16); }
typedef float f32x2_t __attribute__((ext_vector_type(2))); typedef __bf16 bf16x2_t __attribute__((ext_vector_type(2)));
__device__ __forceinline__ unsigned cvt_pk_bf16(float lo, float hi) { f32x2_t v = {lo, hi}; bf16x2_t b = __builtin_convertvector(v, bf16x2_t); return __builtin_bit_cast(unsigned, b); }
__device__ __forceinline__ u32x4 pack8(const f32x4& a, const f32x4& b) { u32x4 w; w.x = cvt_pk_bf16(a[0], a[1]); w.y = cvt_pk_bf16(a[2], a[3]); w.z = cvt_pk_bf16(b[0], b[1]); w.w = cvt_pk_bf16(b[2], b[3]); return w; }
__device__ __forceinline__ void unpack8(const u32x4& w, f32x4& a, f32x4& b) {
    a[0] = __builtin_bit_cast(float, w.x << 16); a[1] = __builtin_bit_cast(float, w.x & 0xffff0000u); a[2] = __builtin_bit_cast(float, w.y << 16); a[3] = __builtin_bit_cast(float, w.y & 0xffff0000u);
    b[0] = __builtin_bit_cast(float, w.z << 16); b[1] = __builtin_bit_cast(float, w.z & 0xffff0000u); b[2] = __builtin_bit_cast(float, w.w << 16); b[3] = __builtin_bit_cast(float, w.w & 0xffff0000u); }
__device__ __forceinline__ float sigmoidf_(float v) { return __builtin_amdgcn_rcpf(1.f + __expf(-v)); }
__device__ __forceinline__ float wave_sum(float v) {
#pragma unroll
    for (int o = 1; o < 64; o <<= 1) v += __shfl_xor(v, o);
    return v;
}
__device__ __forceinline__ float wave_max(float v) {
#pragma unroll
    for (int o = 1; o < 64; o <<= 1) v = fmaxf(v, __shfl_xor(v, o));
    return v;
}
#define WSYNC() asm volatile("s_waitcnt lgkmcnt(0)" ::: "memory")
__device__ __forceinline__ int lane_id() { int r; asm volatile("v_mbcnt_lo_u32_b32 %0, -1, 0\n\tv_mbcnt_hi_u32_b32 %0, -1, %0" : "=v"(r)); return r; }
#define TID_(wv) (64 * (wv) + lane_id())
#define OPAQUE(x) asm volatile("" : "+v"(x))
__host__ __device__ __forceinline__ int incol_ref(int c) {
    if (c < 3072) return c;
    if (c < 4096) return 3120 + (c - 3072);
    if (c < 5120) return 4144 + (c - 4096);
    if (c < 5168) return 3072 + (c - 5120);
    return -1;
}

struct Params {
    const float *x, *norm1_w, *w_in, *pool_w, *pool_scale, *pe_k, *w1_k, *b1_k, *w2_k, *pe_v, *w1_v, *b1_v, *w2_v, *w_pp, *w_pa, *w_out, *norm2_w, *w_g, *w_u, *w_d, *normf_w;
    float* out; unsigned char* ws;
    int ph_lo, ph_hi;
};

typedef const __attribute__((address_space(4))) Params* KParams;
namespace pg8 {
constexpr int BM = 256, BK = 64, HALF = 128, HTB = HALF * BK * 2, STAGE_BYTES = 8 * HTB, NXCD = 8, WGM = 8;
__host__ __device__ __forceinline__ int lds_byte(int r, int c) { const int st = (r >> 4) * 2 + (c >> 5), rr = r & 15, cc = c & 31, ob = rr * 64 + cc * 2; return st * 1024 + (ob ^ (((ob >> 9) & 1) << 5)); }
__host__ __device__ __forceinline__ void stage_rc(int b, int& R, int& C) { const int st = b / 1024, sb = b % 1024, swz = sb ^ (((sb >> 9) & 1) << 5); R = (st >> 1) * 16 + swz / 64; C = (st & 1) * 32 + (swz % 64) / 2; }
__host__ __device__ __forceinline__ int perm32(int rho) { const int n = rho >> 4, i = rho & 15; return 8 * (i >> 2) + 4 * n + (i & 3); }

struct Unit { int pm, pn; const char* A; const char* B; };
struct Gemm { int lda, ldb, ksA, ksB, nt, hsA; };

struct StaticOrder {
    int nM, nN, nwg, G, c;
    __device__ void init(int M, int N, int G_, int c_) { nM = M / BM; nN = N / BM; nwg = nM * nN; G = G_; c = c_; }
    __device__ bool next(int i, int& pm, int& pn) const {
        const long L = (long)i * G + c; if (L >= nwg) return false;
        int wgid = (int)L; { const int q = nwg / NXCD, r = nwg % NXCD, xcd = wgid % NXCD, off = wgid / NXCD; wgid = (xcd < r ? xcd * (q + 1) : r * (q + 1) + (xcd - r) * q) + off; }
        const int nig = WGM * nN, gid = wgid / nig, fm = gid * WGM, gsz = (nM - fm) < WGM ? (nM - fm) : WGM;
        pm = fm + ((wgid % nig) % gsz); pn = (wgid % nig) / gsz; return true;
    }
};
struct StdSched {
    StaticOrder so; const char* A; const char* B; size_t tA, tB;
    __device__ void init(const void* A_, const void* B_, int M, int N, int lda_bytes, int ldb_bytes, int G, int c) { so.init(M, N, G, c); A = (const char*)A_; B = (const char*)B_; tA = (size_t)256 * lda_bytes; tB = (size_t)256 * ldb_bytes; }
    __device__ bool next(int i, Unit& u) const { if (!so.next(i, u.pm, u.pn)) return false; u.A = A + u.pm * tA; u.B = B + u.pn * tB; return true; }
};

template <class Epi, class Sched, bool ALIGN_EPI>
__device__ __forceinline__ void gemm_phase(LAS unsigned char* lds, const Gemm g, const Sched& S, const Epi& E, int wave_k) {
    int tid = TID_(wave_k); asm volatile("" : "+v"(tid));
    const int wid = __builtin_amdgcn_readfirstlane(tid >> 6), lane = tid & 63, wr = wid >> 2, wc = wid & 3, fr = lane & 15, fq = lane >> 4;
    const int nt = g.nt;
    unsigned voffA[2], voffB[2];
#pragma unroll
    for (int i = 0; i < 2; ++i) { int R, C; stage_rc(tid * 16 + i * 8192, R, C); const int Rb = (R & ~31) + perm32(R & 31);
        voffA[i] = (unsigned)(R * g.lda + C * 2); voffB[i] = (unsigned)(Rb * g.ldb + C * 2); }
    const size_t kstepA = (size_t)g.ksA, kstepB = (size_t)g.ksB;
    const ptrdiff_t hstepA = g.hsA ? (ptrdiff_t)g.hsA : (ptrdiff_t)HALF * g.lda; const size_t hstepB = (size_t)HALF * g.ldb;
    const unsigned ldsw = (unsigned)wid * 1024u;
    const int aoff = lds_byte(wr * 64 + fr, fq * 8), boff = lds_byte(wc * 32 + fr, fq * 8);
#define PG8_SA(b, h) (((b) * 2 + (h)) * HTB)
#define PG8_SB(b, h) ((4 + (b) * 2 + (h)) * HTB)
#define PG8_STAGE(bufoff, gbase, voff) do { _Pragma("unroll") for (int _i = 0; _i < 2; ++_i) \
        __builtin_amdgcn_global_load_lds((const unsigned*)((const char*)(gbase) + (voff)[_i]), (LAS unsigned*)(lds + (bufoff) + ldsw + _i * 8192), 16, 0, 0); } while (0)
#define PG8_LDA(dst, b, h) do { _Pragma("unroll") for (int m = 0; m < 4; ++m) _Pragma("unroll") for (int k = 0; k < 2; ++k) dst[m][k] = *(const LAS bf16x8*)(lds + PG8_SA(b, h) + aoff + m * 2048 + k * 1024); } while (0)
#define PG8_LDB(dst, b, h) do { _Pragma("unroll") for (int n = 0; n < 2; ++n) _Pragma("unroll") for (int k = 0; k < 2; ++k) dst[n][k] = *(const LAS bf16x8*)(lds + PG8_SB(b, h) + boff + n * 2048 + k * 1024); } while (0)
#define PG8_MMA(ai, bj, At, Bt) do { __builtin_amdgcn_s_setprio(1); _Pragma("unroll") for (int m = 0; m < 4; ++m) _Pragma("unroll") for (int n = 0; n < 2; ++n) _Pragma("unroll") for (int k = 0; k < 2; ++k) \
        acc[ai][bj][m][n] = __builtin_amdgcn_mfma_f32_16x16x32_bf16(Bt[n][k], At[m][k], acc[ai][bj][m][n], 0, 0, 0); __builtin_amdgcn_s_setprio(0); } while (0)
#define PG8_WAIT_V(n) asm volatile("s_waitcnt vmcnt(" #n ")" ::: "memory")
#define PG8_WAIT_L(n) asm volatile("s_waitcnt lgkmcnt(" #n ")" ::: "memory")
#define PG8_BAR __builtin_amdgcn_s_barrier()
#define PG8_SCHED __builtin_amdgcn_sched_barrier(0)
    Unit cur, nxt; int ui = 0;
    if (!S.next(0, cur)) return;
    f32x4 acc[2][2][4][2];
#pragma unroll
    for (int a = 0; a < 2; ++a)
#pragma unroll
        for (int b = 0; b < 2; ++b)
#pragma unroll
            for (int m = 0; m < 4; ++m)
#pragma unroll
                for (int n = 0; n < 2; ++n) acc[a][b][m][n] = (f32x4){0.f, 0.f, 0.f, 0.f};
    bf16x8 At[4][2], B0[2][2], B1[2][2];
    const char* cA = cur.A; const char* cB = cur.B;
    PG8_STAGE(PG8_SB(0, 0), cB, voffB); PG8_STAGE(PG8_SB(0, 1), cB + hstepB, voffB); PG8_STAGE(PG8_SA(0, 0), cA, voffA); PG8_STAGE(PG8_SA(0, 1), cA + hstepA, voffA);
    if (wr == 1) PG8_BAR;
    PG8_WAIT_V(2); PG8_BAR;
    PG8_STAGE(PG8_SB(1, 0), cB + kstepB, voffB); PG8_STAGE(PG8_SA(1, 0), cA + kstepA, voffA); PG8_STAGE(PG8_SB(1, 1), cB + hstepB + kstepB, voffB);
    PG8_WAIT_V(6); PG8_BAR;
    for (;;) {
        const bool has_next = S.next(ui + 1, nxt);
        const char* nA = has_next ? nxt.A : cA; const char* nB = has_next ? nxt.B : cB;
        for (int t = 0; t < nt; t += 2) {
            const bool last = (t == nt - 2);
            const char* a1 = cA + (size_t)(t + 1) * kstepA;
            const char* a2 = last ? nA : cA + (size_t)(t + 2) * kstepA; const char* b2 = last ? nB : cB + (size_t)(t + 2) * kstepB;
            const char* a3 = a2 + kstepA; const char* b3 = b2 + kstepB;
            PG8_LDB(B0, 0, 0); PG8_LDB(B1, 0, 1); PG8_SCHED; PG8_LDA(At, 0, 0); PG8_STAGE(PG8_SA(1, 1), a1 + hstepA, voffA);
            PG8_WAIT_V(8); PG8_WAIT_L(0); PG8_BAR; PG8_MMA(0, 0, At, B0); PG8_MMA(0, 1, At, B1); PG8_BAR; PG8_SCHED;
            PG8_LDA(At, 0, 1); PG8_STAGE(PG8_SB(0, 0), b2, voffB); PG8_STAGE(PG8_SB(0, 1), b2 + hstepB, voffB); PG8_STAGE(PG8_SA(0, 0), a2, voffA);
            PG8_WAIT_V(8); PG8_WAIT_L(0); PG8_BAR; PG8_MMA(1, 0, At, B0); PG8_MMA(1, 1, At, B1); PG8_BAR; PG8_SCHED;
            PG8_LDB(B0, 1, 0); PG8_LDB(B1, 1, 1); PG8_SCHED; PG8_LDA(At, 1, 0); PG8_STAGE(PG8_SA(0, 1), a2 + hstepA, voffA);
            PG8_WAIT_V(8); PG8_WAIT_L(0); PG8_BAR; PG8_MMA(0, 0, At, B0); PG8_MMA(0, 1, At, B1); PG8_BAR; PG8_SCHED;
            PG8_LDA(At, 1, 1); PG8_STAGE(PG8_SB(1, 0), b3, voffB); PG8_STAGE(PG8_SB(1, 1), b3 + hstepB, voffB); PG8_STAGE(PG8_SA(1, 0), a3, voffA);
            PG8_WAIT_V(8); PG8_WAIT_L(0); PG8_BAR; PG8_MMA(1, 0, At, B0); PG8_MMA(1, 1, At, B1); PG8_BAR; PG8_SCHED;
            if constexpr (Epi::HOOK_KT > 0) { if (t + 2 == Epi::HOOK_KT) { E.hook(acc, cur, wr, wc, fr, fq); PG8_WAIT_V(0); PG8_SCHED; } }
        }
        if constexpr (ALIGN_EPI) { if (wr == 0) PG8_BAR; }
        if constexpr (!Epi::AFTER_DRAIN) { E(acc, cur, wr, wc, fr, fq); }
        if (!has_next) break;
#pragma unroll
        for (int a = 0; a < 2; ++a)
#pragma unroll
            for (int b = 0; b < 2; ++b)
#pragma unroll
                for (int m = 0; m < 4; ++m)
#pragma unroll
                    for (int n = 0; n < 2; ++n) acc[a][b][m][n] = (f32x4){0.f, 0.f, 0.f, 0.f};
        cur = nxt; cA = nA; cB = nB; ++ui;
        if constexpr (ALIGN_EPI) { if (wr == 1) PG8_BAR; }
    }
    PG8_WAIT_V(0);
    if constexpr (!ALIGN_EPI) { if (wr == 0) PG8_BAR; }
    PG8_BAR;
    if constexpr (Epi::AFTER_DRAIN) { E.fused(acc, cur, wr, wc, fr, fq, wid, lane, lds); }
#undef PG8_SA
#undef PG8_SB
#undef PG8_STAGE
#undef PG8_LDA
#undef PG8_LDB
#undef PG8_MMA
#undef PG8_WAIT_V
#undef PG8_WAIT_L
#undef PG8_BAR
#undef PG8_SCHED
}
}
using pg8::Unit;
typedef f32x4 Acc[2][2][4][2];
#define EPI_ROW(u, ai, wr, m, fr) ((u).pm * 256 + (ai) * 128 + (wr) * 64 + (m) * 16 + (fr))
#define EPI_LC(bj, wc, fq) ((bj) * 128 + (wc) * 32 + (fq) * 8)

constexpr int CW_XC = 14600;
struct EpiIn {
    static constexpr bool AFTER_DRAIN = false; static constexpr int HOOK_KT = 0;
    bf16_t *U, *QP, *QR, *KV0, *SP, *SA; float* GN; const float* RC; const float* RS;
    __device__ __forceinline__ void rope8(f32x4& v0, f32x4& v1, int t, bool apply, int fq) const {
        f32x4 p0, p1;
#pragma unroll
        for (int e = 0; e < 4; ++e) { p0[e] = __shfl_xor(v0[e], 16); p1[e] = __shfl_xor(v1[e], 16); }
        if (apply) {
            const f32x4 c0 = *(const f32x4*)(RC + t * 8), c1 = *(const f32x4*)(RC + t * 8 + 4), s0 = *(const f32x4*)(RS + t * 8), s1 = *(const f32x4*)(RS + t * 8 + 4);
            const float sg = (fq & 1) ? 1.f : -1.f;
            v0 = v0 * c0 + (p0 * s0) * sg; v1 = v1 * c1 + (p1 * s1) * sg;
        }
    }
    __device__ __forceinline__ void operator()(const Acc& acc, const Unit& u, int wr, int wc, int fr, int fq) const {
        OPAQUE(fr); OPAQUE(fq);
        const int pn = u.pn; const bool ropel = ((wc & 1) == 0) && fq < 2;
#pragma unroll
        for (int ai = 0; ai < 2; ++ai)
#pragma unroll
            for (int m = 0; m < 4; ++m) {
                const int r = EPI_ROW(u, ai, wr, m, fr), t = r & (SEQ - 1);
#pragma unroll
                for (int bj = 0; bj < 2; ++bj) {
                    const int lc = EPI_LC(bj, wc, fq); f32x4 v0 = acc[ai][bj][m][0], v1 = acc[ai][bj][m][1];
                    if (pn < 2) { *(u32x4*)(U + (size_t)r * 512 + pn * 256 + lc) = pack8(v0, v1); }
                    else if (pn < 6) {
                        v0 = v0 * C2; v1 = v1 * C2; const size_t o = (size_t)r * 1024 + (pn - 2) * 256 + lc;
                        *(u32x4*)(QP + o) = pack8(v0, v1);
                        if ((wc & 1) == 0) rope8(v0, v1, t, ropel, fq);
                        *(u32x4*)(QR + o) = pack8(v0, v1);
                    } else if (pn < 12) {
                        const int ty = pn - 6; bf16_t* dst = KV0 + (size_t)ty * (size_t)(4u << 20);
                        if ((ty == 2 || ty == 4) && (wc & 1) == 0) rope8(v0, v1, t, ropel, fq);
                        *(u32x4*)(dst + (size_t)r * 256 + lc) = pack8(v0, v1);
                    } else if (pn < 20) {
                        bf16_t* dst = pn < 16 ? SP : SA; const int cb = ((pn - 12) & 3) * 256 + lc;
#pragma unroll
                        for (int e = 0; e < 4; ++e) { v0[e] = sigmoidf_(v0[e]); v1[e] = sigmoidf_(v1[e]); }
                        *(u32x4*)(dst + (size_t)r * 1024 + cb) = pack8(v0, v1);
                    } else if (lc < 48) {
#pragma unroll
                        for (int e = 0; e < 4; ++e) { v0[e] = sigmoidf_(v0[e]); v1[e] = sigmoidf_(v1[e]); }
                        *(f32x4*)(GN + (size_t)r * 48 + lc) = v0; *(f32x4*)(GN + (size_t)r * 48 + lc + 4) = v1;
                    }
                }
            }
    }
};
__device__ __forceinline__ float gelu_tanh(float x) { const float u = 0.7978845608028654f * (x + 0.044715f * x * x * x); const float e = __expf(2.f * u); return 0.5f * x * (1.f + (1.f - 2.f * __builtin_amdgcn_rcpf(e + 1.f))); }
struct EpiCmp {
    static constexpr bool AFTER_DRAIN = true; static constexpr int HOOK_KT = 0;
    bf16_t *HIDK, *HIDV; const float *PEBK, *PEBV; const bf16_t *W2K, *W2V; bf16_t *KCMP, *VCMP; unsigned char* wsb; int split;
    template <int AI> __device__ __forceinline__ void gelu_half(const Acc& acc, bf16_t* HID, const float* peb, int rbase, int wr, int wc, int fr, int fq) const {
#pragma unroll
        for (int bj = 0; bj < 2; ++bj) {
            const int lc = EPI_LC(bj, wc, fq); const f32x4 b0 = *(const f32x4*)(peb + lc), b1 = *(const f32x4*)(peb + lc + 4);
#pragma unroll
            for (int m = 0; m < 4; ++m) {
                const int r = rbase + wr * 64 + m * 16 + fr; f32x4 v0 = acc[AI][bj][m][0] + b0, v1 = acc[AI][bj][m][1] + b1;
#pragma unroll
                for (int e = 0; e < 4; ++e) { v0[e] = gelu_tanh(v0[e]); v1[e] = gelu_tanh(v1[e]); }
                *(u32x4*)(HID + (size_t)r * 256 + lc) = pack8(v0, v1);
            }
        }
    }
    __device__ __forceinline__ void fused(Acc& acc, const Unit& u, int wr, int wc, int fr, int fq, int wid, int lane, LAS unsigned char*) const {
        OPAQUE(fr); OPAQUE(fq);
        const int h = u.pn, which = u.pm >> 4, rt = u.pm & 15; bf16_t* HID = which ? HIDV : HIDK; const float* peb = which ? PEBV : PEBK;
        if (split) {
            float* slabs = (float*)(wsb + (u.pm < 16 ? WS_WM : WS_WD)) + (size_t)((u.pm & 15) * 2) * (128 * 256);
            unsigned* cnt = (unsigned*)(wsb + WS_CTL) + CW_XC + (u.pm * 2) * 16;
            float* mine = slabs + (size_t)h * (128 * 256); const float* theirs = slabs + (size_t)(h ^ 1) * (128 * 256);
#pragma unroll
            for (int bj = 0; bj < 2; ++bj)
#pragma unroll
                for (int m = 0; m < 4; ++m) { float* p = mine + (size_t)(wr * 64 + m * 16 + fr) * 256 + EPI_LC(bj, wc, fq);
                    asm volatile("global_store_dwordx4 %0, %1, off sc0 sc1" :: "v"(p), "v"(acc[1][bj][m][0]) : "memory");
                    asm volatile("global_store_dwordx4 %0, %1, off offset:16 sc0 sc1" :: "v"(p), "v"(acc[1][bj][m][1]) : "memory"); }
            asm volatile("s_waitcnt vmcnt(0)" ::: "memory");
            if (lane == 0) __hip_atomic_fetch_add(cnt + 16 * h, 1u, __ATOMIC_RELAXED, __HIP_MEMORY_SCOPE_AGENT);
            if (wid == 0) {
                unsigned sp = 0; while ((unsigned)__builtin_amdgcn_readfirstlane((int)__hip_atomic_load(cnt + 16 * (h ^ 1), __ATOMIC_RELAXED, __HIP_MEMORY_SCOPE_AGENT)) < 8u && ++sp < (1u << 22)) __builtin_amdgcn_s_sleep(2);
            }
            asm volatile("s_waitcnt vmcnt(0) lgkmcnt(0)" ::: "memory"); __builtin_amdgcn_s_barrier(); asm volatile("" ::: "memory");
            __builtin_amdgcn_fence(__ATOMIC_ACQUIRE, "agent");
#pragma unroll
            for (int bj = 0; bj < 2; ++bj)
#pragma unroll
                for (int m = 0; m < 4; ++m) { const float* p = theirs + (size_t)(wr * 64 + m * 16 + fr) * 256 + EPI_LC(bj, wc, fq); acc[0][bj][m][0] += *(const f32x4*)p; acc[0][bj][m][1] += *(const f32x4*)(p + 4); }
        }
        gelu_half<0>(acc, HID, peb, rt * 256 + (split ? h * 128 : 0), wr, wc, fr, fq);
        if (!split) gelu_half<1>(acc, HID, peb, rt * 256 + 128, wr, wc, fr, fq);
        asm volatile("s_waitcnt vmcnt(0)" ::: "memory"); __syncthreads();
        const bf16_t* W2 = which ? W2V : W2K; bf16_t* OUT = which ? VCMP : KCMP; const int r0 = rt * 256 + (split ? h * 128 + wid * 16 : wid * 32);
        f32x4 c2[2][4];
#pragma unroll
        for (int mt = 0; mt < 2; ++mt)
#pragma unroll
            for (int nt = 0; nt < 4; ++nt) c2[mt][nt] = (f32x4){0.f, 0.f, 0.f, 0.f};
        for (int k0 = 0; k0 < 256; k0 += 32) {
            bf16x8 a[2], b[4];
#pragma unroll
            for (int mt = 0; mt < 2; ++mt) a[mt] = *(const bf16x8*)(HID + (size_t)(r0 + (split ? 0 : 16 * mt) + fr) * 256 + k0 + 8 * fq);
#pragma unroll
            for (int nt = 0; nt < 4; ++nt) b[nt] = *(const bf16x8*)(W2 + (size_t)(16 * nt + fr) * 256 + k0 + 8 * fq);
#pragma unroll
            for (int mt = 0; mt < 2; ++mt)
#pragma unroll
                for (int nt = 0; nt < 4; ++nt) c2[mt][nt] = __builtin_amdgcn_mfma_f32_16x16x32_bf16(a[mt], b[nt], c2[mt][nt], 0, 0, 0);
        }
#pragma unroll
        for (int mt = 0; mt < 2; ++mt) {
            if (mt == 0 || !split) {
#pragma unroll
            for (int nt = 0; nt < 4; ++nt)
#pragma unroll
                for (int r = 0; r < 4; ++r) OUT[(size_t)(r0 + 16 * mt + 4 * fq + r) * 64 + 16 * nt + fr] = (bf16_t)f2bf(c2[mt][nt][r]);
            }
        }
    }
};
struct EpiMerged {
    static constexpr bool AFTER_DRAIN = false; static constexpr int HOOK_KT = 8;
    bf16_t* MG; const bf16_t* SP; const bf16_t* SA;
    __device__ __forceinline__ void hook(Acc& acc, const Unit& u, int wr, int wc, int fr, int fq) const {
        OPAQUE(fr); OPAQUE(fq);
#pragma unroll
        for (int ai = 0; ai < 2; ++ai)
#pragma unroll
            for (int m = 0; m < 4; ++m) {
                const int r = EPI_ROW(u, ai, wr, m, fr);
#pragma unroll
                for (int bj = 0; bj < 2; ++bj) {
                    const size_t o = (size_t)r * 1024 + u.pn * 256 + EPI_LC(bj, wc, fq);
                    const u32x4 wp = *(const u32x4*)(SP + o), wa = *(const u32x4*)(SA + o); f32x4 p0, p1, a0, a1; unpack8(wp, p0, p1); unpack8(wa, a0, a1);
#pragma unroll
                    for (int e = 0; e < 4; ++e) { acc[ai][bj][m][0][e] *= p0[e] * __builtin_amdgcn_rcpf(a0[e]); acc[ai][bj][m][1][e] *= p1[e] * __builtin_amdgcn_rcpf(a1[e]); }
                }
            }
    }
    __device__ __forceinline__ void operator()(const Acc& acc, const Unit& u, int wr, int wc, int fr, int fq) const {
        OPAQUE(fr); OPAQUE(fq);
#pragma unroll
        for (int ai = 0; ai < 2; ++ai)
#pragma unroll
            for (int m = 0; m < 4; ++m) {
                const int r = EPI_ROW(u, ai, wr, m, fr);
#pragma unroll
                for (int bj = 0; bj < 2; ++bj) {
                    const size_t o = (size_t)r * 1024 + u.pn * 256 + EPI_LC(bj, wc, fq);
                    const u32x4 wa = *(const u32x4*)(SA + o); f32x4 a0, a1; unpack8(wa, a0, a1);
                    *(u32x4*)(MG + o) = pack8(acc[ai][bj][m][0] * a0, acc[ai][bj][m][1] * a1);
                }
            }
    }
};
struct EpiX1 {
    static constexpr bool AFTER_DRAIN = false; static constexpr int HOOK_KT = 0;
    const float* x; float* X1; bf16_t* X1B; float* RSP;
    __device__ __forceinline__ void operator()(const Acc& acc, const Unit& u, int wr, int wc, int fr, int fq) const {
        OPAQUE(fr); OPAQUE(fq);
#pragma unroll
        for (int ai = 0; ai < 2; ++ai)
#pragma unroll
            for (int m = 0; m < 4; ++m) {
                const int r = EPI_ROW(u, ai, wr, m, fr); float s = 0.f;
#pragma unroll
                for (int bj = 0; bj < 2; ++bj) {
                    const size_t o = (size_t)r * 1024 + u.pn * 256 + EPI_LC(bj, wc, fq);
                    const f32x4 o0 = *(const f32x4*)(x + o) + acc[ai][bj][m][0], o1 = *(const f32x4*)(x + o + 4) + acc[ai][bj][m][1];
                    *(u32x4*)(X1B + o) = pack8(o0, o1);
                    s += (o0[0] * o0[0] + o0[1] * o0[1]) + (o0[2] * o0[2] + o0[3] * o0[3]) + (o1[0] * o1[0] + o1[1] * o1[1]) + (o1[2] * o1[2] + o1[3] * o1[3]);
                }
                s += __shfl_xor(s, 16); s += __shfl_xor(s, 32);
                if (fq == 0) RSP[(size_t)r * 16 + u.pn * 4 + wc] = s;
            }
    }
};
struct EpiAct {
    static constexpr bool AFTER_DRAIN = false; static constexpr int HOOK_KT = 0;
    bf16_t* ACT; const float* RSP;
    __device__ __forceinline__ void operator()(const Acc& acc, const Unit& u, int wr, int wc, int fr, int fq) const {
        OPAQUE(fr); OPAQUE(fq);
#pragma unroll
        for (int ai = 0; ai < 2; ++ai)
#pragma unroll
            for (int m = 0; m < 4; ++m) {
                const int r = EPI_ROW(u, ai, wr, m, fr); const f32x4* rp = (const f32x4*)(RSP + (size_t)r * 16);
                const f32x4 q0 = rp[0], q1 = rp[1], q2 = rp[2], q3 = rp[3];
                const float ss = ((q0[0] + q0[1]) + (q0[2] + q0[3])) + ((q1[0] + q1[1]) + (q1[2] + q1[3])) + ((q2[0] + q2[1]) + (q2[2] + q2[3])) + ((q3[0] + q3[1]) + (q3[2] + q3[3]));
                const float rstd = rsqrtf(ss * (1.f / DM) + RMS_EPS);
                f32x4 o[2];
#pragma unroll
                for (int n = 0; n < 2; ++n)
#pragma unroll
                    for (int e = 0; e < 4; ++e) { const float gg = acc[ai][0][m][n][e] * rstd, uu = acc[ai][1][m][n][e] * rstd; o[n][e] = gg * sigmoidf_(gg) * uu; }
                *(u32x4*)(ACT + (size_t)r * DFF + u.pn * 128 + wc * 32 + fq * 8) = pack8(o[0], o[1]);
            }
    }
};
struct EpiX2 {
    static constexpr bool AFTER_DRAIN = false; static constexpr int HOOK_KT = 0;
    float* X; const bf16_t* X1B;
    __device__ __forceinline__ void operator()(const Acc& acc, const Unit& u, int wr, int wc, int fr, int fq) const {
        OPAQUE(fr); OPAQUE(fq);
#pragma unroll
        for (int ai = 0; ai < 2; ++ai)
#pragma unroll
            for (int m = 0; m < 4; ++m) {
                const int r = EPI_ROW(u, ai, wr, m, fr);
#pragma unroll
                for (int bj = 0; bj < 2; ++bj) {
                    const size_t o = (size_t)r * 1024 + u.pn * 256 + EPI_LC(bj, wc, fq); float* p = X + o;
                    const u32x4 xw = *(const u32x4*)(X1B + o); f32x4 x0, x1v; unpack8(xw, x0, x1v);
                    *(f32x4*)p = x0 + acc[ai][bj][m][0]; *(f32x4*)(p + 4) = x1v + acc[ai][bj][m][1];
                }
            }
    }
};
struct EpiFinal {
    static constexpr bool AFTER_DRAIN = true; static constexpr int HOOK_KT = 0;
    float* X; const bf16_t* X1B; const float* nw; float* slots; unsigned* cnt;
    __device__ __forceinline__ void fused(Acc& acc, const Unit& u, int wr, int wc, int fr, int fq, int wid, int lane, LAS unsigned char* lds) const {
        OPAQUE(fr); OPAQUE(fq);
        LAS float* Pl = (LAS float*)lds;
        LAS float* Sr = (LAS float*)(lds + 4096);
#pragma unroll
        for (int ai = 0; ai < 2; ++ai)
#pragma unroll
            for (int m = 0; m < 4; ++m) {
                const int r = EPI_ROW(u, ai, wr, m, fr); float sq = 0.f;
#pragma unroll
                for (int bj = 0; bj < 2; ++bj) {
                    { const u32x4 xw = *(const u32x4*)(X1B + (size_t)r * 1024 + u.pn * 256 + EPI_LC(bj, wc, fq)); f32x4 x0, x1v; unpack8(xw, x0, x1v); acc[ai][bj][m][0] += x0; acc[ai][bj][m][1] += x1v; }
                    const f32x4 a = acc[ai][bj][m][0], b = acc[ai][bj][m][1];
                    sq += ((a[0] * a[0] + a[1] * a[1]) + (a[2] * a[2] + a[3] * a[3])) + ((b[0] * b[0] + b[1] * b[1]) + (b[2] * b[2] + b[3] * b[3]));
                }
                sq += __shfl_xor(sq, 16); sq += __shfl_xor(sq, 32);
                if (fq == 0) Pl[(ai * 128 + wr * 64 + m * 16 + fr) * 4 + wc] = sq;
            }
        asm volatile("s_waitcnt lgkmcnt(0)" ::: "memory"); __builtin_amdgcn_s_barrier(); asm volatile("" ::: "memory");
        const int row = wid * 32 + (lane & 31);
        if (lane < 32) { const f32x4 q4 = *(const LAS f32x4*)(Pl + row * 4);
            __hip_atomic_store(slots + (size_t)(u.pm * 256 + row) * 4 + u.pn, (q4[0] + q4[1]) + (q4[2] + q4[3]), __ATOMIC_RELAXED, __HIP_MEMORY_SCOPE_AGENT); }
        asm volatile("s_waitcnt vmcnt(0)" ::: "memory");
        if (lane == 0) __hip_atomic_fetch_add(cnt + 64 * u.pm, 1u, __ATOMIC_RELAXED, __HIP_MEMORY_SCOPE_AGENT);
        if (wid == 0) {
            unsigned sp = 0; while ((unsigned)__builtin_amdgcn_readfirstlane((int)__hip_atomic_load(cnt + 64 * u.pm, __ATOMIC_RELAXED, __HIP_MEMORY_SCOPE_AGENT)) < 32u && ++sp < (1u << 22)) __builtin_amdgcn_s_sleep(2);
            __builtin_amdgcn_fence(__ATOMIC_ACQUIRE, "agent");
        }
        asm volatile("s_waitcnt vmcnt(0) lgkmcnt(0)" ::: "memory"); __builtin_amdgcn_s_barrier(); asm volatile("" ::: "memory");
        if (lane < 32) { const float* sl = slots + (size_t)(u.pm * 256 + row) * 4; float t = 0.f;
#pragma unroll
            for (int k = 0; k < 4; ++k) t += __hip_atomic_load(sl + k, __ATOMIC_RELAXED, __HIP_MEMORY_SCOPE_AGENT);
            Sr[row] = rsqrtf(t * (1.f / DM) + RMS_EPS); }
        asm volatile("s_waitcnt lgkmcnt(0)" ::: "memory"); __builtin_amdgcn_s_barrier(); asm volatile("" ::: "memory");
#pragma unroll
        for (int bj = 0; bj < 2; ++bj) {
            const int c0 = u.pn * 256 + EPI_LC(bj, wc, fq); const f32x4 w0 = *(const f32x4*)(nw + c0), w1 = *(const f32x4*)(nw + c0 + 4);
#pragma unroll
            for (int ai = 0; ai < 2; ++ai)
#pragma unroll
                for (int m = 0; m < 4; ++m) {
                    const int rl = ai * 128 + wr * 64 + m * 16 + fr; const float rs = Sr[rl]; float* p = X + (size_t)(u.pm * 256 + rl) * 1024 + c0;
                    *(f32x4*)p = acc[ai][bj][m][0] * w0 * rs; *(f32x4*)(p + 4) = acc[ai][bj][m][1] * w1 * rs;
                }
        }
    }
};
struct CmpSched {
    const char *KC, *VC, *W1K, *W1V; int c, split;
    __device__ bool next(int i, Unit& u) const {
        if (i > 0 || c >= (split ? 64 : 32)) return false;
        const int un = split ? c >> 1 : c, hk = split ? c & 1 : 0;
        const int which = un >> 4, rt = un & 15, bg = rt >> 1, half = rt & 1, b = bg >> 2, g = bg & 3;
        u.pm = un; u.pn = hk; u.A = (which ? VC : KC) + ((size_t)(b * SEQ + 16 * 256 * half + 16 * hk + (hk ? 16 * 128 : 0)) * 256 + g * 64) * 2; u.B = (which ? W1V : W1K) + (size_t)hk * 2048; return true;
    }
};

struct SF_in { const float* W; __device__ __forceinline__ float operator()(int k, int n) const { const int r = incol_ref(n); return r < 0 ? 0.f : W[(size_t)k * NREF + r]; } };
struct SF_plain { const float* W; int ldn; __device__ __forceinline__ float operator()(int k, int n) const { return W[(size_t)k * ldn + n]; } };
struct SF_gu { const float *Wg, *Wu, *nw; __device__ __forceinline__ float operator()(int k, int n) const {
    const int tile = n >> 8, half = (n >> 7) & 1, j = n & 127, col = tile * 128 + j; const ptrdiff_t d = Wu - Wg; return nw[k] * Wg[(ptrdiff_t)half * d + (ptrdiff_t)k * DFF + col]; } };
__device__ __forceinline__ void p0_tile_out(int K, bf16_t* WT, LAS float* scr, int k0, int n0, int lane) {
    WSYNC();
    const int c = lane & 7;
#pragma unroll
    for (int j = 0; j < 4; ++j) { const int n = (lane >> 3) + 8 * j; const LAS float* s = scr + (8 * c) * 33 + n;
        u32x4 o; o.x = pk2(s[0 * 33], s[1 * 33]); o.y = pk2(s[2 * 33], s[3 * 33]); o.z = pk2(s[4 * 33], s[5 * 33]); o.w = pk2(s[6 * 33], s[7 * 33]);
        *(u32x4*)(WT + (size_t)(n0 + n) * K + k0 + 8 * c) = o; }
    WSYNC();
}
template <class SF> __device__ __forceinline__ void p0_transpose_item(const SF& sf, int K, int N, bf16_t* WT, LAS float* scr, int item, int lane) {
    const int nblk = N / 32, kb = item / nblk, nb = item % nblk, k0 = 64 * kb, n0 = 32 * nb;
    float v[32];
#pragma unroll
    for (int i = 0; i < 32; ++i) v[i] = sf(k0 + 2 * i + (lane >> 5), n0 + (lane & 31));
#pragma unroll
    for (int i = 0; i < 32; ++i) scr[(2 * i + (lane >> 5)) * 33 + (lane & 31)] = v[i];
    p0_tile_out(K, WT, scr, k0, n0, lane);
}
__device__ __forceinline__ void p0_fold_item(const float* pool_w, const float* pool_scale, const float* Wp, bf16_t* WT, int f, int wave, int lane) {
    const int k0 = 64 * (f >> 5), n0 = 32 * (f & 31) + 4 * wave, g = k0 >> 7;
    f32x4 acc = (f32x4){0.f, 0.f, 0.f, 0.f};
    const float* arow = pool_w + (size_t)(k0 + lane) * 128;
#pragma unroll 4
    for (int dp = 0; dp < 128; dp += 4) {
        const f32x4 a = *(const f32x4*)(arow + dp); const f32x4 sc = *(const f32x4*)(pool_scale + g * 128 + dp);
#pragma unroll
        for (int e = 0; e < 4; ++e) { const f32x4 w4 = *(const f32x4*)(Wp + (size_t)(g * 128 + dp + e) * 1024 + n0); acc += w4 * (a[e] * sc[e]); }
    }
#pragma unroll
    for (int j = 0; j < 4; ++j) WT[(size_t)(n0 + j) * 1536 + k0 + lane] = (bf16_t)f2bf(acc[j]);
}
__device__ __forceinline__ void p0_fold_item2(const float* pool_w, const float* pool_scale, const float* Wp, bf16_t* WT, int f, int lane) {
    const int g = f >> 5, kb = (f >> 2) & 7, nb = f & 3, kk0 = g * 128 + kb * 16, n0 = nb * 256 + 4 * lane;
    f32x4 acc[16];
#pragma unroll
    for (int r = 0; r < 16; ++r) acc[r] = (f32x4){0.f, 0.f, 0.f, 0.f};
    const float* bp = Wp + (size_t)(g * 128) * 1024 + n0;
#pragma unroll 1
    for (int dp = 0; dp < 128; dp += 4) {
        const f32x4 sc = *(const f32x4*)(pool_scale + g * 128 + dp);
        f32x4 b[4];
#pragma unroll
        for (int e = 0; e < 4; ++e) b[e] = *(const f32x4*)(bp + (size_t)(dp + e) * 1024);
#pragma unroll
        for (int r = 0; r < 16; ++r) {
            const f32x4 a = *(const f32x4*)(pool_w + (size_t)(kk0 + r) * 128 + dp);
#pragma unroll
            for (int e = 0; e < 4; ++e) acc[r] += b[e] * (a[e] * sc[e]);
        }
    }
#pragma unroll
    for (int j = 0; j < 4; ++j) {
        u32x4 w0, w1;
        w0.x = pk2(acc[0][j], acc[1][j]); w0.y = pk2(acc[2][j], acc[3][j]); w0.z = pk2(acc[4][j], acc[5][j]); w0.w = pk2(acc[6][j], acc[7][j]);
        w1.x = pk2(acc[8][j], acc[9][j]); w1.y = pk2(acc[10][j], acc[11][j]); w1.z = pk2(acc[12][j], acc[13][j]); w1.w = pk2(acc[14][j], acc[15][j]);
        bf16_t* o = WT + (size_t)(n0 + j) * 1536 + kk0; *(u32x4*)o = w0; *(u32x4*)(o + 8) = w1;
    }
}
template <int PART> __device__ __forceinline__ void p0_prologue(KParams P, LAS unsigned char* lds, int gw, int NGW, int wave, int lane) {
    unsigned char* ws = P->ws;
    LAS float* scr = (LAS float*)(lds + wave * 16384);
    constexpr int I_IN = (1024 / 64) * (NIN / 32), I_W1 = (2048 / 64) * (256 / 32), I_W2 = (256 / 64) * (64 / 32), I_WM = (1024 / 64) * (1024 / 32), I_WO = (1024 / 64) * (1024 / 32),
                  I_GU = (1024 / 64) * (5632 / 32), I_WD = (2816 / 64) * (1024 / 32);
    if constexpr (PART == 1) {
        constexpr int NITEMS = I_WM + I_WO + I_WD;
        for (int f = gw >> 3; f < 256; f += NGW >> 3) p0_fold_item(P->pool_w, P->pool_scale, P->w_pp, (bf16_t*)(ws + WS_WM), f, wave, lane);
        for (int it = gw; it < NITEMS; it += NGW) {
            int r = it;
            if (r < I_WM) { p0_transpose_item(SF_plain{P->w_pa, 1024}, 1536, 1024, (bf16_t*)(ws + WS_WM) + 512, scr, r, lane); continue; } r -= I_WM;
            if (r < I_WO) { p0_transpose_item(SF_plain{P->w_out, 1024}, 1024, 1024, (bf16_t*)(ws + WS_WO), scr, r, lane); continue; } r -= I_WO;
            p0_transpose_item(SF_plain{P->w_d, 1024}, 2816, 1024, (bf16_t*)(ws + WS_WD), scr, r, lane);
        }
        return;
    }
    const int nGU = (NGW == 256 * NWAVES) ? 0 : I_GU;
    const int NITEMS = I_IN + 2 * I_W1 + 2 * I_W2 + nGU;
    for (int it = gw; it < NITEMS; it += NGW) {
        int r = it;
        if (r < nGU) { p0_transpose_item(SF_gu{P->w_g, P->w_u, P->norm2_w}, 1024, 5632, (bf16_t*)(ws + WS_WGU), scr, r, lane); continue; } r -= nGU;
        if (r < I_IN) { p0_transpose_item(SF_in{P->w_in}, 1024, NIN, (bf16_t*)(ws + WS_WIN), scr, r, lane); continue; } r -= I_IN;
        if (r < I_W1) { p0_transpose_item(SF_plain{P->w1_k, 256}, 2048, 256, (bf16_t*)(ws + WS_W1K), scr, r, lane); continue; } r -= I_W1;
        if (r < I_W1) { p0_transpose_item(SF_plain{P->w1_v, 256}, 2048, 256, (bf16_t*)(ws + WS_W1V), scr, r, lane); continue; } r -= I_W1;
        if (r < I_W2) { p0_transpose_item(SF_plain{P->w2_k, 64}, 256, 64, (bf16_t*)(ws + WS_W2K), scr, r, lane); continue; } r -= I_W2;
        p0_transpose_item(SF_plain{P->w2_v, 64}, 256, 64, (bf16_t*)(ws + WS_W2V), scr, r, lane);
    }
    for (int it = (gw & 31) ? 64 : (gw >> 5); it < 64; it += NGW >> 5) {
        const int which = it >> 5, c0 = (it & 31) * 8; const float* pe = which ? P->pe_v : P->pe_k; const float* w1 = which ? P->w1_v : P->w1_k; const float* b1 = which ? P->b1_v : P->b1_k;
        f32x4 s0 = (f32x4){0.f, 0.f, 0.f, 0.f}, s1 = s0;
#pragma unroll 8
        for (int j = 0; j < 32; ++j) { const int k = lane + 64 * j; const float p = pe[k]; s0 += *(const f32x4*)(w1 + (size_t)k * 256 + c0) * p; s1 += *(const f32x4*)(w1 + (size_t)k * 256 + c0 + 4) * p; }
#pragma unroll
        for (int e = 0; e < 4; ++e) { s0[e] = wave_sum(s0[e]); s1[e] = wave_sum(s1[e]); }
        if (lane == 0) { float* o = (float*)(ws + (which ? WS_PEBV : WS_PEBK)) + c0; *(f32x4*)o = s0 + *(const f32x4*)(b1 + c0); *(f32x4*)(o + 4) = s1 + *(const f32x4*)(b1 + c0 + 4); }
    }
    for (int it = gw; it < SEQ * 8 / 64; it += NGW) {
        const int idx = it * 64 + lane, i = idx & 7, t = idx >> 3;
        const float inv_freq = i == 0 ? 1.0f : i == 1 ? 0.193922758102417f : i == 2 ? 0.03760603070259094f : i == 3 ? 0.00729266507551074f : i == 4 ? 0.001414213445968926f : i == 5 ? 0.00027424818836152554f : i == 6 ? 5.318296462064609e-05f : 1.0313385246263351e-05f;
        const float ang = (float)t * inv_freq;
        ((float*)(ws + WS_RCOS))[idx] = cosf(ang); ((float*)(ws + WS_RSIN))[idx] = sinf(ang);
    }
    bf16_t* H = (bf16_t*)((char*)P->out + DO_H);
#pragma unroll 1
    for (int row = gw; row < T; row += NGW) {
        const f32x4* xr = (const f32x4*)(P->x + (size_t)row * DM) + lane; const f32x4* wr = (const f32x4*)P->norm1_w + lane;
        f32x4 v[4]; float s = 0.f;
#pragma unroll
        for (int j = 0; j < 4; ++j) { v[j] = xr[64 * j]; s += (v[j].x * v[j].x + v[j].y * v[j].y) + (v[j].z * v[j].z + v[j].w * v[j].w); }
        const float rstd = rsqrtf(wave_sum(s) * (1.f / DM) + RMS_EPS);
        u32x2* o = (u32x2*)(H + (size_t)row * DM) + lane;
#pragma unroll
        for (int j = 0; j < 4; ++j) { const f32x4 ww = wr[64 * j]; u32x2 p; p.x = pk2(v[j].x * rstd * ww.x, v[j].y * rstd * ww.y); p.y = pk2(v[j].z * rstd * ww.z, v[j].w * rstd * ww.w); o[64 * j] = p; }
    }
}
template <int W> __device__ __forceinline__ void pooled_item(const bf16_t* U, bf16_t* PA, int g, int rb, int lane) {
    const int row = rb * 4 + (lane >> 4), c0 = g * 128 + (lane & 15) * 8, t = row & (SEQ - 1), cnt = t + 1 < W ? t + 1 : W;
    u32x4 q[W];
#pragma unroll
    for (int i = 0; i < W; ++i) q[i] = *(const u32x4*)(U + (size_t)(row - (i < cnt ? i : 0)) * 512 + c0);
    f32x4 u0, u1; unpack8(q[0], u0, u1); f32x4 s0 = u0, s1 = u1;
#pragma unroll
    for (int i = 1; i < W; ++i) { f32x4 a, b; unpack8(q[i], a, b); if (i < cnt) { s0 += a; s1 += b; } }
    const float ic = 1.f / (float)cnt;
    *(u32x4*)(PA + (size_t)row * 1536 + c0) = pack8(s0 * ic - u0, s1 * ic - u1);
}
template <int W> __device__ __forceinline__ void pooled_load(const bf16_t* U, int g, int rb, int lane, u32x4 (&q)[W]) {
    const int row = rb * 4 + (lane >> 4), c0 = g * 128 + (lane & 15) * 8, t = row & (SEQ - 1), cnt = t + 1 < W ? t + 1 : W;
#pragma unroll
    for (int i = 0; i < W; ++i) q[i] = *(const u32x4*)(U + (size_t)(row - (i < cnt ? i : 0)) * 512 + c0);
}
template <int W> __device__ __forceinline__ void pooled_store(bf16_t* PA, int g, int rb, int lane, const u32x4 (&q)[W]) {
    const int row = rb * 4 + (lane >> 4), c0 = g * 128 + (lane & 15) * 8, t = row & (SEQ - 1), cnt = t + 1 < W ? t + 1 : W;
    f32x4 u0, u1; unpack8(q[0], u0, u1); f32x4 s0 = u0, s1 = u1;
#pragma unroll
    for (int i = 1; i < W; ++i) { f32x4 a, b; unpack8(q[i], a, b); if (i < cnt) { s0 += a; s1 += b; } }
    const float ic = 1.f / (float)cnt;
    *(u32x4*)(PA + (size_t)row * 1536 + c0) = pack8(s0 * ic - u0, s1 * ic - u1);
}
__device__ __forceinline__ void p2_pooled(const bf16_t* U, bf16_t* PA, int gw, int NGW, int lane) {
#pragma unroll 1
    for (int rb = gw; rb < T / 4; rb += NGW) {
        { u32x4 q16[16]; pooled_load<16>(U, 3, rb, lane, q16); pooled_store<16>(PA, 3, rb, lane, q16); }
        { u32x4 q2[2], q4[4], q8[8]; pooled_load<8>(U, 2, rb, lane, q8); pooled_load<4>(U, 1, rb, lane, q4); pooled_load<2>(U, 0, rb, lane, q2);
          pooled_store<2>(PA, 0, rb, lane, q2); pooled_store<4>(PA, 1, rb, lane, q4); pooled_store<8>(PA, 2, rb, lane, q8); }
    }
}

constexpr int CW_DQ = 14400;
constexpr int DQ_FOLD = 128, DQ_I_WM = (1024 / 64) * (1024 / 32), DQ_I_WO = DQ_I_WM, DQ_I_WD = (2816 / 64) * (1024 / 32), DQ_I_GU = (1024 / 64) * (5632 / 32), DQ_TR = (DQ_I_WM + DQ_I_WO + DQ_I_WD + DQ_I_GU) / 2, DQ_NT = DQ_FOLD + DQ_TR;
__device__ __forceinline__ void late_weights_queue(KParams P, LAS unsigned char* lds, int wave, int lane) {
    unsigned char* ws = P->ws; unsigned* ctl = (unsigned*)(ws + WS_CTL);
    LAS float* scr = (LAS float*)(lds + wave * 16384);
#pragma unroll 1
    for (;;) {
        unsigned tk = 0u;
        if (lane == 0) tk = __hip_atomic_fetch_add(ctl + CW_DQ, 1u, __ATOMIC_RELAXED, __HIP_MEMORY_SCOPE_AGENT);
        const int t = __builtin_amdgcn_readfirstlane((int)tk);
        if (t >= DQ_NT) break;
        if (t < DQ_FOLD) p0_fold_item2(P->pool_w, P->pool_scale, P->w_pp, (bf16_t*)(ws + WS_WM), t, lane);
        else {
#pragma unroll 1
            for (int q = 0; q < 2; ++q) {
                int r = (t - DQ_FOLD) * 2 + q;
                if (r < DQ_I_GU) { p0_transpose_item(SF_gu{P->w_g, P->w_u, P->norm2_w}, 1024, 5632, (bf16_t*)(ws + WS_WGU), scr, r, lane); continue; } r -= DQ_I_GU;
                if (r < DQ_I_WD) { p0_transpose_item(SF_plain{P->w_d, 1024}, 2816, 1024, (bf16_t*)(ws + WS_WD), scr, r, lane); continue; } r -= DQ_I_WD;
                if (r < DQ_I_WM) { p0_transpose_item(SF_plain{P->w_pa, 1024}, 1536, 1024, (bf16_t*)(ws + WS_WM) + 512, scr, r, lane); continue; } r -= DQ_I_WM;
                p0_transpose_item(SF_plain{P->w_out, 1024}, 1024, 1024, (bf16_t*)(ws + WS_WO), scr, r, lane);
            }
        }
    }
}

namespace nsa {
constexpr int NS = 4, SLOT = 16384, RING = NS * SLOT, WSCR = 8704;
constexpr float THR = 8.f;
typedef short v4i16_t __attribute__((ext_vector_type(4)));
__device__ __forceinline__ float xor1_add(float v) { return v + __builtin_bit_cast(float, __builtin_amdgcn_mov_dpp(__builtin_bit_cast(int, v), 0xB1, 0xF, 0xF, true)); }
__device__ __forceinline__ float xor2_add(float v) { return v + __builtin_bit_cast(float, __builtin_amdgcn_mov_dpp(__builtin_bit_cast(int, v), 0x4E, 0xF, 0xF, true)); }
__device__ __forceinline__ float gmax(float m) {
    auto a = __builtin_amdgcn_permlane16_swap(__float_as_uint(m), __float_as_uint(m), false, false); m = fmaxf(__uint_as_float(a[0]), __uint_as_float(a[1]));
    auto b = __builtin_amdgcn_permlane32_swap(__float_as_uint(m), __float_as_uint(m), false, false); return fmaxf(__uint_as_float(b[0]), __uint_as_float(b[1])); }
__device__ __forceinline__ float gsum(float m) {
    auto a = __builtin_amdgcn_permlane16_swap(__float_as_uint(m), __float_as_uint(m), false, false); m = __uint_as_float(a[0]) + __uint_as_float(a[1]);
    auto b = __builtin_amdgcn_permlane32_swap(__float_as_uint(m), __float_as_uint(m), false, false); return __uint_as_float(b[0]) + __uint_as_float(b[1]); }
struct Lane {
    int wave, lane, g, c; unsigned kbase, vbase; unsigned lds0;
    __device__ __forceinline__ void init(int tid, LAS unsigned char* lds) {
        lane = tid & 63; wave = __builtin_amdgcn_readfirstlane(tid >> 6); g = lane >> 4; c = lane & 15; lds0 = (unsigned)(size_t)lds;
        kbase = (unsigned)(c * 128 + ((g ^ (lane & 7)) << 4));
        const int q = (lane >> 2) & 3, p = lane & 3, rx = 4 * (g & 1) + q;
        vbase = (unsigned)((4 * g + q) * 128 + (((p >> 1) ^ rx) << 4) + (p & 1) * 8);
    }
};
struct Src { const char* k; const char* v; unsigned loff, tstride; };
__device__ __forceinline__ Src make_src(const bf16_t* K, const bf16_t* V, size_t row0, int stride_el, int col0, const Lane& L) {
    Src s; s.k = (const char*)(K + row0 * stride_el + col0); s.v = (const char*)(V + row0 * stride_el + col0);
    const int R = 8 * L.wave + (L.lane >> 3), ch = (L.lane & 7) ^ ((L.lane >> 3) & 7);
    s.loff = (unsigned)((R * stride_el + ch * 8) * 2); s.tstride = (unsigned)(64 * stride_el * 2); return s;
}
__device__ __forceinline__ void glds16(const void* gsrc, unsigned lds_dst) { unsigned keep;
    asm volatile("s_mov_b32 %0, m0\n\ts_mov_b32 m0, %2\n\ts_nop 0\n\tglobal_load_lds_dwordx4 %1, off\n\ts_mov_b32 m0, %0" : "=&s"(keep) : "v"(gsrc), "s"(lds_dst) : "memory"); }
__device__ __forceinline__ void issue(const Lane& L, const Src& S, int tile, int slot) {
    const char* gk = S.k + (size_t)tile * S.tstride + S.loff; const char* gv = S.v + (size_t)tile * S.tstride + S.loff;
    const unsigned d = (unsigned)__builtin_amdgcn_readfirstlane((int)(L.lds0 + slot * SLOT + L.wave * 1024));
    glds16(gk, d); glds16(gv, d + 8192);
}
struct Frags { unsigned k0, k1, v0, v1, v2, v3; };
typedef Frags TileAddr;
template <bool WITH_V> __device__ __forceinline__ void load_frags(const TileAddr& A, const Lane& L, Frags& F) { F = A; }
__device__ __forceinline__ void load_k(const Frags& F, const Lane& L, bf16x8 (&kf)[4][2]) {
#pragma unroll
    for (int mt = 0; mt < 4; ++mt) {
        kf[mt][0] = *(const LAS bf16x8*)((const LAS unsigned char*)(size_t)F.k0 + mt * 2048);
        kf[mt][1] = *(const LAS bf16x8*)((const LAS unsigned char*)(size_t)F.k1 + mt * 2048);
    }
}
__device__ __forceinline__ void load_vdt(unsigned va, bf16x8 (&vf)[2]) {
#pragma unroll
    for (int ks = 0; ks < 2; ++ks) {
        const v4i16_t lo = __builtin_amdgcn_ds_read_tr16_b64_v4i16((LAS v4i16_t*)((LAS unsigned char*)(size_t)va + ks * 4096));
        const v4i16_t hi = __builtin_amdgcn_ds_read_tr16_b64_v4i16((LAS v4i16_t*)((LAS unsigned char*)(size_t)va + ks * 4096 + 2048));
        vf[ks] = (bf16x8){lo[0], lo[1], lo[2], lo[3], hi[0], hi[1], hi[2], hi[3]};
    }
}
__device__ __forceinline__ void load_v(const Frags& F, const Lane& L, bf16x8 (&vf)[4][2]) { load_vdt(F.v0, vf[0]); load_vdt(F.v1, vf[1]); load_vdt(F.v2, vf[2]); load_vdt(F.v3, vf[3]); }
template <bool WITH_V, bool MASKED, class MaskFn>
__device__ __forceinline__ void visit_slow(const Frags& F, const Lane& L, const bf16x8 (&q)[2], f32x4 (&o)[4], float& mref, float& lsum, bool colsel, const MaskFn& valid) {
    const bool seen = mref != -INFINITY;
    const float c0 = colsel ? (seen ? -mref : 0.f) : -INFINITY;
    const f32x4 ci = (f32x4){c0, c0, c0, c0};
    f32x4 s[4];
    { bf16x8 kf[4][2]; load_k(F, L, kf);
#pragma unroll
    for (int mt = 0; mt < 4; ++mt) {
        s[mt] = __builtin_amdgcn_mfma_f32_16x16x32_bf16(kf[mt][0], q[0], ci, 0, 0, 0);
        s[mt] = __builtin_amdgcn_mfma_f32_16x16x32_bf16(kf[mt][1], q[1], s[mt], 0, 0, 0);
    } }
    __builtin_amdgcn_sched_barrier(0);
    bf16x8 vf[4][2]; if constexpr (WITH_V) load_v(F, L, vf);
    if constexpr (MASKED) {
#pragma unroll
        for (int mt = 0; mt < 4; ++mt)
#pragma unroll
            for (int r = 0; r < 4; ++r) if (!valid(16 * mt + 4 * L.g + r)) s[mt][r] = -INFINITY;
    }
    float mx = fmaxf(fmaxf(s[0][0], s[0][1]), fmaxf(s[0][2], s[0][3]));
#pragma unroll
    for (int mt = 1; mt < 4; ++mt) mx = fmaxf(mx, fmaxf(fmaxf(s[mt][0], s[mt][1]), fmaxf(s[mt][2], s[mt][3])));
    if (__any((mx > THR) || (!seen && mx > -INFINITY))) {
        const float mxr = gmax(mx);
        const float d = (mxr == -INFINITY) ? 0.f : (seen ? fmaxf(mxr, 0.f) : mxr);
        const float f = __builtin_amdgcn_exp2f(-d);
        if (mxr != -INFINITY) mref = (seen ? mref : 0.f) + d;
#pragma unroll
        for (int mt = 0; mt < 4; ++mt) s[mt] = s[mt] - d;
        lsum *= f;
        if constexpr (WITH_V) {
#pragma unroll
            for (int dt = 0; dt < 4; ++dt) o[dt] = o[dt] * f;
        }
    }
#pragma unroll
    for (int mt = 0; mt < 4; ++mt)
#pragma unroll
        for (int r = 0; r < 4; ++r) s[mt][r] = __builtin_amdgcn_exp2f(s[mt][r]);
    bf16x8 pf[2];
#pragma unroll
    for (int ks = 0; ks < 2; ++ks) { const u32x4 w = pack8(s[2 * ks], s[2 * ks + 1]); pf[ks] = __builtin_bit_cast(bf16x8, w); }
    { const f32x4 t4 = (s[0] + s[1]) + (s[2] + s[3]); lsum += (t4[0] + t4[1]) + (t4[2] + t4[3]); }
    if constexpr (WITH_V) {
#pragma unroll
        for (int dt = 0; dt < 4; ++dt)
#pragma unroll
            for (int ks = 0; ks < 2; ++ks) o[dt] = __builtin_amdgcn_mfma_f32_16x16x32_bf16(vf[dt][ks], pf[ks], o[dt], 0, 0, 0);
    }
}
template <bool MASKED, class MaskA, class MaskB>
__device__ __forceinline__ void visitB2(const Frags& F, const Lane& L, const bf16x8 (&qA)[2], const bf16x8 (&qB)[2], f32x4 (&oA)[4], f32x4 (&oB)[4], float msA, float msB, float invA, float invB,
                                        const MaskA& validA, const MaskB& validB, LAS float* impA, LAS float* impB, int jb) {
    const float cA = -msA, cB = -msB; const f32x4 ciA = (f32x4){cA, cA, cA, cA}, ciB = (f32x4){cB, cB, cB, cB};
    f32x4 sA[4], sB[4];
    { bf16x8 kf[4][2]; load_k(F, L, kf);
#pragma unroll
    for (int mt = 0; mt < 4; ++mt) {
        sA[mt] = __builtin_amdgcn_mfma_f32_16x16x32_bf16(kf[mt][0], qA[0], ciA, 0, 0, 0);
        sB[mt] = __builtin_amdgcn_mfma_f32_16x16x32_bf16(kf[mt][0], qB[0], ciB, 0, 0, 0);
        sA[mt] = __builtin_amdgcn_mfma_f32_16x16x32_bf16(kf[mt][1], qA[1], sA[mt], 0, 0, 0);
        sB[mt] = __builtin_amdgcn_mfma_f32_16x16x32_bf16(kf[mt][1], qB[1], sB[mt], 0, 0, 0);
    } }

    bf16x8 vf[4][2]; load_v(F, L, vf);
#pragma unroll
    for (int mt = 0; mt < 4; ++mt) {
#pragma unroll
        for (int r = 0; r < 4; ++r) {
            sA[mt][r] = (!MASKED || validA(16 * mt + 4 * L.g + r)) ? __builtin_amdgcn_exp2f(sA[mt][r]) * invA : 0.f;
            sB[mt][r] = (!MASKED || validB(16 * mt + 4 * L.g + r)) ? __builtin_amdgcn_exp2f(sB[mt][r]) * invB : 0.f;
        }
        float va = (sA[mt][0] + sA[mt][1]) + (sA[mt][2] + sA[mt][3]), va3 = sA[mt][3], vb = (sB[mt][0] + sB[mt][1]) + (sB[mt][2] + sB[mt][3]), vb3 = sB[mt][3];
        va = xor2_add(xor1_add(va)); va3 = xor2_add(xor1_add(va3)); vb = xor2_add(xor1_add(vb)); vb3 = xor2_add(xor1_add(vb3));
        if ((L.c & 3) == 0) { const int j = jb + 4 * mt + L.g;
            __hip_atomic_fetch_add(impA + j, va, __ATOMIC_RELAXED, __HIP_MEMORY_SCOPE_WORKGROUP); __hip_atomic_fetch_add(impB + j, vb, __ATOMIC_RELAXED, __HIP_MEMORY_SCOPE_WORKGROUP);
            if (j + 1 < 128) { __hip_atomic_fetch_add(impA + j + 1, va3, __ATOMIC_RELAXED, __HIP_MEMORY_SCOPE_WORKGROUP); __hip_atomic_fetch_add(impB + j + 1, vb3, __ATOMIC_RELAXED, __HIP_MEMORY_SCOPE_WORKGROUP); } }
    }
    bf16x8 pA[2], pB[2];
#pragma unroll
    for (int ks = 0; ks < 2; ++ks) { const u32x4 wa = pack8(sA[2 * ks], sA[2 * ks + 1]), wb = pack8(sB[2 * ks], sB[2 * ks + 1]); pA[ks] = __builtin_bit_cast(bf16x8, wa); pB[ks] = __builtin_bit_cast(bf16x8, wb); }
#pragma unroll
    for (int dt = 0; dt < 4; ++dt)
#pragma unroll
        for (int ks = 0; ks < 2; ++ks) { oA[dt] = __builtin_amdgcn_mfma_f32_16x16x32_bf16(vf[dt][ks], pA[ks], oA[dt], 0, 0, 0); oB[dt] = __builtin_amdgcn_mfma_f32_16x16x32_bf16(vf[dt][ks], pB[ks], oB[dt], 0, 0, 0); }
}
constexpr float PLIM = 1.8446744e19f;
template <bool WITH_V, bool MASKED, class MaskFn>
__device__ __forceinline__ void visit_fast(const Frags& F, const Lane& L, const bf16x8 (&q)[2], f32x4 (&o)[4], float mref, float& lsum, float& badv, bool colsel, const MaskFn& valid) {
    const float c0 = colsel ? -mref : -INFINITY;
    const f32x4 ci = (f32x4){c0, c0, c0, c0};
    f32x4 s[4];
    { bf16x8 kf[4][2]; load_k(F, L, kf);
#pragma unroll
    for (int mt = 0; mt < 4; ++mt) {
        s[mt] = __builtin_amdgcn_mfma_f32_16x16x32_bf16(kf[mt][0], q[0], ci, 0, 0, 0);
        s[mt] = __builtin_amdgcn_mfma_f32_16x16x32_bf16(kf[mt][1], q[1], s[mt], 0, 0, 0);
    } }

    bf16x8 vf[4][2]; if constexpr (WITH_V) load_v(F, L, vf);
#pragma unroll
    for (int mt = 0; mt < 4; ++mt)
#pragma unroll
        for (int r = 0; r < 4; ++r) { const float e = __builtin_amdgcn_exp2f(s[mt][r]); s[mt][r] = (!MASKED || valid(16 * mt + 4 * L.g + r)) ? e : 0.f; }
    float ps; { const f32x4 t4 = (s[0] + s[1]) + (s[2] + s[3]); ps = (t4[0] + t4[1]) + (t4[2] + t4[3]); }
    lsum += ps; badv = fmaxf(badv, ps);
    if constexpr (WITH_V) {
        bf16x8 pf[2];
#pragma unroll
        for (int ks = 0; ks < 2; ++ks) { const u32x4 w = pack8(s[2 * ks], s[2 * ks + 1]); pf[ks] = __builtin_bit_cast(bf16x8, w); }
#pragma unroll
        for (int dt = 0; dt < 4; ++dt)
#pragma unroll
            for (int ks = 0; ks < 2; ++ks) o[dt] = __builtin_amdgcn_mfma_f32_16x16x32_bf16(vf[dt][ks], pf[ks], o[dt], 0, 0, 0);
    }
}
template <bool MASKED, bool WITH_V = true, class MaskA, class MaskB>
__device__ __forceinline__ void visit_fast2(const Frags& F, const Lane& L, const bf16x8 (&qA)[2], const bf16x8 (&qB)[2], f32x4 (&oA)[4], f32x4 (&oB)[4], float mrefA, float mrefB,
                                            float& lsumA, float& lsumB, float& badv, bool colA, bool colB, const MaskA& validA, const MaskB& validB) {
    const float cA = colA ? -mrefA : -INFINITY, cB = colB ? -mrefB : -INFINITY;
    const f32x4 ciA = (f32x4){cA, cA, cA, cA}, ciB = (f32x4){cB, cB, cB, cB};
    f32x4 sA[4], sB[4];
    { bf16x8 kf[4][2]; load_k(F, L, kf);
#pragma unroll
    for (int mt = 0; mt < 4; ++mt) {
        sA[mt] = __builtin_amdgcn_mfma_f32_16x16x32_bf16(kf[mt][0], qA[0], ciA, 0, 0, 0);
        sB[mt] = __builtin_amdgcn_mfma_f32_16x16x32_bf16(kf[mt][0], qB[0], ciB, 0, 0, 0);
        sA[mt] = __builtin_amdgcn_mfma_f32_16x16x32_bf16(kf[mt][1], qA[1], sA[mt], 0, 0, 0);
        sB[mt] = __builtin_amdgcn_mfma_f32_16x16x32_bf16(kf[mt][1], qB[1], sB[mt], 0, 0, 0);
    } }
    bf16x8 vf[4][2]; if constexpr (WITH_V) load_v(F, L, vf);
#pragma unroll
    for (int mt = 0; mt < 4; ++mt)
#pragma unroll
        for (int r = 0; r < 4; ++r) {
            const float ea = __builtin_amdgcn_exp2f(sA[mt][r]), eb = __builtin_amdgcn_exp2f(sB[mt][r]);
            sA[mt][r] = (!MASKED || validA(16 * mt + 4 * L.g + r)) ? ea : 0.f; sB[mt][r] = (!MASKED || validB(16 * mt + 4 * L.g + r)) ? eb : 0.f;
        }
    { const f32x4 t4 = (sA[0] + sA[1]) + (sA[2] + sA[3]); const float ps = (t4[0] + t4[1]) + (t4[2] + t4[3]); lsumA += ps; badv = fmaxf(badv, ps); }
    { const f32x4 t4 = (sB[0] + sB[1]) + (sB[2] + sB[3]); const float ps = (t4[0] + t4[1]) + (t4[2] + t4[3]); lsumB += ps; badv = fmaxf(badv, ps); }
    if constexpr (!WITH_V) return;
    bf16x8 pA[2], pB[2];
#pragma unroll
    for (int ks = 0; ks < 2; ++ks) { const u32x4 wa = pack8(sA[2 * ks], sA[2 * ks + 1]), wb = pack8(sB[2 * ks], sB[2 * ks + 1]); pA[ks] = __builtin_bit_cast(bf16x8, wa); pB[ks] = __builtin_bit_cast(bf16x8, wb); }
#pragma unroll
    for (int dt = 0; dt < 4; ++dt)
#pragma unroll
        for (int ks = 0; ks < 2; ++ks) { oA[dt] = __builtin_amdgcn_mfma_f32_16x16x32_bf16(vf[dt][ks], pA[ks], oA[dt], 0, 0, 0); oB[dt] = __builtin_amdgcn_mfma_f32_16x16x32_bf16(vf[dt][ks], pB[ks], oB[dt], 0, 0, 0); }
}
template <bool WITH_V, class MaskFn>
__device__ __forceinline__ void visit_init(const Frags& F, const Lane& L, const bf16x8 (&q)[2], f32x4 (&o)[4], float& mref, float& lsum, float& badv, bool colsel, const MaskFn& valid) {
    const bool seen = mref != -INFINITY;
    const float c0 = colsel ? (seen ? -mref : 0.f) : -INFINITY;
    const f32x4 ci = (f32x4){c0, c0, c0, c0};
    f32x4 s[4];
    { bf16x8 kf[4][2]; load_k(F, L, kf);
#pragma unroll
    for (int mt = 0; mt < 4; ++mt) {
        s[mt] = __builtin_amdgcn_mfma_f32_16x16x32_bf16(kf[mt][0], q[0], ci, 0, 0, 0);
        s[mt] = __builtin_amdgcn_mfma_f32_16x16x32_bf16(kf[mt][1], q[1], s[mt], 0, 0, 0);
    } }

    bf16x8 vf[4][2]; if constexpr (WITH_V) load_v(F, L, vf);
#pragma unroll
    for (int mt = 0; mt < 4; ++mt)
#pragma unroll
        for (int r = 0; r < 4; ++r) if (!valid(16 * mt + 4 * L.g + r)) s[mt][r] = -INFINITY;
    float mx = fmaxf(fmaxf(s[0][0], s[0][1]), fmaxf(s[0][2], s[0][3]));
#pragma unroll
    for (int mt = 1; mt < 4; ++mt) mx = fmaxf(mx, fmaxf(fmaxf(s[mt][0], s[mt][1]), fmaxf(s[mt][2], s[mt][3])));
    const float mxr = gmax(mx);
    const float d = (!seen && mxr != -INFINITY) ? mxr : 0.f;
    if (!seen && mxr != -INFINITY) mref = mxr;
#pragma unroll
    for (int mt = 0; mt < 4; ++mt)
#pragma unroll
        for (int r = 0; r < 4; ++r) s[mt][r] = __builtin_amdgcn_exp2f(s[mt][r] - d);
    float ps; { const f32x4 t4 = (s[0] + s[1]) + (s[2] + s[3]); ps = (t4[0] + t4[1]) + (t4[2] + t4[3]); }
    lsum += ps; badv = fmaxf(badv, ps);
    if constexpr (WITH_V) {
        bf16x8 pf[2];
#pragma unroll
        for (int ks = 0; ks < 2; ++ks) { const u32x4 w = pack8(s[2 * ks], s[2 * ks + 1]); pf[ks] = __builtin_bit_cast(bf16x8, w); }
#pragma unroll
        for (int dt = 0; dt < 4; ++dt)
#pragma unroll
            for (int ks = 0; ks < 2; ++ks) o[dt] = __builtin_amdgcn_mfma_f32_16x16x32_bf16(vf[dt][ks], pf[ks], o[dt], 0, 0, 0);
    }
}
template <bool MASKED, class MaskFn>
__device__ __forceinline__ void visitB(const Frags& F, const Lane& L, const bf16x8 (&q)[2], f32x4 (&o)[4], float ms, float inv_l, const MaskFn& valid, LAS float* imp_row, int jb) {
    const float c0 = -ms; const f32x4 ci = (f32x4){c0, c0, c0, c0};
    f32x4 s[4];
    { bf16x8 kf[4][2]; load_k(F, L, kf);
#pragma unroll
    for (int mt = 0; mt < 4; ++mt) {
        s[mt] = __builtin_amdgcn_mfma_f32_16x16x32_bf16(kf[mt][0], q[0], ci, 0, 0, 0);
        s[mt] = __builtin_amdgcn_mfma_f32_16x16x32_bf16(kf[mt][1], q[1], s[mt], 0, 0, 0);
    } }

    bf16x8 vf[4][2]; load_v(F, L, vf);
#pragma unroll
    for (int mt = 0; mt < 4; ++mt) {
#pragma unroll
        for (int r = 0; r < 4; ++r) s[mt][r] = (!MASKED || valid(16 * mt + 4 * L.g + r)) ? __builtin_amdgcn_exp2f(s[mt][r]) * inv_l : 0.f;
        float val = (s[mt][0] + s[mt][1]) + (s[mt][2] + s[mt][3]), v3 = s[mt][3];
        val = xor2_add(xor1_add(val)); v3 = xor2_add(xor1_add(v3));
        if ((L.c & 3) == 0) { const int j = jb + 4 * mt + L.g; __hip_atomic_fetch_add(imp_row + j, val, __ATOMIC_RELAXED, __HIP_MEMORY_SCOPE_WORKGROUP);
            if (j + 1 < 128) __hip_atomic_fetch_add(imp_row + j + 1, v3, __ATOMIC_RELAXED, __HIP_MEMORY_SCOPE_WORKGROUP); }
    }
    bf16x8 pf[2];
#pragma unroll
    for (int ks = 0; ks < 2; ++ks) { const u32x4 w = pack8(s[2 * ks], s[2 * ks + 1]); pf[ks] = __builtin_bit_cast(bf16x8, w); }
#pragma unroll
    for (int dt = 0; dt < 4; ++dt)
#pragma unroll
        for (int ks = 0; ks < 2; ++ks) o[dt] = __builtin_amdgcn_mfma_f32_16x16x32_bf16(vf[dt][ks], pf[ks], o[dt], 0, 0, 0);
}
struct HiMask { int hi; __device__ __forceinline__ bool operator()(int key) const { return key <= hi; } };
struct RangeMask { int lo, hi; __device__ __forceinline__ bool operator()(int key) const { return key >= lo && key <= hi; } };
struct LoMask { int lo; __device__ __forceinline__ bool operator()(int key) const { return key >= lo; } };
struct NoMask { __device__ __forceinline__ bool operator()(int) const { return true; } };
__device__ __forceinline__ unsigned ctr_load(LAS unsigned* p) { return (unsigned)__builtin_amdgcn_readfirstlane((int)__hip_atomic_load(p, __ATOMIC_RELAXED, __HIP_MEMORY_SCOPE_WORKGROUP)); }
template <class Body>
__device__ __forceinline__ void stream(LAS unsigned char* lds, const Lane& L, const Src& S, int tile0, int NT, const Body& body) {
    LAS unsigned* ready = (LAS unsigned*)(lds + MISC_OFF + 64);
    LAS unsigned* done = ready + NS;
    __builtin_amdgcn_s_barrier();
    if (L.wave == 0 && L.lane < 2 * NS) ready[L.lane] = 0u;
    asm volatile("s_waitcnt lgkmcnt(0)" ::: "memory");
    __builtin_amdgcn_s_barrier();
    asm volatile("" ::: "memory");
    int issued = 0, published = 0;
    TileAddr A; A.k0 = L.lds0 + L.kbase; A.k1 = L.lds0 + (L.kbase ^ 64u); A.v0 = L.lds0 + 8192u + L.vbase; A.v1 = L.lds0 + 8192u + (L.vbase ^ 32u); A.v2 = L.lds0 + 8192u + (L.vbase ^ 64u); A.v3 = L.lds0 + 8192u + (L.vbase ^ 96u);
    for (int i = 0; i < NT; ++i) {
        asm volatile("s_waitcnt vmcnt(0)" ::: "memory");
        for (; published < issued; ++published) if (L.lane == 0) __hip_atomic_fetch_add(ready + (published & (NS - 1)), 1u, __ATOMIC_RELAXED, __HIP_MEMORY_SCOPE_WORKGROUP);
        for (;;) {
            if (issued >= NT || issued >= i + NS) break;
            const bool must = issued <= i;
            if (issued >= NS) {
                const unsigned want = 8u * (unsigned)(issued / NS);
                if (ctr_load(done + (issued & (NS - 1))) < want) { if (!must) break; while (ctr_load(done + (issued & (NS - 1))) < want) __builtin_amdgcn_s_sleep(1); }
            }
            issue(L, S, tile0 + issued, issued & (NS - 1)); ++issued;
            if (must) { asm volatile("s_waitcnt vmcnt(0)" ::: "memory"); for (; published < issued; ++published) if (L.lane == 0) __hip_atomic_fetch_add(ready + (published & (NS - 1)), 1u, __ATOMIC_RELAXED, __HIP_MEMORY_SCOPE_WORKGROUP); }
        }
        { const unsigned want = 8u * (unsigned)(i / NS + 1); LAS unsigned* rp = ready + (i & (NS - 1)); while (ctr_load(rp) < want) __builtin_amdgcn_s_sleep(1); }
        asm volatile("" ::: "memory");
        body(i, A);
        { const unsigned d = ((i + 1) & (NS - 1)) ? (unsigned)SLOT : (unsigned)(-(NS - 1) * SLOT); A.k0 += d; A.k1 += d; A.v0 += d; A.v1 += d; A.v2 += d; A.v3 += d; }
        asm volatile("s_waitcnt lgkmcnt(0)" ::: "memory");
        if (L.lane == 0) __hip_atomic_fetch_add(done + (i & (NS - 1)), 1u, __ATOMIC_RELAXED, __HIP_MEMORY_SCOPE_WORKGROUP);
    }
    asm volatile("s_waitcnt vmcnt(0) lgkmcnt(0)" ::: "memory");
}
struct Tensors { unsigned char* ws;
    __device__ __forceinline__ const bf16_t* QP_() const { return (const bf16_t*)(ws + WS_QP); }   __device__ __forceinline__ const bf16_t* QR_() const { return (const bf16_t*)(ws + WS_QR); }
    __device__ __forceinline__ const bf16_t* KCMP_() const { return (const bf16_t*)(ws + WS_KCMP); } __device__ __forceinline__ const bf16_t* VCMP_() const { return (const bf16_t*)(ws + WS_VCMP); }
    __device__ __forceinline__ const bf16_t* KS_() const { return (const bf16_t*)(ws + WS_KS); }   __device__ __forceinline__ const bf16_t* VS_() const { return (const bf16_t*)(ws + WS_VS); }
    __device__ __forceinline__ const bf16_t* KW_() const { return (const bf16_t*)(ws + WS_KW); }   __device__ __forceinline__ const bf16_t* VW_() const { return (const bf16_t*)(ws + WS_VW); }
    __device__ __forceinline__ const float* GN_() const { return (const float*)(ws + WS_GN); }     __device__ __forceinline__ bf16_t* PA_() const { return (bf16_t*)(ws + WS_PA); }
};
__device__ __forceinline__ void unit(LAS unsigned char* lds, const Tensors& X, int b, int gk, int u, int wave_s) {
    const int t0 = 128 * u;
    bf16x8 q[4][2]; f32x4 o[4][4]; float m[4], l[4]; float badv;
#define NSA_STAGE() Lane L; { const int ln_ = lane_id(); L.init(ln_ + 64 * wave_s, lds); } \
    const int tw0 = t0 + 16 * L.wave, tl = L.c >> 2; (void)tl; \
    LAS unsigned char* wscr = lds + RING + L.wave * WSCR; (void)wscr; \
    LAS float* impw = (LAS float*)wscr; (void)impw;                   \
    LAS unsigned* bmask = (LAS unsigned*)(wscr + 8192); (void)bmask;     \
    const int qrow32 = (b * SEQ + tw0 + (L.c >> 2)) * 1024 + (gk * 4 + (L.c & 3)) * 64 + 8 * L.g; (void)qrow32;        \
    const int gnrow = (b * SEQ + tw0 + (L.c >> 2)) * 48 + (gk * 4 + (L.c & 3)) * 3; (void)gnrow;                         \
    LAS unsigned char* park = wscr + ((size_t)L.c * 64 + 4 * L.g) * 2; (void)park
#define NSA_LOADQ(Qp) do { int qo_ = qrow32; OPAQUE(qo_); const bf16_t* qp_ = (Qp) + (size_t)qo_; _Pragma("unroll") for (int rt = 0; rt < 4; ++rt) _Pragma("unroll") for (int dk = 0; dk < 2; ++dk) q[rt][dk] = *(const bf16x8*)(qp_ + rt * 4096 + 32 * dk); \
        _Pragma("unroll") for (int rt = 0; rt < 4; ++rt) _Pragma("unroll") for (int dk = 0; dk < 2; ++dk) asm volatile("" : "+v"(q[rt][dk]));     \
        } while (0)
#define NSA_BAD() (__any(!(badv <= PLIM)))
#define NSA_RESET() do { float z_ = 0.f; OPAQUE(z_); badv = z_; _Pragma("unroll") for (int rt = 0; rt < 4; ++rt) { m[rt] = -INFINITY; l[rt] = z_; _Pragma("unroll") for (int dt = 0; dt < 4; ++dt) o[rt][dt] = (f32x4){z_, z_, z_, z_}; } } while (0)
    {
        NSA_STAGE();
        { float z_ = 0.f; OPAQUE(z_); const f32x4 z4 = (f32x4){z_, z_, z_, z_};
#pragma unroll
        for (int i = 0; i < 8; ++i) *(LAS f32x4*)(impw + (i * 64 + L.lane) * 4) = z4; }
        NSA_LOADQ(X.QP_()); NSA_RESET();
        const int nct = ((8 * u + 6) >> 6) + 1;
        const Src S = make_src(X.KCMP_(), X.VCMP_(), (size_t)(b * 4 + gk) * NCP, 64, 0, L);
        stream(lds, L, S, 0, nct, [&](int i, const TileAddr& Ks) {
            const int nb = 64 * i;
            if (tw0 + 15 >= 31 && nb <= ((tw0 + 15 - 31) >> 4)) {
                Frags F; load_frags<false>(Ks, L, F);
#pragma unroll
                for (int pr = 0; pr < 2; ++pr) {
                    const int rA = 2 * pr, rB = rA + 1, twA = tw0 + 4 * rA, twB = twA + 4;
                    const bool nA = twA + 3 >= 31 && nb <= ((twA + 3 - 31) >> 4), nB = twB + 3 >= 31 && nb <= ((twB + 3 - 31) >> 4);
                    const bool inter = twA >= 31 && nb + 63 <= ((twA - 31) >> 4);
                    const int tA = twA + tl, tB = twB + tl;
                    const HiMask hA{(tA >= 31 ? ((tA - 31) >> 4) : -1) - nb}, hB{(tB >= 31 ? ((tB - 31) >> 4) : -1) - nb};
                    (void)inter;
                    if (i == 0) { if (nA) visit_init<false>(F, L, q[rA], o[rA], m[rA], l[rA], badv, true, hA); if (nB) visit_init<false>(F, L, q[rB], o[rB], m[rB], l[rB], badv, true, hB); }
                    else if (nA && nB) visit_fast2<true, false>(F, L, q[rA], q[rB], o[rA], o[rB], m[rA], m[rB], l[rA], l[rB], badv, true, true, hA, hB);
                    else { if (nA) visit_fast<false, true>(F, L, q[rA], o[rA], m[rA], l[rA], badv, true, hA); if (nB) visit_fast<false, true>(F, L, q[rB], o[rB], m[rB], l[rB], badv, true, hB); }
                }
            }
        });
        if (NSA_BAD()) {
            NSA_RESET();
            stream(lds, L, S, 0, nct, [&](int i, const TileAddr& Ks) {
                const int nb = 64 * i;
                if (tw0 + 15 >= 31 && nb <= ((tw0 + 15 - 31) >> 4)) {
                    Frags F; load_frags<false>(Ks, L, F);
#pragma unroll
                    for (int rt = 0; rt < 4; ++rt) {
                        const int twA = tw0 + 4 * rt, tA = twA + tl;
                        if (twA + 3 >= 31 && nb <= ((twA + 3 - 31) >> 4)) visit_slow<false, true>(F, L, q[rt], o[rt], m[rt], l[rt], true, HiMask{(tA >= 31 ? ((tA - 31) >> 4) : -1) - nb});
                    }
                }
            });
        }
        float inv[4], msf[4];
#pragma unroll
        for (int rt = 0; rt < 4; ++rt) { const float lt = gsum(l[rt]); inv[rt] = lt > 0.f ? __builtin_amdgcn_rcpf(lt) : 0.f; msf[rt] = (m[rt] == -INFINITY) ? 0.f : m[rt]; }
        NSA_RESET();
        stream(lds, L, S, 0, nct, [&](int i, const TileAddr& Ks) {
            const int nb = 64 * i;
            if (tw0 + 15 >= 31 && nb <= ((tw0 + 15 - 31) >> 4)) {
                Frags F; load_frags<true>(Ks, L, F);
#pragma unroll
                for (int pr = 0; pr < 2; ++pr) {
                    const int rA = 2 * pr, rB = rA + 1, twA = tw0 + 4 * rA, twB = twA + 4;
                    const bool nA = twA + 3 >= 31 && nb <= ((twA + 3 - 31) >> 4), nB = twB + 3 >= 31 && nb <= ((twB + 3 - 31) >> 4);
                    const bool inter = twA >= 31 && nb + 63 <= ((twA - 31) >> 4);
                    const int tA = twA + tl, tB = twB + tl;
                    const HiMask hA{(tA >= 31 ? ((tA - 31) >> 4) : -1) - nb}, hB{(tB >= 31 ? ((tB - 31) >> 4) : -1) - nb};
                    LAS float* iA = impw + (4 * rA + tl) * 128; LAS float* iB = impw + (4 * rB + tl) * 128;
                    (void)inter;
                    if (nA && nB) visitB2<true>(F, L, q[rA], q[rB], o[rA], o[rB], msf[rA], msf[rB], inv[rA], inv[rB], hA, hB, iA, iB, 16 * i);
                    else { if (nA) visitB<true>(F, L, q[rA], o[rA], msf[rA], inv[rA], hA, iA, 16 * i);
                           if (nB) visitB<true>(F, L, q[rB], o[rB], msf[rB], inv[rB], hB, iB, 16 * i); }
                }
            }
        });
    }
    asm volatile("s_waitcnt lgkmcnt(0)" ::: "memory");
    {
        NSA_STAGE();
        unsigned bm0 = 0u, bm1 = 0u;
#pragma unroll 1
        for (int tau = 0; tau < 16; ++tau) {
            const int t = tw0 + tau, jt = t >> 6; bool s0, s1;
            if (jt <= 15) { s0 = L.lane <= jt; s1 = false; }
            else {
                const float v0 = impw[tau * 128 + L.lane], v1 = impw[tau * 128 + 64 + L.lane];
                const int j0 = L.lane, j1 = L.lane + 64;
                const unsigned long long k0 = (j0 >= 1 && j0 <= jt - 2) ? ((1ull << 39) | ((unsigned long long)__float_as_uint(v0) << 7) | (unsigned long long)(127 - j0)) : 0ull;
                const unsigned long long k1 = (j1 <= jt - 2) ? ((1ull << 39) | ((unsigned long long)__float_as_uint(v1) << 7) | (unsigned long long)(127 - j1)) : 0ull;
                unsigned long long Tk = 0ull;
#pragma unroll 1
                for (int bit = 39; bit >= 0; --bit) {
                    const unsigned long long C = Tk | (1ull << bit);
                    const int cnt = __popcll(__ballot(k0 >= C)) + __popcll(__ballot(k1 >= C));
                    if (cnt >= 13) Tk = C;
                }
                s0 = (k0 >= Tk && k0 != 0ull) || j0 == 0 || j0 == jt || j0 == jt - 1;
                s1 = (k1 >= Tk && k1 != 0ull) || j1 == jt || j1 == jt - 1;
            }
            bm0 |= (s0 ? 1u : 0u) << tau; bm1 |= (s1 ? 1u : 0u) << tau;
        }
        bmask[L.lane] = bm0; bmask[64 + L.lane] = bm1;
    }
    asm volatile("s_waitcnt lgkmcnt(0)" ::: "memory");
    {
        NSA_STAGE();
#pragma unroll
        for (int rt = 0; rt < 4; ++rt) {
            int gi_ = gnrow + rt * 192; OPAQUE(gi_); const float gc = X.GN_()[gi_];
#pragma unroll
            for (int dt = 0; dt < 4; ++dt) { const f32x4 v = o[rt][dt] * gc; u32x2 w; w.x = cvt_pk_bf16(v[0], v[1]); w.y = cvt_pk_bf16(v[2], v[3]); *(LAS u32x2*)(park + rt * 2048 + dt * 32) = w; }
        }
    }
    {
        NSA_STAGE();
        NSA_LOADQ(X.QR_());
        const int kt_lo = (2 * u - 8) > 0 ? (2 * u - 8) : 0, kt_hi = 2 * u + 1;
        const Src S = make_src(X.KW_(), X.VW_(), (size_t)b * SEQ, 256, gk * 64, L);
        SUBREP(32) { NSA_RESET();
        stream(lds, L, S, kt_lo, kt_hi - kt_lo + 1, [&](int i, const TileAddr& Ks) {
            const int kbase = 64 * (kt_lo + i);
            if (kbase <= tw0 + 15 && kbase + 63 >= tw0 - 511) {
                Frags F; load_frags<true>(Ks, L, F);
#pragma unroll
                for (int pr = 0; pr < 2; ++pr) {
                    const int rA = 2 * pr, rB = rA + 1, twA = tw0 + 4 * rA, twB = twA + 4;
                    const bool nA = kbase <= twA + 3 && kbase + 63 >= twA - 511, nB = kbase <= twB + 3 && kbase + 63 >= twB - 511;
                    const bool inter = kbase + 63 <= twA && kbase >= twB + 3 - 511;
                    const int tA = twA + tl, tB = twB + tl;
                    const bool init = kbase <= (twB + 3 - 511 > 0 ? twB + 3 - 511 : 0);
                    if (init) { if (nA) visit_init<true>(F, L, q[rA], o[rA], m[rA], l[rA], badv, true, RangeMask{tA - 511 - kbase, tA - kbase}); if (nB) visit_init<true>(F, L, q[rB], o[rB], m[rB], l[rB], badv, true, RangeMask{tB - 511 - kbase, tB - kbase}); }
                    else if (nA && nB) { if (inter) visit_fast2<false>(F, L, q[rA], q[rB], o[rA], o[rB], m[rA], m[rB], l[rA], l[rB], badv, true, true, NoMask{}, NoMask{});
                                         else visit_fast2<true>(F, L, q[rA], q[rB], o[rA], o[rB], m[rA], m[rB], l[rA], l[rB], badv, true, true, HiMask{tA - kbase}, HiMask{tB - kbase}); }
                    else if (inter) { if (nA) visit_fast<true, false>(F, L, q[rA], o[rA], m[rA], l[rA], badv, true, NoMask{}); if (nB) visit_fast<true, false>(F, L, q[rB], o[rB], m[rB], l[rB], badv, true, NoMask{}); }
                    else { if (nA) visit_fast<true, true>(F, L, q[rA], o[rA], m[rA], l[rA], badv, true, HiMask{tA - kbase}); if (nB) visit_fast<true, true>(F, L, q[rB], o[rB], m[rB], l[rB], badv, true, HiMask{tB - kbase}); }
                }
            }
        });
        if (NSA_BAD()) {
            NSA_RESET();
            stream(lds, L, S, kt_lo, kt_hi - kt_lo + 1, [&](int i, const TileAddr& Ks) {
                const int kbase = 64 * (kt_lo + i);
                if (kbase <= tw0 + 15 && kbase + 63 >= tw0 - 511) {
                    Frags F; load_frags<true>(Ks, L, F);
#pragma unroll
                    for (int rt = 0; rt < 4; ++rt) {
                        const int twA = tw0 + 4 * rt, tA = twA + tl;
                        if (kbase <= twA + 3 && kbase + 63 >= twA - 511) visit_slow<true, true>(F, L, q[rt], o[rt], m[rt], l[rt], true, RangeMask{tA - 511 - kbase, tA - kbase});
                    }
                }
            });
        }
        }
    }
    {
        NSA_STAGE();
#pragma unroll
        for (int rt = 0; rt < 4; ++rt) {
            int gi_ = gnrow + rt * 192 + 2; OPAQUE(gi_); const float sc = X.GN_()[gi_] * __builtin_amdgcn_rcpf(gsum(l[rt]));
#pragma unroll
            for (int dt = 0; dt < 4; ++dt) {
                LAS u32x2* pp = (LAS u32x2*)(park + rt * 2048 + dt * 32); const u32x2 pw = *pp; const f32x4 v = o[rt][dt] * sc; u32x2 w;
                w.x = cvt_pk_bf16(v[0] + __builtin_bit_cast(float, pw.x << 16), v[1] + __builtin_bit_cast(float, pw.x & 0xffff0000u));
                w.y = cvt_pk_bf16(v[2] + __builtin_bit_cast(float, pw.y << 16), v[3] + __builtin_bit_cast(float, pw.y & 0xffff0000u));
                *pp = w;
            }
        }
    }
    {
        NSA_STAGE();
        const Src S = make_src(X.KS_(), X.VS_(), (size_t)b * SEQ, 256, gk * 64, L);
        if (MK_PROBE == 34) stream(lds, L, S, 0, 2 * u + 2, [&](int j, const TileAddr& Ks) { const unsigned bm = (unsigned)__builtin_amdgcn_readfirstlane((int)bmask[j]); asm volatile("" :: "s"(bm), "v"(Ks.k0)); });
        SUBREP(33) { NSA_RESET();
        stream(lds, L, S, 0, 2 * u + 2, [&](int j, const TileAddr& Ks) {
            const unsigned bm = (unsigned)__builtin_amdgcn_readfirstlane((int)bmask[j]);
            const int kbase = 64 * j; const bool j0 = (j == 0);
            if (bm & 0xffffu) {
                Frags F; load_frags<true>(Ks, L, F);
#pragma unroll
                for (int pr = 0; pr < 2; ++pr) {
                    const int rA = 2 * pr, rB = rA + 1, twA = tw0 + 4 * rA, twB = twA + 4;
                    const bool nA = (bm >> (4 * rA)) & 15u, nB = (bm >> (4 * rB)) & 15u;
                    const bool inter = kbase + 63 <= twA;
                    const bool sA = (bm >> (4 * rA + tl)) & 1u, sB = (bm >> (4 * rB + tl)) & 1u;
                    const HiMask hA{twA + tl - kbase}, hB{twB + tl - kbase};
                    if (j0) { if (nA) visit_init<true>(F, L, q[rA], o[rA], m[rA], l[rA], badv, sA, hA); if (nB) visit_init<true>(F, L, q[rB], o[rB], m[rB], l[rB], badv, sB, hB); }
                    else if (nA && nB && inter) visit_fast2<false>(F, L, q[rA], q[rB], o[rA], o[rB], m[rA], m[rB], l[rA], l[rB], badv, sA, sB, hA, hB);
                    else if (inter) { if (nA) visit_fast<true, false>(F, L, q[rA], o[rA], m[rA], l[rA], badv, sA, hA); if (nB) visit_fast<true, false>(F, L, q[rB], o[rB], m[rB], l[rB], badv, sB, hB); }
                    else { if (nA) visit_fast<true, true>(F, L, q[rA], o[rA], m[rA], l[rA], badv, sA, hA); if (nB) visit_fast<true, true>(F, L, q[rB], o[rB], m[rB], l[rB], badv, sB, hB); }
                }
            }
        });
        if (NSA_BAD()) {
            NSA_RESET();
            stream(lds, L, S, 0, 2 * u + 2, [&](int j, const TileAddr& Ks) {
                const unsigned bm = (unsigned)__builtin_amdgcn_readfirstlane((int)bmask[j]);
                const int kbase = 64 * j;
                if (bm & 0xffffu) {
                    Frags F; load_frags<true>(Ks, L, F);
#pragma unroll
                    for (int rt = 0; rt < 4; ++rt) {
                        const int twA = tw0 + 4 * rt;
                        if ((bm >> (4 * rt)) & 15u) visit_slow<true, true>(F, L, q[rt], o[rt], m[rt], l[rt], (bool)((bm >> (4 * rt + tl)) & 1u), HiMask{twA + tl - kbase});
                    }
                }
            });
        }
        }
    }
    {
        NSA_STAGE();
#pragma unroll
        for (int rt = 0; rt < 4; ++rt) {
            int gi_ = gnrow + rt * 192 + 1; OPAQUE(gi_); const float sc = X.GN_()[gi_] * __builtin_amdgcn_rcpf(gsum(l[rt]));
            int oo_ = (b * SEQ + tw0 + 4 * rt + tl) * 1536 + 512 + (gk * 4 + (L.c & 3)) * 64 + 4 * L.g; OPAQUE(oo_); bf16_t* orow = X.PA_() + (size_t)oo_;
#pragma unroll
            for (int dt = 0; dt < 4; ++dt) {
                const u32x2 pw = *(LAS u32x2*)(park + rt * 2048 + dt * 32); const f32x4 v = o[rt][dt] * sc; u32x2 w;
                w.x = cvt_pk_bf16(v[0] + __builtin_bit_cast(float, pw.x << 16), v[1] + __builtin_bit_cast(float, pw.x & 0xffff0000u));
                w.y = cvt_pk_bf16(v[2] + __builtin_bit_cast(float, pw.y << 16), v[3] + __builtin_bit_cast(float, pw.y & 0xffff0000u));
                *(u32x2*)(orow + 16 * dt) = w;
            }
        }
    }
    asm volatile("s_waitcnt vmcnt(0) lgkmcnt(0)" ::: "memory");
#undef NSA_LOADQ
#undef NSA_RESET
#undef NSA_BAD
#undef NSA_STAGE
}
}

#define XB_TMO      128
#define XB_XCNT(j)  (256  + 64 * (j))
#define XB_XSUB(j)  (1280 + 64 * (j))
#define XB_XGEN(j)  (2304 + 64 * (j))
#define XB_TOP      3328
#define XB_TOPGEN   3392
#define XCD_BAR_WORDS 3456
#define XB_SPIN_CAP (1u << 18)
constexpr int CW_FN = 10240;
constexpr int CW_BAR = 4096;
constexpr size_t CTL_ZERO_BYTES = 65536;
__device__ __forceinline__ unsigned xb_ld(unsigned* p)              { return __hip_atomic_load(p, __ATOMIC_RELAXED, __HIP_MEMORY_SCOPE_AGENT); }
__device__ __forceinline__ unsigned xb_add(unsigned* p, unsigned v) { return __hip_atomic_fetch_add(p, v, __ATOMIC_RELAXED, __HIP_MEMORY_SCOPE_AGENT); }
__device__ __forceinline__ unsigned xb_xcc_id() { return (unsigned)__builtin_amdgcn_s_getreg((3 << 11) | 20) & 0xFu; }
#define XB_SPIN(cond, bar) do { unsigned _sp = 0; while (cond) { __builtin_amdgcn_s_sleep(1); \
    if ((++_sp & 255u) == 0u) { if (xb_ld(&(bar)[XB_TMO])) break; if (_sp > XB_SPIN_CAP) { atomicAdd(&(bar)[XB_TMO], 1u); break; } } } } while (0)
struct XcdBarrier { unsigned* bar; unsigned x; volatile LAS unsigned* st; int wave; };
__device__ __forceinline__ XcdBarrier xcd_barrier_post(unsigned* bar, volatile LAS unsigned* st, int wave) {
    XcdBarrier b; b.bar = bar; b.x = xb_xcc_id(); b.st = st; b.wave = wave;
    if (wave == 0 && lane_id() == 0) (void)xb_add(&bar[XB_XCNT(b.x)], 1u);
    return b;
}
__device__ __forceinline__ void xcd_barrier_complete(unsigned* bar, unsigned x, unsigned& nloc, unsigned& nx) {
    const unsigned G = gridDim.x * gridDim.y * gridDim.z;
    unsigned sum, cnt, mine, sp = 0u;
    for (;;) {
        sum = 0u; cnt = 0u; mine = 0u;
#pragma unroll
        for (unsigned j = 0; j < 16; ++j) { const unsigned c = xb_ld(&bar[XB_XCNT(j)]); sum += c; cnt += (c > 0u) ? 1u : 0u; mine = (j == x) ? c : mine; }
        if (sum == G) break;
        __builtin_amdgcn_s_sleep(1);
        if ((++sp & 255u) == 0u) { if (xb_ld(&bar[XB_TMO])) break; if (sp > XB_SPIN_CAP) { atomicAdd(&bar[XB_TMO], 1u); break; } }
    }
    nloc = mine > 0u ? mine : 1u; nx = cnt > 0u ? cnt : 1u;
}
__device__ __forceinline__ void xcd_barrier(const XcdBarrier& b) {
    asm volatile("s_waitcnt vmcnt(0)" ::: "memory");
    __syncthreads();
    if (b.wave == 0 && lane_id() == 0) {
        unsigned* bar = b.bar;
        __builtin_amdgcn_s_waitcnt(0);
        unsigned nloc = b.st[0], nx = b.st[1];
        if (nloc == 0u) { xcd_barrier_complete(bar, b.x, nloc, nx); b.st[0] = nloc; b.st[1] = nx; }
        const unsigned old = xb_add(&bar[XB_XSUB(b.x)], 1u);
        const unsigned gen = old / nloc;
        if (old + 1u == (gen + 1u) * nloc) {
            __builtin_amdgcn_fence(__ATOMIC_RELEASE, "agent");
            asm volatile("s_waitcnt vmcnt(0)" ::: "memory");
            const unsigned og = xb_add(&bar[XB_TOP], 1u);
            const unsigned tg = og / nx;
            if (og + 1u == (tg + 1u) * nx) xb_add(&bar[XB_TOPGEN], 1u);
            else XB_SPIN(xb_ld(&bar[XB_TOPGEN]) == tg, bar);
            __builtin_amdgcn_fence(__ATOMIC_ACQUIRE, "agent");
            xb_add(&bar[XB_XGEN(b.x)], 1u);
            asm volatile("s_waitcnt vmcnt(0)" ::: "memory");
        } else {
            XB_SPIN(xb_ld(&bar[XB_XGEN(b.x)]) == gen, bar);
            __builtin_amdgcn_fence(__ATOMIC_ACQUIRE, "agent");
            asm volatile("s_waitcnt vmcnt(0)" ::: "memory");
        }
    }
    __syncthreads();
}

#ifndef MK_COOP
#define MK_COOP 1
#endif
constexpr int N_PHASES = 9;
#define REP(k) for (int rep_ = 0; rep_ < ((MK_PROBE) == (k) ? 2 : 1); ++rep_)
__device__ __forceinline__ KParams kparams() { KParams p = (KParams)__builtin_amdgcn_kernarg_segment_ptr(); asm volatile("" : "+s"(p)); return p; }
__global__ void __launch_bounds__(NTHREADS, 2) mk_fwd(Params Parg) {
    (void)Parg;
    extern __shared__ __attribute__((aligned(16))) unsigned char lds_raw[];
    LAS unsigned char* lds = (LAS unsigned char*)lds_raw;
    const int wave_k = __builtin_amdgcn_readfirstlane((int)(threadIdx.x >> 6));
    const int G = gridDim.x, bx = blockIdx.x;
    const int vcu = (G % 8 == 0) ? (bx % 8) * (G / 8) + bx / 8 : bx;
    const int NGW = G * NWAVES;
#define PHASE_IDS() int tid = TID_(wave_k); asm volatile("" : "+v"(tid)); const int lane = tid & 63, wave = __builtin_amdgcn_readfirstlane(tid >> 6), gw = vcu * NWAVES + wave; (void)lane; (void)gw
#define ws (kparams()->ws)
#define dout ((char*)kparams()->out)
    const int ph_lo = kparams()->ph_lo, ph_hi = kparams()->ph_hi;
#define WSP(T_, off) ((T_*)(ws + (off)))
#if MK_COOP
#ifndef MK_CG_SYNC
#define MK_CG_SYNC 0
#endif
#if MK_CG_SYNC
#define GRID_SYNC() cg::this_grid().sync()
#else
    volatile LAS unsigned* MISC = (volatile LAS unsigned*)(lds + MISC_OFF);
    if (wave_k == 0 && lane_id() < 32) MISC[lane_id()] = 0u;
    __syncthreads();
    const XcdBarrier xbar = xcd_barrier_post((unsigned*)(ws + WS_CTL) + CW_BAR, MISC + 8, wave_k);
#define GRID_SYNC() xcd_barrier(xbar)
#endif
#else
#define GRID_SYNC() do {} while (0)
#endif
#define IN(k) (ph_lo <= (k) && (k) < ph_hi)
#define SEAM(k) do { if (IN(k) && IN((k) + 1)) GRID_SYNC(); } while (0)
#define H ((bf16_t*)(dout + DO_H))
#define SP ((bf16_t*)(dout + DO_SP))
#define X1 ((float*)dout)

    if (IN(0)) REP(0) { PHASE_IDS(); p0_prologue<0>(kparams(), lds, gw, NGW, wave, lane); }
    SEAM(0);
    if (IN(1)) REP(1) {
        pg8::Gemm g{1024 * 2, 1024 * 2, 128, 128, 16}; pg8::StdSched S; S.init(H, WSP(bf16_t, WS_WIN), T, 5120, 2048, 2048, G, bx);
        EpiIn E{WSP(bf16_t, WS_U), WSP(bf16_t, WS_QP), WSP(bf16_t, WS_QR), WSP(bf16_t, WS_KC), SP, WSP(bf16_t, WS_SA),
                WSP(float, WS_GN), WSP(float, WS_RCOS), WSP(float, WS_RSIN)};
        pg8::gemm_phase<EpiIn, pg8::StdSched, true>(lds, g, S, E, wave_k);
    }
    SEAM(1);
    if (IN(2)) REP(2) {
        const int ncmp = (G == 256) ? 64 : 32;
        if (bx >= ncmp) {
            { PHASE_IDS(); (void)gw; p2_pooled(WSP(bf16_t, WS_U), WSP(bf16_t, WS_PA), (bx - ncmp) * NWAVES + wave, (G - ncmp) * NWAVES, lane); }
            PHASE_IDS(); (void)gw;
            const int fr = lane & 15, fq = lane >> 4; const bf16_t* Wg = WSP(bf16_t, WS_WIN) + (size_t)5120 * 1024; float* GNp = WSP(float, WS_GN);
#pragma unroll 1
            for (int it = (((bx - ncmp) * NWAVES + wave) % 3) ? T / 32 : ((bx - ncmp) * NWAVES + wave) / 3; it < T / 32; it += ((G - ncmp) * NWAVES + 2) / 3) {
                const int r0 = 32 * it; f32x4 c2[2][3];
#pragma unroll
                for (int mt = 0; mt < 2; ++mt)
#pragma unroll
                    for (int nt = 0; nt < 3; ++nt) c2[mt][nt] = (f32x4){0.f, 0.f, 0.f, 0.f};
#pragma unroll 4
                for (int k0 = 0; k0 < 1024; k0 += 32) {
                    bf16x8 a[2], b[3];
#pragma unroll
                    for (int mt = 0; mt < 2; ++mt) a[mt] = *(const bf16x8*)(H + (size_t)(r0 + 16 * mt + fr) * 1024 + k0 + 8 * fq);
#pragma unroll
                    for (int nt = 0; nt < 3; ++nt) b[nt] = *(const bf16x8*)(Wg + (size_t)(16 * nt + fr) * 1024 + k0 + 8 * fq);
#pragma unroll
                    for (int mt = 0; mt < 2; ++mt)
#pragma unroll
                        for (int nt = 0; nt < 3; ++nt) c2[mt][nt] = __builtin_amdgcn_mfma_f32_16x16x32_bf16(a[mt], b[nt], c2[mt][nt], 0, 0, 0);
                }
#pragma unroll
                for (int mt = 0; mt < 2; ++mt)
#pragma unroll
                    for (int nt = 0; nt < 3; ++nt)
#pragma unroll
                        for (int r = 0; r < 4; ++r) GNp[(size_t)(r0 + 16 * mt + 4 * fq + r) * 48 + 16 * nt + fr] = sigmoidf_(c2[mt][nt][r] + 0.f);
            }
            if (G != 256) p0_prologue<1>(kparams(), lds, (bx - ncmp) * NWAVES + wave, (G - ncmp) * NWAVES, wave, lane);
        }
        __syncthreads();
        const int split = (G == 256) ? 1 : 0;
        pg8::Gemm g{4096 * 2, 2048 * 2, 512, 128, split ? 16 : 32, (split && (bx & 1)) ? -128 * 4096 * 2 : 0};
        CmpSched S{(const char*)WSP(bf16_t, WS_KC), (const char*)WSP(bf16_t, WS_VC), (const char*)WSP(bf16_t, WS_W1K), (const char*)WSP(bf16_t, WS_W1V), bx, split};
        EpiCmp E{WSP(bf16_t, WS_HIDK), WSP(bf16_t, WS_HIDV), WSP(float, WS_PEBK), WSP(float, WS_PEBV), WSP(bf16_t, WS_W2K), WSP(bf16_t, WS_W2V), WSP(bf16_t, WS_KCMP), WSP(bf16_t, WS_VCMP), ws, split};
        pg8::gemm_phase<EpiCmp, CmpSched, false>(lds, g, S, E, wave_k);
    }
    SEAM(2);
    if (IN(3)) REP(3) {
        const nsa::Tensors X{ws};
        const int wave_s = wave_k;
#pragma unroll 1
        for (int uu = vcu; uu < 256; uu += G) { const int bg = uu >> 5, i = uu & 31;
#pragma unroll 1
            for (int hh = 0; hh < 2; ++hh) nsa::unit(lds, X, bg >> 2, bg & 3, hh ? 63 - i : i, wave_s); }
        if (G == 256) {
            __syncthreads();
            PHASE_IDS(); (void)gw;
            late_weights_queue(kparams(), lds, wave, lane);
        }
    }
    SEAM(3);
    if (IN(4)) REP(4) {
        pg8::Gemm g{1536 * 2, 1536 * 2, 128, 128, 24}; pg8::StdSched S; S.init(WSP(bf16_t, WS_PA), WSP(bf16_t, WS_WM), T, 1024, 3072, 3072, G, bx);
        EpiMerged E{WSP(bf16_t, WS_MG), SP, WSP(bf16_t, WS_SA)};
        pg8::gemm_phase<EpiMerged, pg8::StdSched, false>(lds, g, S, E, wave_k);
    }
    SEAM(4);
    if (IN(5)) REP(5) {
        pg8::Gemm g{1024 * 2, 1024 * 2, 128, 128, 16}; pg8::StdSched S; S.init(WSP(bf16_t, WS_MG), WSP(bf16_t, WS_WO), T, 1024, 2048, 2048, G, bx);
        EpiX1 E{kparams()->x, X1, WSP(bf16_t, WS_X1B), WSP(float, WS_RS1)};
        pg8::gemm_phase<EpiX1, pg8::StdSched, false>(lds, g, S, E, wave_k);
    }
    SEAM(5);
    if (IN(6)) REP(6) {
        pg8::Gemm g{1024 * 2, 1024 * 2, 128, 128, 16}; pg8::StdSched S; S.init(WSP(bf16_t, WS_X1B), WSP(bf16_t, WS_WGU), T, 5632, 2048, 2048, G, bx);
        EpiAct E{WSP(bf16_t, WS_ACT), WSP(float, WS_RS1)};
        pg8::gemm_phase<EpiAct, pg8::StdSched, true>(lds, g, S, E, wave_k);
    }
    SEAM(6);
    if (IN(7)) {
        pg8::Gemm g{DFF * 2, DFF * 2, 128, 128, DFF / 64}; pg8::StdSched S; S.init(WSP(bf16_t, WS_ACT), WSP(bf16_t, WS_WD), T, 1024, DFF * 2, DFF * 2, G, bx);
        if (G == 256) {
            EpiFinal E{X1, WSP(bf16_t, WS_X1B), kparams()->normf_w, WSP(float, WS_SEL), (unsigned*)(ws + WS_CTL) + CW_FN};
            pg8::gemm_phase<EpiFinal, pg8::StdSched, false>(lds, g, S, E, wave_k);
        } else {
            EpiX2 E{X1, WSP(bf16_t, WS_X1B)};
            pg8::gemm_phase<EpiX2, pg8::StdSched, false>(lds, g, S, E, wave_k);
        }
    }
    if (G != 256) {
    SEAM(7);
    if (IN(8)) {
        PHASE_IDS();
        for (int row = gw; row < T; row += NGW) {
            f32x4* xr = (f32x4*)(X1 + (size_t)row * DM) + lane; const f32x4* wr = (const f32x4*)kparams()->normf_w + lane;
            f32x4 v[4]; float s = 0.f;
#pragma unroll
            for (int j = 0; j < 4; ++j) { v[j] = xr[64 * j]; s += (v[j].x * v[j].x + v[j].y * v[j].y) + (v[j].z * v[j].z + v[j].w * v[j].w); }
            const float rstd = rsqrtf(wave_sum(s) * (1.f / DM) + RMS_EPS);
#pragma unroll
            for (int j = 0; j < 4; ++j) { const f32x4 ww = wr[64 * j]; xr[64 * j] = (f32x4){v[j].x * rstd * ww.x, v[j].y * rstd * ww.y, v[j].z * rstd * ww.z, v[j].w * rstd * ww.w}; }
        }
    }
    }
#undef WSP
#undef ws
#undef dout
#undef H
#undef SP
#undef X1
}

extern "C" void kernel_launch(void* const* d_in, const int* in_sizes, int n_in, void* d_out, int out_size, void* d_ws, size_t ws_size, hipStream_t stream) {
    static int grid = 0;
    if (grid == 0) {
        if (n_in != 21 || ws_size < WS_END || out_size != T * DM) { fprintf(stderr, "kernel_launch: unexpected shapes n_in %d ws %zu out %d\n", n_in, ws_size, out_size); grid = -1; return; }
        int dev = 0, cus = 0, per_cu = 0;
        if (hipGetDevice(&dev) != hipSuccess || hipDeviceGetAttribute(&cus, hipDeviceAttributeMultiprocessorCount, dev) != hipSuccess) { grid = -1; return; }
        if (hipFuncSetAttribute((const void*)mk_fwd, hipFuncAttributeMaxDynamicSharedMemorySize, LDS_BYTES) != hipSuccess) { fprintf(stderr, "kernel_launch: hipFuncSetAttribute failed\n"); grid = -1; return; }
        if (hipOccupancyMaxActiveBlocksPerMultiprocessor(&per_cu, (const void*)mk_fwd, NTHREADS, LDS_BYTES) != hipSuccess || per_cu < 1) { fprintf(stderr, "kernel_launch: occupancy query says %d\n", per_cu); (void)hipGetLastError(); per_cu = 1; }
        grid = cus;
    }
    if (grid < 0) return;
    Params p{};
    const float** pin = (const float**)&p;
    for (int i = 0; i < 21; ++i) pin[i] = (const float*)d_in[i];
    p.out = (float*)d_out; p.ws = (unsigned char*)d_ws;
#if MK_COOP
    p.ph_lo = 0; p.ph_hi = N_PHASES;
    if (hipMemsetAsync((char*)d_ws + WS_CTL, 0, CTL_ZERO_BYTES, stream) != hipSuccess) { fprintf(stderr, "kernel_launch: memset failed\n"); return; }
    void* args[] = {&p};
    hipError_t e = hipLaunchCooperativeKernel((const void*)mk_fwd, dim3(grid), dim3(NTHREADS), args, LDS_BYTES, stream);
    if (e != hipSuccess) fprintf(stderr, "kernel_launch: cooperative launch failed: %s (grid %d)\n", hipGetErrorString(e), grid);
#else
    for (int ph = 0; ph < N_PHASES; ++ph) { p.ph_lo = ph; p.ph_hi = ph + 1; hipLaunchKernelGGL(mk_fwd, dim3(grid), dim3(NTHREADS), LDS_BYTES, stream, p); }
#endif
}
```

```cpp
#include <hip/hip_runtime.h>
#include <hip/hip_cooperative_groups.h>
#include <cstdint>
#include <cstdio>
namespace cg = cooperative_groups;
#ifndef MK_PROBE
#define MK_PROBE -1
#endif
#define SUBREP(k) for (int srep_ = 0; srep_ < ((MK_PROBE) == (k) ? 2 : 1); ++srep_)

#define LAS __attribute__((address_space(3)))
typedef unsigned short bf16_t;
typedef short bf16x8 __attribute__((ext_vector_type(8)));
typedef float f32x4 __attribute__((ext_vector_type(4)));
typedef unsigned u32x4 __attribute__((ext_vector_type(4)));
typedef unsigned u32x2 __attribute__((ext_vector_type(2)));

constexpr int BATCH = 2, SEQ = 8192, T = BATCH * SEQ, DM = 1024;
constexpr int NREF = 5168, NIN = 5376;
constexpr int DFF = 2816;
constexpr int NCP = 512;
constexpr float RMS_EPS = 1e-6f;
constexpr float C2 = 0.125f * 1.4426950408889634f;
constexpr int NWAVES = 8, NTHREADS = 512;

constexpr size_t MiB = 1u << 20;
constexpr size_t WS_CTL = 0;
constexpr size_t WS_PEBK = 1 * MiB, WS_PEBV = 1 * MiB + 4096, WS_RCOS = 1 * MiB + 65536, WS_RSIN = WS_RCOS + 262144;
constexpr size_t WS_RS1 = 2 * MiB;
constexpr size_t WS_SEL = 3 * MiB;
constexpr size_t WS_KCMP = 4 * MiB, WS_VCMP = 4 * MiB + 512 * 1024;
constexpr size_t WS_W2K = 5 * MiB, WS_W2V = 5 * MiB + 65536;
constexpr size_t WS_W1K = 6 * MiB, WS_W1V = 7 * MiB;
constexpr size_t WS_WIN = 8 * MiB;
constexpr size_t WS_WM = 19 * MiB;
constexpr size_t WS_WO = 22 * MiB;
constexpr size_t WS_WGU = 24 * MiB;
constexpr size_t WS_WD = 35 * MiB;
constexpr size_t WS_GN = 41 * MiB;
constexpr size_t WS_U = 44 * MiB;
constexpr size_t WS_QP = 60 * MiB;
constexpr size_t WS_MG = 60 * MiB;
constexpr size_t WS_KC = 92 * MiB, WS_VC = 100 * MiB, WS_KS = 108 * MiB, WS_VS = 116 * MiB, WS_KW = 124 * MiB, WS_VW = 132 * MiB;
constexpr size_t WS_SA = 140 * MiB;
constexpr size_t WS_PA = 172 * MiB;
constexpr size_t WS_QR = 220 * MiB;
constexpr size_t WS_X1B = 220 * MiB;
constexpr size_t WS_HIDK = 252 * MiB, WS_HIDV = 254 * MiB;
constexpr size_t WS_ACT = 44 * MiB;
constexpr size_t WS_END = 256 * MiB;
constexpr size_t DO_H = 0, DO_SP = 32 * MiB;

constexpr int RING_BYTES = 131072;
constexpr int MISC_OFF = 147456 - 256;
constexpr int LDS_BYTES = 147456;

__device__ __forceinline__ unsigned f2bf(float f) { unsigned u = __builtin_bit_cast(unsigned, f); return (u + 0x7fffu + ((u >> 16) & 1u)) >> 16; }
__device__ __forceinline__ float bf2f(unsigned b) { return __builtin_bit_cast(float, (b & 0xffffu) << 16); }
__device__ __forceinline__ unsigned pk2(float lo, float hi) { return f2bf(lo) | (f2bf(hi) << 16); }
typedef float f32x2_t __attribute__((ext_vector_type(2))); typedef __bf16 bf16x2_t __attribute__((ext_vector_type(2)));
__device__ __forceinline__ unsigned cvt_pk_bf16(float lo, float hi) { f32x2_t v = {lo, hi}; bf16x2_t b = __builtin_convertvector(v, bf16x2_t); return __builtin_bit_cast(unsigned, b); }
__device__ __forceinline__ u32x4 pack8(const f32x4& a, const f32x4& b) { u32x4 w; w.x = cvt_pk_bf16(a[0], a[1]); w.y = cvt_pk_bf16(a[2], a[3]); w.z = cvt_pk_bf16(b[0], b[1]); w.w = cvt_pk_bf16(b[2], b[3]); return w; }
__device__ __forceinline__ void unpack8(const u32x4& w, f32x4& a, f32x4& b) {
    a[0] = __builtin_bit_cast(float, w.x << 16); a[1] = __builtin_bit_cast(float, w.x & 0xffff0000u); a[2] = __builtin_bit_cast(float, w.y << 16); a[3] = __builtin_bit_cast(float, w.y & 0xffff0000u);
    b[0] = __builtin_bit_cast(float, w.z << 16); b[1] = __builtin_bit_cast(float, w.z & 0xffff0000u); b[2] = __builtin_bit_cast(float, w.w << 16); b[3] = __builtin_bit_cast(float, w.w & 0xffff0000u); }
__device__ __forceinline__ float sigmoidf_(float v) { return __builtin_amdgcn_rcpf(1.f + __expf(-v)); }
__device__ __forceinline__ float wave_sum(float v) {
#pragma unroll
    for (int o = 1; o < 64; o <<= 1) v += __shfl_xor(v, o);
    return v;
}
__device__ __forceinline__ float wave_max(float v) {
#pragma unroll
    for (int o = 1; o < 64; o <<= 1) v = fmaxf(v, __shfl_xor(v, o));
    return v;
}
#define WSYNC() asm volatile("s_waitcnt lgkmcnt(0)" ::: "memory")
__device__ __forceinline__ int lane_id() { int r; asm volatile("v_mbcnt_lo_u32_b32 %0, -1, 0\n\tv_mbcnt_hi_u32_b32 %0, -1, %0" : "=v"(r)); return r; }
#define TID_(wv) (64 * (wv) + lane_id())
#define OPAQUE(x) asm volatile("" : "+v"(x))
__host__ __device__ __forceinline__ int incol_ref(int c) {
    if (c < 3072) return c;
    if (c < 4096) return 3120 + (c - 3072);
    if (c < 5120) return 4144 + (c - 4096);
    if (c < 5168) return 3072 + (c - 5120);
    return -1;
}

struct Params {
    const float *x, *norm1_w, *w_in, *pool_w, *pool_scale, *pe_k, *w1_k, *b1_k, *w2_k, *pe_v, *w1_v, *b1_v, *w2_v, *w_pp, *w_pa, *w_out, *norm2_w, *w_g, *w_u, *w_d, *normf_w;
    float* out; unsigned char* ws;
    int ph_lo, ph_hi;
};

typedef const __attribute__((address_space(4))) Params* KParams;
namespace pg8 {
constexpr int BM = 256, BK = 64, HALF = 128, HTB = HALF * BK * 2, STAGE_BYTES = 8 * HTB, NXCD = 8, WGM = 8;
__host__ __device__ __forceinline__ int lds_byte(int r, int c) { const int st = (r >> 4) * 2 + (c >> 5), rr = r & 15, cc = c & 31, ob = rr * 64 + cc * 2; return st * 1024 + (ob ^ (((ob >> 9) & 1) << 5)); }
__host__ __device__ __forceinline__ void stage_rc(int b, int& R, int& C) { const int st = b / 1024, sb = b % 1024, swz = sb ^ (((sb >> 9) & 1) << 5); R = (st >> 1) * 16 + swz / 64; C = (st & 1) * 32 + (swz % 64) / 2; }
__host__ __device__ __forceinline__ int perm32(int rho) { const int n = rho >> 4, i = rho & 15; return 8 * (i >> 2) + 4 * n + (i & 3); }

struct Unit { int pm, pn; const char* A; const char* B; };
struct Gemm { int lda, ldb, ksA, ksB, nt, hsA; };

struct StaticOrder {
    int nM, nN, nwg, G, c;
    __device__ void init(int M, int N, int G_, int c_) { nM = M / BM; nN = N / BM; nwg = nM * nN; G = G_; c = c_; }
    __device__ bool next(int i, int& pm, int& pn) const {
        const long L = (long)i * G + c; if (L >= nwg) return false;
        int wgid = (int)L; { const int q = nwg / NXCD, r = nwg % NXCD, xcd = wgid % NXCD, off = wgid / NXCD; wgid = (xcd < r ? xcd * (q + 1) : r * (q + 1) + (xcd - r) * q) + off; }
        const int nig = WGM * nN, gid = wgid / nig, fm = gid * WGM, gsz = (nM - fm) < WGM ? (nM - fm) : WGM;
        pm = fm + ((wgid % nig) % gsz); pn = (wgid % nig) / gsz; return true;
    }
};
struct StdSched {
    StaticOrder so; const char* A; const char* B; size_t tA, tB;
    __device__ void init(const void* A_, const void* B_, int M, int N, int lda_bytes, int ldb_bytes, int G, int c) { so.init(M, N, G, c); A = (const char*)A_; B = (const char*)B_; tA = (size_t)256 * lda_bytes; tB = (size_t)256 * ldb_bytes; }
    __device__ bool next(int i, Unit& u) const { if (!so.next(i, u.pm, u.pn)) return false; u.A = A + u.pm * tA; u.B = B + u.pn * tB; return true; }
};

template <class Epi, class Sched, bool ALIGN_EPI>
__device__ __forceinline__ void gemm_phase(LAS unsigned char* lds, const Gemm g, const Sched& S, const Epi& E, int wave_k) {
    int tid = TID_(wave_k); asm volatile("" : "+v"(tid));
    const int wid = __builtin_amdgcn_readfirstlane(tid >> 6), lane = tid & 63, wr = wid >> 2, wc = wid & 3, fr = lane & 15, fq = lane >> 4;
    const int nt = g.nt;
    unsigned voffA[2], voffB[2];
#pragma unroll
    for (int i = 0; i < 2; ++i) { int R, C; stage_rc(tid * 16 + i * 8192, R, C); const int Rb = (R & ~31) + perm32(R & 31);
        voffA[i] = (unsigned)(R * g.lda + C * 2); voffB[i] = (unsigned)(Rb * g.ldb + C * 2); }
    const size_t kstepA = (size_t)g.ksA, kstepB = (size_t)g.ksB;
    const ptrdiff_t hstepA = g.hsA ? (ptrdiff_t)g.hsA : (ptrdiff_t)HALF * g.lda; const size_t hstepB = (size_t)HALF * g.ldb;
    const unsigned ldsw = (unsigned)wid * 1024u;
    const int aoff = lds_byte(wr * 64 + fr, fq * 8), boff = lds_byte(wc * 32 + fr, fq * 8);
#define PG8_SA(b, h) (((b) * 2 + (h)) * HTB)
#define PG8_SB(b, h) ((4 + (b) * 2 + (h)) * HTB)
#define PG8_STAGE(bufoff, gbase, voff) do { _Pragma("unroll") for (int _i = 0; _i < 2; ++_i) \
        __builtin_amdgcn_global_load_lds((const unsigned*)((const char*)(gbase) + (voff)[_i]), (LAS unsigned*)(lds + (bufoff) + ldsw + _i * 8192), 16, 0, 0); } while (0)
#define PG8_LDA(dst, b, h) do { _Pragma("unroll") for (int m = 0; m < 4; ++m) _Pragma("unroll") for (int k = 0; k < 2; ++k) dst[m][k] = *(const LAS bf16x8*)(lds + PG8_SA(b, h) + aoff + m * 2048 + k * 1024); } while (0)
#define PG8_LDB(dst, b, h) do { _Pragma("unroll") for (int n = 0; n < 2; ++n) _Pragma("unroll") for (int k = 0; k < 2; ++k) dst[n][k] = *(const LAS bf16x8*)(lds + PG8_SB(b, h) + boff + n * 2048 + k * 1024); } while (0)
#define PG8_MMA(ai, bj, At, Bt) do { __builtin_amdgcn_s_setprio(1); _Pragma("unroll") for (int m = 0; m < 4; ++m) _Pragma("unroll") for (int n = 0; n < 2; ++n) _Pragma("unroll") for (int k = 0; k < 2; ++k) \
        acc[ai][bj][m][n] = __builtin_amdgcn_mfma_f32_16x16x32_bf16(Bt[n][k], At[m][k], acc[ai][bj][m][n], 0, 0, 0); __builtin_amdgcn_s_setprio(0); } while (0)
#define PG8_WAIT_V(n) asm volatile("s_waitcnt vmcnt(" #n ")" ::: "memory")
#define PG8_WAIT_L(n) asm volatile("s_waitcnt lgkmcnt(" #n ")" ::: "memory")
#define PG8_BAR __builtin_amdgcn_s_barrier()
#define PG8_SCHED __builtin_amdgcn_sched_barrier(0)
    Unit cur, nxt; int ui = 0;
    if (!S.next(0, cur)) return;
    f32x4 acc[2][2][4][2];
#pragma unroll
    for (int a = 0; a < 2; ++a)
#pragma unroll
        for (int b = 0; b < 2; ++b)
#pragma unroll
            for (int m = 0; m < 4; ++m)
#pragma unroll
                for (int n = 0; n < 2; ++n) acc[a][b][m][n] = (f32x4){0.f, 0.f, 0.f, 0.f};
    bf16x8 At[4][2], B0[2][2], B1[2][2];
    const char* cA = cur.A; const char* cB = cur.B;
    PG8_STAGE(PG8_SB(0, 0), cB, voffB); PG8_STAGE(PG8_SB(0, 1), cB + hstepB, voffB); PG8_STAGE(PG8_SA(0, 0), cA, voffA); PG8_STAGE(PG8_SA(0, 1), cA + hstepA, voffA);
    if (wr == 1) PG8_BAR;
    PG8_WAIT_V(2); PG8_BAR;
    PG8_STAGE(PG8_SB(1, 0), cB + kstepB, voffB); PG8_STAGE(PG8_SA(1, 0), cA + kstepA, voffA); PG8_STAGE(PG8_SB(1, 1), cB + hstepB + kstepB, voffB);
    PG8_WAIT_V(6); PG8_BAR;
    for (;;) {
        const bool has_next = S.next(ui + 1, nxt);
        const char* nA = has_next ? nxt.A : cA; const char* nB = has_next ? nxt.B : cB;
        for (int t = 0; t < nt; t += 2) {
            const bool last = (t == nt - 2);
            const char* a1 = cA + (size_t)(t + 1) * kstepA;
            const char* a2 = last ? nA : cA + (size_t)(t + 2) * kstepA; const char* b2 = last ? nB : cB + (size_t)(t + 2) * kstepB;
            const char* a3 = a2 + kstepA; const char* b3 = b2 + kstepB;
            PG8_LDB(B0, 0, 0); PG8_LDB(B1, 0, 1); PG8_SCHED; PG8_LDA(At, 0, 0); PG8_STAGE(PG8_SA(1, 1), a1 + hstepA, voffA);
            PG8_WAIT_V(8); PG8_WAIT_L(0); PG8_BAR; PG8_MMA(0, 0, At, B0); PG8_MMA(0, 1, At, B1); PG8_BAR; PG8_SCHED;
            PG8_LDA(At, 0, 1); PG8_STAGE(PG8_SB(0, 0), b2, voffB); PG8_STAGE(PG8_SB(0, 1), b2 + hstepB, voffB); PG8_STAGE(PG8_SA(0, 0), a2, voffA);
            PG8_WAIT_V(8); PG8_WAIT_L(0); PG8_BAR; PG8_MMA(1, 0, At, B0); PG8_MMA(1, 1, At, B1); PG8_BAR; PG8_SCHED;
            PG8_LDB(B0, 1, 0); PG8_LDB(B1, 1, 1); PG8_SCHED; PG8_LDA(At, 1, 0); PG8_STAGE(PG8_SA(0, 1), a2 + hstepA, voffA);
            PG8_WAIT_V(8); PG8_WAIT_L(0); PG8_BAR; PG8_MMA(0, 0, At, B0); PG8_MMA(0, 1, At, B1); PG8_BAR; PG8_SCHED;
            PG8_LDA(At, 1, 1); PG8_STAGE(PG8_SB(1, 0), b3, voffB); PG8_STAGE(PG8_SB(1, 1), b3 + hstepB, voffB); PG8_STAGE(PG8_SA(1, 0), a3, voffA);
            PG8_WAIT_V(8); PG8_WAIT_L(0); PG8_BAR; PG8_MMA(1, 0, At, B0); PG8_MMA(1, 1, At, B1); PG8_BAR; PG8_SCHED;
            if constexpr (Epi::HOOK_KT > 0) { if (t + 2 == Epi::HOOK_KT) { E.hook(acc, cur, wr, wc, fr, fq); PG8_WAIT_V(0); PG8_SCHED; } }
        }
        if constexpr (ALIGN_EPI) { if (wr == 0) PG8_BAR; }
        if constexpr (!Epi::AFTER_DRAIN) { E(acc, cur, wr, wc, fr, fq); }
        if (!has_next) break;
#pragma unroll
        for (int a = 0; a < 2; ++a)
#pragma unroll
            for (int b = 0; b < 2; ++b)
#pragma unroll
                for (int m = 0; m < 4; ++m)
#pragma unroll
                    for (int n = 0; n < 2; ++n) acc[a][b][m][n] = (f32x4){0.f, 0.f, 0.f, 0.f};
        cur = nxt; cA = nA; cB = nB; ++ui;
        if constexpr (ALIGN_EPI) { if (wr == 1) PG8_BAR; }
    }
    PG8_WAIT_V(0);
    if constexpr (!ALIGN_EPI) { if (wr == 0) PG8_BAR; }
    PG8_BAR;
    if constexpr (Epi::AFTER_DRAIN) { E.fused(acc, cur, wr, wc, fr, fq, wid, lane, lds); }
#undef PG8_SA
#undef PG8_SB
#undef PG8_STAGE
#undef PG8_LDA
#undef PG8_LDB
#undef PG8_MMA
#undef PG8_WAIT_V
#undef PG8_WAIT_L
#undef PG8_BAR
#undef PG8_SCHED
}
}
using pg8::Unit;
typedef f32x4 Acc[2][2][4][2];
#define EPI_ROW(u, ai, wr, m, fr) ((u).pm * 256 + (ai) * 128 + (wr) * 64 + (m) * 16 + (fr))
#define EPI_LC(bj, wc, fq) ((bj) * 128 + (wc) * 32 + (fq) * 8)

constexpr int CW_XC = 14600;
struct EpiIn {
    static constexpr bool AFTER_DRAIN = false; static constexpr int HOOK_KT = 0;
    bf16_t *U, *QP, *QR, *KV0, *SP, *SA; float* GN; const float* RC; const float* RS;
    __device__ __forceinline__ void rope8(f32x4& v0, f32x4& v1, int t, bool apply, int fq) const {
        f32x4 p0, p1;
#pragma unroll
        for (int e = 0; e < 4; ++e) { p0[e] = __shfl_xor(v0[e], 16); p1[e] = __shfl_xor(v1[e], 16); }
        if (apply) {
            const f32x4 c0 = *(const f32x4*)(RC + t * 8), c1 = *(const f32x4*)(RC + t * 8 + 4), s0 = *(const f32x4*)(RS + t * 8), s1 = *(const f32x4*)(RS + t * 8 + 4);
            const float sg = (fq & 1) ? 1.f : -1.f;
            v0 = v0 * c0 + (p0 * s0) * sg; v1 = v1 * c1 + (p1 * s1) * sg;
        }
    }
    __device__ __forceinline__ void operator()(const Acc& acc, const Unit& u, int wr, int wc, int fr, int fq) const {
        OPAQUE(fr); OPAQUE(fq);
        const int pn = u.pn; const bool ropel = ((wc & 1) == 0) && fq < 2;
#pragma unroll
        for (int ai = 0; ai < 2; ++ai)
#pragma unroll
            for (int m = 0; m < 4; ++m) {
                const int r = EPI_ROW(u, ai, wr, m, fr), t = r & (SEQ - 1);
#pragma unroll
                for (int bj = 0; bj < 2; ++bj) {
                    const int lc = EPI_LC(bj, wc, fq); f32x4 v0 = acc[ai][bj][m][0], v1 = acc[ai][bj][m][1];
                    if (pn < 2) { *(u32x4*)(U + (size_t)r * 512 + pn * 256 + lc) = pack8(v0, v1); }
                    else if (pn < 6) {
                        v0 = v0 * C2; v1 = v1 * C2; const size_t o = (size_t)r * 1024 + (pn - 2) * 256 + lc;
                        *(u32x4*)(QP + o) = pack8(v0, v1);
                        if ((wc & 1) == 0) rope8(v0, v1, t, ropel, fq);
                        *(u32x4*)(QR + o) = pack8(v0, v1);
                    } else if (pn < 12) {
                        const int ty = pn - 6; bf16_t* dst = KV0 + (size_t)ty * (size_t)(4u << 20);
                        if ((ty == 2 || ty == 4) && (wc & 1) == 0) rope8(v0, v1, t, ropel, fq);
                        *(u32x4*)(dst + (size_t)r * 256 + lc) = pack8(v0, v1);
                    } else if (pn < 20) {
                        bf16_t* dst = pn < 16 ? SP : SA; const int cb = ((pn - 12) & 3) * 256 + lc;
#pragma unroll
                        for (int e = 0; e < 4; ++e) { v0[e] = sigmoidf_(v0[e]); v1[e] = sigmoidf_(v1[e]); }
                        *(u32x4*)(dst + (size_t)r * 1024 + cb) = pack8(v0, v1);
                    } else if (lc < 48) {
#pragma unroll
                        for (int e = 0; e < 4; ++e) { v0[e] = sigmoidf_(v0[e]); v1[e] = sigmoidf_(v1[e]); }
                        *(f32x4*)(GN + (size_t)r * 48 + lc) = v0; *(f32x4*)(GN + (size_t)r * 48 + lc + 4) = v1;
                    }
                }
            }
    }
};
__device__ __forceinline__ float gelu_tanh(float x) { const float u = 0.7978845608028654f * (x + 0.044715f * x * x * x); const float e = __expf(2.f * u); return 0.5f * x * (1.f + (1.f - 2.f * __builtin_amdgcn_rcpf(e + 1.f))); }
struct EpiCmp {
    static constexpr bool AFTER_DRAIN = true; static constexpr int HOOK_KT = 0;
    bf16_t *HIDK, *HIDV; const float *PEBK, *PEBV; const bf16_t *W2K, *W2V; bf16_t *KCMP, *VCMP; unsigned char* wsb; int split;
    template <int AI> __device__ __forceinline__ void gelu_half(const Acc& acc, bf16_t* HID, const float* peb, int rbase, int wr, int wc, int fr, int fq) const {
#pragma unroll
        for (int bj = 0; bj < 2; ++bj) {
            const int lc = EPI_LC(bj, wc, fq); const f32x4 b0 = *(const f32x4*)(peb + lc), b1 = *(const f32x4*)(peb + lc + 4);
#pragma unroll
            for (int m = 0; m < 4; ++m) {
                const int r = rbase + wr * 64 + m * 16 + fr; f32x4 v0 = acc[AI][bj][m][0] + b0, v1 = acc[AI][bj][m][1] + b1;
#pragma unroll
                for (int e = 0; e < 4; ++e) { v0[e] = gelu_tanh(v0[e]); v1[e] = gelu_tanh(v1[e]); }
                *(u32x4*)(HID + (size_t)r * 256 + lc) = pack8(v0, v1);
            }
        }
    }
    __device__ __forceinline__ void fused(Acc& acc, const Unit& u, int wr, int wc, int fr, int fq, int wid, int lane, LAS unsigned char*) const {
        OPAQUE(fr); OPAQUE(fq);
        const int h = u.pn, which = u.pm >> 4, rt = u.pm & 15; bf16_t* HID = which ? HIDV : HIDK; const float* peb = which ? PEBV : PEBK;
        if (split) {
            float* slabs = (float*)(wsb + (u.pm < 16 ? WS_WM : WS_WD)) + (size_t)((u.pm & 15) * 2) * (128 * 256);
            unsigned* cnt = (unsigned*)(wsb + WS_CTL) + CW_XC + (u.pm * 2) * 16;
            float* mine = slabs + (size_t)h * (128 * 256); const float* theirs = slabs + (size_t)(h ^ 1) * (128 * 256);
#pragma unroll
            for (int bj = 0; bj < 2; ++bj)
#pragma unroll
                for (int m = 0; m < 4; ++m) { float* p = mine + (size_t)(wr * 64 + m * 16 + fr) * 256 + EPI_LC(bj, wc, fq);
                    asm volatile("global_store_dwordx4 %0, %1, off sc0 sc1" :: "v"(p), "v"(acc[1][bj][m][0]) : "memory");
                    asm volatile("global_store_dwordx4 %0, %1, off offset:16 sc0 sc1" :: "v"(p), "v"(acc[1][bj][m][1]) : "memory"); }
            asm volatile("s_waitcnt vmcnt(0)" ::: "memory");
            if (lane == 0) __hip_atomic_fetch_add(cnt + 16 * h, 1u, __ATOMIC_RELAXED, __HIP_MEMORY_SCOPE_AGENT);
            if (wid == 0) {
                unsigned sp = 0; while ((unsigned)__builtin_amdgcn_readfirstlane((int)__hip_atomic_load(cnt + 16 * (h ^ 1), __ATOMIC_RELAXED, __HIP_MEMORY_SCOPE_AGENT)) < 8u && ++sp < (1u << 22)) __builtin_amdgcn_s_sleep(2);
            }
            asm volatile("s_waitcnt vmcnt(0) lgkmcnt(0)" ::: "memory"); __builtin_amdgcn_s_barrier(); asm volatile("" ::: "memory");
            __builtin_amdgcn_fence(__ATOMIC_ACQUIRE, "agent");
#pragma unroll
            for (int bj = 0; bj < 2; ++bj)
#pragma unroll
                for (int m = 0; m < 4; ++m) { const float* p = theirs + (size_t)(wr * 64 + m * 16 + fr) * 256 + EPI_LC(bj, wc, fq); acc[0][bj][m][0] += *(const f32x4*)p; acc[0][bj][m][1] += *(const f32x4*)(p + 4); }
        }
        gelu_half<0>(acc, HID, peb, rt * 256 + (split ? h * 128 : 0), wr, wc, fr, fq);
        if (!split) gelu_half<1>(acc, HID, peb, rt * 256 + 128, wr, wc, fr, fq);
        asm volatile("s_waitcnt vmcnt(0)" ::: "memory"); __syncthreads();
        const bf16_t* W2 = which ? W2V : W2K; bf16_t* OUT = which ? VCMP : KCMP; const int r0 = rt * 256 + (split ? h * 128 + wid * 16 : wid * 32);
        f32x4 c2[2][4];
#pragma unroll
        for (int mt = 0; mt < 2; ++mt)
#pragma unroll
            for (int nt = 0; nt < 4; ++nt) c2[mt][nt] = (f32x4){0.f, 0.f, 0.f, 0.f};
        for (int k0 = 0; k0 < 256; k0 += 32) {
            bf16x8 a[2], b[4];
#pragma unroll
            for (int mt = 0; mt < 2; ++mt) a[mt] = *(const bf16x8*)(HID + (size_t)(r0 + (split ? 0 : 16 * mt) + fr) * 256 + k0 + 8 * fq);
#pragma unroll
            for (int nt = 0; nt < 4; ++nt) b[nt] = *(const bf16x8*)(W2 + (size_t)(16 * nt + fr) * 256 + k0 + 8 * fq);
#pragma unroll
            for (int mt = 0; mt < 2; ++mt)
#pragma unroll
                for (int nt = 0; nt < 4; ++nt) c2[mt][nt] = __builtin_amdgcn_mfma_f32_16x16x32_bf16(a[mt], b[nt], c2[mt][nt], 0, 0, 0);
        }
#pragma unroll
        for (int mt = 0; mt < 2; ++mt) {
            if (mt == 0 || !split) {
#pragma unroll
            for (int nt = 0; nt < 4; ++nt)
#pragma unroll
                for (int r = 0; r < 4; ++r) OUT[(size_t)(r0 + 16 * mt + 4 * fq + r) * 64 + 16 * nt + fr] = (bf16_t)f2bf(c2[mt][nt][r]);
            }
        }
    }
};
struct EpiMerged {
    static constexpr bool AFTER_DRAIN = false; static constexpr int HOOK_KT = 8;
    bf16_t* MG; const bf16_t* SP; const bf16_t* SA;
    __device__ __forceinline__ void hook(Acc& acc, const Unit& u, int wr, int wc, int fr, int fq) const {
        OPAQUE(fr); OPAQUE(fq);
#pragma unroll
        for (int ai = 0; ai < 2; ++ai)
#pragma unroll
            for (int m = 0; m < 4; ++m) {
                const int r = EPI_ROW(u, ai, wr, m, fr);
#pragma unroll
                for (int bj = 0; bj < 2; ++bj) {
                    const size_t o = (size_t)r * 1024 + u.pn * 256 + EPI_LC(bj, wc, fq);
                    const u32x4 wp = *(const u32x4*)(SP + o), wa = *(const u32x4*)(SA + o); f32x4 p0, p1, a0, a1; unpack8(wp, p0, p1); unpack8(wa, a0, a1);
#pragma unroll
                    for (int e = 0; e < 4; ++e) { acc[ai][bj][m][0][e] *= p0[e] * __builtin_amdgcn_rcpf(a0[e]); acc[ai][bj][m][1][e] *= p1[e] * __builtin_amdgcn_rcpf(a1[e]); }
                }
            }
    }
    __device__ __forceinline__ void operator()(const Acc& acc, const Unit& u, int wr, int wc, int fr, int fq) const {
        OPAQUE(fr); OPAQUE(fq);
#pragma unroll
        for (int ai = 0; ai < 2; ++ai)
#pragma unroll
            for (int m = 0; m < 4; ++m) {
                const int r = EPI_ROW(u, ai, wr, m, fr);
#pragma unroll
                for (int bj = 0; bj < 2; ++bj) {
                    const size_t o = (size_t)r * 1024 + u.pn * 256 + EPI_LC(bj, wc, fq);
                    const u32x4 wa = *(const u32x4*)(SA + o); f32x4 a0, a1; unpack8(wa, a0, a1);
                    *(u32x4*)(MG + o) = pack8(acc[ai][bj][m][0] * a0, acc[ai][bj][m][1] * a1);
                }
            }
    }
};
struct EpiX1 {
    static constexpr bool AFTER_DRAIN = false; static constexpr int HOOK_KT = 0;
    const float* x; float* X1; bf16_t* X1B; float* RSP;
    __device__ __forceinline__ void operator()(const Acc& acc, const Unit& u, int wr, int wc, int fr, int fq) const {
        OPAQUE(fr); OPAQUE(fq);
#pragma unroll
        for (int ai = 0; ai < 2; ++ai)
#pragma unroll
            for (int m = 0; m < 4; ++m) {
                const int r = EPI_ROW(u, ai, wr, m, fr); float s = 0.f;
#pragma unroll
                for (int bj = 0; bj < 2; ++bj) {
                    const size_t o = (size_t)r * 1024 + u.pn * 256 + EPI_LC(bj, wc, fq);
                    const f32x4 o0 = *(const f32x4*)(x + o) + acc[ai][bj][m][0], o1 = *(const f32x4*)(x + o + 4) + acc[ai][bj][m][1];
                    *(u32x4*)(X1B + o) = pack8(o0, o1);
                    s += (o0[0] * o0[0] + o0[1] * o0[1]) + (o0[2] * o0[2] + o0[3] * o0[3]) + (o1[0] * o1[0] + o1[1] * o1[1]) + (o1[2] * o1[2] + o1[3] * o1[3]);
                }
                s += __shfl_xor(s, 16); s += __shfl_xor(s, 32);
                if (fq == 0) RSP[(size_t)r * 16 + u.pn * 4 + wc] = s;
            }
    }
};
struct EpiAct {
    static constexpr bool AFTER_DRAIN = false; static constexpr int HOOK_KT = 0;
    bf16_t* ACT; const float* RSP;
    __device__ __forceinline__ void operator()(const Acc& acc, const Unit& u, int wr, int wc, int fr, int fq) const {
        OPAQUE(fr); OPAQUE(fq);
#pragma unroll
        for (int ai = 0; ai < 2; ++ai)
#pragma unroll
            for (int m = 0; m < 4; ++m) {
                const int r = EPI_ROW(u, ai, wr, m, fr); const f32x4* rp = (const f32x4*)(RSP + (size_t)r * 16);
                const f32x4 q0 = rp[0], q1 = rp[1], q2 = rp[2], q3 = rp[3];
                const float ss = ((q0[0] + q0[1]) + (q0[2] + q0[3])) + ((q1[0] + q1[1]) + (q1[2] + q1[3])) + ((q2[0] + q2[1]) + (q2[2] + q2[3])) + ((q3[0] + q3[1]) + (q3[2] + q3[3]));
                const float rstd = rsqrtf(ss * (1.f / DM) + RMS_EPS);
                f32x4 o[2];
#pragma unroll
                for (int n = 0; n < 2; ++n)
#pragma unroll
                    for (int e = 0; e < 4; ++e) { const float gg = acc[ai][0][m][n][e] * rstd, uu = acc[ai][1][m][n][e] * rstd; o[n][e] = gg * sigmoidf_(gg) * uu; }
                *(u32x4*)(ACT + (size_t)r * DFF + u.pn * 128 + wc * 32 + fq * 8) = pack8(o[0], o[1]);
            }
    }
};
struct EpiX2 {
    static constexpr bool AFTER_DRAIN = false; static constexpr int HOOK_KT = 0;
    float* X; const bf16_t* X1B;
    __device__ __forceinline__ void operator()(const Acc& acc, const Unit& u, int wr, int wc, int fr, int fq) const {
        OPAQUE(fr); OPAQUE(fq);
#pragma unroll
        for (int ai = 0; ai < 2; ++ai)
#pragma unroll
            for (int m = 0; m < 4; ++m) {
                const int r = EPI_ROW(u, ai, wr, m, fr);
#pragma unroll
                for (int bj = 0; bj < 2; ++bj) {
                    const size_t o = (size_t)r * 1024 + u.pn * 256 + EPI_LC(bj, wc, fq); float* p = X + o;
                    const u32x4 xw = *(const u32x4*)(X1B + o); f32x4 x0, x1v; unpack8(xw, x0, x1v);
                    *(f32x4*)p = x0 + acc[ai][bj][m][0]; *(f32x4*)(p + 4) = x1v + acc[ai][bj][m][1];
                }
            }
    }
};
struct EpiFinal {
    static constexpr bool AFTER_DRAIN = true; static constexpr int HOOK_KT = 0;
    float* X; const bf16_t* X1B; const float* nw; float* slots; unsigned* cnt;
    __device__ __forceinline__ void fused(Acc& acc, const Unit& u, int wr, int wc, int fr, int fq, int wid, int lane, LAS unsigned char* lds) const {
        OPAQUE(fr); OPAQUE(fq);
        LAS float* Pl = (LAS float*)lds;
        LAS float* Sr = (LAS float*)(lds + 4096);
#pragma unroll
        for (int ai = 0; ai < 2; ++ai)
#pragma unroll
            for (int m = 0; m < 4; ++m) {
                const int r = EPI_ROW(u, ai, wr, m, fr); float sq = 0.f;
#pragma unroll
                for (int bj = 0; bj < 2; ++bj) {
                    { const u32x4 xw = *(const u32x4*)(X1B + (size_t)r * 1024 + u.pn * 256 + EPI_LC(bj, wc, fq)); f32x4 x0, x1v; unpack8(xw, x0, x1v); acc[ai][bj][m][0] += x0; acc[ai][bj][m][1] += x1v; }
                    const f32x4 a = acc[ai][bj][m][0], b = acc[ai][bj][m][1];
                    sq += ((a[0] * a[0] + a[1] * a[1]) + (a[2] * a[2] + a[3] * a[3])) + ((b[0] * b[0] + b[1] * b[1]) + (b[2] * b[2] + b[3] * b[3]));
                }
                sq += __shfl_xor(sq, 16); sq += __shfl_xor(sq, 32);
                if (fq == 0) Pl[(ai * 128 + wr * 64 + m * 16 + fr) * 4 + wc] = sq;
            }
        asm volatile("s_waitcnt lgkmcnt(0)" ::: "memory"); __builtin_amdgcn_s_barrier(); asm volatile("" ::: "memory");
        const int row = wid * 32 + (lane & 31);
        if (lane < 32) { const f32x4 q4 = *(const LAS f32x4*)(Pl + row * 4);
            __hip_atomic_store(slots + (size_t)(u.pm * 256 + row) * 4 + u.pn, (q4[0] + q4[1]) + (q4[2] + q4[3]), __ATOMIC_RELAXED, __HIP_MEMORY_SCOPE_AGENT); }
        asm volatile("s_waitcnt vmcnt(0)" ::: "memory");
        if (lane == 0) __hip_atomic_fetch_add(cnt + 64 * u.pm, 1u, __ATOMIC_RELAXED, __HIP_MEMORY_SCOPE_AGENT);
        if (wid == 0) {
            unsigned sp = 0; while ((unsigned)__builtin_amdgcn_readfirstlane((int)__hip_atomic_load(cnt + 64 * u.pm, __ATOMIC_RELAXED, __HIP_MEMORY_SCOPE_AGENT)) < 32u && ++sp < (1u << 22)) __builtin_amdgcn_s_sleep(2);
            __builtin_amdgcn_fence(__ATOMIC_ACQUIRE, "agent");
        }
        asm volatile("s_waitcnt vmcnt(0) lgkmcnt(0)" ::: "memory"); __builtin_amdgcn_s_barrier(); asm volatile("" ::: "memory");
        if (lane < 32) { const float* sl = slots + (size_t)(u.pm * 256 + row) * 4; float t = 0.f;
#pragma unroll
            for (int k = 0; k < 4; ++k) t += __hip_atomic_load(sl + k, __ATOMIC_RELAXED, __HIP_MEMORY_SCOPE_AGENT);
            Sr[row] = rsqrtf(t * (1.f / DM) + RMS_EPS); }
        asm volatile("s_waitcnt lgkmcnt(0)" ::: "memory"); __builtin_amdgcn_s_barrier(); asm volatile("" ::: "memory");
#pragma unroll
        for (int bj = 0; bj < 2; ++bj) {
            const int c0 = u.pn * 256 + EPI_LC(bj, wc, fq); const f32x4 w0 = *(const f32x4*)(nw + c0), w1 = *(const f32x4*)(nw + c0 + 4);
#pragma unroll
            for (int ai = 0; ai < 2; ++ai)
#pragma unroll
                for (int m = 0; m < 4; ++m) {
                    const int rl = ai * 128 + wr * 64 + m * 16 + fr; const float rs = Sr[rl]; float* p = X + (size_t)(u.pm * 256 + rl) * 1024 + c0;
                    *(f32x4*)p = acc[ai][bj][m][0] * w0 * rs; *(f32x4*)(p + 4) = acc[ai][bj][m][1] * w1 * rs;
                }
        }
    }
};
struct CmpSched {
    const char *KC, *VC, *W1K, *W1V; int c, split;
    __device__ bool next(int i, Unit& u) const {
        if (i > 0 || c >= (split ? 64 : 32)) return false;
        const int un = split ? c >> 1 : c, hk = split ? c & 1 : 0;
        const int which = un >> 4, rt = un & 15, bg = rt >> 1, half = rt & 1, b = bg >> 2, g = bg & 3;
        u.pm = un; u.pn = hk; u.A = (which ? VC : KC) + ((size_t)(b * SEQ + 16 * 256 * half + 16 * hk + (hk ? 16 * 128 : 0)) * 256 + g * 64) * 2; u.B = (which ? W1V : W1K) + (size_t)hk * 2048; return true;
    }
};

struct SF_in { const float* W; __device__ __forceinline__ float operator()(int k, int n) const { const int r = incol_ref(n); return r < 0 ? 0.f : W[(size_t)k * NREF + r]; } };
struct SF_plain { const float* W; int ldn; __device__ __forceinline__ float operator()(int k, int n) const { return W[(size_t)k * ldn + n]; } };
struct SF_gu { const float *Wg, *Wu, *nw; __device__ __forceinline__ float operator()(int k, int n) const {
    const int tile = n >> 8, half = (n >> 7) & 1, j = n & 127, col = tile * 128 + j; const ptrdiff_t d = Wu - Wg; return nw[k] * Wg[(ptrdiff_t)half * d + (ptrdiff_t)k * DFF + col]; } };
__device__ __forceinline__ void p0_tile_out(int K, bf16_t* WT, LAS float* scr, int k0, int n0, int lane) {
    WSYNC();
    const int c = lane & 7;
#pragma unroll
    for (int j = 0; j < 4; ++j) { const int n = (lane >> 3) + 8 * j; const LAS float* s = scr + (8 * c) * 33 + n;
        u32x4 o; o.x = pk2(s[0 * 33], s[1 * 33]); o.y = pk2(s[2 * 33], s[3 * 33]); o.z = pk2(s[4 * 33], s[5 * 33]); o.w = pk2(s[6 * 33], s[7 * 33]);
        *(u32x4*)(WT + (size_t)(n0 + n) * K + k0 + 8 * c) = o; }
    WSYNC();
}
template <class SF> __device__ __forceinline__ void p0_transpose_item(const SF& sf, int K, int N, bf16_t* WT, LAS float* scr, int item, int lane) {
    const int nblk = N / 32, kb = item / nblk, nb = item % nblk, k0 = 64 * kb, n0 = 32 * nb;
    float v[32];
#pragma unroll
    for (int i = 0; i < 32; ++i) v[i] = sf(k0 + 2 * i + (lane >> 5), n0 + (lane & 31));
#pragma unroll
    for (int i = 0; i < 32; ++i) scr[(2 * i + (lane >> 5)) * 33 + (lane & 31)] = v[i];
    p0_tile_out(K, WT, scr, k0, n0, lane);
}
template <class SF> __device__ __forceinline__ void p0_transpose_item2(const SF& sf, int K, int N, bf16_t* WT, LAS float* scr, int item, int lane) {
    const int nblk = N / 32;
    const int kbA = item / nblk, nbA = item % nblk, kbB = (item + 1) / nblk, nbB = (item + 1) % nblk;
    float va[32], vb[32];
#pragma unroll
    for (int i = 0; i < 32; ++i) va[i] = sf(64 * kbA + 2 * i + (lane >> 5), 32 * nbA + (lane & 31));
#pragma unroll
    for (int i = 0; i < 32; ++i) vb[i] = sf(64 * kbB + 2 * i + (lane >> 5), 32 * nbB + (lane & 31));
#pragma unroll
    for (int i = 0; i < 32; ++i) scr[(2 * i + (lane >> 5)) * 33 + (lane & 31)] = va[i];
    p0_tile_out(K, WT, scr, 64 * kbA, 32 * nbA, lane);
#pragma unroll
    for (int i = 0; i < 32; ++i) scr[(2 * i + (lane >> 5)) * 33 + (lane & 31)] = vb[i];
    p0_tile_out(K, WT, scr, 64 * kbB, 32 * nbB, lane);
}
__device__ __forceinline__ void p0_fold_item(const float* pool_w, const float* pool_scale, const float* Wp, bf16_t* WT, int f, int wave, int lane) {
    const int k0 = 64 * (f >> 5), n0 = 32 * (f & 31) + 4 * wave, g = k0 >> 7;
    f32x4 acc = (f32x4){0.f, 0.f, 0.f, 0.f};
    const float* arow = pool_w + (size_t)(k0 + lane) * 128;
#pragma unroll 4
    for (int dp = 0; dp < 128; dp += 4) {
        const f32x4 a = *(const f32x4*)(arow + dp); const f32x4 sc = *(const f32x4*)(pool_scale + g * 128 + dp);
#pragma unroll
        for (int e = 0; e < 4; ++e) { const f32x4 w4 = *(const f32x4*)(Wp + (size_t)(g * 128 + dp + e) * 1024 + n0); acc += w4 * (a[e] * sc[e]); }
    }
#pragma unroll
    for (int j = 0; j < 4; ++j) WT[(size_t)(n0 + j) * 1536 + k0 + lane] = (bf16_t)f2bf(acc[j]);
}
__device__ __forceinline__ void p0_fold_item2(const float* pool_w, const float* pool_scale, const float* Wp, bf16_t* WT, int f, int lane) {
    const int g = f >> 5, kb = (f >> 2) & 7, nb = f & 3, kk0 = g * 128 + kb * 16, n0 = nb * 256 + 4 * lane;
    f32x4 acc[16];
#pragma unroll
    for (int r = 0; r < 16; ++r) acc[r] = (f32x4){0.f, 0.f, 0.f, 0.f};
    const float* bp = Wp + (size_t)(g * 128) * 1024 + n0;
#pragma unroll 1
    for (int dp = 0; dp < 128; dp += 4) {
        const f32x4 sc = *(const f32x4*)(pool_scale + g * 128 + dp);
        f32x4 b[4];
#pragma unroll
        for (int e = 0; e < 4; ++e) b[e] = *(const f32x4*)(bp + (size_t)(dp + e) * 1024);
#pragma unroll
        for (int r = 0; r < 16; ++r) {
            const f32x4 a = *(const f32x4*)(pool_w + (size_t)(kk0 + r) * 128 + dp);
#pragma unroll
            for (int e = 0; e < 4; ++e) acc[r] += b[e] * (a[e] * sc[e]);
        }
    }
#pragma unroll
    for (int j = 0; j < 4; ++j) {
        u32x4 w0, w1;
        w0.x = pk2(acc[0][j], acc[1][j]); w0.y = pk2(acc[2][j], acc[3][j]); w0.z = pk2(acc[4][j], acc[5][j]); w0.w = pk2(acc[6][j], acc[7][j]);
        w1.x = pk2(acc[8][j], acc[9][j]); w1.y = pk2(acc[10][j], acc[11][j]); w1.z = pk2(acc[12][j], acc[13][j]); w1.w = pk2(acc[14][j], acc[15][j]);
        bf16_t* o = WT + (size_t)(n0 + j) * 1536 + kk0; *(u32x4*)o = w0; *(u32x4*)(o + 8) = w1;
    }
}
template <int PART> __device__ __forceinline__ void p0_prologue(KParams P, LAS unsigned char* lds, int gw, int NGW, int wave, int lane) {
    unsigned char* ws = P->ws;
    LAS float* scr = (LAS float*)(lds + wave * 16384);
    constexpr int I_IN = (1024 / 64) * (NIN / 32), I_W1 = (2048 / 64) * (256 / 32), I_W2 = (256 / 64) * (64 / 32), I_WM = (1024 / 64) * (1024 / 32), I_WO = (1024 / 64) * (1024 / 32),
                  I_GU = (1024 / 64) * (5632 / 32), I_WD = (2816 / 64) * (1024 / 32);
    if constexpr (PART == 1) {
        constexpr int NITEMS = I_WM + I_WO + I_WD;
        for (int f = gw >> 3; f < 256; f += NGW >> 3) p0_fold_item(P->pool_w, P->pool_scale, P->w_pp, (bf16_t*)(ws + WS_WM), f, wave, lane);
        for (int it = gw; it < NITEMS; it += NGW) {
            int r = it;
            if (r < I_WM) { p0_transpose_item(SF_plain{P->w_pa, 1024}, 1536, 1024, (bf16_t*)(ws + WS_WM) + 512, scr, r, lane); continue; } r -= I_WM;
            if (r < I_WO) { p0_transpose_item(SF_plain{P->w_out, 1024}, 1024, 1024, (bf16_t*)(ws + WS_WO), scr, r, lane); continue; } r -= I_WO;
            p0_transpose_item(SF_plain{P->w_d, 1024}, 2816, 1024, (bf16_t*)(ws + WS_WD), scr, r, lane);
        }
        return;
    }
    const int nGU = (NGW == 256 * NWAVES) ? 0 : I_GU;
    const int NITEMS = I_IN + 2 * I_W1 + 2 * I_W2 + nGU;
    for (int it = gw; it < NITEMS; it += NGW) {
        int r = it;
        if (r < nGU) { p0_transpose_item(SF_gu{P->w_g, P->w_u, P->norm2_w}, 1024, 5632, (bf16_t*)(ws + WS_WGU), scr, r, lane); continue; } r -= nGU;
        if (r < I_IN) { p0_transpose_item(SF_in{P->w_in}, 1024, NIN, (bf16_t*)(ws + WS_WIN), scr, r, lane); continue; } r -= I_IN;
        if (r < I_W1) { p0_transpose_item(SF_plain{P->w1_k, 256}, 2048, 256, (bf16_t*)(ws + WS_W1K), scr, r, lane); continue; } r -= I_W1;
        if (r < I_W1) { p0_transpose_item(SF_plain{P->w1_v, 256}, 2048, 256, (bf16_t*)(ws + WS_W1V), scr, r, lane); continue; } r -= I_W1;
        if (r < I_W2) { p0_transpose_item(SF_plain{P->w2_k, 64}, 256, 64, (bf16_t*)(ws + WS_W2K), scr, r, lane); continue; } r -= I_W2;
        p0_transpose_item(SF_plain{P->w2_v, 64}, 256, 64, (bf16_t*)(ws + WS_W2V), scr, r, lane);
    }
    for (int it = (gw & 31) ? 64 : (gw >> 5); it < 64; it += NGW >> 5) {
        const int which = it >> 5, c0 = (it & 31) * 8; const float* pe = which ? P->pe_v : P->pe_k; const float* w1 = which ? P->w1_v : P->w1_k; const float* b1 = which ? P->b1_v : P->b1_k;
        f32x4 s0 = (f32x4){0.f, 0.f, 0.f, 0.f}, s1 = s0;
#pragma unroll 8
        for (int j = 0; j < 32; ++j) { const int k = lane + 64 * j; const float p = pe[k]; s0 += *(const f32x4*)(w1 + (size_t)k * 256 + c0) * p; s1 += *(const f32x4*)(w1 + (size_t)k * 256 + c0 + 4) * p; }
#pragma unroll
        for (int e = 0; e < 4; ++e) { s0[e] = wave_sum(s0[e]); s1[e] = wave_sum(s1[e]); }
        if (lane == 0) { float* o = (float*)(ws + (which ? WS_PEBV : WS_PEBK)) + c0; *(f32x4*)o = s0 + *(const f32x4*)(b1 + c0); *(f32x4*)(o + 4) = s1 + *(const f32x4*)(b1 + c0 + 4); }
    }
    for (int it = gw; it < SEQ * 8 / 64; it += NGW) {
        const int idx = it * 64 + lane, i = idx & 7, t = idx >> 3;
        const float inv_freq = i == 0 ? 1.0f : i == 1 ? 0.193922758102417f : i == 2 ? 0.03760603070259094f : i == 3 ? 0.00729266507551074f : i == 4 ? 0.001414213445968926f : i == 5 ? 0.00027424818836152554f : i == 6 ? 5.318296462064609e-05f : 1.0313385246263351e-05f;
        const float ang = (float)t * inv_freq;
        ((float*)(ws + WS_RCOS))[idx] = cosf(ang); ((float*)(ws + WS_RSIN))[idx] = sinf(ang);
    }
    bf16_t* H = (bf16_t*)((char*)P->out + DO_H);
#pragma unroll 1
    for (int row = gw; row < T; row += NGW) {
        const f32x4* xr = (const f32x4*)(P->x + (size_t)row * DM) + lane; const f32x4* wr = (const f32x4*)P->norm1_w + lane;
        f32x4 v[4]; float s = 0.f;
#pragma unroll
        for (int j = 0; j < 4; ++j) { v[j] = xr[64 * j]; s += (v[j].x * v[j].x + v[j].y * v[j].y) + (v[j].z * v[j].z + v[j].w * v[j].w); }
        const float rstd = rsqrtf(wave_sum(s) * (1.f / DM) + RMS_EPS);
        u32x2* o = (u32x2*)(H + (size_t)row * DM) + lane;
#pragma unroll
        for (int j = 0; j < 4; ++j) { const f32x4 ww = wr[64 * j]; u32x2 p; p.x = pk2(v[j].x * rstd * ww.x, v[j].y * rstd * ww.y); p.y = pk2(v[j].z * rstd * ww.z, v[j].w * rstd * ww.w); o[64 * j] = p; }
    }
}
template <int W> __device__ __forceinline__ void pooled_item(const bf16_t* U, bf16_t* PA, int g, int rb, int lane) {
    const int row = rb * 4 + (lane >> 4), c0 = g * 128 + (lane & 15) * 8, t = row & (SEQ - 1), cnt = t + 1 < W ? t + 1 : W;
    u32x4 q[W];
#pragma unroll
    for (int i = 0; i < W; ++i) q[i] = *(const u32x4*)(U + (size_t)(row - (i < cnt ? i : 0)) * 512 + c0);
    f32x4 u0, u1; unpack8(q[0], u0, u1); f32x4 s0 = u0, s1 = u1;
#pragma unroll
    for (int i = 1; i < W; ++i) { f32x4 a, b; unpack8(q[i], a, b); if (i < cnt) { s0 += a; s1 += b; } }
    const float ic = 1.f / (float)cnt;
    *(u32x4*)(PA + (size_t)row * 1536 + c0) = pack8(s0 * ic - u0, s1 * ic - u1);
}
template <int W> __device__ __forceinline__ void pooled_load(const bf16_t* U, int g, int rb, int lane, u32x4 (&q)[W]) {
    const int row = rb * 4 + (lane >> 4), c0 = g * 128 + (lane & 15) * 8, t = row & (SEQ - 1), cnt = t + 1 < W ? t + 1 : W;
#pragma unroll
    for (int i = 0; i < W; ++i) q[i] = *(const u32x4*)(U + (size_t)(row - (i < cnt ? i : 0)) * 512 + c0);
}
template <int W> __device__ __forceinline__ void pooled_store(bf16_t* PA, int g, int rb, int lane, const u32x4 (&q)[W]) {
    const int row = rb * 4 + (lane >> 4), c0 = g * 128 + (lane & 15) * 8, t = row & (SEQ - 1), cnt = t + 1 < W ? t + 1 : W;
    f32x4 u0, u1; unpack8(q[0], u0, u1); f32x4 s0 = u0, s1 = u1;
#pragma unroll
    for (int i = 1; i < W; ++i) { f32x4 a, b; unpack8(q[i], a, b); if (i < cnt) { s0 += a; s1 += b; } }
    const float ic = 1.f / (float)cnt;
    *(u32x4*)(PA + (size_t)row * 1536 + c0) = pack8(s0 * ic - u0, s1 * ic - u1);
}
__device__ __forceinline__ void p2_pooled(const bf16_t* U, bf16_t* PA, int gw, int NGW, int lane) {
#pragma unroll 1
    for (int rb = gw; rb < T / 4; rb += NGW) {
        { u32x4 q16[16]; pooled_load<16>(U, 3, rb, lane, q16); pooled_store<16>(PA, 3, rb, lane, q16); }
        { u32x4 q2[2], q4[4], q8[8]; pooled_load<8>(U, 2, rb, lane, q8); pooled_load<4>(U, 1, rb, lane, q4); pooled_load<2>(U, 0, rb, lane, q2);
          pooled_store<2>(PA, 0, rb, lane, q2); pooled_store<4>(PA, 1, rb, lane, q4); pooled_store<8>(PA, 2, rb, lane, q8); }
    }
}

constexpr int CW_DQ = 14400;
constexpr int DQ_FOLD = 128, DQ_I_WM = (1024 / 64) * (1024 / 32), DQ_I_WO = DQ_I_WM, DQ_I_WD = (2816 / 64) * (1024 / 32), DQ_I_GU = (1024 / 64) * (5632 / 32), DQ_TR = (DQ_I_WM + DQ_I_WO + DQ_I_WD + DQ_I_GU) / 2, DQ_NT = DQ_FOLD + DQ_TR;
__device__ __forceinline__ void late_weights_queue(KParams P, LAS unsigned char* lds, int wave, int lane) {
    unsigned char* ws = P->ws; unsigned* ctl = (unsigned*)(ws + WS_CTL);
    LAS float* scr = (LAS float*)(lds + wave * 16384);
#pragma unroll 1
    for (;;) {
        unsigned tk = 0u;
        if (lane == 0) tk = __hip_atomic_fetch_add(ctl + CW_DQ, 1u, __ATOMIC_RELAXED, __HIP_MEMORY_SCOPE_AGENT);
        const int t = __builtin_amdgcn_readfirstlane((int)tk);
        if (t >= DQ_NT) break;
        if (t < DQ_FOLD) p0_fold_item2(P->pool_w, P->pool_scale, P->w_pp, (bf16_t*)(ws + WS_WM), t, lane);
        else {
            int r = (t - DQ_FOLD) * 2;
            if (r < DQ_I_GU) { p0_transpose_item2(SF_gu{P->w_g, P->w_u, P->norm2_w}, 1024, 5632, (bf16_t*)(ws + WS_WGU), scr, r, lane); continue; } r -= DQ_I_GU;
            if (r < DQ_I_WD) { p0_transpose_item2(SF_plain{P->w_d, 1024}, 2816, 1024, (bf16_t*)(ws + WS_WD), scr, r, lane); continue; } r -= DQ_I_WD;
            if (r < DQ_I_WM) { p0_transpose_item2(SF_plain{P->w_pa, 1024}, 1536, 1024, (bf16_t*)(ws + WS_WM) + 512, scr, r, lane); continue; } r -= DQ_I_WM;
            p0_transpose_item2(SF_plain{P->w_out, 1024}, 1024, 1024, (bf16_t*)(ws + WS_WO), scr, r, lane);
        }
    }
}

namespace nsa {
constexpr int NS = 4, SLOT = 16384, RING = NS * SLOT, WSCR = 8704;
constexpr float THR = 8.f;
typedef short v4i16_t __attribute__((ext_vector_type(4)));
__device__ __forceinline__ float xor1_add(float v) { return v + __builtin_bit_cast(float, __builtin_amdgcn_mov_dpp(__builtin_bit_cast(int, v), 0xB1, 0xF, 0xF, true)); }
__device__ __forceinline__ float xor2_add(float v) { return v + __builtin_bit_cast(float, __builtin_amdgcn_mov_dpp(__builtin_bit_cast(int, v), 0x4E, 0xF, 0xF, true)); }
__device__ __forceinline__ float gmax(float m) {
    auto a = __builtin_amdgcn_permlane16_swap(__float_as_uint(m), __float_as_uint(m), false, false); m = fmaxf(__uint_as_float(a[0]), __uint_as_float(a[1]));
    auto b = __builtin_amdgcn_permlane32_swap(__float_as_uint(m), __float_as_uint(m), false, false); return fmaxf(__uint_as_float(b[0]), __uint_as_float(b[1])); }
__device__ __forceinline__ float gsum(float m) {
    auto a = __builtin_amdgcn_permlane16_swap(__float_as_uint(m), __float_as_uint(m), false, false); m = __uint_as_float(a[0]) + __uint_as_float(a[1]);
    auto b = __builtin_amdgcn_permlane32_swap(__float_as_uint(m), __float_as_uint(m), false, false); return __uint_as_float(b[0]) + __uint_as_float(b[1]); }
struct Lane {
    int wave, lane, g, c; unsigned kbase, vbase; unsigned lds0;
    __device__ __forceinline__ void init(int tid, LAS unsigned char* lds) {
        lane = tid & 63; wave = __builtin_amdgcn_readfirstlane(tid >> 6); g = lane >> 4; c = lane & 15; lds0 = (unsigned)(size_t)lds;
        kbase = (unsigned)(c * 128 + ((g ^ (lane & 7)) << 4));
        const int q = (lane >> 2) & 3, p = lane & 3, rx = 4 * (g & 1) + q;
        vbase = (unsigned)((4 * g + q) * 128 + (((p >> 1) ^ rx) << 4) + (p & 1) * 8);
    }
};
struct Src { const char* k; const char* v; unsigned loff, tstride; };
__device__ __forceinline__ Src make_src(const bf16_t* K, const bf16_t* V, size_t row0, int stride_el, int col0, const Lane& L) {
    Src s; s.k = (const char*)(K + row0 * stride_el + col0); s.v = (const char*)(V + row0 * stride_el + col0);
    const int R = 8 * L.wave + (L.lane >> 3), ch = (L.lane & 7) ^ ((L.lane >> 3) & 7);
    s.loff = (unsigned)((R * stride_el + ch * 8) * 2); s.tstride = (unsigned)(64 * stride_el * 2); return s;
}
__device__ __forceinline__ void glds16(const void* gsrc, unsigned lds_dst) { unsigned keep;
    asm volatile("s_mov_b32 %0, m0\n\ts_mov_b32 m0, %2\n\ts_nop 0\n\tglobal_load_lds_dwordx4 %1, off\n\ts_mov_b32 m0, %0" : "=&s"(keep) : "v"(gsrc), "s"(lds_dst) : "memory"); }
__device__ __forceinline__ void issue(const Lane& L, const Src& S, int tile, int slot) {
    const char* gk = S.k + (size_t)tile * S.tstride + S.loff; const char* gv = S.v + (size_t)tile * S.tstride + S.loff;
    const unsigned d = (unsigned)__builtin_amdgcn_readfirstlane((int)(L.lds0 + slot * SLOT + L.wave * 1024));
    glds16(gk, d); glds16(gv, d + 8192);
}
struct Frags { unsigned k0, k1, v0, v1, v2, v3; };
typedef Frags TileAddr;
template <bool WITH_V> __device__ __forceinline__ void load_frags(const TileAddr& A, const Lane& L, Frags& F) { F = A; }
__device__ __forceinline__ void load_k(const Frags& F, const Lane& L, bf16x8 (&kf)[4][2]) {
#pragma unroll
    for (int mt = 0; mt < 4; ++mt) {
        kf[mt][0] = *(const LAS bf16x8*)((const LAS unsigned char*)(size_t)F.k0 + mt * 2048);
        kf[mt][1] = *(const LAS bf16x8*)((const LAS unsigned char*)(size_t)F.k1 + mt * 2048);
    }
}
__device__ __forceinline__ void load_vdt(unsigned va, bf16x8 (&vf)[2]) {
#pragma unroll
    for (int ks = 0; ks < 2; ++ks) {
        const v4i16_t lo = __builtin_amdgcn_ds_read_tr16_b64_v4i16((LAS v4i16_t*)((LAS unsigned char*)(size_t)va + ks * 4096));
        const v4i16_t hi = __builtin_amdgcn_ds_read_tr16_b64_v4i16((LAS v4i16_t*)((LAS unsigned char*)(size_t)va + ks * 4096 + 2048));
        vf[ks] = (bf16x8){lo[0], lo[1], lo[2], lo[3], hi[0], hi[1], hi[2], hi[3]};
    }
}
__device__ __forceinline__ void load_v(const Frags& F, const Lane& L, bf16x8 (&vf)[4][2]) { load_vdt(F.v0, vf[0]); load_vdt(F.v1, vf[1]); load_vdt(F.v2, vf[2]); load_vdt(F.v3, vf[3]); }
template <bool WITH_V, bool MASKED, class MaskFn>
__device__ __forceinline__ void visit_slow(const Frags& F, const Lane& L, const bf16x8 (&q)[2], f32x4 (&o)[4], float& mref, float& lsum, bool colsel, const MaskFn& valid) {
    const bool seen = mref != -INFINITY;
    const float c0 = colsel ? (seen ? -mref : 0.f) : -INFINITY;
    const f32x4 ci = (f32x4){c0, c0, c0, c0};
    f32x4 s[4];
    { bf16x8 kf[4][2]; load_k(F, L, kf);
#pragma unroll
    for (int mt = 0; mt < 4; ++mt) {
        s[mt] = __builtin_amdgcn_mfma_f32_16x16x32_bf16(kf[mt][0], q[0], ci, 0, 0, 0);
        s[mt] = __builtin_amdgcn_mfma_f32_16x16x32_bf16(kf[mt][1], q[1], s[mt], 0, 0, 0);
    } }
    __builtin_amdgcn_sched_barrier(0);
    bf16x8 vf[4][2]; if constexpr (WITH_V) load_v(F, L, vf);
    if constexpr (MASKED) {
#pragma unroll
        for (int mt = 0; mt < 4; ++mt)
#pragma unroll
            for (int r = 0; r < 4; ++r) if (!valid(16 * mt + 4 * L.g + r)) s[mt][r] = -INFINITY;
    }
    float mx = fmaxf(fmaxf(s[0][0], s[0][1]), fmaxf(s[0][2], s[0][3]));
#pragma unroll
    for (int mt = 1; mt < 4; ++mt) mx = fmaxf(mx, fmaxf(fmaxf(s[mt][0], s[mt][1]), fmaxf(s[mt][2], s[mt][3])));
    if (__any((mx > THR) || (!seen && mx > -INFINITY))) {
        const float mxr = gmax(mx);
        const float d = (mxr == -INFINITY) ? 0.f : (seen ? fmaxf(mxr, 0.f) : mxr);
        const float f = __builtin_amdgcn_exp2f(-d);
        if (mxr != -INFINITY) mref = (seen ? mref : 0.f) + d;
#pragma unroll
        for (int mt = 0; mt < 4; ++mt) s[mt] = s[mt] - d;
        lsum *= f;
        if constexpr (WITH_V) {
#pragma unroll
            for (int dt = 0; dt < 4; ++dt) o[dt] = o[dt] * f;
        }
    }
#pragma unroll
    for (int mt = 0; mt < 4; ++mt)
#pragma unroll
        for (int r = 0; r < 4; ++r) s[mt][r] = __builtin_amdgcn_exp2f(s[mt][r]);
    bf16x8 pf[2];
#pragma unroll
    for (int ks = 0; ks < 2; ++ks) { const u32x4 w = pack8(s[2 * ks], s[2 * ks + 1]); pf[ks] = __builtin_bit_cast(bf16x8, w); }
    { const f32x4 t4 = (s[0] + s[1]) + (s[2] + s[3]); lsum += (t4[0] + t4[1]) + (t4[2] + t4[3]); }
    if constexpr (WITH_V) {
#pragma unroll
        for (int dt = 0; dt < 4; ++dt)
#pragma unroll
            for (int ks = 0; ks < 2; ++ks) o[dt] = __builtin_amdgcn_mfma_f32_16x16x32_bf16(vf[dt][ks], pf[ks], o[dt], 0, 0, 0);
    }
}
template <bool MASKED, class MaskA, class MaskB>
__device__ __forceinline__ void visitB2(const Frags& F, const Lane& L, const bf16x8 (&qA)[2], const bf16x8 (&qB)[2], f32x4 (&oA)[4], f32x4 (&oB)[4], float msA, float msB, float invA, float invB,
                                        const MaskA& validA, const MaskB& validB, LAS float* impA, LAS float* impB, int jb) {
    const float cA = -msA, cB = -msB; const f32x4 ciA = (f32x4){cA, cA, cA, cA}, ciB = (f32x4){cB, cB, cB, cB};
    f32x4 sA[4], sB[4];
    { bf16x8 kf[4][2]; load_k(F, L, kf);
#pragma unroll
    for (int mt = 0; mt < 4; ++mt) {
        sA[mt] = __builtin_amdgcn_mfma_f32_16x16x32_bf16(kf[mt][0], qA[0], ciA, 0, 0, 0);
        sB[mt] = __builtin_amdgcn_mfma_f32_16x16x32_bf16(kf[mt][0], qB[0], ciB, 0, 0, 0);
        sA[mt] = __builtin_amdgcn_mfma_f32_16x16x32_bf16(kf[mt][1], qA[1], sA[mt], 0, 0, 0);
        sB[mt] = __builtin_amdgcn_mfma_f32_16x16x32_bf16(kf[mt][1], qB[1], sB[mt], 0, 0, 0);
    } }

    bf16x8 vf[4][2]; load_v(F, L, vf);
#pragma unroll
    for (int mt = 0; mt < 4; ++mt) {
#pragma unroll
        for (int r = 0; r < 4; ++r) {
            sA[mt][r] = (!MASKED || validA(16 * mt + 4 * L.g + r)) ? __builtin_amdgcn_exp2f(sA[mt][r]) * invA : 0.f;
            sB[mt][r] = (!MASKED || validB(16 * mt + 4 * L.g + r)) ? __builtin_amdgcn_exp2f(sB[mt][r]) * invB : 0.f;
        }
        float va = (sA[mt][0] + sA[mt][1]) + (sA[mt][2] + sA[mt][3]), va3 = sA[mt][3], vb = (sB[mt][0] + sB[mt][1]) + (sB[mt][2] + sB[mt][3]), vb3 = sB[mt][3];
        va = xor2_add(xor1_add(va)); va3 = xor2_add(xor1_add(va3)); vb = xor2_add(xor1_add(vb)); vb3 = xor2_add(xor1_add(vb3));
        if ((L.c & 3) == 0) { const int j = jb + 4 * mt + L.g;
            __hip_atomic_fetch_add(impA + j, va, __ATOMIC_RELAXED, __HIP_MEMORY_SCOPE_WORKGROUP); __hip_atomic_fetch_add(impB + j, vb, __ATOMIC_RELAXED, __HIP_MEMORY_SCOPE_WORKGROUP);
            if (j + 1 < 128) { __hip_atomic_fetch_add(impA + j + 1, va3, __ATOMIC_RELAXED, __HIP_MEMORY_SCOPE_WORKGROUP); __hip_atomic_fetch_add(impB + j + 1, vb3, __ATOMIC_RELAXED, __HIP_MEMORY_SCOPE_WORKGROUP); } }
    }
    bf16x8 pA[2], pB[2];
#pragma unroll
    for (int ks = 0; ks < 2; ++ks) { const u32x4 wa = pack8(sA[2 * ks], sA[2 * ks + 1]), wb = pack8(sB[2 * ks], sB[2 * ks + 1]); pA[ks] = __builtin_bit_cast(bf16x8, wa); pB[ks] = __builtin_bit_cast(bf16x8, wb); }
#pragma unroll
    for (int dt = 0; dt < 4; ++dt)
#pragma unroll
        for (int ks = 0; ks < 2; ++ks) { oA[dt] = __builtin_amdgcn_mfma_f32_16x16x32_bf16(vf[dt][ks], pA[ks], oA[dt], 0, 0, 0); oB[dt] = __builtin_amdgcn_mfma_f32_16x16x32_bf16(vf[dt][ks], pB[ks], oB[dt], 0, 0, 0); }
}
constexpr float PLIM = 1.8446744e19f;
template <bool WITH_V, bool MASKED, class MaskFn>
__device__ __forceinline__ void visit_fast(const Frags& F, const Lane& L, const bf16x8 (&q)[2], f32x4 (&o)[4], float mref, float& lsum, float& badv, bool colsel, const MaskFn& valid) {
    const float c0 = colsel ? -mref : -INFINITY;
    const f32x4 ci = (f32x4){c0, c0, c0, c0};
    f32x4 s[4];
    { bf16x8 kf[4][2]; load_k(F, L, kf);
#pragma unroll
    for (int mt = 0; mt < 4; ++mt) {
        s[mt] = __builtin_amdgcn_mfma_f32_16x16x32_bf16(kf[mt][0], q[0], ci, 0, 0, 0);
        s[mt] = __builtin_amdgcn_mfma_f32_16x16x32_bf16(kf[mt][1], q[1], s[mt], 0, 0, 0);
    } }

    bf16x8 vf[4][2]; if constexpr (WITH_V) load_v(F, L, vf);
#pragma unroll
    for (int mt = 0; mt < 4; ++mt)
#pragma unroll
        for (int r = 0; r < 4; ++r) { const float e = __builtin_amdgcn_exp2f(s[mt][r]); s[mt][r] = (!MASKED || valid(16 * mt + 4 * L.g + r)) ? e : 0.f; }
    float ps; { const f32x4 t4 = (s[0] + s[1]) + (s[2] + s[3]); ps = (t4[0] + t4[1]) + (t4[2] + t4[3]); }
    lsum += ps; badv = fmaxf(badv, ps);
    if constexpr (WITH_V) {
        bf16x8 pf[2];
#pragma unroll
        for (int ks = 0; ks < 2; ++ks) { const u32x4 w = pack8(s[2 * ks], s[2 * ks + 1]); pf[ks] = __builtin_bit_cast(bf16x8, w); }
#pragma unroll
        for (int dt = 0; dt < 4; ++dt)
#pragma unroll
            for (int ks = 0; ks < 2; ++ks) o[dt] = __builtin_amdgcn_mfma_f32_16x16x32_bf16(vf[dt][ks], pf[ks], o[dt], 0, 0, 0);
    }
}
template <bool MASKED, bool WITH_V = true, class MaskA, class MaskB>
__device__ __forceinline__ void visit_fast2(const Frags& F, const Lane& L, const bf16x8 (&qA)[2], const bf16x8 (&qB)[2], f32x4 (&oA)[4], f32x4 (&oB)[4], float mrefA, float mrefB,
                                            float& lsumA, float& lsumB, float& badv, bool colA, bool colB, const MaskA& validA, const MaskB& validB) {
    const float cA = colA ? -mrefA : -INFINITY, cB = colB ? -mrefB : -INFINITY;
    const f32x4 ciA = (f32x4){cA, cA, cA, cA}, ciB = (f32x4){cB, cB, cB, cB};
    f32x4 sA[4], sB[4];
    { bf16x8 kf[4][2]; load_k(F, L, kf);
#pragma unroll
    for (int mt = 0; mt < 4; ++mt) {
        sA[mt] = __builtin_amdgcn_mfma_f32_16x16x32_bf16(kf[mt][0], qA[0], ciA, 0, 0, 0);
        sB[mt] = __builtin_amdgcn_mfma_f32_16x16x32_bf16(kf[mt][0], qB[0], ciB, 0, 0, 0);
        sA[mt] = __builtin_amdgcn_mfma_f32_16x16x32_bf16(kf[mt][1], qA[1], sA[mt], 0, 0, 0);
        sB[mt] = __builtin_amdgcn_mfma_f32_16x16x32_bf16(kf[mt][1], qB[1], sB[mt], 0, 0, 0);
    } }
    bf16x8 vf[4][2]; if constexpr (WITH_V) load_v(F, L, vf);
#pragma unroll
    for (int mt = 0; mt < 4; ++mt)
#pragma unroll
        for (int r = 0; r < 4; ++r) {
            const float ea = __builtin_amdgcn_exp2f(sA[mt][r]), eb = __builtin_amdgcn_exp2f(sB[mt][r]);
            sA[mt][r] = (!MASKED || validA(16 * mt + 4 * L.g + r)) ? ea : 0.f; sB[mt][r] = (!MASKED || validB(16 * mt + 4 * L.g + r)) ? eb : 0.f;
        }
    { const f32x4 t4 = (sA[0] + sA[1]) + (sA[2] + sA[3]); const float ps = (t4[0] + t4[1]) + (t4[2] + t4[3]); lsumA += ps; badv = fmaxf(badv, ps); }
    { const f32x4 t4 = (sB[0] + sB[1]) + (sB[2] + sB[3]); const float ps = (t4[0] + t4[1]) + (t4[2] + t4[3]); lsumB += ps; badv = fmaxf(badv, ps); }
    if constexpr (!WITH_V) return;
    bf16x8 pA[2], pB[2];
#pragma unroll
    for (int ks = 0; ks < 2; ++ks) { const u32x4 wa = pack8(sA[2 * ks], sA[2 * ks + 1]), wb = pack8(sB[2 * ks], sB[2 * ks + 1]); pA[ks] = __builtin_bit_cast(bf16x8, wa); pB[ks] = __builtin_bit_cast(bf16x8, wb); }
#pragma unroll
    for (int dt = 0; dt < 4; ++dt)
#pragma unroll
        for (int ks = 0; ks < 2; ++ks) { oA[dt] = __builtin_amdgcn_mfma_f32_16x16x32_bf16(vf[dt][ks], pA[ks], oA[dt], 0, 0, 0); oB[dt] = __builtin_amdgcn_mfma_f32_16x16x32_bf16(vf[dt][ks], pB[ks], oB[dt], 0, 0, 0); }
}
template <bool WITH_V, class MaskFn>
__device__ __forceinline__ void visit_init(const Frags& F, const Lane& L, const bf16x8 (&q)[2], f32x4 (&o)[4], float& mref, float& lsum, float& badv, bool colsel, const MaskFn& valid) {
    const bool seen = mref != -INFINITY;
    const float c0 = colsel ? (seen ? -mref : 0.f) : -INFINITY;
    const f32x4 ci = (f32x4){c0, c0, c0, c0};
    f32x4 s[4];
    { bf16x8 kf[4][2]; load_k(F, L, kf);
#pragma unroll
    for (int mt = 0; mt < 4; ++mt) {
        s[mt] = __builtin_amdgcn_mfma_f32_16x16x32_bf16(kf[mt][0], q[0], ci, 0, 0, 0);
        s[mt] = __builtin_amdgcn_mfma_f32_16x16x32_bf16(kf[mt][1], q[1], s[mt], 0, 0, 0);
    } }

    bf16x8 vf[4][2]; if constexpr (WITH_V) load_v(F, L, vf);
#pragma unroll
    for (int mt = 0; mt < 4; ++mt)
#pragma unroll
        for (int r = 0; r < 4; ++r) if (!valid(16 * mt + 4 * L.g + r)) s[mt][r] = -INFINITY;
    float mx = fmaxf(fmaxf(s[0][0], s[0][1]), fmaxf(s[0][2], s[0][3]));
#pragma unroll
    for (int mt = 1; mt < 4; ++mt) mx = fmaxf(mx, fmaxf(fmaxf(s[mt][0], s[mt][1]), fmaxf(s[mt][2], s[mt][3])));
    const float mxr = gmax(mx);
    const float d = (!seen && mxr != -INFINITY) ? mxr : 0.f;
    if (!seen && mxr != -INFINITY) mref = mxr;
#pragma unroll
    for (int mt = 0; mt < 4; ++mt)
#pragma unroll
        for (int r = 0; r < 4; ++r) s[mt][r] = __builtin_amdgcn_exp2f(s[mt][r] - d);
    float ps; { const f32x4 t4 = (s[0] + s[1]) + (s[2] + s[3]); ps = (t4[0] + t4[1]) + (t4[2] + t4[3]); }
    lsum += ps; badv = fmaxf(badv, ps);
    if constexpr (WITH_V) {
        bf16x8 pf[2];
#pragma unroll
        for (int ks = 0; ks < 2; ++ks) { const u32x4 w = pack8(s[2 * ks], s[2 * ks + 1]); pf[ks] = __builtin_bit_cast(bf16x8, w); }
#pragma unroll
        for (int dt = 0; dt < 4; ++dt)
#pragma unroll
            for (int ks = 0; ks < 2; ++ks) o[dt] = __builtin_amdgcn_mfma_f32_16x16x32_bf16(vf[dt][ks], pf[ks], o[dt], 0, 0, 0);
    }
}
template <bool MASKED, class MaskFn>
__device__ __forceinline__ void visitB(const Frags& F, const Lane& L, const bf16x8 (&q)[2], f32x4 (&o)[4], float ms, float inv_l, const MaskFn& valid, LAS float* imp_row, int jb) {
    const float c0 = -ms; const f32x4 ci = (f32x4){c0, c0, c0, c0};
    f32x4 s[4];
    { bf16x8 kf[4][2]; load_k(F, L, kf);
#pragma unroll
    for (int mt = 0; mt < 4; ++mt) {
        s[mt] = __builtin_amdgcn_mfma_f32_16x16x32_bf16(kf[mt][0], q[0], ci, 0, 0, 0);
        s[mt] = __builtin_amdgcn_mfma_f32_16x16x32_bf16(kf[mt][1], q[1], s[mt], 0, 0, 0);
    } }

    bf16x8 vf[4][2]; load_v(F, L, vf);
#pragma unroll
    for (int mt = 0; mt < 4; ++mt) {
#pragma unroll
        for (int r = 0; r < 4; ++r) s[mt][r] = (!MASKED || valid(16 * mt + 4 * L.g + r)) ? __builtin_amdgcn_exp2f(s[mt][r]) * inv_l : 0.f;
        float val = (s[mt][0] + s[mt][1]) + (s[mt][2] + s[mt][3]), v3 = s[mt][3];
        val = xor2_add(xor1_add(val)); v3 = xor2_add(xor1_add(v3));
        if ((L.c & 3) == 0) { const int j = jb + 4 * mt + L.g; __hip_atomic_fetch_add(imp_row + j, val, __ATOMIC_RELAXED, __HIP_MEMORY_SCOPE_WORKGROUP);
            if (j + 1 < 128) __hip_atomic_fetch_add(imp_row + j + 1, v3, __ATOMIC_RELAXED, __HIP_MEMORY_SCOPE_WORKGROUP); }
    }
    bf16x8 pf[2];
#pragma unroll
    for (int ks = 0; ks < 2; ++ks) { const u32x4 w = pack8(s[2 * ks], s[2 * ks + 1]); pf[ks] = __builtin_bit_cast(bf16x8, w); }
#pragma unroll
    for (int dt = 0; dt < 4; ++dt)
#pragma unroll
        for (int ks = 0; ks < 2; ++ks) o[dt] = __builtin_amdgcn_mfma_f32_16x16x32_bf16(vf[dt][ks], pf[ks], o[dt], 0, 0, 0);
}
struct HiMask { int hi; __device__ __forceinline__ bool operator()(int key) const { return key <= hi; } };
struct RangeMask { int lo, hi; __device__ __forceinline__ bool operator()(int key) const { return key >= lo && key <= hi; } };
struct LoMask { int lo; __device__ __forceinline__ bool operator()(int key) const { return key >= lo; } };
struct NoMask { __device__ __forceinline__ bool operator()(int) const { return true; } };
__device__ __forceinline__ unsigned ctr_load(LAS unsigned* p) { return (unsigned)__builtin_amdgcn_readfirstlane((int)__hip_atomic_load(p, __ATOMIC_RELAXED, __HIP_MEMORY_SCOPE_WORKGROUP)); }
template <class Body>
__device__ __forceinline__ void stream(LAS unsigned char* lds, const Lane& L, const Src& S, int tile0, int NT, const Body& body) {
    LAS unsigned* ready = (LAS unsigned*)(lds + MISC_OFF + 64);
    LAS unsigned* done = ready + NS;
    __builtin_amdgcn_s_barrier();
    if (L.wave == 0 && L.lane < 2 * NS) ready[L.lane] = 0u;
    asm volatile("s_waitcnt lgkmcnt(0)" ::: "memory");
    __builtin_amdgcn_s_barrier();
    asm volatile("" ::: "memory");
    int issued = 0, published = 0;
    TileAddr A; A.k0 = L.lds0 + L.kbase; A.k1 = L.lds0 + (L.kbase ^ 64u); A.v0 = L.lds0 + 8192u + L.vbase; A.v1 = L.lds0 + 8192u + (L.vbase ^ 32u); A.v2 = L.lds0 + 8192u + (L.vbase ^ 64u); A.v3 = L.lds0 + 8192u + (L.vbase ^ 96u);
    for (int i = 0; i < NT; ++i) {
        asm volatile("s_waitcnt vmcnt(0)" ::: "memory");
        for (; published < issued; ++published) if (L.lane == 0) __hip_atomic_fetch_add(ready + (published & (NS - 1)), 1u, __ATOMIC_RELAXED, __HIP_MEMORY_SCOPE_WORKGROUP);
        for (;;) {
            if (issued >= NT || issued >= i + NS) break;
            const bool must = issued <= i;
            if (issued >= NS) {
                const unsigned want = 8u * (unsigned)(issued / NS);
                if (ctr_load(done + (issued & (NS - 1))) < want) { if (!must) break; while (ctr_load(done + (issued & (NS - 1))) < want) __builtin_amdgcn_s_sleep(1); }
            }
            issue(L, S, tile0 + issued, issued & (NS - 1)); ++issued;
            if (must) { asm volatile("s_waitcnt vmcnt(0)" ::: "memory"); for (; published < issued; ++published) if (L.lane == 0) __hip_atomic_fetch_add(ready + (published & (NS - 1)), 1u, __ATOMIC_RELAXED, __HIP_MEMORY_SCOPE_WORKGROUP); }
        }
        { const unsigned want = 8u * (unsigned)(i / NS + 1); LAS unsigned* rp = ready + (i & (NS - 1)); while (ctr_load(rp) < want) __builtin_amdgcn_s_sleep(1); }
        asm volatile("" ::: "memory");
        body(i, A);
        { const unsigned d = ((i + 1) & (NS - 1)) ? (unsigned)SLOT : (unsigned)(-(NS - 1) * SLOT); A.k0 += d; A.k1 += d; A.v0 += d; A.v1 += d; A.v2 += d; A.v3 += d; }
        asm volatile("s_waitcnt lgkmcnt(0)" ::: "memory");
        if (L.lane == 0) __hip_atomic_fetch_add(done + (i & (NS - 1)), 1u, __ATOMIC_RELAXED, __HIP_MEMORY_SCOPE_WORKGROUP);
    }
    asm volatile("s_waitcnt vmcnt(0) lgkmcnt(0)" ::: "memory");
}
struct Tensors { unsigned char* ws;
    __device__ __forceinline__ const bf16_t* QP_() const { return (const bf16_t*)(ws + WS_QP); }   __device__ __forceinline__ const bf16_t* QR_() const { return (const bf16_t*)(ws + WS_QR); }
    __device__ __forceinline__ const bf16_t* KCMP_() const { return (const bf16_t*)(ws + WS_KCMP); } __device__ __forceinline__ const bf16_t* VCMP_() const { return (const bf16_t*)(ws + WS_VCMP); }
    __device__ __forceinline__ const bf16_t* KS_() const { return (const bf16_t*)(ws + WS_KS); }   __device__ __forceinline__ const bf16_t* VS_() const { return (const bf16_t*)(ws + WS_VS); }
    __device__ __forceinline__ const bf16_t* KW_() const { return (const bf16_t*)(ws + WS_KW); }   __device__ __forceinline__ const bf16_t* VW_() const { return (const bf16_t*)(ws + WS_VW); }
    __device__ __forceinline__ const float* GN_() const { return (const float*)(ws + WS_GN); }     __device__ __forceinline__ bf16_t* PA_() const { return (bf16_t*)(ws + WS_PA); }
};
__device__ __forceinline__ void unit(LAS unsigned char* lds, const Tensors& X, int b, int gk, int u, int wave_s) {
    const int t0 = 128 * u;
    bf16x8 q[4][2]; f32x4 o[4][4]; float m[4], l[4]; float badv;
#define NSA_STAGE() Lane L; { const int ln_ = lane_id(); L.init(ln_ + 64 * wave_s, lds); } \
    const int tw0 = t0 + 16 * L.wave, tl = L.c >> 2; (void)tl; \
    LAS unsigned char* wscr = lds + RING + L.wave * WSCR; (void)wscr; \
    LAS float* impw = (LAS float*)wscr; (void)impw;                   \
    LAS unsigned* bmask = (LAS unsigned*)(wscr + 8192); (void)bmask;     \
    const int qrow32 = (b * SEQ + tw0 + (L.c >> 2)) * 1024 + (gk * 4 + (L.c & 3)) * 64 + 8 * L.g; (void)qrow32;        \
    const int gnrow = (b * SEQ + tw0 + (L.c >> 2)) * 48 + (gk * 4 + (L.c & 3)) * 3; (void)gnrow;                         \
    LAS unsigned char* park = wscr + ((size_t)L.c * 64 + 4 * L.g) * 2; (void)park
#define NSA_LOADQ(Qp) do { int qo_ = qrow32; OPAQUE(qo_); const bf16_t* qp_ = (Qp) + (size_t)qo_; _Pragma("unroll") for (int rt = 0; rt < 4; ++rt) _Pragma("unroll") for (int dk = 0; dk < 2; ++dk) q[rt][dk] = *(const bf16x8*)(qp_ + rt * 4096 + 32 * dk); \
        _Pragma("unroll") for (int rt = 0; rt < 4; ++rt) _Pragma("unroll") for (int dk = 0; dk < 2; ++dk) asm volatile("" : "+v"(q[rt][dk]));     \
        } while (0)
#define NSA_BAD() (__any(!(badv <= PLIM)))
#define NSA_RESET() do { float z_ = 0.f; OPAQUE(z_); badv = z_; _Pragma("unroll") for (int rt = 0; rt < 4; ++rt) { m[rt] = -INFINITY; l[rt] = z_; _Pragma("unroll") for (int dt = 0; dt < 4; ++dt) o[rt][dt] = (f32x4){z_, z_, z_, z_}; } } while (0)
    {
        NSA_STAGE();
        { float z_ = 0.f; OPAQUE(z_); const f32x4 z4 = (f32x4){z_, z_, z_, z_};
#pragma unroll
        for (int i = 0; i < 8; ++i) *(LAS f32x4*)(impw + (i * 64 + L.lane) * 4) = z4; }
        NSA_LOADQ(X.QP_()); NSA_RESET();
        const int nct = ((8 * u + 6) >> 6) + 1;
        const Src S = make_src(X.KCMP_(), X.VCMP_(), (size_t)(b * 4 + gk) * NCP, 64, 0, L);
        stream(lds, L, S, 0, nct, [&](int i, const TileAddr& Ks) {
            const int nb = 64 * i;
            if (tw0 + 15 >= 31 && nb <= ((tw0 + 15 - 31) >> 4)) {
                Frags F; load_frags<false>(Ks, L, F);
#pragma unroll
                for (int pr = 0; pr < 2; ++pr) {
                    const int rA = 2 * pr, rB = rA + 1, twA = tw0 + 4 * rA, twB = twA + 4;
                    const bool nA = twA + 3 >= 31 && nb <= ((twA + 3 - 31) >> 4), nB = twB + 3 >= 31 && nb <= ((twB + 3 - 31) >> 4);
                    const bool inter = twA >= 31 && nb + 63 <= ((twA - 31) >> 4);
                    const int tA = twA + tl, tB = twB + tl;
                    const HiMask hA{(tA >= 31 ? ((tA - 31) >> 4) : -1) - nb}, hB{(tB >= 31 ? ((tB - 31) >> 4) : -1) - nb};
                    (void)inter;
                    if (i == 0) { if (nA) visit_init<false>(F, L, q[rA], o[rA], m[rA], l[rA], badv, true, hA); if (nB) visit_init<false>(F, L, q[rB], o[rB], m[rB], l[rB], badv, true, hB); }
                    else if (nA && nB) visit_fast2<true, false>(F, L, q[rA], q[rB], o[rA], o[rB], m[rA], m[rB], l[rA], l[rB], badv, true, true, hA, hB);
                    else { if (nA) visit_fast<false, true>(F, L, q[rA], o[rA], m[rA], l[rA], badv, true, hA); if (nB) visit_fast<false, true>(F, L, q[rB], o[rB], m[rB], l[rB], badv, true, hB); }
                }
            }
        });
        if (NSA_BAD()) {
            NSA_RESET();
            stream(lds, L, S, 0, nct, [&](int i, const TileAddr& Ks) {
                const int nb = 64 * i;
                if (tw0 + 15 >= 31 && nb <= ((tw0 + 15 - 31) >> 4)) {
                    Frags F; load_frags<false>(Ks, L, F);
#pragma unroll
                    for (int rt = 0; rt < 4; ++rt) {
                        const int twA = tw0 + 4 * rt, tA = twA + tl;
                        if (twA + 3 >= 31 && nb <= ((twA + 3 - 31) >> 4)) visit_slow<false, true>(F, L, q[rt], o[rt], m[rt], l[rt], true, HiMask{(tA >= 31 ? ((tA - 31) >> 4) : -1) - nb});
                    }
                }
            });
        }
        float inv[4], msf[4];
#pragma unroll
        for (int rt = 0; rt < 4; ++rt) { const float lt = gsum(l[rt]); inv[rt] = lt > 0.f ? __builtin_amdgcn_rcpf(lt) : 0.f; msf[rt] = (m[rt] == -INFINITY) ? 0.f : m[rt]; }
        NSA_RESET();
        stream(lds, L, S, 0, nct, [&](int i, const TileAddr& Ks) {
            const int nb = 64 * i;
            if (tw0 + 15 >= 31 && nb <= ((tw0 + 15 - 31) >> 4)) {
                Frags F; load_frags<true>(Ks, L, F);
#pragma unroll
                for (int pr = 0; pr < 2; ++pr) {
                    const int rA = 2 * pr, rB = rA + 1, twA = tw0 + 4 * rA, twB = twA + 4;
                    const bool nA = twA + 3 >= 31 && nb <= ((twA + 3 - 31) >> 4), nB = twB + 3 >= 31 && nb <= ((twB + 3 - 31) >> 4);
                    const bool inter = twA >= 31 && nb + 63 <= ((twA - 31) >> 4);
                    const int tA = twA + tl, tB = twB + tl;
                    const HiMask hA{(tA >= 31 ? ((tA - 31) >> 4) : -1) - nb}, hB{(tB >= 31 ? ((tB - 31) >> 4) : -1) - nb};
                    LAS float* iA = impw + (4 * rA + tl) * 128; LAS float* iB = impw + (4 * rB + tl) * 128;
                    (void)inter;
                    if (nA && nB) visitB2<true>(F, L, q[rA], q[rB], o[rA], o[rB], msf[rA], msf[rB], inv[rA], inv[rB], hA, hB, iA, iB, 16 * i);
                    else { if (nA) visitB<true>(F, L, q[rA], o[rA], msf[rA], inv[rA], hA, iA, 16 * i);
                           if (nB) visitB<true>(F, L, q[rB], o[rB], msf[rB], inv[rB], hB, iB, 16 * i); }
                }
            }
        });
    }
    asm volatile("s_waitcnt lgkmcnt(0)" ::: "memory");
    {
        NSA_STAGE();
        unsigned bm0 = 0u, bm1 = 0u;
        const int jt = tw0 >> 6;
        if (jt <= 15) { bm0 = (L.lane <= jt) ? 0xffffu : 0u; }
        else {
            const int tau = L.lane >> 2, part = L.lane & 3;
            unsigned A[32];
            { const LAS f32x4* src = (const LAS f32x4*)(impw + tau * 128 + part * 32);
#pragma unroll
              for (int i4 = 0; i4 < 8; ++i4) { const f32x4 v = src[i4];
#pragma unroll
                for (int e = 0; e < 4; ++e) { const int j = part * 32 + 4 * i4 + e; A[4 * i4 + e] = (j >= 1 && j <= jt - 2) ? (0x80000000u | __float_as_uint(v[e])) : 0u; } } }
#define TSTEP(J, M) _Pragma("unroll") for (int r = 0; r < 32; ++r) if (!(r & (J))) { const unsigned t_ = ((A[r] >> (J)) ^ A[r + (J)]) & (M); A[r + (J)] ^= t_; A[r] ^= t_ << (J); }
            TSTEP(16, 0x0000FFFFu) TSTEP(8, 0x00FF00FFu) TSTEP(4, 0x0F0F0F0Fu) TSTEP(2, 0x33333333u) TSTEP(1, 0x55555555u)
#undef TSTEP
#define QSUM(x) do { x += __builtin_amdgcn_mov_dpp(x, 0xB1, 0xF, 0xF, true); x += __builtin_amdgcn_mov_dpp(x, 0x4E, 0xF, 0xF, true); } while (0)
            unsigned cand = 0xffffffffu, gt = 0u; int G = 0;
#pragma unroll
            for (int bit = 31; bit >= 0; --bit) {
                const unsigned ones = cand & A[bit];
                int c1 = __builtin_popcount(ones); QSUM(c1);
                const bool take = G + c1 >= 13;
                gt |= take ? 0u : ones; cand = take ? ones : (cand ^ ones); G += take ? 0 : c1;
            }
            int eq = __builtin_popcount(cand);
            const int e0 = __builtin_amdgcn_mov_dpp(eq, 0x00, 0xF, 0xF, true), e1 = __builtin_amdgcn_mov_dpp(eq, 0x55, 0xF, 0xF, true), e2 = __builtin_amdgcn_mov_dpp(eq, 0xAA, 0xF, 0xF, true);
            const int rem = (13 - G) - ((part > 0 ? e0 : 0) + (part > 1 ? e1 : 0) + (part > 2 ? e2 : 0));
            unsigned W = gt, tq = cand;
#pragma unroll
            for (int n = 0; n < 13; ++n) { const unsigned low = (rem > n) ? (tq & (0u - tq)) : 0u; W |= low; tq ^= low; }
            { const int d0 = 0 - 32 * part, d1 = jt - 32 * part, d2 = jt - 1 - 32 * part;
              W |= ((unsigned)d0 < 32u ? 1u << d0 : 0u) | ((unsigned)d1 < 32u ? 1u << d1 : 0u) | ((unsigned)d2 < 32u ? 1u << d2 : 0u); }
#undef QSUM
            LAS unsigned* Wt = (LAS unsigned*)impw;
            asm volatile("s_waitcnt lgkmcnt(0)" ::: "memory");
            Wt[L.lane] = W;
            asm volatile("s_waitcnt lgkmcnt(0)" ::: "memory");
            const int hp = L.lane >> 5, sh = L.lane & 31;
#pragma unroll
            for (int t2 = 0; t2 < 16; ++t2) { const unsigned w0 = Wt[t2 * 4 + hp], w1 = Wt[t2 * 4 + 2 + hp]; bm0 |= ((w0 >> sh) & 1u) << t2; bm1 |= ((w1 >> sh) & 1u) << t2; }
        }
        bmask[L.lane] = bm0; bmask[64 + L.lane] = bm1;
    }
    asm volatile("s_waitcnt lgkmcnt(0)" ::: "memory");
    {
        NSA_STAGE();
#pragma unroll
        for (int rt = 0; rt < 4; ++rt) {
            int gi_ = gnrow + rt * 192; OPAQUE(gi_); const float gc = X.GN_()[gi_];
#pragma unroll
            for (int dt = 0; dt < 4; ++dt) { const f32x4 v = o[rt][dt] * gc; u32x2 w; w.x = cvt_pk_bf16(v[0], v[1]); w.y = cvt_pk_bf16(v[2], v[3]); *(LAS u32x2*)(park + rt * 2048 + dt * 32) = w; }
        }
    }
    {
        NSA_STAGE();
        NSA_LOADQ(X.QR_());
        const int kt_lo = (2 * u - 8) > 0 ? (2 * u - 8) : 0, kt_hi = 2 * u + 1;
        const Src S = make_src(X.KW_(), X.VW_(), (size_t)b * SEQ, 256, gk * 64, L);
        SUBREP(32) { NSA_RESET();
        stream(lds, L, S, kt_lo, kt_hi - kt_lo + 1, [&](int i, const TileAddr& Ks) {
            const int kbase = 64 * (kt_lo + i);
            if (kbase <= tw0 + 15 && kbase + 63 >= tw0 - 511) {
                Frags F; load_frags<true>(Ks, L, F);
#pragma unroll
                for (int pr = 0; pr < 2; ++pr) {
                    const int rA = 2 * pr, rB = rA + 1, twA = tw0 + 4 * rA, twB = twA + 4;
                    const bool nA = kbase <= twA + 3 && kbase + 63 >= twA - 511, nB = kbase <= twB + 3 && kbase + 63 >= twB - 511;
                    const bool inter = kbase + 63 <= twA && kbase >= twB + 3 - 511;
                    const int tA = twA + tl, tB = twB + tl;
                    const bool init = kbase <= (twB + 3 - 511 > 0 ? twB + 3 - 511 : 0);
                    if (init) { if (nA) visit_init<true>(F, L, q[rA], o[rA], m[rA], l[rA], badv, true, RangeMask{tA - 511 - kbase, tA - kbase}); if (nB) visit_init<true>(F, L, q[rB], o[rB], m[rB], l[rB], badv, true, RangeMask{tB - 511 - kbase, tB - kbase}); }
                    else if (nA && nB) { if (inter) visit_fast2<false>(F, L, q[rA], q[rB], o[rA], o[rB], m[rA], m[rB], l[rA], l[rB], badv, true, true, NoMask{}, NoMask{});
                                         else visit_fast2<true>(F, L, q[rA], q[rB], o[rA], o[rB], m[rA], m[rB], l[rA], l[rB], badv, true, true, HiMask{tA - kbase}, HiMask{tB - kbase}); }
                    else if (inter) { if (nA) visit_fast<true, false>(F, L, q[rA], o[rA], m[rA], l[rA], badv, true, NoMask{}); if (nB) visit_fast<true, false>(F, L, q[rB], o[rB], m[rB], l[rB], badv, true, NoMask{}); }
                    else { if (nA) visit_fast<true, true>(F, L, q[rA], o[rA], m[rA], l[rA], badv, true, HiMask{tA - kbase}); if (nB) visit_fast<true, true>(F, L, q[rB], o[rB], m[rB], l[rB], badv, true, HiMask{tB - kbase}); }
                }
            }
        });
        if (NSA_BAD()) {
            NSA_RESET();
            stream(lds, L, S, kt_lo, kt_hi - kt_lo + 1, [&](int i, const TileAddr& Ks) {
                const int kbase = 64 * (kt_lo + i);
                if (kbase <= tw0 + 15 && kbase + 63 >= tw0 - 511) {
                    Frags F; load_frags<true>(Ks, L, F);
#pragma unroll
                    for (int rt = 0; rt < 4; ++rt) {
                        const int twA = tw0 + 4 * rt, tA = twA + tl;
                        if (kbase <= twA + 3 && kbase + 63 >= twA - 511) visit_slow<true, true>(F, L, q[rt], o[rt], m[rt], l[rt], true, RangeMask{tA - 511 - kbase, tA - kbase});
                    }
                }
            });
        }
        }
    }
    {
        NSA_STAGE();
#pragma unroll
        for (int rt = 0; rt < 4; ++rt) {
            int gi_ = gnrow + rt * 192 + 2; OPAQUE(gi_); const float sc = X.GN_()[gi_] * __builtin_amdgcn_rcpf(gsum(l[rt]));
#pragma unroll
            for (int dt = 0; dt < 4; ++dt) {
                LAS u32x2* pp = (LAS u32x2*)(park + rt * 2048 + dt * 32); const u32x2 pw = *pp; const f32x4 v = o[rt][dt] * sc; u32x2 w;
                w.x = cvt_pk_bf16(v[0] + __builtin_bit_cast(float, pw.x << 16), v[1] + __builtin_bit_cast(float, pw.x & 0xffff0000u));
                w.y = cvt_pk_bf16(v[2] + __builtin_bit_cast(float, pw.y << 16), v[3] + __builtin_bit_cast(float, pw.y & 0xffff0000u));
                *pp = w;
            }
        }
    }
    {
        NSA_STAGE();
        const Src S = make_src(X.KS_(), X.VS_(), (size_t)b * SEQ, 256, gk * 64, L);
        if (MK_PROBE == 34) stream(lds, L, S, 0, 2 * u + 2, [&](int j, const TileAddr& Ks) { const unsigned bm = (unsigned)__builtin_amdgcn_readfirstlane((int)bmask[j]); asm volatile("" :: "s"(bm), "v"(Ks.k0)); });
        SUBREP(33) { NSA_RESET();
        stream(lds, L, S, 0, 2 * u + 2, [&](int j, const TileAddr& Ks) {
            const unsigned bm = (unsigned)__builtin_amdgcn_readfirstlane((int)bmask[j]);
            const int kbase = 64 * j; const bool j0 = (j == 0);
            if (bm & 0xffffu) {
                Frags F; load_frags<true>(Ks, L, F);
#pragma unroll
                for (int pr = 0; pr < 2; ++pr) {
                    const int rA = 2 * pr, rB = rA + 1, twA = tw0 + 4 * rA, twB = twA + 4;
                    const bool nA = (bm >> (4 * rA)) & 15u, nB = (bm >> (4 * rB)) & 15u;
                    const bool inter = kbase + 63 <= twA;
                    const bool sA = (bm >> (4 * rA + tl)) & 1u, sB = (bm >> (4 * rB + tl)) & 1u;
                    const HiMask hA{twA + tl - kbase}, hB{twB + tl - kbase};
                    if (j0) { if (nA) visit_init<true>(F, L, q[rA], o[rA], m[rA], l[rA], badv, sA, hA); if (nB) visit_init<true>(F, L, q[rB], o[rB], m[rB], l[rB], badv, sB, hB); }
                    else if (nA && nB && inter) visit_fast2<false>(F, L, q[rA], q[rB], o[rA], o[rB], m[rA], m[rB], l[rA], l[rB], badv, sA, sB, hA, hB);
                    else if (inter) { if (nA) visit_fast<true, false>(F, L, q[rA], o[rA], m[rA], l[rA], badv, sA, hA); if (nB) visit_fast<true, false>(F, L, q[rB], o[rB], m[rB], l[rB], badv, sB, hB); }
                    else { if (nA) visit_fast<true, true>(F, L, q[rA], o[rA], m[rA], l[rA], badv, sA, hA); if (nB) visit_fast<true, true>(F, L, q[rB], o[rB], m[rB], l[rB], badv, sB, hB); }
                }
            }
        });
        if (NSA_BAD()) {
            NSA_RESET();
            stream(lds, L, S, 0, 2 * u + 2, [&](int j, const TileAddr& Ks) {
                const unsigned bm = (unsigned)__builtin_amdgcn_readfirstlane((int)bmask[j]);
                const int kbase = 64 * j;
                if (bm & 0xffffu) {
                    Frags F; load_frags<true>(Ks, L, F);
#pragma unroll
                    for (int rt = 0; rt < 4; ++rt) {
                        const int twA = tw0 + 4 * rt;
                        if ((bm >> (4 * rt)) & 15u) visit_slow<true, true>(F, L, q[rt], o[rt], m[rt], l[rt], (bool)((bm >> (4 * rt + tl)) & 1u), HiMask{twA + tl - kbase});
                    }
                }
            });
        }
        }
    }
    {
        NSA_STAGE();
#pragma unroll
        for (int rt = 0; rt < 4; ++rt) {
            int gi_ = gnrow + rt * 192 + 1; OPAQUE(gi_); const float sc = X.GN_()[gi_] * __builtin_amdgcn_rcpf(gsum(l[rt]));
            int oo_ = (b * SEQ + tw0 + 4 * rt + tl) * 1536 + 512 + (gk * 4 + (L.c & 3)) * 64 + 4 * L.g; OPAQUE(oo_); bf16_t* orow = X.PA_() + (size_t)oo_;
#pragma unroll
            for (int dt = 0; dt < 4; ++dt) {
                const u32x2 pw = *(LAS u32x2*)(park + rt * 2048 + dt * 32); const f32x4 v = o[rt][dt] * sc; u32x2 w;
                w.x = cvt_pk_bf16(v[0] + __builtin_bit_cast(float, pw.x << 16), v[1] + __builtin_bit_cast(float, pw.x & 0xffff0000u));
                w.y = cvt_pk_bf16(v[2] + __builtin_bit_cast(float, pw.y << 16), v[3] + __builtin_bit_cast(float, pw.y & 0xffff0000u));
                *(u32x2*)(orow + 16 * dt) = w;
            }
        }
    }
    asm volatile("s_waitcnt vmcnt(0) lgkmcnt(0)" ::: "memory");
#undef NSA_LOADQ
#undef NSA_RESET
#undef NSA_BAD
#undef NSA_STAGE
}
}

#define XB_TMO      128
#define XB_XCNT(j)  (256  + 64 * (j))
#define XB_XSUB(j)  (1280 + 64 * (j))
#define XB_XGEN(j)  (2304 + 64 * (j))
#define XB_TOP      3328
#define XB_TOPGEN   3392
#define XCD_BAR_WORDS 3456
#define XB_SPIN_CAP (1u << 18)
constexpr int CW_FN = 10240;
constexpr int CW_BAR = 4096;
constexpr size_t CTL_ZERO_BYTES = 65536;
__device__ __forceinline__ unsigned xb_ld(unsigned* p)              { return __hip_atomic_load(p, __ATOMIC_RELAXED, __HIP_MEMORY_SCOPE_AGENT); }
__device__ __forceinline__ unsigned xb_add(unsigned* p, unsigned v) { return __hip_atomic_fetch_add(p, v, __ATOMIC_RELAXED, __HIP_MEMORY_SCOPE_AGENT); }
__device__ __forceinline__ unsigned xb_xcc_id() { return (unsigned)__builtin_amdgcn_s_getreg((3 << 11) | 20) & 0xFu; }
#define XB_SPIN(cond, bar) do { unsigned _sp = 0; while (cond) { __builtin_amdgcn_s_sleep(1); \
    if ((++_sp & 255u) == 0u) { if (xb_ld(&(bar)[XB_TMO])) break; if (_sp > XB_SPIN_CAP) { atomicAdd(&(bar)[XB_TMO], 1u); break; } } } } while (0)
struct XcdBarrier { unsigned* bar; unsigned x; volatile LAS unsigned* st; int wave; };
__device__ __forceinline__ XcdBarrier xcd_barrier_post(unsigned* bar, volatile LAS unsigned* st, int wave) {
    XcdBarrier b; b.bar = bar; b.x = xb_xcc_id(); b.st = st; b.wave = wave;
    if (wave == 0 && lane_id() == 0) (void)xb_add(&bar[XB_XCNT(b.x)], 1u);
    return b;
}
__device__ __forceinline__ void xcd_barrier_complete(unsigned* bar, unsigned x, unsigned& nloc, unsigned& nx) {
    const unsigned G = gridDim.x * gridDim.y * gridDim.z;
    unsigned sum, cnt, mine, sp = 0u;
    for (;;) {
        sum = 0u; cnt = 0u; mine = 0u;
#pragma unroll
        for (unsigned j = 0; j < 16; ++j) { const unsigned c = xb_ld(&bar[XB_XCNT(j)]); sum += c; cnt += (c > 0u) ? 1u : 0u; mine = (j == x) ? c : mine; }
        if (sum == G) break;
        __builtin_amdgcn_s_sleep(1);
        if ((++sp & 255u) == 0u) { if (xb_ld(&bar[XB_TMO])) break; if (sp > XB_SPIN_CAP) { atomicAdd(&bar[XB_TMO], 1u); break; } }
    }
    nloc = mine > 0u ? mine : 1u; nx = cnt > 0u ? cnt : 1u;
}
__device__ __forceinline__ void xcd_barrier(const XcdBarrier& b) {
    asm volatile("s_waitcnt vmcnt(0)" ::: "memory");
    __syncthreads();
    if (b.wave == 0 && lane_id() == 0) {
        unsigned* bar = b.bar;
        __builtin_amdgcn_s_waitcnt(0);
        unsigned nloc = b.st[0], nx = b.st[1];
        if (nloc == 0u) { xcd_barrier_complete(bar, b.x, nloc, nx); b.st[0] = nloc; b.st[1] = nx; }
        const unsigned old = xb_add(&bar[XB_XSUB(b.x)], 1u);
        const unsigned gen = old / nloc;
        if (old + 1u == (gen + 1u) * nloc) {
            __builtin_amdgcn_fence(__ATOMIC_RELEASE, "agent");
            asm volatile("s_waitcnt vmcnt(0)" ::: "memory");
            const unsigned og = xb_add(&bar[XB_TOP], 1u);
            const unsigned tg = og / nx;
            if (og + 1u == (tg + 1u) * nx) xb_add(&bar[XB_TOPGEN], 1u);
            else XB_SPIN(xb_ld(&bar[XB_TOPGEN]) == tg, bar);
            __builtin_amdgcn_fence(__ATOMIC_ACQUIRE, "agent");
            xb_add(&bar[XB_XGEN(b.x)], 1u);
            asm volatile("s_waitcnt vmcnt(0)" ::: "memory");
        } else {
            XB_SPIN(xb_ld(&bar[XB_XGEN(b.x)]) == gen, bar);
            __builtin_amdgcn_fence(__ATOMIC_ACQUIRE, "agent");
            asm volatile("s_waitcnt vmcnt(0)" ::: "memory");
        }
    }
    __syncthreads();
}

#ifndef MK_COOP
#define MK_COOP 1
#endif
constexpr int N_PHASES = 9;
#define REP(k) for (int rep_ = 0; rep_ < ((MK_PROBE) == (k) ? 2 : 1); ++rep_)
__device__ __forceinline__ KParams kparams() { KParams p = (KParams)__builtin_amdgcn_kernarg_segment_ptr(); asm volatile("" : "+s"(p)); return p; }
__global__ void __launch_bounds__(NTHREADS, 2) mk_fwd(Params Parg) {
    (void)Parg;
    extern __shared__ __attribute__((aligned(16))) unsigned char lds_raw[];
    LAS unsigned char* lds = (LAS unsigned char*)lds_raw;
    const int wave_k = __builtin_amdgcn_readfirstlane((int)(threadIdx.x >> 6));
    const int G = gridDim.x, bx = blockIdx.x;
    const int vcu = (G % 8 == 0) ? (bx % 8) * (G / 8) + bx / 8 : bx;
    const int NGW = G * NWAVES;
#define PHASE_IDS() int tid = TID_(wave_k); asm volatile("" : "+v"(tid)); const int lane = tid & 63, wave = __builtin_amdgcn_readfirstlane(tid >> 6), gw = vcu * NWAVES + wave; (void)lane; (void)gw
#define ws (kparams()->ws)
#define dout ((char*)kparams()->out)
    const int ph_lo = kparams()->ph_lo, ph_hi = kparams()->ph_hi;
#define WSP(T_, off) ((T_*)(ws + (off)))
#if MK_COOP
#ifndef MK_CG_SYNC
#define MK_CG_SYNC 0
#endif
#if MK_CG_SYNC
#define GRID_SYNC() cg::this_grid().sync()
#else
    volatile LAS unsigned* MISC = (volatile LAS unsigned*)(lds + MISC_OFF);
    if (wave_k == 0 && lane_id() < 32) MISC[lane_id()] = 0u;
    __syncthreads();
    const XcdBarrier xbar = xcd_barrier_post((unsigned*)(ws + WS_CTL) + CW_BAR, MISC + 8, wave_k);
#define GRID_SYNC() xcd_barrier(xbar)
#endif
#else
#define GRID_SYNC() do {} while (0)
#endif
#define IN(k) (ph_lo <= (k) && (k) < ph_hi)
#define SEAM(k) do { if (IN(k) && IN((k) + 1)) GRID_SYNC(); } while (0)
#define H ((bf16_t*)(dout + DO_H))
#define SP ((bf16_t*)(dout + DO_SP))
#define X1 ((float*)dout)

    if (IN(0)) REP(0) { PHASE_IDS(); p0_prologue<0>(kparams(), lds, gw, NGW, wave, lane); }
    SEAM(0);
    if (IN(1)) REP(1) {
        pg8::Gemm g{1024 * 2, 1024 * 2, 128, 128, 16}; pg8::StdSched S; S.init(H, WSP(bf16_t, WS_WIN), T, 5120, 2048, 2048, G, bx);
        EpiIn E{WSP(bf16_t, WS_U), WSP(bf16_t, WS_QP), WSP(bf16_t, WS_QR), WSP(bf16_t, WS_KC), SP, WSP(bf16_t, WS_SA),
                WSP(float, WS_GN), WSP(float, WS_RCOS), WSP(float, WS_RSIN)};
        pg8::gemm_phase<EpiIn, pg8::StdSched, true>(lds, g, S, E, wave_k);
    }
    SEAM(1);
    if (IN(2)) REP(2) {
        const int ncmp = (G == 256) ? 64 : 32;
        if (bx >= ncmp) {
            { PHASE_IDS(); (void)gw; p2_pooled(WSP(bf16_t, WS_U), WSP(bf16_t, WS_PA), (bx - ncmp) * NWAVES + wave, (G - ncmp) * NWAVES, lane); }
            PHASE_IDS(); (void)gw;
            const int fr = lane & 15, fq = lane >> 4; const bf16_t* Wg = WSP(bf16_t, WS_WIN) + (size_t)5120 * 1024; float* GNp = WSP(float, WS_GN);
#pragma unroll 1
            for (int it = (((bx - ncmp) * NWAVES + wave) % 3) ? T / 32 : ((bx - ncmp) * NWAVES + wave) / 3; it < T / 32; it += ((G - ncmp) * NWAVES + 2) / 3) {
                const int r0 = 32 * it; f32x4 c2[2][3];
#pragma unroll
                for (int mt = 0; mt < 2; ++mt)
#pragma unroll
                    for (int nt = 0; nt < 3; ++nt) c2[mt][nt] = (f32x4){0.f, 0.f, 0.f, 0.f};
#pragma unroll 4
                for (int k0 = 0; k0 < 1024; k0 += 32) {
                    bf16x8 a[2], b[3];
#pragma unroll
                    for (int mt = 0; mt < 2; ++mt) a[mt] = *(const bf16x8*)(H + (size_t)(r0 + 16 * mt + fr) * 1024 + k0 + 8 * fq);
#pragma unroll
                    for (int nt = 0; nt < 3; ++nt) b[nt] = *(const bf16x8*)(Wg + (size_t)(16 * nt + fr) * 1024 + k0 + 8 * fq);
#pragma unroll
                    for (int mt = 0; mt < 2; ++mt)
#pragma unroll
                        for (int nt = 0; nt < 3; ++nt) c2[mt][nt] = __builtin_amdgcn_mfma_f32_16x16x32_bf16(a[mt], b[nt], c2[mt][nt], 0, 0, 0);
                }
#pragma unroll
                for (int mt = 0; mt < 2; ++mt)
#pragma unroll
                    for (int nt = 0; nt < 3; ++nt)
#pragma unroll
                        for (int r = 0; r < 4; ++r) GNp[(size_t)(r0 + 16 * mt + 4 * fq + r) * 48 + 16 * nt + fr] = sigmoidf_(c2[mt][nt][r] + 0.f);
            }
            if (G != 256) p0_prologue<1>(kparams(), lds, (bx - ncmp) * NWAVES + wave, (G - ncmp) * NWAVES, wave, lane);
        }
        __syncthreads();
        const int split = (G == 256) ? 1 : 0;
        pg8::Gemm g{4096 * 2, 2048 * 2, 512, 128, split ? 16 : 32, (split && (bx & 1)) ? -128 * 4096 * 2 : 0};
        CmpSched S{(const char*)WSP(bf16_t, WS_KC), (const char*)WSP(bf16_t, WS_VC), (const char*)WSP(bf16_t, WS_W1K), (const char*)WSP(bf16_t, WS_W1V), bx, split};
        EpiCmp E{WSP(bf16_t, WS_HIDK), WSP(bf16_t, WS_HIDV), WSP(float, WS_PEBK), WSP(float, WS_PEBV), WSP(bf16_t, WS_W2K), WSP(bf16_t, WS_W2V), WSP(bf16_t, WS_KCMP), WSP(bf16_t, WS_VCMP), ws, split};
        pg8::gemm_phase<EpiCmp, CmpSched, false>(lds, g, S, E, wave_k);
    }
    SEAM(2);
    if (IN(3)) REP(3) {
        const nsa::Tensors X{ws};
        const int wave_s = wave_k;
#pragma unroll 1
        for (int uu = vcu; uu < 256; uu += G) { const int bg = uu >> 5, i = uu & 31;
#pragma unroll 1
            for (int hh = 0; hh < 2; ++hh) nsa::unit(lds, X, bg >> 2, bg & 3, hh ? 63 - i : i, wave_s); }
        if (G == 256) {
            __syncthreads();
            PHASE_IDS(); (void)gw;
            late_weights_queue(kparams(), lds, wave, lane);
        }
    }
    SEAM(3);
    if (IN(4)) REP(4) {
        pg8::Gemm g{1536 * 2, 1536 * 2, 128, 128, 24}; pg8::StdSched S; S.init(WSP(bf16_t, WS_PA), WSP(bf16_t, WS_WM), T, 1024, 3072, 3072, G, bx);
        EpiMerged E{WSP(bf16_t, WS_MG), SP, WSP(bf16_t, WS_SA)};
        pg8::gemm_phase<EpiMerged, pg8::StdSched, false>(lds, g, S, E, wave_k);
    }
    SEAM(4);
    if (IN(5)) REP(5) {
        pg8::Gemm g{1024 * 2, 1024 * 2, 128, 128, 16}; pg8::StdSched S; S.init(WSP(bf16_t, WS_MG), WSP(bf16_t, WS_WO), T, 1024, 2048, 2048, G, bx);
        EpiX1 E{kparams()->x, X1, WSP(bf16_t, WS_X1B), WSP(float, WS_RS1)};
        pg8::gemm_phase<EpiX1, pg8::StdSched, false>(lds, g, S, E, wave_k);
    }
    SEAM(5);
    if (IN(6)) REP(6) {
        pg8::Gemm g{1024 * 2, 1024 * 2, 128, 128, 16}; pg8::StdSched S; S.init(WSP(bf16_t, WS_X1B), WSP(bf16_t, WS_WGU), T, 5632, 2048, 2048, G, bx);
        EpiAct E{WSP(bf16_t, WS_ACT), WSP(float, WS_RS1)};
        pg8::gemm_phase<EpiAct, pg8::StdSched, true>(lds, g, S, E, wave_k);
    }
    SEAM(6);
    if (IN(7)) {
        pg8::Gemm g{DFF * 2, DFF * 2, 128, 128, DFF / 64}; pg8::StdSched S; S.init(WSP(bf16_t, WS_ACT), WSP(bf16_t, WS_WD), T, 1024, DFF * 2, DFF * 2, G, bx);
        if (G == 256) {
            EpiFinal E{X1, WSP(bf16_t, WS_X1B), kparams()->normf_w, WSP(float, WS_SEL), (unsigned*)(ws + WS_CTL) + CW_FN};
            pg8::gemm_phase<EpiFinal, pg8::StdSched, false>(lds, g, S, E, wave_k);
        } else {
            EpiX2 E{X1, WSP(bf16_t, WS_X1B)};
            pg8::gemm_phase<EpiX2, pg8::StdSched, false>(lds, g, S, E, wave_k);
        }
    }
    if (G != 256) {
    SEAM(7);
    if (IN(8)) {
        PHASE_IDS();
        for (int row = gw; row < T; row += NGW) {
            f32x4* xr = (f32x4*)(X1 + (size_t)row * DM) + lane; const f32x4* wr = (const f32x4*)kparams()->normf_w + lane;
            f32x4 v[4]; float s = 0.f;
#pragma unroll
            for (int j = 0; j < 4; ++j) { v[j] = xr[64 * j]; s += (v[j].x * v[j].x + v[j].y * v[j].y) + (v[j].z * v[j].z + v[j].w * v[j].w); }
            const float rstd = rsqrtf(wave_sum(s) * (1.f / DM) + RMS_EPS);
#pragma unroll
            for (int j = 0; j < 4; ++j) { const f32x4 ww = wr[64 * j]; xr[64 * j] = (f32x4){v[j].x * rstd * ww.x, v[j].y * rstd * ww.y, v[j].z * rstd * ww.z, v[j].w * rstd * ww.w}; }
        }
    }
    }
#undef WSP
#undef ws
#undef dout
#undef H
#undef SP
#undef X1
}

extern "C" void kernel_launch(void* const* d_in, const int* in_sizes, int n_in, void* d_out, int out_size, void* d_ws, size_t ws_size, hipStream_t stream) {
    static int grid = 0;
    if (grid == 0) {
        if (n_in != 21 || ws_size < WS_END || out_size != T * DM) { fprintf(stderr, "kernel_launch: unexpected shapes n_in %d ws %zu out %d\n", n_in, ws_size, out_size); grid = -1; return; }
        int dev = 0, cus = 0, per_cu = 0;
        if (hipGetDevice(&dev) != hipSuccess || hipDeviceGetAttribute(&cus, hipDeviceAttributeMultiprocessorCount, dev) != hipSuccess) { grid = -1; return; }
        if (hipFuncSetAttribute((const void*)mk_fwd, hipFuncAttributeMaxDynamicSharedMemorySize, LDS_BYTES) != hipSuccess) { fprintf(stderr, "kernel_launch: hipFuncSetAttribute failed\n"); grid = -1; return; }
        if (hipOccupancyMaxActiveBlocksPerMultiprocessor(&per_cu, (const void*)mk_fwd, NTHREADS, LDS_BYTES) != hipSuccess || per_cu < 1) { fprintf(stderr, "kernel_launch: occupancy query says %d\n", per_cu); (void)hipGetLastError(); per_cu = 1; }
        grid = cus;
    }
    if (grid < 0) return;
    Params p{};
    const float** pin = (const float**)&p;
    for (int i = 0; i < 21; ++i) pin[i] = (const float*)d_in[i];
    p.out = (float*)d_out; p.ws = (unsigned char*)d_ws;
#if MK_COOP
    p.ph_lo = 0; p.ph_hi = N_PHASES;
    if (hipMemsetAsync((char*)d_ws + WS_CTL, 0, CTL_ZERO_BYTES, stream) != hipSuccess) { fprintf(stderr, "kernel_launch: memset failed\n"); return; }
    void* args[] = {&p};
    hipError_t e = hipLaunchCooperativeKernel((const void*)mk_fwd, dim3(grid), dim3(NTHREADS), args, LDS_BYTES, stream);
    if (e != hipSuccess) fprintf(stderr, "kernel_launch: cooperative launch failed: %s (grid %d)\n", hipGetErrorString(e), grid);
#else
    for (int ph = 0; ph < N_PHASES; ++ph) { p.ph_lo = ph; p.ph_hi = ph + 1; hipLaunchKernelGGL(mk_fwd, dim3(grid), dim3(NTHREADS), LDS_BYTES, stream, p); }
#endif
}
```

```cpp
#include <hip/hip_runtime.h>
#include <hip/hip_cooperative_groups.h>
#include <cstdint>
#include <cstdio>
namespace cg = cooperative_groups;
#ifndef MK_PROBE
#define MK_PROBE -1
#endif
#define SUBREP(k) for (int srep_ = 0; srep_ < ((MK_PROBE) == (k) ? 2 : 1); ++srep_)

#define LAS __attribute__((address_space(3)))
typedef unsigned short bf16_t;
typedef short bf16x8 __attribute__((ext_vector_type(8)));
typedef float f32x4 __attribute__((ext_vector_type(4)));
typedef unsigned u32x4 __attribute__((ext_vector_type(4)));
typedef unsigned u32x2 __attribute__((ext_vector_type(2)));

constexpr int BATCH = 2, SEQ = 8192, T = BATCH * SEQ, DM = 1024;
constexpr int NREF = 5168, NIN = 5376;
constexpr int DFF = 2816;
constexpr int NCP = 512;
constexpr float RMS_EPS = 1e-6f;
constexpr float C2 = 0.125f * 1.4426950408889634f;
constexpr int NWAVES = 8, NTHREADS = 512;

constexpr size_t MiB = 1u << 20;
constexpr size_t WS_CTL = 0;
constexpr size_t WS_PEBK = 1 * MiB, WS_PEBV = 1 * MiB + 4096, WS_RCOS = 1 * MiB + 65536, WS_RSIN = WS_RCOS + 262144;
constexpr size_t WS_RS1 = 2 * MiB;
constexpr size_t WS_SEL = 3 * MiB;
constexpr size_t WS_KCMP = 4 * MiB, WS_VCMP = 4 * MiB + 512 * 1024;
constexpr size_t WS_W2K = 5 * MiB, WS_W2V = 5 * MiB + 65536;
constexpr size_t WS_W1K = 6 * MiB, WS_W1V = 7 * MiB;
constexpr size_t WS_WIN = 8 * MiB;
constexpr size_t WS_WM = 19 * MiB;
constexpr size_t WS_WO = 22 * MiB;
constexpr size_t WS_WGU = 24 * MiB;
constexpr size_t WS_WD = 35 * MiB;
constexpr size_t WS_GN = 41 * MiB;
constexpr size_t WS_U = 44 * MiB;
constexpr size_t WS_QP = 60 * MiB;
constexpr size_t WS_MG = 60 * MiB;
constexpr size_t WS_KC = 92 * MiB, WS_VC = 100 * MiB, WS_KS = 108 * MiB, WS_VS = 116 * MiB, WS_KW = 124 * MiB, WS_VW = 132 * MiB;
constexpr size_t WS_SA = 140 * MiB;
constexpr size_t WS_PA = 172 * MiB;
constexpr size_t WS_QR = 220 * MiB;
constexpr size_t WS_X1B = 220 * MiB;
constexpr size_t WS_HIDK = 252 * MiB, WS_HIDV = 254 * MiB;
constexpr size_t WS_ACT = 44 * MiB;
constexpr size_t WS_END = 256 * MiB;
constexpr size_t DO_H = 0, DO_SP = 32 * MiB;

constexpr int RING_BYTES = 131072;
constexpr int MISC_OFF = 147456 - 256;
constexpr int GATE_OFF = 147456;
constexpr int LDS_BYTES = 147456 + 8 * 768;

__device__ __forceinline__ unsigned f2bf(float f) { unsigned u = __builtin_bit_cast(unsigned, f); return (u + 0x7fffu + ((u >> 16) & 1u)) >> 16; }
__device__ __forceinline__ float bf2f(unsigned b) { return __builtin_bit_cast(float, (b & 0xffffu) << 16); }
__device__ __forceinline__ unsigned pk2(float lo, float hi) { return f2bf(lo) | (f2bf(hi) << 16); }
typedef float f32x2_t __attribute__((ext_vector_type(2))); typedef __bf16 bf16x2_t __attribute__((ext_vector_type(2)));
__device__ __forceinline__ unsigned cvt_pk_bf16(float lo, float hi) { f32x2_t v = {lo, hi}; bf16x2_t b = __builtin_convertvector(v, bf16x2_t); return __builtin_bit_cast(unsigned, b); }
__device__ __forceinline__ u32x4 pack8(const f32x4& a, const f32x4& b) { u32x4 w; w.x = cvt_pk_bf16(a[0], a[1]); w.y = cvt_pk_bf16(a[2], a[3]); w.z = cvt_pk_bf16(b[0], b[1]); w.w = cvt_pk_bf16(b[2], b[3]); return w; }
__device__ __forceinline__ void unpack8(const u32x4& w, f32x4& a, f32x4& b) {
    a[0] = __builtin_bit_cast(float, w.x << 16); a[1] = __builtin_bit_cast(float, w.x & 0xffff0000u); a[2] = __builtin_bit_cast(float, w.y << 16); a[3] = __builtin_bit_cast(float, w.y & 0xffff0000u);
    b[0] = __builtin_bit_cast(float, w.z << 16); b[1] = __builtin_bit_cast(float, w.z & 0xffff0000u); b[2] = __builtin_bit_cast(float, w.w << 16); b[3] = __builtin_bit_cast(float, w.w & 0xffff0000u); }
__device__ __forceinline__ float sigmoidf_(float v) { return __builtin_amdgcn_rcpf(1.f + __expf(-v)); }
__device__ __forceinline__ float wave_sum(float v) {
#pragma unroll
    for (int o = 1; o < 64; o <<= 1) v += __shfl_xor(v, o);
    return v;
}
__device__ __forceinline__ float wave_max(float v) {
#pragma unroll
    for (int o = 1; o < 64; o <<= 1) v = fmaxf(v, __shfl_xor(v, o));
    return v;
}
#define WSYNC() asm volatile("s_waitcnt lgkmcnt(0)" ::: "memory")
__device__ __forceinline__ int lane_id() { int r; asm volatile("v_mbcnt_lo_u32_b32 %0, -1, 0\n\tv_mbcnt_hi_u32_b32 %0, -1, %0" : "=v"(r)); return r; }
#define TID_(wv) (64 * (wv) + lane_id())
#define OPAQUE(x) asm volatile("" : "+v"(x))
__host__ __device__ __forceinline__ int incol_ref(int c) {
    if (c < 3072) return c;
    if (c < 4096) return 3120 + (c - 3072);
    if (c < 5120) return 4144 + (c - 4096);
    if (c < 5168) return 3072 + (c - 5120);
    return -1;
}

struct Params {
    const float *x, *norm1_w, *w_in, *pool_w, *pool_scale, *pe_k, *w1_k, *b1_k, *w2_k, *pe_v, *w1_v, *b1_v, *w2_v, *w_pp, *w_pa, *w_out, *norm2_w, *w_g, *w_u, *w_d, *normf_w;
    float* out; unsigned char* ws;
    int ph_lo, ph_hi;
};

typedef const __attribute__((address_space(4))) Params* KParams;
namespace pg8 {
constexpr int BM = 256, BK = 64, HALF = 128, HTB = HALF * BK * 2, STAGE_BYTES = 8 * HTB, NXCD = 8, WGM = 8;
__host__ __device__ __forceinline__ int lds_byte(int r, int c) { const int st = (r >> 4) * 2 + (c >> 5), rr = r & 15, cc = c & 31, ob = rr * 64 + cc * 2; return st * 1024 + (ob ^ (((ob >> 9) & 1) << 5)); }
__host__ __device__ __forceinline__ void stage_rc(int b, int& R, int& C) { const int st = b / 1024, sb = b % 1024, swz = sb ^ (((sb >> 9) & 1) << 5); R = (st >> 1) * 16 + swz / 64; C = (st & 1) * 32 + (swz % 64) / 2; }
__host__ __device__ __forceinline__ int perm32(int rho) { const int n = rho >> 4, i = rho & 15; return 8 * (i >> 2) + 4 * n + (i & 3); }

struct Unit { int pm, pn; const char* A; const char* B; };
struct Gemm { int lda, ldb, ksA, ksB, nt, hsA; };

struct StaticOrder {
    int nM, nN, nwg, G, c;
    __device__ void init(int M, int N, int G_, int c_) { nM = M / BM; nN = N / BM; nwg = nM * nN; G = G_; c = c_; }
    __device__ bool next(int i, int& pm, int& pn) const {
        const long L = (long)i * G + c; if (L >= nwg) return false;
        int wgid = (int)L; { const int q = nwg / NXCD, r = nwg % NXCD, xcd = wgid % NXCD, off = wgid / NXCD; wgid = (xcd < r ? xcd * (q + 1) : r * (q + 1) + (xcd - r) * q) + off; }
        const int nig = WGM * nN, gid = wgid / nig, fm = gid * WGM, gsz = (nM - fm) < WGM ? (nM - fm) : WGM;
        pm = fm + ((wgid % nig) % gsz); pn = (wgid % nig) / gsz; return true;
    }
};
struct StdSched {
    StaticOrder so; const char* A; const char* B; size_t tA, tB;
    __device__ void init(const void* A_, const void* B_, int M, int N, int lda_bytes, int ldb_bytes, int G, int c) { so.init(M, N, G, c); A = (const char*)A_; B = (const char*)B_; tA = (size_t)256 * lda_bytes; tB = (size_t)256 * ldb_bytes; }
    __device__ bool next(int i, Unit& u) const { if (!so.next(i, u.pm, u.pn)) return false; u.A = A + u.pm * tA; u.B = B + u.pn * tB; return true; }
};

template <class Epi, class Sched, bool ALIGN_EPI>
__device__ __forceinline__ void gemm_phase(LAS unsigned char* lds, const Gemm g, const Sched& S, const Epi& E, int wave_k) {
    int tid = TID_(wave_k); asm volatile("" : "+v"(tid));
    const int wid = __builtin_amdgcn_readfirstlane(tid >> 6), lane = tid & 63, wr = wid >> 2, wc = wid & 3, fr = lane & 15, fq = lane >> 4;
    const int nt = g.nt;
    unsigned voffA[2], voffB[2];
#pragma unroll
    for (int i = 0; i < 2; ++i) { int R, C; stage_rc(tid * 16 + i * 8192, R, C); const int Rb = (R & ~31) + perm32(R & 31);
        voffA[i] = (unsigned)(R * g.lda + C * 2); voffB[i] = (unsigned)(Rb * g.ldb + C * 2); }
    const size_t kstepA = (size_t)g.ksA, kstepB = (size_t)g.ksB;
    const ptrdiff_t hstepA = g.hsA ? (ptrdiff_t)g.hsA : (ptrdiff_t)HALF * g.lda; const size_t hstepB = (size_t)HALF * g.ldb;
    const unsigned ldsw = (unsigned)wid * 1024u;
    const int aoff = lds_byte(wr * 64 + fr, fq * 8), boff = lds_byte(wc * 32 + fr, fq * 8);
#define PG8_SA(b, h) (((b) * 2 + (h)) * HTB)
#define PG8_SB(b, h) ((4 + (b) * 2 + (h)) * HTB)
#define PG8_STAGE(bufoff, gbase, voff) do { _Pragma("unroll") for (int _i = 0; _i < 2; ++_i) \
        __builtin_amdgcn_global_load_lds((const unsigned*)((const char*)(gbase) + (voff)[_i]), (LAS unsigned*)(lds + (bufoff) + ldsw + _i * 8192), 16, 0, 0); } while (0)
#define PG8_LDA(dst, b, h) do { _Pragma("unroll") for (int m = 0; m < 4; ++m) _Pragma("unroll") for (int k = 0; k < 2; ++k) dst[m][k] = *(const LAS bf16x8*)(lds + PG8_SA(b, h) + aoff + m * 2048 + k * 1024); } while (0)
#define PG8_LDB(dst, b, h) do { _Pragma("unroll") for (int n = 0; n < 2; ++n) _Pragma("unroll") for (int k = 0; k < 2; ++k) dst[n][k] = *(const LAS bf16x8*)(lds + PG8_SB(b, h) + boff + n * 2048 + k * 1024); } while (0)
#define PG8_MMA(ai, bj, At, Bt) do { __builtin_amdgcn_s_setprio(1); _Pragma("unroll") for (int m = 0; m < 4; ++m) _Pragma("unroll") for (int n = 0; n < 2; ++n) _Pragma("unroll") for (int k = 0; k < 2; ++k) \
        acc[ai][bj][m][n] = __builtin_amdgcn_mfma_f32_16x16x32_bf16(Bt[n][k], At[m][k], acc[ai][bj][m][n], 0, 0, 0); __builtin_amdgcn_s_setprio(0); } while (0)
#define PG8_WAIT_V(n) asm volatile("s_waitcnt vmcnt(" #n ")" ::: "memory")
#define PG8_WAIT_L(n) asm volatile("s_waitcnt lgkmcnt(" #n ")" ::: "memory")
#define PG8_BAR __builtin_amdgcn_s_barrier()
#define PG8_SCHED __builtin_amdgcn_sched_barrier(0)
    Unit cur, nxt; int ui = 0;
    if (!S.next(0, cur)) return;
    f32x4 acc[2][2][4][2];
#pragma unroll
    for (int a = 0; a < 2; ++a)
#pragma unroll
        for (int b = 0; b < 2; ++b)
#pragma unroll
            for (int m = 0; m < 4; ++m)
#pragma unroll
                for (int n = 0; n < 2; ++n) acc[a][b][m][n] = (f32x4){0.f, 0.f, 0.f, 0.f};
    bf16x8 At[4][2], B0[2][2], B1[2][2];
    const char* cA = cur.A; const char* cB = cur.B;
    PG8_STAGE(PG8_SB(0, 0), cB, voffB); PG8_STAGE(PG8_SB(0, 1), cB + hstepB, voffB); PG8_STAGE(PG8_SA(0, 0), cA, voffA); PG8_STAGE(PG8_SA(0, 1), cA + hstepA, voffA);
    if (wr == 1) PG8_BAR;
    PG8_WAIT_V(2); PG8_BAR;
    PG8_STAGE(PG8_SB(1, 0), cB + kstepB, voffB); PG8_STAGE(PG8_SA(1, 0), cA + kstepA, voffA); PG8_STAGE(PG8_SB(1, 1), cB + hstepB + kstepB, voffB);
    PG8_WAIT_V(6); PG8_BAR;
    for (;;) {
        const bool has_next = S.next(ui + 1, nxt);
        const char* nA = has_next ? nxt.A : cA; const char* nB = has_next ? nxt.B : cB;
        for (int t = 0; t < nt; t += 2) {
            const bool last = (t == nt - 2);
            const char* a1 = cA + (size_t)(t + 1) * kstepA;
            const char* a2 = last ? nA : cA + (size_t)(t + 2) * kstepA; const char* b2 = last ? nB : cB + (size_t)(t + 2) * kstepB;
            const char* a3 = a2 + kstepA; const char* b3 = b2 + kstepB;
            PG8_LDB(B0, 0, 0); PG8_LDB(B1, 0, 1); PG8_SCHED; PG8_LDA(At, 0, 0); PG8_STAGE(PG8_SA(1, 1), a1 + hstepA, voffA);
            PG8_WAIT_V(8); PG8_WAIT_L(0); PG8_BAR; PG8_MMA(0, 0, At, B0); PG8_MMA(0, 1, At, B1); PG8_BAR; PG8_SCHED;
            PG8_LDA(At, 0, 1); PG8_STAGE(PG8_SB(0, 0), b2, voffB); PG8_STAGE(PG8_SB(0, 1), b2 + hstepB, voffB); PG8_STAGE(PG8_SA(0, 0), a2, voffA);
            PG8_WAIT_V(8); PG8_WAIT_L(0); PG8_BAR; PG8_MMA(1, 0, At, B0); PG8_MMA(1, 1, At, B1); PG8_BAR; PG8_SCHED;
            PG8_LDB(B0, 1, 0); PG8_LDB(B1, 1, 1); PG8_SCHED; PG8_LDA(At, 1, 0); PG8_STAGE(PG8_SA(0, 1), a2 + hstepA, voffA);
            PG8_WAIT_V(8); PG8_WAIT_L(0); PG8_BAR; PG8_MMA(0, 0, At, B0); PG8_MMA(0, 1, At, B1); PG8_BAR; PG8_SCHED;
            PG8_LDA(At, 1, 1); PG8_STAGE(PG8_SB(1, 0), b3, voffB); PG8_STAGE(PG8_SB(1, 1), b3 + hstepB, voffB); PG8_STAGE(PG8_SA(1, 0), a3, voffA);
            PG8_WAIT_V(8); PG8_WAIT_L(0); PG8_BAR; PG8_MMA(1, 0, At, B0); PG8_MMA(1, 1, At, B1); PG8_BAR; PG8_SCHED;
            if constexpr (Epi::HOOK_KT > 0) { if (t + 2 == Epi::HOOK_KT) { E.hook(acc, cur, wr, wc, fr, fq); PG8_WAIT_V(0); PG8_SCHED; } }
        }
        if constexpr (ALIGN_EPI) { if (wr == 0) PG8_BAR; }
        if constexpr (!Epi::AFTER_DRAIN) { E(acc, cur, wr, wc, fr, fq); }
        if (!has_next) break;
#pragma unroll
        for (int a = 0; a < 2; ++a)
#pragma unroll
            for (int b = 0; b < 2; ++b)
#pragma unroll
                for (int m = 0; m < 4; ++m)
#pragma unroll
                    for (int n = 0; n < 2; ++n) acc[a][b][m][n] = (f32x4){0.f, 0.f, 0.f, 0.f};
        cur = nxt; cA = nA; cB = nB; ++ui;
        if constexpr (ALIGN_EPI) { if (wr == 1) PG8_BAR; }
    }
    PG8_WAIT_V(0);
    if constexpr (!ALIGN_EPI) { if (wr == 0) PG8_BAR; }
    PG8_BAR;
    if constexpr (Epi::AFTER_DRAIN) { E.fused(acc, cur, wr, wc, fr, fq, wid, lane, lds); }
#undef PG8_SA
#undef PG8_SB
#undef PG8_STAGE
#undef PG8_LDA
#undef PG8_LDB
#undef PG8_MMA
#undef PG8_WAIT_V
#undef PG8_WAIT_L
#undef PG8_BAR
#undef PG8_SCHED
}
}
using pg8::Unit;
typedef f32x4 Acc[2][2][4][2];
#define EPI_ROW(u, ai, wr, m, fr) ((u).pm * 256 + (ai) * 128 + (wr) * 64 + (m) * 16 + (fr))
#define EPI_LC(bj, wc, fq) ((bj) * 128 + (wc) * 32 + (fq) * 8)

constexpr int CW_XC = 14600;
struct EpiIn {
    static constexpr bool AFTER_DRAIN = false; static constexpr int HOOK_KT = 0;
    bf16_t *U, *QP, *QR, *KV0, *SP, *SA; float* GN; const float* RC; const float* RS;
    __device__ __forceinline__ void rope8(f32x4& v0, f32x4& v1, int t, bool apply, int fq) const {
        f32x4 p0, p1;
#pragma unroll
        for (int e = 0; e < 4; ++e) { p0[e] = __shfl_xor(v0[e], 16); p1[e] = __shfl_xor(v1[e], 16); }
        if (apply) {
            const f32x4 c0 = *(const f32x4*)(RC + t * 8), c1 = *(const f32x4*)(RC + t * 8 + 4), s0 = *(const f32x4*)(RS + t * 8), s1 = *(const f32x4*)(RS + t * 8 + 4);
            const float sg = (fq & 1) ? 1.f : -1.f;
            v0 = v0 * c0 + (p0 * s0) * sg; v1 = v1 * c1 + (p1 * s1) * sg;
        }
    }
    __device__ __forceinline__ void operator()(const Acc& acc, const Unit& u, int wr, int wc, int fr, int fq) const {
        OPAQUE(fr); OPAQUE(fq);
        const int pn = u.pn; const bool ropel = ((wc & 1) == 0) && fq < 2;
#pragma unroll
        for (int ai = 0; ai < 2; ++ai)
#pragma unroll
            for (int m = 0; m < 4; ++m) {
                const int r = EPI_ROW(u, ai, wr, m, fr), t = r & (SEQ - 1);
#pragma unroll
                for (int bj = 0; bj < 2; ++bj) {
                    const int lc = EPI_LC(bj, wc, fq); f32x4 v0 = acc[ai][bj][m][0], v1 = acc[ai][bj][m][1];
                    if (pn < 2) { *(u32x4*)(U + (size_t)r * 512 + pn * 256 + lc) = pack8(v0, v1); }
                    else if (pn < 6) {
                        v0 = v0 * C2; v1 = v1 * C2; const size_t o = (size_t)r * 1024 + (pn - 2) * 256 + lc;
                        *(u32x4*)(QP + o) = pack8(v0, v1);
                        if ((wc & 1) == 0) rope8(v0, v1, t, ropel, fq);
                        *(u32x4*)(QR + o) = pack8(v0, v1);
                    } else if (pn < 12) {
                        const int ty = pn - 6; bf16_t* dst = KV0 + (size_t)ty * (size_t)(4u << 20);
                        if ((ty == 2 || ty == 4) && (wc & 1) == 0) rope8(v0, v1, t, ropel, fq);
                        *(u32x4*)(dst + (size_t)r * 256 + lc) = pack8(v0, v1);
                    } else if (pn < 20) {
                        bf16_t* dst = pn < 16 ? SP : SA; const int cb = ((pn - 12) & 3) * 256 + lc;
#pragma unroll
                        for (int e = 0; e < 4; ++e) { v0[e] = sigmoidf_(v0[e]); v1[e] = sigmoidf_(v1[e]); }
                        *(u32x4*)(dst + (size_t)r * 1024 + cb) = pack8(v0, v1);
                    } else if (lc < 48) {
#pragma unroll
                        for (int e = 0; e < 4; ++e) { v0[e] = sigmoidf_(v0[e]); v1[e] = sigmoidf_(v1[e]); }
                        *(f32x4*)(GN + (size_t)r * 48 + lc) = v0; *(f32x4*)(GN + (size_t)r * 48 + lc + 4) = v1;
                    }
                }
            }
    }
};
__device__ __forceinline__ float gelu_tanh(float x) { const float u = 0.7978845608028654f * (x + 0.044715f * x * x * x); const float e = __expf(2.f * u); return 0.5f * x * (1.f + (1.f - 2.f * __builtin_amdgcn_rcpf(e + 1.f))); }
struct EpiCmp {
    static constexpr bool AFTER_DRAIN = true; static constexpr int HOOK_KT = 0;
    bf16_t *HIDK, *HIDV; const float *PEBK, *PEBV; const bf16_t *W2K, *W2V; bf16_t *KCMP, *VCMP; unsigned char* wsb; int split;
    template <int AI> __device__ __forceinline__ void gelu_half(const Acc& acc, bf16_t* HID, const float* peb, int rbase, int wr, int wc, int fr, int fq) const {
#pragma unroll
        for (int bj = 0; bj < 2; ++bj) {
            const int lc = EPI_LC(bj, wc, fq); const f32x4 b0 = *(const f32x4*)(peb + lc), b1 = *(const f32x4*)(peb + lc + 4);
#pragma unroll
            for (int m = 0; m < 4; ++m) {
                const int r = rbase + wr * 64 + m * 16 + fr; f32x4 v0 = acc[AI][bj][m][0] + b0, v1 = acc[AI][bj][m][1] + b1;
#pragma unroll
                for (int e = 0; e < 4; ++e) { v0[e] = gelu_tanh(v0[e]); v1[e] = gelu_tanh(v1[e]); }
                *(u32x4*)(HID + (size_t)r * 256 + lc) = pack8(v0, v1);
            }
        }
    }
    __device__ __forceinline__ void fused(Acc& acc, const Unit& u, int wr, int wc, int fr, int fq, int wid, int lane, LAS unsigned char*) const {
        OPAQUE(fr); OPAQUE(fq);
        const int h = u.pn, which = u.pm >> 4, rt = u.pm & 15; bf16_t* HID = which ? HIDV : HIDK; const float* peb = which ? PEBV : PEBK;
        if (split) {
            float* slabs = (float*)(wsb + (u.pm < 16 ? WS_WM : WS_WD)) + (size_t)((u.pm & 15) * 2) * (128 * 256);
            unsigned* cnt = (unsigned*)(wsb + WS_CTL) + CW_XC + (u.pm * 2) * 16;
            float* mine = slabs + (size_t)h * (128 * 256); const float* theirs = slabs + (size_t)(h ^ 1) * (128 * 256);
#pragma unroll
            for (int bj = 0; bj < 2; ++bj)
#pragma unroll
                for (int m = 0; m < 4; ++m) { float* p = mine + (size_t)(wr * 64 + m * 16 + fr) * 256 + EPI_LC(bj, wc, fq);
                    asm volatile("global_store_dwordx4 %0, %1, off sc0 sc1" :: "v"(p), "v"(acc[1][bj][m][0]) : "memory");
                    asm volatile("global_store_dwordx4 %0, %1, off offset:16 sc0 sc1" :: "v"(p), "v"(acc[1][bj][m][1]) : "memory"); }
            asm volatile("s_waitcnt vmcnt(0)" ::: "memory");
            if (lane == 0) __hip_atomic_fetch_add(cnt + 16 * h, 1u, __ATOMIC_RELAXED, __HIP_MEMORY_SCOPE_AGENT);
            if (wid == 0) {
                unsigned sp = 0; while ((unsigned)__builtin_amdgcn_readfirstlane((int)__hip_atomic_load(cnt + 16 * (h ^ 1), __ATOMIC_RELAXED, __HIP_MEMORY_SCOPE_AGENT)) < 8u && ++sp < (1u << 22)) __builtin_amdgcn_s_sleep(2);
            }
            asm volatile("s_waitcnt vmcnt(0) lgkmcnt(0)" ::: "memory"); __builtin_amdgcn_s_barrier(); asm volatile("" ::: "memory");
            __builtin_amdgcn_fence(__ATOMIC_ACQUIRE, "agent");
#pragma unroll
            for (int bj = 0; bj < 2; ++bj)
#pragma unroll
                for (int m = 0; m < 4; ++m) { const float* p = theirs + (size_t)(wr * 64 + m * 16 + fr) * 256 + EPI_LC(bj, wc, fq); acc[0][bj][m][0] += *(const f32x4*)p; acc[0][bj][m][1] += *(const f32x4*)(p + 4); }
        }
        gelu_half<0>(acc, HID, peb, rt * 256 + (split ? h * 128 : 0), wr, wc, fr, fq);
        if (!split) gelu_half<1>(acc, HID, peb, rt * 256 + 128, wr, wc, fr, fq);
        asm volatile("s_waitcnt vmcnt(0)" ::: "memory"); __syncthreads();
        const bf16_t* W2 = which ? W2V : W2K; bf16_t* OUT = which ? VCMP : KCMP; const int r0 = rt * 256 + (split ? h * 128 + wid * 16 : wid * 32);
        f32x4 c2[2][4];
#pragma unroll
        for (int mt = 0; mt < 2; ++mt)
#pragma unroll
            for (int nt = 0; nt < 4; ++nt) c2[mt][nt] = (f32x4){0.f, 0.f, 0.f, 0.f};
        for (int k0 = 0; k0 < 256; k0 += 32) {
            bf16x8 a[2], b[4];
#pragma unroll
            for (int mt = 0; mt < 2; ++mt) a[mt] = *(const bf16x8*)(HID + (size_t)(r0 + (split ? 0 : 16 * mt) + fr) * 256 + k0 + 8 * fq);
#pragma unroll
            for (int nt = 0; nt < 4; ++nt) b[nt] = *(const bf16x8*)(W2 + (size_t)(16 * nt + fr) * 256 + k0 + 8 * fq);
#pragma unroll
            for (int mt = 0; mt < 2; ++mt)
#pragma unroll
                for (int nt = 0; nt < 4; ++nt) c2[mt][nt] = __builtin_amdgcn_mfma_f32_16x16x32_bf16(a[mt], b[nt], c2[mt][nt], 0, 0, 0);
        }
#pragma unroll
        for (int mt = 0; mt < 2; ++mt) {
            if (mt == 0 || !split) {
#pragma unroll
            for (int nt = 0; nt < 4; ++nt)
#pragma unroll
                for (int r = 0; r < 4; ++r) OUT[(size_t)(r0 + 16 * mt + 4 * fq + r) * 64 + 16 * nt + fr] = (bf16_t)f2bf(c2[mt][nt][r]);
            }
        }
    }
};
struct EpiMerged {
    static constexpr bool AFTER_DRAIN = false; static constexpr int HOOK_KT = 8;
    bf16_t* MG; const bf16_t* SP; const bf16_t* SA;
    __device__ __forceinline__ void hook(Acc& acc, const Unit& u, int wr, int wc, int fr, int fq) const {
        OPAQUE(fr); OPAQUE(fq);
#pragma unroll
        for (int ai = 0; ai < 2; ++ai)
#pragma unroll
            for (int m = 0; m < 4; ++m) {
                const int r = EPI_ROW(u, ai, wr, m, fr);
#pragma unroll
                for (int bj = 0; bj < 2; ++bj) {
                    const size_t o = (size_t)r * 1024 + u.pn * 256 + EPI_LC(bj, wc, fq);
                    const u32x4 wp = *(const u32x4*)(SP + o), wa = *(const u32x4*)(SA + o); f32x4 p0, p1, a0, a1; unpack8(wp, p0, p1); unpack8(wa, a0, a1);
#pragma unroll
                    for (int e = 0; e < 4; ++e) { acc[ai][bj][m][0][e] *= p0[e] * __builtin_amdgcn_rcpf(a0[e]); acc[ai][bj][m][1][e] *= p1[e] * __builtin_amdgcn_rcpf(a1[e]); }
                }
            }
    }
    __device__ __forceinline__ void operator()(const Acc& acc, const Unit& u, int wr, int wc, int fr, int fq) const {
        OPAQUE(fr); OPAQUE(fq);
#pragma unroll
        for (int ai = 0; ai < 2; ++ai)
#pragma unroll
            for (int m = 0; m < 4; ++m) {
                const int r = EPI_ROW(u, ai, wr, m, fr);
#pragma unroll
                for (int bj = 0; bj < 2; ++bj) {
                    const size_t o = (size_t)r * 1024 + u.pn * 256 + EPI_LC(bj, wc, fq);
                    const u32x4 wa = *(const u32x4*)(SA + o); f32x4 a0, a1; unpack8(wa, a0, a1);
                    *(u32x4*)(MG + o) = pack8(acc[ai][bj][m][0] * a0, acc[ai][bj][m][1] * a1);
                }
            }
    }
};
struct EpiX1 {
    static constexpr bool AFTER_DRAIN = false; static constexpr int HOOK_KT = 0;
    const float* x; float* X1; bf16_t* X1B; float* RSP;
    __device__ __forceinline__ void operator()(const Acc& acc, const Unit& u, int wr, int wc, int fr, int fq) const {
        OPAQUE(fr); OPAQUE(fq);
#pragma unroll
        for (int ai = 0; ai < 2; ++ai)
#pragma unroll
            for (int m = 0; m < 4; ++m) {
                const int r = EPI_ROW(u, ai, wr, m, fr); float s = 0.f;
#pragma unroll
                for (int bj = 0; bj < 2; ++bj) {
                    const size_t o = (size_t)r * 1024 + u.pn * 256 + EPI_LC(bj, wc, fq);
                    const f32x4 o0 = *(const f32x4*)(x + o) + acc[ai][bj][m][0], o1 = *(const f32x4*)(x + o + 4) + acc[ai][bj][m][1];
                    *(u32x4*)(X1B + o) = pack8(o0, o1);
                    s += (o0[0] * o0[0] + o0[1] * o0[1]) + (o0[2] * o0[2] + o0[3] * o0[3]) + (o1[0] * o1[0] + o1[1] * o1[1]) + (o1[2] * o1[2] + o1[3] * o1[3]);
                }
                s += __shfl_xor(s, 16); s += __shfl_xor(s, 32);
                if (fq == 0) RSP[(size_t)r * 16 + u.pn * 4 + wc] = s;
            }
    }
};
struct EpiAct {
    static constexpr bool AFTER_DRAIN = false; static constexpr int HOOK_KT = 0;
    bf16_t* ACT; const float* RSP;
    __device__ __forceinline__ void operator()(const Acc& acc, const Unit& u, int wr, int wc, int fr, int fq) const {
        OPAQUE(fr); OPAQUE(fq);
#pragma unroll
        for (int ai = 0; ai < 2; ++ai)
#pragma unroll
            for (int m = 0; m < 4; ++m) {
                const int r = EPI_ROW(u, ai, wr, m, fr); const f32x4* rp = (const f32x4*)(RSP + (size_t)r * 16);
                const f32x4 q0 = rp[0], q1 = rp[1], q2 = rp[2], q3 = rp[3];
                const float ss = ((q0[0] + q0[1]) + (q0[2] + q0[3])) + ((q1[0] + q1[1]) + (q1[2] + q1[3])) + ((q2[0] + q2[1]) + (q2[2] + q2[3])) + ((q3[0] + q3[1]) + (q3[2] + q3[3]));
                const float rstd = rsqrtf(ss * (1.f / DM) + RMS_EPS);
                f32x4 o[2];
#pragma unroll
                for (int n = 0; n < 2; ++n)
#pragma unroll
                    for (int e = 0; e < 4; ++e) { const float gg = acc[ai][0][m][n][e] * rstd, uu = acc[ai][1][m][n][e] * rstd; o[n][e] = gg * sigmoidf_(gg) * uu; }
                *(u32x4*)(ACT + (size_t)r * DFF + u.pn * 128 + wc * 32 + fq * 8) = pack8(o[0], o[1]);
            }
    }
};
struct EpiX2 {
    static constexpr bool AFTER_DRAIN = false; static constexpr int HOOK_KT = 0;
    float* X; const bf16_t* X1B;
    __device__ __forceinline__ void operator()(const Acc& acc, const Unit& u, int wr, int wc, int fr, int fq) const {
        OPAQUE(fr); OPAQUE(fq);
#pragma unroll
        for (int ai = 0; ai < 2; ++ai)
#pragma unroll
            for (int m = 0; m < 4; ++m) {
                const int r = EPI_ROW(u, ai, wr, m, fr);
#pragma unroll
                for (int bj = 0; bj < 2; ++bj) {
                    const size_t o = (size_t)r * 1024 + u.pn * 256 + EPI_LC(bj, wc, fq); float* p = X + o;
                    const u32x4 xw = *(const u32x4*)(X1B + o); f32x4 x0, x1v; unpack8(xw, x0, x1v);
                    *(f32x4*)p = x0 + acc[ai][bj][m][0]; *(f32x4*)(p + 4) = x1v + acc[ai][bj][m][1];
                }
            }
    }
};
struct EpiFinal {
    static constexpr bool AFTER_DRAIN = true; static constexpr int HOOK_KT = 0;
    float* X; const bf16_t* X1B; const float* nw; float* slots; unsigned* cnt;
    __device__ __forceinline__ void fused(Acc& acc, const Unit& u, int wr, int wc, int fr, int fq, int wid, int lane, LAS unsigned char* lds) const {
        OPAQUE(fr); OPAQUE(fq);
        LAS float* Pl = (LAS float*)lds;
        LAS float* Sr = (LAS float*)(lds + 4096);
#pragma unroll
        for (int ai = 0; ai < 2; ++ai)
#pragma unroll
            for (int m = 0; m < 4; ++m) {
                const int r = EPI_ROW(u, ai, wr, m, fr); float sq = 0.f;
#pragma unroll
                for (int bj = 0; bj < 2; ++bj) {
                    { const u32x4 xw = *(const u32x4*)(X1B + (size_t)r * 1024 + u.pn * 256 + EPI_LC(bj, wc, fq)); f32x4 x0, x1v; unpack8(xw, x0, x1v); acc[ai][bj][m][0] += x0; acc[ai][bj][m][1] += x1v; }
                    const f32x4 a = acc[ai][bj][m][0], b = acc[ai][bj][m][1];
                    sq += ((a[0] * a[0] + a[1] * a[1]) + (a[2] * a[2] + a[3] * a[3])) + ((b[0] * b[0] + b[1] * b[1]) + (b[2] * b[2] + b[3] * b[3]));
                }
                sq += __shfl_xor(sq, 16); sq += __shfl_xor(sq, 32);
                if (fq == 0) Pl[(ai * 128 + wr * 64 + m * 16 + fr) * 4 + wc] = sq;
            }
        asm volatile("s_waitcnt lgkmcnt(0)" ::: "memory"); __builtin_amdgcn_s_barrier(); asm volatile("" ::: "memory");
        const int row = wid * 32 + (lane & 31);
        if (lane < 32) { const f32x4 q4 = *(const LAS f32x4*)(Pl + row * 4);
            __hip_atomic_store(slots + (size_t)(u.pm * 256 + row) * 4 + u.pn, (q4[0] + q4[1]) + (q4[2] + q4[3]), __ATOMIC_RELAXED, __HIP_MEMORY_SCOPE_AGENT); }
        asm volatile("s_waitcnt vmcnt(0)" ::: "memory");
        if (lane == 0) __hip_atomic_fetch_add(cnt + 64 * u.pm, 1u, __ATOMIC_RELAXED, __HIP_MEMORY_SCOPE_AGENT);
        if (wid == 0) {
            unsigned sp = 0; while ((unsigned)__builtin_amdgcn_readfirstlane((int)__hip_atomic_load(cnt + 64 * u.pm, __ATOMIC_RELAXED, __HIP_MEMORY_SCOPE_AGENT)) < 32u && ++sp < (1u << 22)) __builtin_amdgcn_s_sleep(2);
            __builtin_amdgcn_fence(__ATOMIC_ACQUIRE, "agent");
        }
        asm volatile("s_waitcnt vmcnt(0) lgkmcnt(0)" ::: "memory"); __builtin_amdgcn_s_barrier(); asm volatile("" ::: "memory");
        if (lane < 32) { const float* sl = slots + (size_t)(u.pm * 256 + row) * 4; float t = 0.f;
#pragma unroll
            for (int k = 0; k < 4; ++k) t += __hip_atomic_load(sl + k, __ATOMIC_RELAXED, __HIP_MEMORY_SCOPE_AGENT);
            Sr[row] = rsqrtf(t * (1.f / DM) + RMS_EPS); }
        asm volatile("s_waitcnt lgkmcnt(0)" ::: "memory"); __builtin_amdgcn_s_barrier(); asm volatile("" ::: "memory");
#pragma unroll
        for (int bj = 0; bj < 2; ++bj) {
            const int c0 = u.pn * 256 + EPI_LC(bj, wc, fq); const f32x4 w0 = *(const f32x4*)(nw + c0), w1 = *(const f32x4*)(nw + c0 + 4);
#pragma unroll
            for (int ai = 0; ai < 2; ++ai)
#pragma unroll
                for (int m = 0; m < 4; ++m) {
                    const int rl = ai * 128 + wr * 64 + m * 16 + fr; const float rs = Sr[rl]; float* p = X + (size_t)(u.pm * 256 + rl) * 1024 + c0;
                    *(f32x4*)p = acc[ai][bj][m][0] * w0 * rs; *(f32x4*)(p + 4) = acc[ai][bj][m][1] * w1 * rs;
                }
        }
    }
};
struct CmpSched {
    const char *KC, *VC, *W1K, *W1V; int c, split;
    __device__ bool next(int i, Unit& u) const {
        if (i > 0 || c >= (split ? 64 : 32)) return false;
        const int un = split ? c >> 1 : c, hk = split ? c & 1 : 0;
        const int which = un >> 4, rt = un & 15, bg = rt >> 1, half = rt & 1, b = bg >> 2, g = bg & 3;
        u.pm = un; u.pn = hk; u.A = (which ? VC : KC) + ((size_t)(b * SEQ + 16 * 256 * half + 16 * hk + (hk ? 16 * 128 : 0)) * 256 + g * 64) * 2; u.B = (which ? W1V : W1K) + (size_t)hk * 2048; return true;
    }
};

struct SF_in { const float* W; __device__ __forceinline__ float operator()(int k, int n) const { const int r = incol_ref(n); return r < 0 ? 0.f : W[(size_t)k * NREF + r]; } };
struct SF_plain { const float* W; int ldn; __device__ __forceinline__ float operator()(int k, int n) const { return W[(size_t)k * ldn + n]; } };
struct SF_gu { const float *Wg, *Wu, *nw; __device__ __forceinline__ float operator()(int k, int n) const {
    const int tile = n >> 8, half = (n >> 7) & 1, j = n & 127, col = tile * 128 + j; const ptrdiff_t d = Wu - Wg; return nw[k] * Wg[(ptrdiff_t)half * d + (ptrdiff_t)k * DFF + col]; } };
__device__ __forceinline__ void p0_tile_out(int K, bf16_t* WT, LAS float* scr, int k0, int n0, int lane) {
    WSYNC();
    const int c = lane & 7;
#pragma unroll
    for (int j = 0; j < 4; ++j) { const int n = (lane >> 3) + 8 * j; const LAS float* s = scr + (8 * c) * 33 + n;
        u32x4 o; o.x = pk2(s[0 * 33], s[1 * 33]); o.y = pk2(s[2 * 33], s[3 * 33]); o.z = pk2(s[4 * 33], s[5 * 33]); o.w = pk2(s[6 * 33], s[7 * 33]);
        *(u32x4*)(WT + (size_t)(n0 + n) * K + k0 + 8 * c) = o; }
    WSYNC();
}
template <class SF> __device__ __forceinline__ void p0_transpose_item(const SF& sf, int K, int N, bf16_t* WT, LAS float* scr, int item, int lane) {
    const int nblk = N / 32, kb = item / nblk, nb = item % nblk, k0 = 64 * kb, n0 = 32 * nb;
    float v[32];
#pragma unroll
    for (int i = 0; i < 32; ++i) v[i] = sf(k0 + 2 * i + (lane >> 5), n0 + (lane & 31));
#pragma unroll
    for (int i = 0; i < 32; ++i) scr[(2 * i + (lane >> 5)) * 33 + (lane & 31)] = v[i];
    p0_tile_out(K, WT, scr, k0, n0, lane);
}
template <class SF> __device__ __forceinline__ void p0_transpose_item2(const SF& sf, int K, int N, bf16_t* WT, LAS float* scr, int item, int lane) {
    const int nblk = N / 32;
    const int kbA = item / nblk, nbA = item % nblk, kbB = (item + 1) / nblk, nbB = (item + 1) % nblk;
    float va[32], vb[32];
#pragma unroll
    for (int i = 0; i < 32; ++i) va[i] = sf(64 * kbA + 2 * i + (lane >> 5), 32 * nbA + (lane & 31));
#pragma unroll
    for (int i = 0; i < 32; ++i) vb[i] = sf(64 * kbB + 2 * i + (lane >> 5), 32 * nbB + (lane & 31));
#pragma unroll
    for (int i = 0; i < 32; ++i) scr[(2 * i + (lane >> 5)) * 33 + (lane & 31)] = va[i];
    p0_tile_out(K, WT, scr, 64 * kbA, 32 * nbA, lane);
#pragma unroll
    for (int i = 0; i < 32; ++i) scr[(2 * i + (lane >> 5)) * 33 + (lane & 31)] = vb[i];
    p0_tile_out(K, WT, scr, 64 * kbB, 32 * nbB, lane);
}
__device__ __forceinline__ void p0_fold_item(const float* pool_w, const float* pool_scale, const float* Wp, bf16_t* WT, int f, int wave, int lane) {
    const int k0 = 64 * (f >> 5), n0 = 32 * (f & 31) + 4 * wave, g = k0 >> 7;
    f32x4 acc = (f32x4){0.f, 0.f, 0.f, 0.f};
    const float* arow = pool_w + (size_t)(k0 + lane) * 128;
#pragma unroll 4
    for (int dp = 0; dp < 128; dp += 4) {
        const f32x4 a = *(const f32x4*)(arow + dp); const f32x4 sc = *(const f32x4*)(pool_scale + g * 128 + dp);
#pragma unroll
        for (int e = 0; e < 4; ++e) { const f32x4 w4 = *(const f32x4*)(Wp + (size_t)(g * 128 + dp + e) * 1024 + n0); acc += w4 * (a[e] * sc[e]); }
    }
#pragma unroll
    for (int j = 0; j < 4; ++j) WT[(size_t)(n0 + j) * 1536 + k0 + lane] = (bf16_t)f2bf(acc[j]);
}
__device__ __forceinline__ void p0_fold_item2(const float* pool_w, const float* pool_scale, const float* Wp, bf16_t* WT, int f, int lane) {
    const int g = f >> 5, kb = (f >> 2) & 7, nb = f & 3, kk0 = g * 128 + kb * 16, n0 = nb * 256 + 4 * lane;
    f32x4 acc[16];
#pragma unroll
    for (int r = 0; r < 16; ++r) acc[r] = (f32x4){0.f, 0.f, 0.f, 0.f};
    const float* bp = Wp + (size_t)(g * 128) * 1024 + n0;
#pragma unroll 1
    for (int dp = 0; dp < 128; dp += 4) {
        const f32x4 sc = *(const f32x4*)(pool_scale + g * 128 + dp);
        f32x4 b[4];
#pragma unroll
        for (int e = 0; e < 4; ++e) b[e] = *(const f32x4*)(bp + (size_t)(dp + e) * 1024);
#pragma unroll
        for (int r = 0; r < 16; ++r) {
            const f32x4 a = *(const f32x4*)(pool_w + (size_t)(kk0 + r) * 128 + dp);
#pragma unroll
            for (int e = 0; e < 4; ++e) acc[r] += b[e] * (a[e] * sc[e]);
        }
    }
#pragma unroll
    for (int j = 0; j < 4; ++j) {
        u32x4 w0, w1;
        w0.x = pk2(acc[0][j], acc[1][j]); w0.y = pk2(acc[2][j], acc[3][j]); w0.z = pk2(acc[4][j], acc[5][j]); w0.w = pk2(acc[6][j], acc[7][j]);
        w1.x = pk2(acc[8][j], acc[9][j]); w1.y = pk2(acc[10][j], acc[11][j]); w1.z = pk2(acc[12][j], acc[13][j]); w1.w = pk2(acc[14][j], acc[15][j]);
        bf16_t* o = WT + (size_t)(n0 + j) * 1536 + kk0; *(u32x4*)o = w0; *(u32x4*)(o + 8) = w1;
    }
}
template <int PART> __device__ __forceinline__ void p0_prologue(KParams P, LAS unsigned char* lds, int gw, int NGW, int wave, int lane) {
    unsigned char* ws = P->ws;
    LAS float* scr = (LAS float*)(lds + wave * 16384);
    constexpr int I_IN = (1024 / 64) * (NIN / 32), I_W1 = (2048 / 64) * (256 / 32), I_W2 = (256 / 64) * (64 / 32), I_WM = (1024 / 64) * (1024 / 32), I_WO = (1024 / 64) * (1024 / 32),
                  I_GU = (1024 / 64) * (5632 / 32), I_WD = (2816 / 64) * (1024 / 32);
    if constexpr (PART == 1) {
        constexpr int NITEMS = I_WM + I_WO + I_WD;
        for (int f = gw >> 3; f < 256; f += NGW >> 3) p0_fold_item(P->pool_w, P->pool_scale, P->w_pp, (bf16_t*)(ws + WS_WM), f, wave, lane);
        for (int it = gw; it < NITEMS; it += NGW) {
            int r = it;
            if (r < I_WM) { p0_transpose_item(SF_plain{P->w_pa, 1024}, 1536, 1024, (bf16_t*)(ws + WS_WM) + 512, scr, r, lane); continue; } r -= I_WM;
            if (r < I_WO) { p0_transpose_item(SF_plain{P->w_out, 1024}, 1024, 1024, (bf16_t*)(ws + WS_WO), scr, r, lane); continue; } r -= I_WO;
            p0_transpose_item(SF_plain{P->w_d, 1024}, 2816, 1024, (bf16_t*)(ws + WS_WD), scr, r, lane);
        }
        return;
    }
    const int nGU = (NGW == 256 * NWAVES) ? 0 : I_GU;
    const int NITEMS = I_IN + 2 * I_W1 + 2 * I_W2 + nGU;
    for (int it = gw; it < NITEMS; it += NGW) {
        int r = it;
        if (r < nGU) { p0_transpose_item(SF_gu{P->w_g, P->w_u, P->norm2_w}, 1024, 5632, (bf16_t*)(ws + WS_WGU), scr, r, lane); continue; } r -= nGU;
        if (r < I_IN) { p0_transpose_item(SF_in{P->w_in}, 1024, NIN, (bf16_t*)(ws + WS_WIN), scr, r, lane); continue; } r -= I_IN;
        if (r < I_W1) { p0_transpose_item(SF_plain{P->w1_k, 256}, 2048, 256, (bf16_t*)(ws + WS_W1K), scr, r, lane); continue; } r -= I_W1;
        if (r < I_W1) { p0_transpose_item(SF_plain{P->w1_v, 256}, 2048, 256, (bf16_t*)(ws + WS_W1V), scr, r, lane); continue; } r -= I_W1;
        if (r < I_W2) { p0_transpose_item(SF_plain{P->w2_k, 64}, 256, 64, (bf16_t*)(ws + WS_W2K), scr, r, lane); continue; } r -= I_W2;
        p0_transpose_item(SF_plain{P->w2_v, 64}, 256, 64, (bf16_t*)(ws + WS_W2V), scr, r, lane);
    }
    for (int it = (gw & 31) ? 64 : (gw >> 5); it < 64; it += NGW >> 5) {
        const int which = it >> 5, c0 = (it & 31) * 8; const float* pe = which ? P->pe_v : P->pe_k; const float* w1 = which ? P->w1_v : P->w1_k; const float* b1 = which ? P->b1_v : P->b1_k;
        f32x4 s0 = (f32x4){0.f, 0.f, 0.f, 0.f}, s1 = s0;
#pragma unroll 8
        for (int j = 0; j < 32; ++j) { const int k = lane + 64 * j; const float p = pe[k]; s0 += *(const f32x4*)(w1 + (size_t)k * 256 + c0) * p; s1 += *(const f32x4*)(w1 + (size_t)k * 256 + c0 + 4) * p; }
#pragma unroll
        for (int e = 0; e < 4; ++e) { s0[e] = wave_sum(s0[e]); s1[e] = wave_sum(s1[e]); }
        if (lane == 0) { float* o = (float*)(ws + (which ? WS_PEBV : WS_PEBK)) + c0; *(f32x4*)o = s0 + *(const f32x4*)(b1 + c0); *(f32x4*)(o + 4) = s1 + *(const f32x4*)(b1 + c0 + 4); }
    }
    for (int it = gw; it < SEQ * 8 / 64; it += NGW) {
        const int idx = it * 64 + lane, i = idx & 7, t = idx >> 3;
        const float inv_freq = i == 0 ? 1.0f : i == 1 ? 0.193922758102417f : i == 2 ? 0.03760603070259094f : i == 3 ? 0.00729266507551074f : i == 4 ? 0.001414213445968926f : i == 5 ? 0.00027424818836152554f : i == 6 ? 5.318296462064609e-05f : 1.0313385246263351e-05f;
        const float ang = (float)t * inv_freq;
        ((float*)(ws + WS_RCOS))[idx] = cosf(ang); ((float*)(ws + WS_RSIN))[idx] = sinf(ang);
    }
    bf16_t* H = (bf16_t*)((char*)P->out + DO_H);
#pragma unroll 1
    for (int row = gw; row < T; row += NGW) {
        const f32x4* xr = (const f32x4*)(P->x + (size_t)row * DM) + lane; const f32x4* wr = (const f32x4*)P->norm1_w + lane;
        f32x4 v[4]; float s = 0.f;
#pragma unroll
        for (int j = 0; j < 4; ++j) { v[j] = xr[64 * j]; s += (v[j].x * v[j].x + v[j].y * v[j].y) + (v[j].z * v[j].z + v[j].w * v[j].w); }
        const float rstd = rsqrtf(wave_sum(s) * (1.f / DM) + RMS_EPS);
        u32x2* o = (u32x2*)(H + (size_t)row * DM) + lane;
#pragma unroll
        for (int j = 0; j < 4; ++j) { const f32x4 ww = wr[64 * j]; u32x2 p; p.x = pk2(v[j].x * rstd * ww.x, v[j].y * rstd * ww.y); p.y = pk2(v[j].z * rstd * ww.z, v[j].w * rstd * ww.w); o[64 * j] = p; }
    }
}
template <int W> __device__ __forceinline__ void pooled_item(const bf16_t* U, bf16_t* PA, int g, int rb, int lane) {
    const int row = rb * 4 + (lane >> 4), c0 = g * 128 + (lane & 15) * 8, t = row & (SEQ - 1), cnt = t + 1 < W ? t + 1 : W;
    u32x4 q[W];
#pragma unroll
    for (int i = 0; i < W; ++i) q[i] = *(const u32x4*)(U + (size_t)(row - (i < cnt ? i : 0)) * 512 + c0);
    f32x4 u0, u1; unpack8(q[0], u0, u1); f32x4 s0 = u0, s1 = u1;
#pragma unroll
    for (int i = 1; i < W; ++i) { f32x4 a, b; unpack8(q[i], a, b); if (i < cnt) { s0 += a; s1 += b; } }
    const float ic = 1.f / (float)cnt;
    *(u32x4*)(PA + (size_t)row * 1536 + c0) = pack8(s0 * ic - u0, s1 * ic - u1);
}
template <int W> __device__ __forceinline__ void pooled_load(const bf16_t* U, int g, int rb, int lane, u32x4 (&q)[W]) {
    const int row = rb * 4 + (lane >> 4), c0 = g * 128 + (lane & 15) * 8, t = row & (SEQ - 1), cnt = t + 1 < W ? t + 1 : W;
#pragma unroll
    for (int i = 0; i < W; ++i) q[i] = *(const u32x4*)(U + (size_t)(row - (i < cnt ? i : 0)) * 512 + c0);
}
template <int W> __device__ __forceinline__ void pooled_store(bf16_t* PA, int g, int rb, int lane, const u32x4 (&q)[W]) {
    const int row = rb * 4 + (lane >> 4), c0 = g * 128 + (lane & 15) * 8, t = row & (SEQ - 1), cnt = t + 1 < W ? t + 1 : W;
    f32x4 u0, u1; unpack8(q[0], u0, u1); f32x4 s0 = u0, s1 = u1;
#pragma unroll
    for (int i = 1; i < W; ++i) { f32x4 a, b; unpack8(q[i], a, b); if (i < cnt) { s0 += a; s1 += b; } }
    const float ic = 1.f / (float)cnt;
    *(u32x4*)(PA + (size_t)row * 1536 + c0) = pack8(s0 * ic - u0, s1 * ic - u1);
}
__device__ __forceinline__ void p2_pooled(const bf16_t* U, bf16_t* PA, int gw, int NGW, int lane) {
#pragma unroll 1
    for (int rb = gw; rb < T / 4; rb += NGW) {
        { u32x4 q16[16]; pooled_load<16>(U, 3, rb, lane, q16); pooled_store<16>(PA, 3, rb, lane, q16); }
        { u32x4 q2[2], q4[4], q8[8]; pooled_load<8>(U, 2, rb, lane, q8); pooled_load<4>(U, 1, rb, lane, q4); pooled_load<2>(U, 0, rb, lane, q2);
          pooled_store<2>(PA, 0, rb, lane, q2); pooled_store<4>(PA, 1, rb, lane, q4); pooled_store<8>(PA, 2, rb, lane, q8); }
    }
}

constexpr int CW_DQ = 14400;
constexpr int DQ_FOLD = 128, DQ_I_WM = (1024 / 64) * (1024 / 32), DQ_I_WO = DQ_I_WM, DQ_I_WD = (2816 / 64) * (1024 / 32), DQ_I_GU = (1024 / 64) * (5632 / 32), DQ_TR = (DQ_I_WM + DQ_I_WO + DQ_I_WD + DQ_I_GU) / 2, DQ_NT = DQ_FOLD + DQ_TR;
__device__ __forceinline__ void late_weights_queue(KParams P, LAS unsigned char* lds, int wave, int lane) {
    unsigned char* ws = P->ws; unsigned* ctl = (unsigned*)(ws + WS_CTL);
    LAS float* scr = (LAS float*)(lds + wave * 16384);
#pragma unroll 1
    for (;;) {
        unsigned tk = 0u;
        if (lane == 0) tk = __hip_atomic_fetch_add(ctl + CW_DQ, 1u, __ATOMIC_RELAXED, __HIP_MEMORY_SCOPE_AGENT);
        const int t = __builtin_amdgcn_readfirstlane((int)tk);
        if (t >= DQ_NT) break;
        if (t < DQ_FOLD) p0_fold_item2(P->pool_w, P->pool_scale, P->w_pp, (bf16_t*)(ws + WS_WM), t, lane);
        else {
            int r = (t - DQ_FOLD) * 2;
            if (r < DQ_I_GU) { p0_transpose_item2(SF_gu{P->w_g, P->w_u, P->norm2_w}, 1024, 5632, (bf16_t*)(ws + WS_WGU), scr, r, lane); continue; } r -= DQ_I_GU;
            if (r < DQ_I_WD) { p0_transpose_item2(SF_plain{P->w_d, 1024}, 2816, 1024, (bf16_t*)(ws + WS_WD), scr, r, lane); continue; } r -= DQ_I_WD;
            if (r < DQ_I_WM) { p0_transpose_item2(SF_plain{P->w_pa, 1024}, 1536, 1024, (bf16_t*)(ws + WS_WM) + 512, scr, r, lane); continue; } r -= DQ_I_WM;
            p0_transpose_item2(SF_plain{P->w_out, 1024}, 1024, 1024, (bf16_t*)(ws + WS_WO), scr, r, lane);
        }
    }
}

namespace nsa {
constexpr int NS = 4, SLOT = 16384, RING = NS * SLOT, WSCR = 8704;
constexpr float THR = 8.f;
typedef short v4i16_t __attribute__((ext_vector_type(4)));
__device__ __forceinline__ float xor1_add(float v) { return v + __builtin_bit_cast(float, __builtin_amdgcn_mov_dpp(__builtin_bit_cast(int, v), 0xB1, 0xF, 0xF, true)); }
__device__ __forceinline__ float xor2_add(float v) { return v + __builtin_bit_cast(float, __builtin_amdgcn_mov_dpp(__builtin_bit_cast(int, v), 0x4E, 0xF, 0xF, true)); }
__device__ __forceinline__ float gmax(float m) {
    auto a = __builtin_amdgcn_permlane16_swap(__float_as_uint(m), __float_as_uint(m), false, false); m = fmaxf(__uint_as_float(a[0]), __uint_as_float(a[1]));
    auto b = __builtin_amdgcn_permlane32_swap(__float_as_uint(m), __float_as_uint(m), false, false); return fmaxf(__uint_as_float(b[0]), __uint_as_float(b[1])); }
__device__ __forceinline__ float gsum(float m) {
    auto a = __builtin_amdgcn_permlane16_swap(__float_as_uint(m), __float_as_uint(m), false, false); m = __uint_as_float(a[0]) + __uint_as_float(a[1]);
    auto b = __builtin_amdgcn_permlane32_swap(__float_as_uint(m), __float_as_uint(m), false, false); return __uint_as_float(b[0]) + __uint_as_float(b[1]); }
struct Lane {
    int wave, lane, g, c; unsigned kbase, vbase; unsigned lds0;
    __device__ __forceinline__ void init(int tid, LAS unsigned char* lds) {
        lane = tid & 63; wave = __builtin_amdgcn_readfirstlane(tid >> 6); g = lane >> 4; c = lane & 15; lds0 = (unsigned)(size_t)lds;
        kbase = (unsigned)(c * 128 + ((g ^ (lane & 7)) << 4));
        const int q = (lane >> 2) & 3, p = lane & 3, rx = 4 * (g & 1) + q;
        vbase = (unsigned)((4 * g + q) * 128 + (((p >> 1) ^ rx) << 4) + (p & 1) * 8);
    }
};
struct Src { const char* k; const char* v; unsigned loff, tstride; };
__device__ __forceinline__ Src make_src(const bf16_t* K, const bf16_t* V, size_t row0, int stride_el, int col0, const Lane& L) {
    Src s; s.k = (const char*)(K + row0 * stride_el + col0); s.v = (const char*)(V + row0 * stride_el + col0);
    const int R = 8 * L.wave + (L.lane >> 3), ch = (L.lane & 7) ^ ((L.lane >> 3) & 7);
    s.loff = (unsigned)((R * stride_el + ch * 8) * 2); s.tstride = (unsigned)(64 * stride_el * 2); return s;
}
__device__ __forceinline__ void glds16(const void* gsrc, unsigned lds_dst) { unsigned keep;
    asm volatile("s_mov_b32 %0, m0\n\ts_mov_b32 m0, %2\n\ts_nop 0\n\tglobal_load_lds_dwordx4 %1, off\n\ts_mov_b32 m0, %0" : "=&s"(keep) : "v"(gsrc), "s"(lds_dst) : "memory"); }
__device__ __forceinline__ void issue(const Lane& L, const Src& S, int tile, int slot) {
    const char* gk = S.k + (size_t)tile * S.tstride + S.loff; const char* gv = S.v + (size_t)tile * S.tstride + S.loff;
    const unsigned d = (unsigned)__builtin_amdgcn_readfirstlane((int)(L.lds0 + slot * SLOT + L.wave * 1024));
    glds16(gk, d); glds16(gv, d + 8192);
}
struct Frags { unsigned k0, k1, v0, v1, v2, v3; };
typedef Frags TileAddr;
template <bool WITH_V> __device__ __forceinline__ void load_frags(const TileAddr& A, const Lane& L, Frags& F) { F = A; }
__device__ __forceinline__ void load_k(const Frags& F, const Lane& L, bf16x8 (&kf)[4][2]) {
#pragma unroll
    for (int mt = 0; mt < 4; ++mt) {
        kf[mt][0] = *(const LAS bf16x8*)((const LAS unsigned char*)(size_t)F.k0 + mt * 2048);
        kf[mt][1] = *(const LAS bf16x8*)((const LAS unsigned char*)(size_t)F.k1 + mt * 2048);
    }
}
__device__ __forceinline__ void load_vdt(unsigned va, bf16x8 (&vf)[2]) {
#pragma unroll
    for (int ks = 0; ks < 2; ++ks) {
        const v4i16_t lo = __builtin_amdgcn_ds_read_tr16_b64_v4i16((LAS v4i16_t*)((LAS unsigned char*)(size_t)va + ks * 4096));
        const v4i16_t hi = __builtin_amdgcn_ds_read_tr16_b64_v4i16((LAS v4i16_t*)((LAS unsigned char*)(size_t)va + ks * 4096 + 2048));
        vf[ks] = (bf16x8){lo[0], lo[1], lo[2], lo[3], hi[0], hi[1], hi[2], hi[3]};
    }
}
__device__ __forceinline__ void load_v(const Frags& F, const Lane& L, bf16x8 (&vf)[4][2]) { load_vdt(F.v0, vf[0]); load_vdt(F.v1, vf[1]); load_vdt(F.v2, vf[2]); load_vdt(F.v3, vf[3]); }
template <bool WITH_V, bool MASKED, class MaskFn>
__device__ __forceinline__ void visit_slow(const Frags& F, const Lane& L, const bf16x8 (&q)[2], f32x4 (&o)[4], float& mref, float& lsum, bool colsel, const MaskFn& valid) {
    const bool seen = mref != -INFINITY;
    const float c0 = colsel ? (seen ? -mref : 0.f) : -INFINITY;
    const f32x4 ci = (f32x4){c0, c0, c0, c0};
    f32x4 s[4];
    { bf16x8 kf[4][2]; load_k(F, L, kf);
#pragma unroll
    for (int mt = 0; mt < 4; ++mt) {
        s[mt] = __builtin_amdgcn_mfma_f32_16x16x32_bf16(kf[mt][0], q[0], ci, 0, 0, 0);
        s[mt] = __builtin_amdgcn_mfma_f32_16x16x32_bf16(kf[mt][1], q[1], s[mt], 0, 0, 0);
    } }
    __builtin_amdgcn_sched_barrier(0);
    bf16x8 vf[4][2]; if constexpr (WITH_V) load_v(F, L, vf);
    if constexpr (MASKED) {
#pragma unroll
        for (int mt = 0; mt < 4; ++mt)
#pragma unroll
            for (int r = 0; r < 4; ++r) if (!valid(16 * mt + 4 * L.g + r)) s[mt][r] = -INFINITY;
    }
    float mx = fmaxf(fmaxf(s[0][0], s[0][1]), fmaxf(s[0][2], s[0][3]));
#pragma unroll
    for (int mt = 1; mt < 4; ++mt) mx = fmaxf(mx, fmaxf(fmaxf(s[mt][0], s[mt][1]), fmaxf(s[mt][2], s[mt][3])));
    if (__any((mx > THR) || (!seen && mx > -INFINITY))) {
        const float mxr = gmax(mx);
        const float d = (mxr == -INFINITY) ? 0.f : (seen ? fmaxf(mxr, 0.f) : mxr);
        const float f = __builtin_amdgcn_exp2f(-d);
        if (mxr != -INFINITY) mref = (seen ? mref : 0.f) + d;
#pragma unroll
        for (int mt = 0; mt < 4; ++mt) s[mt] = s[mt] - d;
        lsum *= f;
        if constexpr (WITH_V) {
#pragma unroll
            for (int dt = 0; dt < 4; ++dt) o[dt] = o[dt] * f;
        }
    }
#pragma unroll
    for (int mt = 0; mt < 4; ++mt)
#pragma unroll
        for (int r = 0; r < 4; ++r) s[mt][r] = __builtin_amdgcn_exp2f(s[mt][r]);
    bf16x8 pf[2];
#pragma unroll
    for (int ks = 0; ks < 2; ++ks) { const u32x4 w = pack8(s[2 * ks], s[2 * ks + 1]); pf[ks] = __builtin_bit_cast(bf16x8, w); }
    { const f32x4 t4 = (s[0] + s[1]) + (s[2] + s[3]); lsum += (t4[0] + t4[1]) + (t4[2] + t4[3]); }
    if constexpr (WITH_V) {
#pragma unroll
        for (int dt = 0; dt < 4; ++dt)
#pragma unroll
            for (int ks = 0; ks < 2; ++ks) o[dt] = __builtin_amdgcn_mfma_f32_16x16x32_bf16(vf[dt][ks], pf[ks], o[dt], 0, 0, 0);
    }
}
template <bool MASKED, class MaskA, class MaskB>
__device__ __forceinline__ void visitB2(const Frags& F, const Lane& L, const bf16x8 (&qA)[2], const bf16x8 (&qB)[2], f32x4 (&oA)[4], f32x4 (&oB)[4], float msA, float msB, float invA, float invB,
                                        const MaskA& validA, const MaskB& validB, LAS float* impA, LAS float* impB, int jb) {
    const float cA = -msA, cB = -msB; const f32x4 ciA = (f32x4){cA, cA, cA, cA}, ciB = (f32x4){cB, cB, cB, cB};
    f32x4 sA[4], sB[4];
    { bf16x8 kf[4][2]; load_k(F, L, kf);
#pragma unroll
    for (int mt = 0; mt < 4; ++mt) {
        sA[mt] = __builtin_amdgcn_mfma_f32_16x16x32_bf16(kf[mt][0], qA[0], ciA, 0, 0, 0);
        sB[mt] = __builtin_amdgcn_mfma_f32_16x16x32_bf16(kf[mt][0], qB[0], ciB, 0, 0, 0);
        sA[mt] = __builtin_amdgcn_mfma_f32_16x16x32_bf16(kf[mt][1], qA[1], sA[mt], 0, 0, 0);
        sB[mt] = __builtin_amdgcn_mfma_f32_16x16x32_bf16(kf[mt][1], qB[1], sB[mt], 0, 0, 0);
    } }

    bf16x8 vf[4][2]; load_v(F, L, vf);
#pragma unroll
    for (int mt = 0; mt < 4; ++mt) {
#pragma unroll
        for (int r = 0; r < 4; ++r) {
            sA[mt][r] = (!MASKED || validA(16 * mt + 4 * L.g + r)) ? __builtin_amdgcn_exp2f(sA[mt][r]) * invA : 0.f;
            sB[mt][r] = (!MASKED || validB(16 * mt + 4 * L.g + r)) ? __builtin_amdgcn_exp2f(sB[mt][r]) * invB : 0.f;
        }
        float va = (sA[mt][0] + sA[mt][1]) + (sA[mt][2] + sA[mt][3]), va3 = sA[mt][3], vb = (sB[mt][0] + sB[mt][1]) + (sB[mt][2] + sB[mt][3]), vb3 = sB[mt][3];
        va = xor2_add(xor1_add(va)); va3 = xor2_add(xor1_add(va3)); vb = xor2_add(xor1_add(vb)); vb3 = xor2_add(xor1_add(vb3));
        if ((L.c & 3) == 0) { const int j = jb + 4 * mt + L.g;
            __hip_atomic_fetch_add(impA + j, va, __ATOMIC_RELAXED, __HIP_MEMORY_SCOPE_WORKGROUP); __hip_atomic_fetch_add(impB + j, vb, __ATOMIC_RELAXED, __HIP_MEMORY_SCOPE_WORKGROUP);
            if (j + 1 < 128) { __hip_atomic_fetch_add(impA + j + 1, va3, __ATOMIC_RELAXED, __HIP_MEMORY_SCOPE_WORKGROUP); __hip_atomic_fetch_add(impB + j + 1, vb3, __ATOMIC_RELAXED, __HIP_MEMORY_SCOPE_WORKGROUP); } }
    }
    bf16x8 pA[2], pB[2];
#pragma unroll
    for (int ks = 0; ks < 2; ++ks) { const u32x4 wa = pack8(sA[2 * ks], sA[2 * ks + 1]), wb = pack8(sB[2 * ks], sB[2 * ks + 1]); pA[ks] = __builtin_bit_cast(bf16x8, wa); pB[ks] = __builtin_bit_cast(bf16x8, wb); }
#pragma unroll
    for (int dt = 0; dt < 4; ++dt)
#pragma unroll
        for (int ks = 0; ks < 2; ++ks) { oA[dt] = __builtin_amdgcn_mfma_f32_16x16x32_bf16(vf[dt][ks], pA[ks], oA[dt], 0, 0, 0); oB[dt] = __builtin_amdgcn_mfma_f32_16x16x32_bf16(vf[dt][ks], pB[ks], oB[dt], 0, 0, 0); }
}
constexpr float PLIM = 1.8446744e19f;
template <bool WITH_V, bool MASKED, class MaskFn>
__device__ __forceinline__ void visit_fast(const Frags& F, const Lane& L, const bf16x8 (&q)[2], f32x4 (&o)[4], float mref, float& lsum, float& badv, bool colsel, const MaskFn& valid) {
    const float c0 = colsel ? -mref : -INFINITY;
    const f32x4 ci = (f32x4){c0, c0, c0, c0};
    f32x4 s[4];
    { bf16x8 kf[4][2]; load_k(F, L, kf);
#pragma unroll
    for (int mt = 0; mt < 4; ++mt) {
        s[mt] = __builtin_amdgcn_mfma_f32_16x16x32_bf16(kf[mt][0], q[0], ci, 0, 0, 0);
        s[mt] = __builtin_amdgcn_mfma_f32_16x16x32_bf16(kf[mt][1], q[1], s[mt], 0, 0, 0);
    } }

    bf16x8 vf[4][2]; if constexpr (WITH_V) load_v(F, L, vf);
#pragma unroll
    for (int mt = 0; mt < 4; ++mt)
#pragma unroll
        for (int r = 0; r < 4; ++r) { const float e = __builtin_amdgcn_exp2f(s[mt][r]); s[mt][r] = (!MASKED || valid(16 * mt + 4 * L.g + r)) ? e : 0.f; }
    float ps; { const f32x4 t4 = (s[0] + s[1]) + (s[2] + s[3]); ps = (t4[0] + t4[1]) + (t4[2] + t4[3]); }
    lsum += ps; badv = fmaxf(badv, ps);
    if constexpr (WITH_V) {
        bf16x8 pf[2];
#pragma unroll
        for (int ks = 0; ks < 2; ++ks) { const u32x4 w = pack8(s[2 * ks], s[2 * ks + 1]); pf[ks] = __builtin_bit_cast(bf16x8, w); }
#pragma unroll
        for (int dt = 0; dt < 4; ++dt)
#pragma unroll
            for (int ks = 0; ks < 2; ++ks) o[dt] = __builtin_amdgcn_mfma_f32_16x16x32_bf16(vf[dt][ks], pf[ks], o[dt], 0, 0, 0);
    }
}
template <bool MASKED, bool WITH_V = true, class MaskA, class MaskB>
__device__ __forceinline__ void visit_fast2(const Frags& F, const Lane& L, const bf16x8 (&qA)[2], const bf16x8 (&qB)[2], f32x4 (&oA)[4], f32x4 (&oB)[4], float mrefA, float mrefB,
                                            float& lsumA, float& lsumB, float& badv, bool colA, bool colB, const MaskA& validA, const MaskB& validB) {
    const float cA = colA ? -mrefA : -INFINITY, cB = colB ? -mrefB : -INFINITY;
    const f32x4 ciA = (f32x4){cA, cA, cA, cA}, ciB = (f32x4){cB, cB, cB, cB};
    f32x4 sA[4], sB[4];
    { bf16x8 kf[4][2]; load_k(F, L, kf);
#pragma unroll
    for (int mt = 0; mt < 4; ++mt) {
        sA[mt] = __builtin_amdgcn_mfma_f32_16x16x32_bf16(kf[mt][0], qA[0], ciA, 0, 0, 0);
        sB[mt] = __builtin_amdgcn_mfma_f32_16x16x32_bf16(kf[mt][0], qB[0], ciB, 0, 0, 0);
        sA[mt] = __builtin_amdgcn_mfma_f32_16x16x32_bf16(kf[mt][1], qA[1], sA[mt], 0, 0, 0);
        sB[mt] = __builtin_amdgcn_mfma_f32_16x16x32_bf16(kf[mt][1], qB[1], sB[mt], 0, 0, 0);
    } }
    bf16x8 vf[4][2]; if constexpr (WITH_V) load_v(F, L, vf);
#pragma unroll
    for (int mt = 0; mt < 4; ++mt)
#pragma unroll
        for (int r = 0; r < 4; ++r) {
            const float ea = __builtin_amdgcn_exp2f(sA[mt][r]), eb = __builtin_amdgcn_exp2f(sB[mt][r]);
            sA[mt][r] = (!MASKED || validA(16 * mt + 4 * L.g + r)) ? ea : 0.f; sB[mt][r] = (!MASKED || validB(16 * mt + 4 * L.g + r)) ? eb : 0.f;
        }
    { const f32x4 t4 = (sA[0] + sA[1]) + (sA[2] + sA[3]); const float ps = (t4[0] + t4[1]) + (t4[2] + t4[3]); lsumA += ps; badv = fmaxf(badv, ps); }
    { const f32x4 t4 = (sB[0] + sB[1]) + (sB[2] + sB[3]); const float ps = (t4[0] + t4[1]) + (t4[2] + t4[3]); lsumB += ps; badv = fmaxf(badv, ps); }
    if constexpr (!WITH_V) return;
    bf16x8 pA[2], pB[2];
#pragma unroll
    for (int ks = 0; ks < 2; ++ks) { const u32x4 wa = pack8(sA[2 * ks], sA[2 * ks + 1]), wb = pack8(sB[2 * ks], sB[2 * ks + 1]); pA[ks] = __builtin_bit_cast(bf16x8, wa); pB[ks] = __builtin_bit_cast(bf16x8, wb); }
#pragma unroll
    for (int dt = 0; dt < 4; ++dt)
#pragma unroll
        for (int ks = 0; ks < 2; ++ks) { oA[dt] = __builtin_amdgcn_mfma_f32_16x16x32_bf16(vf[dt][ks], pA[ks], oA[dt], 0, 0, 0); oB[dt] = __builtin_amdgcn_mfma_f32_16x16x32_bf16(vf[dt][ks], pB[ks], oB[dt], 0, 0, 0); }
}
template <bool WITH_V, class MaskFn>
__device__ __forceinline__ void visit_init(const Frags& F, const Lane& L, const bf16x8 (&q)[2], f32x4 (&o)[4], float& mref, float& lsum, float& badv, bool colsel, const MaskFn& valid) {
    const bool seen = mref != -INFINITY;
    const float c0 = colsel ? (seen ? -mref : 0.f) : -INFINITY;
    const f32x4 ci = (f32x4){c0, c0, c0, c0};
    f32x4 s[4];
    { bf16x8 kf[4][2]; load_k(F, L, kf);
#pragma unroll
    for (int mt = 0; mt < 4; ++mt) {
        s[mt] = __builtin_amdgcn_mfma_f32_16x16x32_bf16(kf[mt][0], q[0], ci, 0, 0, 0);
        s[mt] = __builtin_amdgcn_mfma_f32_16x16x32_bf16(kf[mt][1], q[1], s[mt], 0, 0, 0);
    } }

    bf16x8 vf[4][2]; if constexpr (WITH_V) load_v(F, L, vf);
#pragma unroll
    for (int mt = 0; mt < 4; ++mt)
#pragma unroll
        for (int r = 0; r < 4; ++r) if (!valid(16 * mt + 4 * L.g + r)) s[mt][r] = -INFINITY;
    float mx = fmaxf(fmaxf(s[0][0], s[0][1]), fmaxf(s[0][2], s[0][3]));
#pragma unroll
    for (int mt = 1; mt < 4; ++mt) mx = fmaxf(mx, fmaxf(fmaxf(s[mt][0], s[mt][1]), fmaxf(s[mt][2], s[mt][3])));
    const float mxr = gmax(mx);
    const float d = (!seen && mxr != -INFINITY) ? mxr : 0.f;
    if (!seen && mxr != -INFINITY) mref = mxr;
#pragma unroll
    for (int mt = 0; mt < 4; ++mt)
#pragma unroll
        for (int r = 0; r < 4; ++r) s[mt][r] = __builtin_amdgcn_exp2f(s[mt][r] - d);
    float ps; { const f32x4 t4 = (s[0] + s[1]) + (s[2] + s[3]); ps = (t4[0] + t4[1]) + (t4[2] + t4[3]); }
    lsum += ps; badv = fmaxf(badv, ps);
    if constexpr (WITH_V) {
        bf16x8 pf[2];
#pragma unroll
        for (int ks = 0; ks < 2; ++ks) { const u32x4 w = pack8(s[2 * ks], s[2 * ks + 1]); pf[ks] = __builtin_bit_cast(bf16x8, w); }
#pragma unroll
        for (int dt = 0; dt < 4; ++dt)
#pragma unroll
            for (int ks = 0; ks < 2; ++ks) o[dt] = __builtin_amdgcn_mfma_f32_16x16x32_bf16(vf[dt][ks], pf[ks], o[dt], 0, 0, 0);
    }
}
template <bool MASKED, class MaskFn>
__device__ __forceinline__ void visitB(const Frags& F, const Lane& L, const bf16x8 (&q)[2], f32x4 (&o)[4], float ms, float inv_l, const MaskFn& valid, LAS float* imp_row, int jb) {
    const float c0 = -ms; const f32x4 ci = (f32x4){c0, c0, c0, c0};
    f32x4 s[4];
    { bf16x8 kf[4][2]; load_k(F, L, kf);
#pragma unroll
    for (int mt = 0; mt < 4; ++mt) {
        s[mt] = __builtin_amdgcn_mfma_f32_16x16x32_bf16(kf[mt][0], q[0], ci, 0, 0, 0);
        s[mt] = __builtin_amdgcn_mfma_f32_16x16x32_bf16(kf[mt][1], q[1], s[mt], 0, 0, 0);
    } }

    bf16x8 vf[4][2]; load_v(F, L, vf);
#pragma unroll
    for (int mt = 0; mt < 4; ++mt) {
#pragma unroll
        for (int r = 0; r < 4; ++r) s[mt][r] = (!MASKED || valid(16 * mt + 4 * L.g + r)) ? __builtin_amdgcn_exp2f(s[mt][r]) * inv_l : 0.f;
        float val = (s[mt][0] + s[mt][1]) + (s[mt][2] + s[mt][3]), v3 = s[mt][3];
        val = xor2_add(xor1_add(val)); v3 = xor2_add(xor1_add(v3));
        if ((L.c & 3) == 0) { const int j = jb + 4 * mt + L.g; __hip_atomic_fetch_add(imp_row + j, val, __ATOMIC_RELAXED, __HIP_MEMORY_SCOPE_WORKGROUP);
            if (j + 1 < 128) __hip_atomic_fetch_add(imp_row + j + 1, v3, __ATOMIC_RELAXED, __HIP_MEMORY_SCOPE_WORKGROUP); }
    }
    bf16x8 pf[2];
#pragma unroll
    for (int ks = 0; ks < 2; ++ks) { const u32x4 w = pack8(s[2 * ks], s[2 * ks + 1]); pf[ks] = __builtin_bit_cast(bf16x8, w); }
#pragma unroll
    for (int dt = 0; dt < 4; ++dt)
#pragma unroll
        for (int ks = 0; ks < 2; ++ks) o[dt] = __builtin_amdgcn_mfma_f32_16x16x32_bf16(vf[dt][ks], pf[ks], o[dt], 0, 0, 0);
}
struct HiMask { int hi; __device__ __forceinline__ bool operator()(int key) const { return key <= hi; } };
struct RangeMask { int lo, hi; __device__ __forceinline__ bool operator()(int key) const { return key >= lo && key <= hi; } };
struct LoMask { int lo; __device__ __forceinline__ bool operator()(int key) const { return key >= lo; } };
struct NoMask { __device__ __forceinline__ bool operator()(int) const { return true; } };
__device__ __forceinline__ unsigned ctr_load(LAS unsigned* p) { return (unsigned)__builtin_amdgcn_readfirstlane((int)__hip_atomic_load(p, __ATOMIC_RELAXED, __HIP_MEMORY_SCOPE_WORKGROUP)); }
template <class Body>
__device__ __forceinline__ void stream(LAS unsigned char* lds, const Lane& L, const Src& S, int tile0, int NT, const Body& body) {
    LAS unsigned* ready = (LAS unsigned*)(lds + MISC_OFF + 64);
    LAS unsigned* done = ready + NS;
    __builtin_amdgcn_s_barrier();
    if (L.wave == 0 && L.lane < 2 * NS) ready[L.lane] = 0u;
    asm volatile("s_waitcnt lgkmcnt(0)" ::: "memory");
    __builtin_amdgcn_s_barrier();
    asm volatile("" ::: "memory");
    int issued = 0, published = 0;
    TileAddr A; A.k0 = L.lds0 + L.kbase; A.k1 = L.lds0 + (L.kbase ^ 64u); A.v0 = L.lds0 + 8192u + L.vbase; A.v1 = L.lds0 + 8192u + (L.vbase ^ 32u); A.v2 = L.lds0 + 8192u + (L.vbase ^ 64u); A.v3 = L.lds0 + 8192u + (L.vbase ^ 96u);
    for (int i = 0; i < NT; ++i) {
        asm volatile("s_waitcnt vmcnt(0)" ::: "memory");
        for (; published < issued; ++published) if (L.lane == 0) __hip_atomic_fetch_add(ready + (published & (NS - 1)), 1u, __ATOMIC_RELAXED, __HIP_MEMORY_SCOPE_WORKGROUP);
        for (;;) {
            if (issued >= NT || issued >= i + NS) break;
            const bool must = issued <= i;
            if (issued >= NS) {
                const unsigned want = 8u * (unsigned)(issued / NS);
                if (ctr_load(done + (issued & (NS - 1))) < want) { if (!must) break; while (ctr_load(done + (issued & (NS - 1))) < want) __builtin_amdgcn_s_sleep(1); }
            }
            issue(L, S, tile0 + issued, issued & (NS - 1)); ++issued;
            if (must) { asm volatile("s_waitcnt vmcnt(0)" ::: "memory"); for (; published < issued; ++published) if (L.lane == 0) __hip_atomic_fetch_add(ready + (published & (NS - 1)), 1u, __ATOMIC_RELAXED, __HIP_MEMORY_SCOPE_WORKGROUP); }
        }
        { const unsigned want = 8u * (unsigned)(i / NS + 1); LAS unsigned* rp = ready + (i & (NS - 1)); while (ctr_load(rp) < want) __builtin_amdgcn_s_sleep(1); }
        asm volatile("" ::: "memory");
        body(i, A);
        { const unsigned d = ((i + 1) & (NS - 1)) ? (unsigned)SLOT : (unsigned)(-(NS - 1) * SLOT); A.k0 += d; A.k1 += d; A.v0 += d; A.v1 += d; A.v2 += d; A.v3 += d; }
        asm volatile("s_waitcnt lgkmcnt(0)" ::: "memory");
        if (L.lane == 0) __hip_atomic_fetch_add(done + (i & (NS - 1)), 1u, __ATOMIC_RELAXED, __HIP_MEMORY_SCOPE_WORKGROUP);
    }
    asm volatile("s_waitcnt vmcnt(0) lgkmcnt(0)" ::: "memory");
}
struct Tensors { unsigned char* ws;
    __device__ __forceinline__ const bf16_t* QP_() const { return (const bf16_t*)(ws + WS_QP); }   __device__ __forceinline__ const bf16_t* QR_() const { return (const bf16_t*)(ws + WS_QR); }
    __device__ __forceinline__ const bf16_t* KCMP_() const { return (const bf16_t*)(ws + WS_KCMP); } __device__ __forceinline__ const bf16_t* VCMP_() const { return (const bf16_t*)(ws + WS_VCMP); }
    __device__ __forceinline__ const bf16_t* KS_() const { return (const bf16_t*)(ws + WS_KS); }   __device__ __forceinline__ const bf16_t* VS_() const { return (const bf16_t*)(ws + WS_VS); }
    __device__ __forceinline__ const bf16_t* KW_() const { return (const bf16_t*)(ws + WS_KW); }   __device__ __forceinline__ const bf16_t* VW_() const { return (const bf16_t*)(ws + WS_VW); }
    __device__ __forceinline__ const float* GN_() const { return (const float*)(ws + WS_GN); }     __device__ __forceinline__ bf16_t* PA_() const { return (bf16_t*)(ws + WS_PA); }
};
__device__ __forceinline__ void unit(LAS unsigned char* lds, const Tensors& X, int b, int gk, int u, int wave_s) {
    const int t0 = 128 * u;
    bf16x8 q[4][2]; f32x4 o[4][4]; float m[4], l[4]; float badv;
#define NSA_STAGE() Lane L; { const int ln_ = lane_id(); L.init(ln_ + 64 * wave_s, lds); } \
    const int tw0 = t0 + 16 * L.wave, tl = L.c >> 2; (void)tl; \
    LAS unsigned char* wscr = lds + RING + L.wave * WSCR; (void)wscr; \
    LAS float* impw = (LAS float*)wscr; (void)impw;                   \
    LAS unsigned* bmask = (LAS unsigned*)(wscr + 8192); (void)bmask;     \
    const int qrow32 = (b * SEQ + tw0 + (L.c >> 2)) * 1024 + (gk * 4 + (L.c & 3)) * 64 + 8 * L.g; (void)qrow32;        \
    const LAS float* gate = (const LAS float*)(lds + GATE_OFF + L.wave * 768) + (L.c >> 2) * 12 + (L.c & 3) * 3; (void)gate;     \
    LAS unsigned char* park = wscr + ((size_t)L.c * 64 + 4 * L.g) * 2; (void)park
#define NSA_LOADQ_ISSUE(Qp) do { int qo_ = qrow32; OPAQUE(qo_); const bf16_t* qp_ = (Qp) + (size_t)qo_; _Pragma("unroll") for (int rt = 0; rt < 4; ++rt) _Pragma("unroll") for (int dk = 0; dk < 2; ++dk) q[rt][dk] = *(const bf16x8*)(qp_ + rt * 4096 + 32 * dk); } while (0)
#define NSA_LOADQ_USE() do { _Pragma("unroll") for (int rt = 0; rt < 4; ++rt) _Pragma("unroll") for (int dk = 0; dk < 2; ++dk) asm volatile("" : "+v"(q[rt][dk])); } while (0)
#define NSA_LOADQ(Qp) do { NSA_LOADQ_ISSUE(Qp); NSA_LOADQ_USE(); } while (0)
#define NSA_BAD() (__any(!(badv <= PLIM)))
#define NSA_RESET() do { float z_ = 0.f; OPAQUE(z_); badv = z_; _Pragma("unroll") for (int rt = 0; rt < 4; ++rt) { m[rt] = -INFINITY; l[rt] = z_; _Pragma("unroll") for (int dt = 0; dt < 4; ++dt) o[rt][dt] = (f32x4){z_, z_, z_, z_}; } } while (0)
    {
        NSA_STAGE();
        { float z_ = 0.f; OPAQUE(z_); const f32x4 z4 = (f32x4){z_, z_, z_, z_};
#pragma unroll
        for (int i = 0; i < 8; ++i) *(LAS f32x4*)(impw + (i * 64 + L.lane) * 4) = z4; }
        {
            const float* gsrc = X.GN_() + (size_t)(b * SEQ + tw0) * 48 + gk * 12; LAS float* gdst = (LAS float*)(lds + GATE_OFF + L.wave * 768);
            float gv[3];
#pragma unroll
            for (int k3 = 0; k3 < 3; ++k3) { const int idx = L.lane + 64 * k3; gv[k3] = gsrc[(idx / 12) * 48 + idx % 12]; }
            NSA_LOADQ(X.QP_());
#pragma unroll
            for (int k3 = 0; k3 < 3; ++k3) gdst[L.lane + 64 * k3] = gv[k3];
        }
        NSA_RESET();
        const int nct = ((8 * u + 6) >> 6) + 1;
        const Src S = make_src(X.KCMP_(), X.VCMP_(), (size_t)(b * 4 + gk) * NCP, 64, 0, L);
        stream(lds, L, S, 0, nct, [&](int i, const TileAddr& Ks) {
            const int nb = 64 * i;
            if (tw0 + 15 >= 31 && nb <= ((tw0 + 15 - 31) >> 4)) {
                Frags F; load_frags<false>(Ks, L, F);
#pragma unroll
                for (int pr = 0; pr < 2; ++pr) {
                    const int rA = 2 * pr, rB = rA + 1, twA = tw0 + 4 * rA, twB = twA + 4;
                    const bool nA = twA + 3 >= 31 && nb <= ((twA + 3 - 31) >> 4), nB = twB + 3 >= 31 && nb <= ((twB + 3 - 31) >> 4);
                    const bool inter = twA >= 31 && nb + 63 <= ((twA - 31) >> 4);
                    const int tA = twA + tl, tB = twB + tl;
                    const HiMask hA{(tA >= 31 ? ((tA - 31) >> 4) : -1) - nb}, hB{(tB >= 31 ? ((tB - 31) >> 4) : -1) - nb};
                    (void)inter;
                    if (i == 0) { if (nA) visit_init<false>(F, L, q[rA], o[rA], m[rA], l[rA], badv, true, hA); if (nB) visit_init<false>(F, L, q[rB], o[rB], m[rB], l[rB], badv, true, hB); }
                    else if (nA && nB) visit_fast2<true, false>(F, L, q[rA], q[rB], o[rA], o[rB], m[rA], m[rB], l[rA], l[rB], badv, true, true, hA, hB);
                    else { if (nA) visit_fast<false, true>(F, L, q[rA], o[rA], m[rA], l[rA], badv, true, hA); if (nB) visit_fast<false, true>(F, L, q[rB], o[rB], m[rB], l[rB], badv, true, hB); }
                }
            }
        });
        if (NSA_BAD()) {
            NSA_RESET();
            stream(lds, L, S, 0, nct, [&](int i, const TileAddr& Ks) {
                const int nb = 64 * i;
                if (tw0 + 15 >= 31 && nb <= ((tw0 + 15 - 31) >> 4)) {
                    Frags F; load_frags<false>(Ks, L, F);
#pragma unroll
                    for (int rt = 0; rt < 4; ++rt) {
                        const int twA = tw0 + 4 * rt, tA = twA + tl;
                        if (twA + 3 >= 31 && nb <= ((twA + 3 - 31) >> 4)) visit_slow<false, true>(F, L, q[rt], o[rt], m[rt], l[rt], true, HiMask{(tA >= 31 ? ((tA - 31) >> 4) : -1) - nb});
                    }
                }
            });
        }
        float inv[4], msf[4];
#pragma unroll
        for (int rt = 0; rt < 4; ++rt) { const float lt = gsum(l[rt]); inv[rt] = lt > 0.f ? __builtin_amdgcn_rcpf(lt) : 0.f; msf[rt] = (m[rt] == -INFINITY) ? 0.f : m[rt]; }
        NSA_RESET();
        stream(lds, L, S, 0, nct, [&](int i, const TileAddr& Ks) {
            const int nb = 64 * i;
            if (tw0 + 15 >= 31 && nb <= ((tw0 + 15 - 31) >> 4)) {
                Frags F; load_frags<true>(Ks, L, F);
#pragma unroll
                for (int pr = 0; pr < 2; ++pr) {
                    const int rA = 2 * pr, rB = rA + 1, twA = tw0 + 4 * rA, twB = twA + 4;
                    const bool nA = twA + 3 >= 31 && nb <= ((twA + 3 - 31) >> 4), nB = twB + 3 >= 31 && nb <= ((twB + 3 - 31) >> 4);
                    const bool inter = twA >= 31 && nb + 63 <= ((twA - 31) >> 4);
                    const int tA = twA + tl, tB = twB + tl;
                    const HiMask hA{(tA >= 31 ? ((tA - 31) >> 4) : -1) - nb}, hB{(tB >= 31 ? ((tB - 31) >> 4) : -1) - nb};
                    LAS float* iA = impw + (4 * rA + tl) * 128; LAS float* iB = impw + (4 * rB + tl) * 128;
                    (void)inter;
                    if (nA && nB) visitB2<true>(F, L, q[rA], q[rB], o[rA], o[rB], msf[rA], msf[rB], inv[rA], inv[rB], hA, hB, iA, iB, 16 * i);
                    else { if (nA) visitB<true>(F, L, q[rA], o[rA], msf[rA], inv[rA], hA, iA, 16 * i);
                           if (nB) visitB<true>(F, L, q[rB], o[rB], msf[rB], inv[rB], hB, iB, 16 * i); }
                }
            }
        });
    }
    asm volatile("s_waitcnt lgkmcnt(0)" ::: "memory");
    {
        NSA_STAGE();
        NSA_LOADQ_ISSUE(X.QR_());
        unsigned bm0 = 0u, bm1 = 0u;
        const int jt = tw0 >> 6;
        if (jt <= 15) { bm0 = (L.lane <= jt) ? 0xffffu : 0u; }
        else {
            const int tau = L.lane >> 2, part = L.lane & 3;
            unsigned A[32];
            { const LAS f32x4* src = (const LAS f32x4*)(impw + tau * 128 + part * 32);
#pragma unroll
              for (int i4 = 0; i4 < 8; ++i4) { const f32x4 v = src[i4];
#pragma unroll
                for (int e = 0; e < 4; ++e) { const int j = part * 32 + 4 * i4 + e; A[4 * i4 + e] = (j >= 1 && j <= jt - 2) ? (0x80000000u | __float_as_uint(v[e])) : 0u; } } }
#define TSTEP(J, M) _Pragma("unroll") for (int r = 0; r < 32; ++r) if (!(r & (J))) { const unsigned t_ = ((A[r] >> (J)) ^ A[r + (J)]) & (M); A[r + (J)] ^= t_; A[r] ^= t_ << (J); }
            TSTEP(16, 0x0000FFFFu) TSTEP(8, 0x00FF00FFu) TSTEP(4, 0x0F0F0F0Fu) TSTEP(2, 0x33333333u) TSTEP(1, 0x55555555u)
#undef TSTEP
#define QSUM(x) do { x += __builtin_amdgcn_mov_dpp(x, 0xB1, 0xF, 0xF, true); x += __builtin_amdgcn_mov_dpp(x, 0x4E, 0xF, 0xF, true); } while (0)
            unsigned cand = 0xffffffffu, gt = 0u; int G = 0;
#pragma unroll
            for (int bit = 31; bit >= 0; --bit) {
                const unsigned ones = cand & A[bit];
                int c1 = __builtin_popcount(ones); QSUM(c1);
                const bool take = G + c1 >= 13;
                gt |= take ? 0u : ones; cand = take ? ones : (cand ^ ones); G += take ? 0 : c1;
            }
            int eq = __builtin_popcount(cand);
            const int e0 = __builtin_amdgcn_mov_dpp(eq, 0x00, 0xF, 0xF, true), e1 = __builtin_amdgcn_mov_dpp(eq, 0x55, 0xF, 0xF, true), e2 = __builtin_amdgcn_mov_dpp(eq, 0xAA, 0xF, 0xF, true);
            const int rem = (13 - G) - ((part > 0 ? e0 : 0) + (part > 1 ? e1 : 0) + (part > 2 ? e2 : 0));
            unsigned W = gt, tq = cand;
#pragma unroll
            for (int n = 0; n < 13; ++n) { const unsigned low = (rem > n) ? (tq & (0u - tq)) : 0u; W |= low; tq ^= low; }
            { const int d0 = 0 - 32 * part, d1 = jt - 32 * part, d2 = jt - 1 - 32 * part;
              W |= ((unsigned)d0 < 32u ? 1u << d0 : 0u) | ((unsigned)d1 < 32u ? 1u << d1 : 0u) | ((unsigned)d2 < 32u ? 1u << d2 : 0u); }
#undef QSUM
            LAS unsigned* Wt = (LAS unsigned*)impw;
            asm volatile("s_waitcnt lgkmcnt(0)" ::: "memory");
            Wt[L.lane] = W;
            asm volatile("s_waitcnt lgkmcnt(0)" ::: "memory");
            const int hp = L.lane >> 5, sh = L.lane & 31;
#pragma unroll
            for (int t2 = 0; t2 < 16; ++t2) { const unsigned w0 = Wt[t2 * 4 + hp], w1 = Wt[t2 * 4 + 2 + hp]; bm0 |= ((w0 >> sh) & 1u) << t2; bm1 |= ((w1 >> sh) & 1u) << t2; }
        }
        bmask[L.lane] = bm0; bmask[64 + L.lane] = bm1;
    }
    asm volatile("s_waitcnt lgkmcnt(0)" ::: "memory");
    {
        NSA_STAGE();
#pragma unroll
        for (int rt = 0; rt < 4; ++rt) {
            const float gc = gate[rt * 48];
#pragma unroll
            for (int dt = 0; dt < 4; ++dt) { const f32x4 v = o[rt][dt] * gc; u32x2 w; w.x = cvt_pk_bf16(v[0], v[1]); w.y = cvt_pk_bf16(v[2], v[3]); *(LAS u32x2*)(park + rt * 2048 + dt * 32) = w; }
        }
    }
    {
        NSA_STAGE();
        NSA_LOADQ_USE();
        const int kt_lo = (2 * u - 8) > 0 ? (2 * u - 8) : 0, kt_hi = 2 * u + 1;
        const Src S = make_src(X.KW_(), X.VW_(), (size_t)b * SEQ, 256, gk * 64, L);
        SUBREP(32) { NSA_RESET();
        stream(lds, L, S, kt_lo, kt_hi - kt_lo + 1, [&](int i, const TileAddr& Ks) {
            const int kbase = 64 * (kt_lo + i);
            if (kbase <= tw0 + 15 && kbase + 63 >= tw0 - 511) {
                Frags F; load_frags<true>(Ks, L, F);
#pragma unroll
                for (int pr = 0; pr < 2; ++pr) {
                    const int rA = 2 * pr, rB = rA + 1, twA = tw0 + 4 * rA, twB = twA + 4;
                    const bool nA = kbase <= twA + 3 && kbase + 63 >= twA - 511, nB = kbase <= twB + 3 && kbase + 63 >= twB - 511;
                    const bool inter = kbase + 63 <= twA && kbase >= twB + 3 - 511;
                    const int tA = twA + tl, tB = twB + tl;
                    const bool init = kbase <= (twB + 3 - 511 > 0 ? twB + 3 - 511 : 0);
                    if (init) { if (nA) visit_init<true>(F, L, q[rA], o[rA], m[rA], l[rA], badv, true, RangeMask{tA - 511 - kbase, tA - kbase}); if (nB) visit_init<true>(F, L, q[rB], o[rB], m[rB], l[rB], badv, true, RangeMask{tB - 511 - kbase, tB - kbase}); }
                    else if (nA && nB) { if (inter) visit_fast2<false>(F, L, q[rA], q[rB], o[rA], o[rB], m[rA], m[rB], l[rA], l[rB], badv, true, true, NoMask{}, NoMask{});
                                         else visit_fast2<true>(F, L, q[rA], q[rB], o[rA], o[rB], m[rA], m[rB], l[rA], l[rB], badv, true, true, HiMask{tA - kbase}, HiMask{tB - kbase}); }
                    else if (inter) { if (nA) visit_fast<true, false>(F, L, q[rA], o[rA], m[rA], l[rA], badv, true, NoMask{}); if (nB) visit_fast<true, false>(F, L, q[rB], o[rB], m[rB], l[rB], badv, true, NoMask{}); }
                    else { if (nA) visit_fast<true, true>(F, L, q[rA], o[rA], m[rA], l[rA], badv, true, HiMask{tA - kbase}); if (nB) visit_fast<true, true>(F, L, q[rB], o[rB], m[rB], l[rB], badv, true, HiMask{tB - kbase}); }
                }
            }
        });
        if (NSA_BAD()) {
            NSA_RESET();
            stream(lds, L, S, kt_lo, kt_hi - kt_lo + 1, [&](int i, const TileAddr& Ks) {
                const int kbase = 64 * (kt_lo + i);
                if (kbase <= tw0 + 15 && kbase + 63 >= tw0 - 511) {
                    Frags F; load_frags<true>(Ks, L, F);
#pragma unroll
                    for (int rt = 0; rt < 4; ++rt) {
                        const int twA = tw0 + 4 * rt, tA = twA + tl;
                        if (kbase <= twA + 3 && kbase + 63 >= twA - 511) visit_slow<true, true>(F, L, q[rt], o[rt], m[rt], l[rt], true, RangeMask{tA - 511 - kbase, tA - kbase});
                    }
                }
            });
        }
        }
    }
    {
        NSA_STAGE();
#pragma unroll
        for (int rt = 0; rt < 4; ++rt) {
            const float sc = gate[rt * 48 + 2] * __builtin_amdgcn_rcpf(gsum(l[rt]));
#pragma unroll
            for (int dt = 0; dt < 4; ++dt) {
                LAS u32x2* pp = (LAS u32x2*)(park + rt * 2048 + dt * 32); const u32x2 pw = *pp; const f32x4 v = o[rt][dt] * sc; u32x2 w;
                w.x = cvt_pk_bf16(v[0] + __builtin_bit_cast(float, pw.x << 16), v[1] + __builtin_bit_cast(float, pw.x & 0xffff0000u));
                w.y = cvt_pk_bf16(v[2] + __builtin_bit_cast(float, pw.y << 16), v[3] + __builtin_bit_cast(float, pw.y & 0xffff0000u));
                *pp = w;
            }
        }
    }
    {
        NSA_STAGE();
        const Src S = make_src(X.KS_(), X.VS_(), (size_t)b * SEQ, 256, gk * 64, L);
        if (MK_PROBE == 34) stream(lds, L, S, 0, 2 * u + 2, [&](int j, const TileAddr& Ks) { const unsigned bm = (unsigned)__builtin_amdgcn_readfirstlane((int)bmask[j]); asm volatile("" :: "s"(bm), "v"(Ks.k0)); });
        SUBREP(33) { NSA_RESET();
        stream(lds, L, S, 0, 2 * u + 2, [&](int j, const TileAddr& Ks) {
            const unsigned bm = (unsigned)__builtin_amdgcn_readfirstlane((int)bmask[j]);
            const int kbase = 64 * j; const bool j0 = (j == 0);
            if (bm & 0xffffu) {
                Frags F; load_frags<true>(Ks, L, F);
#pragma unroll
                for (int pr = 0; pr < 2; ++pr) {
                    const int rA = 2 * pr, rB = rA + 1, twA = tw0 + 4 * rA, twB = twA + 4;
                    const bool nA = (bm >> (4 * rA)) & 15u, nB = (bm >> (4 * rB)) & 15u;
                    const bool inter = kbase + 63 <= twA;
                    const bool sA = (bm >> (4 * rA + tl)) & 1u, sB = (bm >> (4 * rB + tl)) & 1u;
                    const HiMask hA{twA + tl - kbase}, hB{twB + tl - kbase};
                    if (j0) { if (nA) visit_init<true>(F, L, q[rA], o[rA], m[rA], l[rA], badv, sA, hA); if (nB) visit_init<true>(F, L, q[rB], o[rB], m[rB], l[rB], badv, sB, hB); }
                    else if (nA && nB && inter) visit_fast2<false>(F, L, q[rA], q[rB], o[rA], o[rB], m[rA], m[rB], l[rA], l[rB], badv, sA, sB, hA, hB);
                    else if (inter) { if (nA) visit_fast<true, false>(F, L, q[rA], o[rA], m[rA], l[rA], badv, sA, hA); if (nB) visit_fast<true, false>(F, L, q[rB], o[rB], m[rB], l[rB], badv, sB, hB); }
                    else { if (nA) visit_fast<true, true>(F, L, q[rA], o[rA], m[rA], l[rA], badv, sA, hA); if (nB) visit_fast<true, true>(F, L, q[rB], o[rB], m[rB], l[rB], badv, sB, hB); }
                }
            }
        });
        if (NSA_BAD()) {
            NSA_RESET();
            stream(lds, L, S, 0, 2 * u + 2, [&](int j, const TileAddr& Ks) {
                const unsigned bm = (unsigned)__builtin_amdgcn_readfirstlane((int)bmask[j]);
                const int kbase = 64 * j;
                if (bm & 0xffffu) {
                    Frags F; load_frags<true>(Ks, L, F);
#pragma unroll
                    for (int rt = 0; rt < 4; ++rt) {
                        const int twA = tw0 + 4 * rt;
                        if ((bm >> (4 * rt)) & 15u) visit_slow<true, true>(F, L, q[rt], o[rt], m[rt], l[rt], (bool)((bm >> (4 * rt + tl)) & 1u), HiMask{twA + tl - kbase});
                    }
                }
            });
        }
        }
    }
    {
        NSA_STAGE();
#pragma unroll
        for (int rt = 0; rt < 4; ++rt) {
            const float sc = gate[rt * 48 + 1] * __builtin_amdgcn_rcpf(gsum(l[rt]));
            int oo_ = (b * SEQ + tw0 + 4 * rt + tl) * 1536 + 512 + (gk * 4 + (L.c & 3)) * 64 + 4 * L.g; OPAQUE(oo_); bf16_t* orow = X.PA_() + (size_t)oo_;
#pragma unroll
            for (int dt = 0; dt < 4; ++dt) {
                const u32x2 pw = *(LAS u32x2*)(park + rt * 2048 + dt * 32); const f32x4 v = o[rt][dt] * sc; u32x2 w;
                w.x = cvt_pk_bf16(v[0] + __builtin_bit_cast(float, pw.x << 16), v[1] + __builtin_bit_cast(float, pw.x & 0xffff0000u));
                w.y = cvt_pk_bf16(v[2] + __builtin_bit_cast(float, pw.y << 16), v[3] + __builtin_bit_cast(float, pw.y & 0xffff0000u));
                *(u32x2*)(orow + 16 * dt) = w;
            }
        }
    }
    asm volatile("s_waitcnt vmcnt(0) lgkmcnt(0)" ::: "memory");
#undef NSA_LOADQ
#undef NSA_LOADQ_ISSUE
#undef NSA_LOADQ_USE
#undef NSA_RESET
#undef NSA_BAD
#undef NSA_STAGE
}
}

#define XB_TMO      128
#define XB_XCNT(j)  (256  + 64 * (j))
#define XB_XSUB(j)  (1280 + 64 * (j))
#define XB_XGEN(j)  (2304 + 64 * (j))
#define XB_TOP      3328
#define XB_TOPGEN   3392
#define XCD_BAR_WORDS 3456
#define XB_SPIN_CAP (1u << 18)
constexpr int CW_FN = 10240;
constexpr int CW_BAR = 4096;
constexpr size_t CTL_ZERO_BYTES = 65536;
__device__ __forceinline__ unsigned xb_ld(unsigned* p)              { return __hip_atomic_load(p, __ATOMIC_RELAXED, __HIP_MEMORY_SCOPE_AGENT); }
__device__ __forceinline__ unsigned xb_add(unsigned* p, unsigned v) { return __hip_atomic_fetch_add(p, v, __ATOMIC_RELAXED, __HIP_MEMORY_SCOPE_AGENT); }
__device__ __forceinline__ unsigned xb_xcc_id() { return (unsigned)__builtin_amdgcn_s_getreg((3 << 11) | 20) & 0xFu; }
#define XB_SPIN(cond, bar) do { unsigned _sp = 0; while (cond) { __builtin_amdgcn_s_sleep(1); \
    if ((++_sp & 255u) == 0u) { if (xb_ld(&(bar)[XB_TMO])) break; if (_sp > XB_SPIN_CAP) { atomicAdd(&(bar)[XB_TMO], 1u); break; } } } } while (0)
struct XcdBarrier { unsigned* bar; unsigned x; volatile LAS unsigned* st; int wave; };
__device__ __forceinline__ XcdBarrier xcd_barrier_post(unsigned* bar, volatile LAS unsigned* st, int wave) {
    XcdBarrier b; b.bar = bar; b.x = xb_xcc_id(); b.st = st; b.wave = wave;
    if (wave == 0 && lane_id() == 0) (void)xb_add(&bar[XB_XCNT(b.x)], 1u);
    return b;
}
__device__ __forceinline__ void xcd_barrier_complete(unsigned* bar, unsigned x, unsigned& nloc, unsigned& nx) {
    const unsigned G = gridDim.x * gridDim.y * gridDim.z;
    unsigned sum, cnt, mine, sp = 0u;
    for (;;) {
        sum = 0u; cnt = 0u; mine = 0u;
#pragma unroll
        for (unsigned j = 0; j < 16; ++j) { const unsigned c = xb_ld(&bar[XB_XCNT(j)]); sum += c; cnt += (c > 0u) ? 1u : 0u; mine = (j == x) ? c : mine; }
        if (sum == G) break;
        __builtin_amdgcn_s_sleep(1);
        if ((++sp & 255u) == 0u) { if (xb_ld(&bar[XB_TMO])) break; if (sp > XB_SPIN_CAP) { atomicAdd(&bar[XB_TMO], 1u); break; } }
    }
    nloc = mine > 0u ? mine : 1u; nx = cnt > 0u ? cnt : 1u;
}
__device__ __forceinline__ void xcd_barrier(const XcdBarrier& b) {
    asm volatile("s_waitcnt vmcnt(0)" ::: "memory");
    __syncthreads();
    if (b.wave == 0 && lane_id() == 0) {
        unsigned* bar = b.bar;
        __builtin_amdgcn_s_waitcnt(0);
        unsigned nloc = b.st[0], nx = b.st[1];
        if (nloc == 0u) { xcd_barrier_complete(bar, b.x, nloc, nx); b.st[0] = nloc; b.st[1] = nx; }
        const unsigned old = xb_add(&bar[XB_XSUB(b.x)], 1u);
        const unsigned gen = old / nloc;
        if (old + 1u == (gen + 1u) * nloc) {
            __builtin_amdgcn_fence(__ATOMIC_RELEASE, "agent");
            asm volatile("s_waitcnt vmcnt(0)" ::: "memory");
            const unsigned og = xb_add(&bar[XB_TOP], 1u);
            const unsigned tg = og / nx;
            if (og + 1u == (tg + 1u) * nx) xb_add(&bar[XB_TOPGEN], 1u);
            else XB_SPIN(xb_ld(&bar[XB_TOPGEN]) == tg, bar);
            __builtin_amdgcn_fence(__ATOMIC_ACQUIRE, "agent");
            xb_add(&bar[XB_XGEN(b.x)], 1u);
            asm volatile("s_waitcnt vmcnt(0)" ::: "memory");
        } else {
            XB_SPIN(xb_ld(&bar[XB_XGEN(b.x)]) == gen, bar);
            __builtin_amdgcn_fence(__ATOMIC_ACQUIRE, "agent");
            asm volatile("s_waitcnt vmcnt(0)" ::: "memory");
        }
    }
    __syncthreads();
}

#ifndef MK_COOP
#define MK_COOP 1
#endif
constexpr int N_PHASES = 9;
#define REP(k) for (int rep_ = 0; rep_ < ((MK_PROBE) == (k) ? 2 : 1); ++rep_)
__device__ __forceinline__ KParams kparams() { KParams p = (KParams)__builtin_amdgcn_kernarg_segment_ptr(); asm volatile("" : "+s"(p)); return p; }
__global__ void __launch_bounds__(NTHREADS, 2) mk_fwd(Params Parg) {
    (void)Parg;
    extern __shared__ __attribute__((aligned(16))) unsigned char lds_raw[];
    LAS unsigned char* lds = (LAS unsigned char*)lds_raw;
    const int wave_k = __builtin_amdgcn_readfirstlane((int)(threadIdx.x >> 6));
    const int G = gridDim.x, bx = blockIdx.x;
    const int vcu = (G % 8 == 0) ? (bx % 8) * (G / 8) + bx / 8 : bx;
    const int NGW = G * NWAVES;
#define PHASE_IDS() int tid = TID_(wave_k); asm volatile("" : "+v"(tid)); const int lane = tid & 63, wave = __builtin_amdgcn_readfirstlane(tid >> 6), gw = vcu * NWAVES + wave; (void)lane; (void)gw
#define ws (kparams()->ws)
#define dout ((char*)kparams()->out)
    const int ph_lo = kparams()->ph_lo, ph_hi = kparams()->ph_hi;
#define WSP(T_, off) ((T_*)(ws + (off)))
#if MK_COOP
#ifndef MK_CG_SYNC
#define MK_CG_SYNC 0
#endif
#if MK_CG_SYNC
#define GRID_SYNC() cg::this_grid().sync()
#else
    volatile LAS unsigned* MISC = (volatile LAS unsigned*)(lds + MISC_OFF);
    if (wave_k == 0 && lane_id() < 32) MISC[lane_id()] = 0u;
    __syncthreads();
    const XcdBarrier xbar = xcd_barrier_post((unsigned*)(ws + WS_CTL) + CW_BAR, MISC + 8, wave_k);
#define GRID_SYNC() xcd_barrier(xbar)
#endif
#else
#define GRID_SYNC() do {} while (0)
#endif
#define IN(k) (ph_lo <= (k) && (k) < ph_hi)
#define SEAM(k) do { if (IN(k) && IN((k) + 1)) GRID_SYNC(); } while (0)
#define H ((bf16_t*)(dout + DO_H))
#define SP ((bf16_t*)(dout + DO_SP))
#define X1 ((float*)dout)

    if (IN(0)) REP(0) { PHASE_IDS(); p0_prologue<0>(kparams(), lds, gw, NGW, wave, lane); }
    SEAM(0);
    if (IN(1)) REP(1) {
        pg8::Gemm g{1024 * 2, 1024 * 2, 128, 128, 16}; pg8::StdSched S; S.init(H, WSP(bf16_t, WS_WIN), T, 5120, 2048, 2048, G, bx);
        EpiIn E{WSP(bf16_t, WS_U), WSP(bf16_t, WS_QP), WSP(bf16_t, WS_QR), WSP(bf16_t, WS_KC), SP, WSP(bf16_t, WS_SA),
                WSP(float, WS_GN), WSP(float, WS_RCOS), WSP(float, WS_RSIN)};
        pg8::gemm_phase<EpiIn, pg8::StdSched, true>(lds, g, S, E, wave_k);
    }
    SEAM(1);
    if (IN(2)) REP(2) {
        const int ncmp = (G == 256) ? 64 : 32;
        if (bx >= ncmp) {
            { PHASE_IDS(); (void)gw; p2_pooled(WSP(bf16_t, WS_U), WSP(bf16_t, WS_PA), (bx - ncmp) * NWAVES + wave, (G - ncmp) * NWAVES, lane); }
            PHASE_IDS(); (void)gw;
            const int fr = lane & 15, fq = lane >> 4; const bf16_t* Wg = WSP(bf16_t, WS_WIN) + (size_t)5120 * 1024; float* GNp = WSP(float, WS_GN);
#pragma unroll 1
            for (int it = (((bx - ncmp) * NWAVES + wave) % 3) ? T / 32 : ((bx - ncmp) * NWAVES + wave) / 3; it < T / 32; it += ((G - ncmp) * NWAVES + 2) / 3) {
                const int r0 = 32 * it; f32x4 c2[2][3];
#pragma unroll
                for (int mt = 0; mt < 2; ++mt)
#pragma unroll
                    for (int nt = 0; nt < 3; ++nt) c2[mt][nt] = (f32x4){0.f, 0.f, 0.f, 0.f};
#pragma unroll 4
                for (int k0 = 0; k0 < 1024; k0 += 32) {
                    bf16x8 a[2], b[3];
#pragma unroll
                    for (int mt = 0; mt < 2; ++mt) a[mt] = *(const bf16x8*)(H + (size_t)(r0 + 16 * mt + fr) * 1024 + k0 + 8 * fq);
#pragma unroll
                    for (int nt = 0; nt < 3; ++nt) b[nt] = *(const bf16x8*)(Wg + (size_t)(16 * nt + fr) * 1024 + k0 + 8 * fq);
#pragma unroll
                    for (int mt = 0; mt < 2; ++mt)
#pragma unroll
                        for (int nt = 0; nt < 3; ++nt) c2[mt][nt] = __builtin_amdgcn_mfma_f32_16x16x32_bf16(a[mt], b[nt], c2[mt][nt], 0, 0, 0);
                }
#pragma unroll
                for (int mt = 0; mt < 2; ++mt)
#pragma unroll
                    for (int nt = 0; nt < 3; ++nt)
#pragma unroll
                        for (int r = 0; r < 4; ++r) GNp[(size_t)(r0 + 16 * mt + 4 * fq + r) * 48 + 16 * nt + fr] = sigmoidf_(c2[mt][nt][r] + 0.f);
            }
            if (G != 256) p0_prologue<1>(kparams(), lds, (bx - ncmp) * NWAVES + wave, (G - ncmp) * NWAVES, wave, lane);
        }
        __syncthreads();
        const int split = (G == 256) ? 1 : 0;
        pg8::Gemm g{4096 * 2, 2048 * 2, 512, 128, split ? 16 : 32, (split && (bx & 1)) ? -128 * 4096 * 2 : 0};
        CmpSched S{(const char*)WSP(bf16_t, WS_KC), (const char*)WSP(bf16_t, WS_VC), (const char*)WSP(bf16_t, WS_W1K), (const char*)WSP(bf16_t, WS_W1V), bx, split};
        EpiCmp E{WSP(bf16_t, WS_HIDK), WSP(bf16_t, WS_HIDV), WSP(float, WS_PEBK), WSP(float, WS_PEBV), WSP(bf16_t, WS_W2K), WSP(bf16_t, WS_W2V), WSP(bf16_t, WS_KCMP), WSP(bf16_t, WS_VCMP), ws, split};
        pg8::gemm_phase<EpiCmp, CmpSched, false>(lds, g, S, E, wave_k);
    }
    SEAM(2);
    if (IN(3)) REP(3) {
        const nsa::Tensors X{ws};
        const int wave_s = wave_k;
#pragma unroll 1
        for (int uu = vcu; uu < 256; uu += G) { const int bg = uu >> 5, i = uu & 31;
#pragma unroll 1
            for (int hh = 0; hh < 2; ++hh) nsa::unit(lds, X, bg >> 2, bg & 3, hh ? 63 - i : i, wave_s); }
        if (G == 256) {
            __syncthreads();
            PHASE_IDS(); (void)gw;
            late_weights_queue(kparams(), lds, wave, lane);
        }
    }
    SEAM(3);
    if (IN(4)) REP(4) {
        pg8::Gemm g{1536 * 2, 1536 * 2, 128, 128, 24}; pg8::StdSched S; S.init(WSP(bf16_t, WS_PA), WSP(bf16_t, WS_WM), T, 1024, 3072, 3072, G, bx);
        EpiMerged E{WSP(bf16_t, WS_MG), SP, WSP(bf16_t, WS_SA)};
        pg8::gemm_phase<EpiMerged, pg8::StdSched, false>(lds, g, S, E, wave_k);
    }
    SEAM(4);
    if (IN(5)) REP(5) {
        pg8::Gemm g{1024 * 2, 1024 * 2, 128, 128, 16}; pg8::StdSched S; S.init(WSP(bf16_t, WS_MG), WSP(bf16_t, WS_WO), T, 1024, 2048, 2048, G, bx);
        EpiX1 E{kparams()->x, X1, WSP(bf16_t, WS_X1B), WSP(float, WS_RS1)};
        pg8::gemm_phase<EpiX1, pg8::StdSched, false>(lds, g, S, E, wave_k);
    }
    SEAM(5);
    if (IN(6)) REP(6) {
        pg8::Gemm g{1024 * 2, 1024 * 2, 128, 128, 16}; pg8::StdSched S; S.init(WSP(bf16_t, WS_X1B), WSP(bf16_t, WS_WGU), T, 5632, 2048, 2048, G, bx);
        EpiAct E{WSP(bf16_t, WS_ACT), WSP(float, WS_RS1)};
        pg8::gemm_phase<EpiAct, pg8::StdSched, true>(lds, g, S, E, wave_k);
    }
    SEAM(6);
    if (IN(7)) {
        pg8::Gemm g{DFF * 2, DFF * 2, 128, 128, DFF / 64}; pg8::StdSched S; S.init(WSP(bf16_t, WS_ACT), WSP(bf16_t, WS_WD), T, 1024, DFF * 2, DFF * 2, G, bx);
        if (G == 256) {
            EpiFinal E{X1, WSP(bf16_t, WS_X1B), kparams()->normf_w, WSP(float, WS_SEL), (unsigned*)(ws + WS_CTL) + CW_FN};
            pg8::gemm_phase<EpiFinal, pg8::StdSched, false>(lds, g, S, E, wave_k);
        } else {
            EpiX2 E{X1, WSP(bf16_t, WS_X1B)};
            pg8::gemm_phase<EpiX2, pg8::StdSched, false>(lds, g, S, E, wave_k);
        }
    }
    if (G != 256) {
    SEAM(7);
    if (IN(8)) {
        PHASE_IDS();
        for (int row = gw; row < T; row += NGW) {
            f32x4* xr = (f32x4*)(X1 + (size_t)row * DM) + lane; const f32x4* wr = (const f32x4*)kparams()->normf_w + lane;
            f32x4 v[4]; float s = 0.f;
#pragma unroll
            for (int j = 0; j < 4; ++j) { v[j] = xr[64 * j]; s += (v[j].x * v[j].x + v[j].y * v[j].y) + (v[j].z * v[j].z + v[j].w * v[j].w); }
            const float rstd = rsqrtf(wave_sum(s) * (1.f / DM) + RMS_EPS);
#pragma unroll
            for (int j = 0; j < 4; ++j) { const f32x4 ww = wr[64 * j]; xr[64 * j] = (f32x4){v[j].x * rstd * ww.x, v[j].y * rstd * ww.y, v[j].z * rstd * ww.z, v[j].w * rstd * ww.w}; }
        }
    }
    }
#undef WSP
#undef ws
#undef dout
#undef H
#undef SP
#undef X1
}

extern "C" void kernel_launch(void* const* d_in, const int* in_sizes, int n_in, void* d_out, int out_size, void* d_ws, size_t ws_size, hipStream_t stream) {
    static int grid = 0;
    if (grid == 0) {
        if (n_in != 21 || ws_size < WS_END || out_size != T * DM) { fprintf(stderr, "kernel_launch: unexpected shapes n_in %d ws %zu out %d\n", n_in, ws_size, out_size); grid = -1; return; }
        int dev = 0, cus = 0, per_cu = 0;
        if (hipGetDevice(&dev) != hipSuccess || hipDeviceGetAttribute(&cus, hipDeviceAttributeMultiprocessorCount, dev) != hipSuccess) { grid = -1; return; }
        if (hipFuncSetAttribute((const void*)mk_fwd, hipFuncAttributeMaxDynamicSharedMemorySize, LDS_BYTES) != hipSuccess) { fprintf(stderr, "kernel_launch: hipFuncSetAttribute failed\n"); grid = -1; return; }
        if (hipOccupancyMaxActiveBlocksPerMultiprocessor(&per_cu, (const void*)mk_fwd, NTHREADS, LDS_BYTES) != hipSuccess || per_cu < 1) { fprintf(stderr, "kernel_launch: occupancy query says %d\n", per_cu); (void)hipGetLastError(); per_cu = 1; }
        grid = cus;
    }
    if (grid < 0) return;
    Params p{};
    const float** pin = (const float**)&p;
    for (int i = 0; i < 21; ++i) pin[i] = (const float*)d_in[i];
    p.out = (float*)d_out; p.ws = (unsigned char*)d_ws;
#if MK_COOP
    p.ph_lo = 0; p.ph_hi = N_PHASES;
    if (hipMemsetAsync((char*)d_ws + WS_CTL, 0, CTL_ZERO_BYTES, stream) != hipSuccess) { fprintf(stderr, "kernel_launch: memset failed\n"); return; }
    void* args[] = {&p};
    hipError_t e = hipLaunchCooperativeKernel((const void*)mk_fwd, dim3(grid), dim3(NTHREADS), args, LDS_BYTES, stream);
    if (e != hipSuccess) fprintf(stderr, "kernel_launch: cooperative launch failed: %s (grid %d)\n", hipGetErrorString(e), grid);
#else
    for (int ph = 0; ph < N_PHASES; ++ph) { p.ph_lo = ph; p.ph_hi = ph + 1; hipLaunchKernelGGL(mk_fwd, dim3(grid), dim3(NTHREADS), LDS_BYTES, stream, p); }
#endif
}
```

```cpp
#include <hip/hip_runtime.h>
#include <hip/hip_cooperative_groups.h>
#include <cstdint>
#include <cstdio>
namespace cg = cooperative_groups;
#ifndef MK_PROBE
#define MK_PROBE -1
#endif
#define SUBREP(k) for (int srep_ = 0; srep_ < ((MK_PROBE) == (k) ? 2 : 1); ++srep_)

#define LAS __attribute__((address_space(3)))
typedef unsigned short bf16_t;
typedef short bf16x8 __attribute__((ext_vector_type(8)));
typedef float f32x4 __attribute__((ext_vector_type(4)));
typedef unsigned u32x4 __attribute__((ext_vector_type(4)));
typedef unsigned u32x2 __attribute__((ext_vector_type(2)));

constexpr int BATCH = 2, SEQ = 8192, T = BATCH * SEQ, DM = 1024;
constexpr int NREF = 5168, NIN = 5376;
constexpr int DFF = 2816;
constexpr int NCP = 512;
constexpr float RMS_EPS = 1e-6f;
constexpr float C2 = 0.125f * 1.4426950408889634f;
constexpr int NWAVES = 8, NTHREADS = 512;

constexpr size_t MiB = 1u << 20;
constexpr size_t WS_CTL = 0;
constexpr size_t WS_PEBK = 1 * MiB, WS_PEBV = 1 * MiB + 4096, WS_RCOS = 1 * MiB + 65536, WS_RSIN = WS_RCOS + 262144;
constexpr size_t WS_RS1 = 2 * MiB;
constexpr size_t WS_SEL = 3 * MiB;
constexpr size_t WS_KCMP = 4 * MiB, WS_VCMP = 4 * MiB + 512 * 1024;
constexpr size_t WS_W2K = 5 * MiB, WS_W2V = 5 * MiB + 65536;
constexpr size_t WS_W1K = 6 * MiB, WS_W1V = 7 * MiB;
constexpr size_t WS_WIN = 8 * MiB;
constexpr size_t WS_WM = 19 * MiB;
constexpr size_t WS_WO = 22 * MiB;
constexpr size_t WS_WGU = 24 * MiB;
constexpr size_t WS_WD = 35 * MiB;
constexpr size_t WS_GN = 41 * MiB;
constexpr size_t WS_U = 44 * MiB;
constexpr size_t WS_QP = 60 * MiB;
constexpr size_t WS_MG = 60 * MiB;
constexpr size_t WS_KC = 92 * MiB, WS_VC = 100 * MiB, WS_KS = 108 * MiB, WS_VS = 116 * MiB, WS_KW = 124 * MiB, WS_VW = 132 * MiB;
constexpr size_t WS_SA = 140 * MiB;
constexpr size_t WS_PA = 172 * MiB;
constexpr size_t WS_QR = 220 * MiB;
constexpr size_t WS_X1B = 220 * MiB;
constexpr size_t WS_HIDK = 252 * MiB, WS_HIDV = 254 * MiB;
constexpr size_t WS_ACT = 44 * MiB;
constexpr size_t WS_END = 256 * MiB;
constexpr size_t DO_H = 0, DO_SP = 32 * MiB;

constexpr int RING_BYTES = 131072;
constexpr int MISC_OFF = 147456 - 256;
constexpr int GATE_OFF = 147456;
constexpr int LDS_BYTES = 147456 + 8 * 768;

__device__ __forceinline__ unsigned f2bf(float f) { unsigned u = __builtin_bit_cast(unsigned, f); return (u + 0x7fffu + ((u >> 16) & 1u)) >> 16; }
__device__ __forceinline__ float bf2f(unsigned b) { return __builtin_bit_cast(float, (b & 0xffffu) << 16); }
__device__ __forceinline__ unsigned pk2(float lo, float hi) { return f2bf(lo) | (f2bf(hi) << 16); }
typedef float f32x2_t __attribute__((ext_vector_type(2))); typedef __bf16 bf16x2_t __attribute__((ext_vector_type(2)));
__device__ __forceinline__ unsigned cvt_pk_bf16(float lo, float hi) { f32x2_t v = {lo, hi}; bf16x2_t b = __builtin_convertvector(v, bf16x2_t); return __builtin_bit_cast(unsigned, b); }
__device__ __forceinline__ u32x4 pack8(const f32x4& a, const f32x4& b) { u32x4 w; w.x = cvt_pk_bf16(a[0], a[1]); w.y = cvt_pk_bf16(a[2], a[3]); w.z = cvt_pk_bf16(b[0], b[1]); w.w = cvt_pk_bf16(b[2], b[3]); return w; }
__device__ __forceinline__ void unpack8(const u32x4& w, f32x4& a, f32x4& b) {
    a[0] = __builtin_bit_cast(float, w.x << 16); a[1] = __builtin_bit_cast(float, w.x & 0xffff0000u); a[2] = __builtin_bit_cast(float, w.y << 16); a[3] = __builtin_bit_cast(float, w.y & 0xffff0000u);
    b[0] = __builtin_bit_cast(float, w.z << 16); b[1] = __builtin_bit_cast(float, w.z & 0xffff0000u); b[2] = __builtin_bit_cast(float, w.w << 16); b[3] = __builtin_bit_cast(float, w.w & 0xffff0000u); }
__device__ __forceinline__ float sigmoidf_(float v) { return __builtin_amdgcn_rcpf(1.f + __expf(-v)); }
__device__ __forceinline__ float wave_sum(float v) {
#pragma unroll
    for (int o = 1; o < 64; o <<= 1) v += __shfl_xor(v, o);
    return v;
}
__device__ __forceinline__ float wave_max(float v) {
#pragma unroll
    for (int o = 1; o < 64; o <<= 1) v = fmaxf(v, __shfl_xor(v, o));
    return v;
}
#define WSYNC() asm volatile("s_waitcnt lgkmcnt(0)" ::: "memory")
__device__ __forceinline__ int lane_id() { int r; asm volatile("v_mbcnt_lo_u32_b32 %0, -1, 0\n\tv_mbcnt_hi_u32_b32 %0, -1, %0" : "=v"(r)); return r; }
#define TID_(wv) (64 * (wv) + lane_id())
#define OPAQUE(x) asm volatile("" : "+v"(x))
__host__ __device__ __forceinline__ int incol_ref(int c) {
    if (c < 3072) return c;
    if (c < 4096) return 3120 + (c - 3072);
    if (c < 5120) return 4144 + (c - 4096);
    if (c < 5168) return 3072 + (c - 5120);
    return -1;
}

struct Params {
    const float *x, *norm1_w, *w_in, *pool_w, *pool_scale, *pe_k, *w1_k, *b1_k, *w2_k, *pe_v, *w1_v, *b1_v, *w2_v, *w_pp, *w_pa, *w_out, *norm2_w, *w_g, *w_u, *w_d, *normf_w;
    float* out; unsigned char* ws;
    int ph_lo, ph_hi;
};

typedef const __attribute__((address_space(4))) Params* KParams;
namespace pg8 {
constexpr int BM = 256, BK = 64, HALF = 128, HTB = HALF * BK * 2, STAGE_BYTES = 8 * HTB, NXCD = 8, WGM = 8;
__host__ __device__ __forceinline__ int lds_byte(int r, int c) { const int st = (r >> 4) * 2 + (c >> 5), rr = r & 15, cc = c & 31, ob = rr * 64 + cc * 2; return st * 1024 + (ob ^ (((ob >> 9) & 1) << 5)); }
__host__ __device__ __forceinline__ void stage_rc(int b, int& R, int& C) { const int st = b / 1024, sb = b % 1024, swz = sb ^ (((sb >> 9) & 1) << 5); R = (st >> 1) * 16 + swz / 64; C = (st & 1) * 32 + (swz % 64) / 2; }
__host__ __device__ __forceinline__ int perm32(int rho) { const int n = rho >> 4, i = rho & 15; return 8 * (i >> 2) + 4 * n + (i & 3); }

struct Unit { int pm, pn; const char* A; const char* B; };
struct Gemm { int lda, ldb, ksA, ksB, nt, hsA; };

struct StaticOrder {
    int nM, nN, nwg, G, c;
    __device__ void init(int M, int N, int G_, int c_) { nM = M / BM; nN = N / BM; nwg = nM * nN; G = G_; c = c_; }
    __device__ bool next(int i, int& pm, int& pn) const {
        const long L = (long)i * G + c; if (L >= nwg) return false;
        int wgid = (int)L; { const int q = nwg / NXCD, r = nwg % NXCD, xcd = wgid % NXCD, off = wgid / NXCD; wgid = (xcd < r ? xcd * (q + 1) : r * (q + 1) + (xcd - r) * q) + off; }
        const int nig = WGM * nN, gid = wgid / nig, fm = gid * WGM, gsz = (nM - fm) < WGM ? (nM - fm) : WGM;
        pm = fm + ((wgid % nig) % gsz); pn = (wgid % nig) / gsz; return true;
    }
};
struct StdSched {
    StaticOrder so; const char* A; const char* B; size_t tA, tB;
    __device__ void init(const void* A_, const void* B_, int M, int N, int lda_bytes, int ldb_bytes, int G, int c) { so.init(M, N, G, c); A = (const char*)A_; B = (const char*)B_; tA = (size_t)256 * lda_bytes; tB = (size_t)256 * ldb_bytes; }
    __device__ bool next(int i, Unit& u) const { if (!so.next(i, u.pm, u.pn)) return false; u.A = A + u.pm * tA; u.B = B + u.pn * tB; return true; }
};

template <class Epi, class Sched, bool ALIGN_EPI>
__device__ __forceinline__ void gemm_phase(LAS unsigned char* lds, const Gemm g, const Sched& S, const Epi& E, int wave_k) {
    int tid = TID_(wave_k); asm volatile("" : "+v"(tid));
    const int wid = __builtin_amdgcn_readfirstlane(tid >> 6), lane = tid & 63, wr = wid >> 2, wc = wid & 3, fr = lane & 15, fq = lane >> 4;
    const int nt = g.nt;
    unsigned voffA[2], voffB[2];
#pragma unroll
    for (int i = 0; i < 2; ++i) { int R, C; stage_rc(tid * 16 + i * 8192, R, C); const int Rb = (R & ~31) + perm32(R & 31);
        voffA[i] = (unsigned)(R * g.lda + C * 2); voffB[i] = (unsigned)(Rb * g.ldb + C * 2); }
    const size_t kstepA = (size_t)g.ksA, kstepB = (size_t)g.ksB;
    const ptrdiff_t hstepA = g.hsA ? (ptrdiff_t)g.hsA : (ptrdiff_t)HALF * g.lda; const size_t hstepB = (size_t)HALF * g.ldb;
    const unsigned ldsw = (unsigned)wid * 1024u;
    const int aoff = lds_byte(wr * 64 + fr, fq * 8), boff = lds_byte(wc * 32 + fr, fq * 8);
#define PG8_SA(b, h) (((b) * 2 + (h)) * HTB)
#define PG8_SB(b, h) ((4 + (b) * 2 + (h)) * HTB)
#define PG8_STAGE(bufoff, gbase, voff) do { _Pragma("unroll") for (int _i = 0; _i < 2; ++_i) \
        __builtin_amdgcn_global_load_lds((const unsigned*)((const char*)(gbase) + (voff)[_i]), (LAS unsigned*)(lds + (bufoff) + ldsw + _i * 8192), 16, 0, 0); } while (0)
#define PG8_LDA(dst, b, h) do { _Pragma("unroll") for (int m = 0; m < 4; ++m) _Pragma("unroll") for (int k = 0; k < 2; ++k) dst[m][k] = *(const LAS bf16x8*)(lds + PG8_SA(b, h) + aoff + m * 2048 + k * 1024); } while (0)
#define PG8_LDB(dst, b, h) do { _Pragma("unroll") for (int n = 0; n < 2; ++n) _Pragma("unroll") for (int k = 0; k < 2; ++k) dst[n][k] = *(const LAS bf16x8*)(lds + PG8_SB(b, h) + boff + n * 2048 + k * 1024); } while (0)
#define PG8_MMA(ai, bj, At, Bt) do { __builtin_amdgcn_s_setprio(1); _Pragma("unroll") for (int m = 0; m < 4; ++m) _Pragma("unroll") for (int n = 0; n < 2; ++n) _Pragma("unroll") for (int k = 0; k < 2; ++k) \
        acc[ai][bj][m][n] = __builtin_amdgcn_mfma_f32_16x16x32_bf16(Bt[n][k], At[m][k], acc[ai][bj][m][n], 0, 0, 0); __builtin_amdgcn_s_setprio(0); } while (0)
#define PG8_WAIT_V(n) asm volatile("s_waitcnt vmcnt(" #n ")" ::: "memory")
#define PG8_WAIT_L(n) asm volatile("s_waitcnt lgkmcnt(" #n ")" ::: "memory")
#define PG8_BAR __builtin_amdgcn_s_barrier()
#define PG8_SCHED __builtin_amdgcn_sched_barrier(0)
    Unit cur, nxt; int ui = 0;
    if (!S.next(0, cur)) return;
    f32x4 acc[2][2][4][2];
#pragma unroll
    for (int a = 0; a < 2; ++a)
#pragma unroll
        for (int b = 0; b < 2; ++b)
#pragma unroll
            for (int m = 0; m < 4; ++m)
#pragma unroll
                for (int n = 0; n < 2; ++n) acc[a][b][m][n] = (f32x4){0.f, 0.f, 0.f, 0.f};
    bf16x8 At[4][2], B0[2][2], B1[2][2];
    const char* cA = cur.A; const char* cB = cur.B;
    PG8_STAGE(PG8_SB(0, 0), cB, voffB); PG8_STAGE(PG8_SB(0, 1), cB + hstepB, voffB); PG8_STAGE(PG8_SA(0, 0), cA, voffA); PG8_STAGE(PG8_SA(0, 1), cA + hstepA, voffA);
    if (wr == 1) PG8_BAR;
    PG8_WAIT_V(2); PG8_BAR;
    PG8_STAGE(PG8_SB(1, 0), cB + kstepB, voffB); PG8_STAGE(PG8_SA(1, 0), cA + kstepA, voffA); PG8_STAGE(PG8_SB(1, 1), cB + hstepB + kstepB, voffB);
    PG8_WAIT_V(6); PG8_BAR;
    for (;;) {
        const bool has_next = S.next(ui + 1, nxt);
        const char* nA = has_next ? nxt.A : cA; const char* nB = has_next ? nxt.B : cB;
        for (int t = 0; t < nt; t += 2) {
            const bool last = (t == nt - 2);
            const char* a1 = cA + (size_t)(t + 1) * kstepA;
            const char* a2 = last ? nA : cA + (size_t)(t + 2) * kstepA; const char* b2 = last ? nB : cB + (size_t)(t + 2) * kstepB;
            const char* a3 = a2 + kstepA; const char* b3 = b2 + kstepB;
            PG8_LDB(B0, 0, 0); PG8_LDB(B1, 0, 1); PG8_SCHED; PG8_LDA(At, 0, 0); PG8_STAGE(PG8_SA(1, 1), a1 + hstepA, voffA);
            PG8_WAIT_V(8); PG8_WAIT_L(0); PG8_BAR; PG8_MMA(0, 0, At, B0); PG8_MMA(0, 1, At, B1); PG8_BAR; PG8_SCHED;
            PG8_LDA(At, 0, 1); PG8_STAGE(PG8_SB(0, 0), b2, voffB); PG8_STAGE(PG8_SB(0, 1), b2 + hstepB, voffB); PG8_STAGE(PG8_SA(0, 0), a2, voffA);
            PG8_WAIT_V(8); PG8_WAIT_L(0); PG8_BAR; PG8_MMA(1, 0, At, B0); PG8_MMA(1, 1, At, B1); PG8_BAR; PG8_SCHED;
            PG8_LDB(B0, 1, 0); PG8_LDB(B1, 1, 1); PG8_SCHED; PG8_LDA(At, 1, 0); PG8_STAGE(PG8_SA(0, 1), a2 + hstepA, voffA);
            PG8_WAIT_V(8); PG8_WAIT_L(0); PG8_BAR; PG8_MMA(0, 0, At, B0); PG8_MMA(0, 1, At, B1); PG8_BAR; PG8_SCHED;
            PG8_LDA(At, 1, 1); PG8_STAGE(PG8_SB(1, 0), b3, voffB); PG8_STAGE(PG8_SB(1, 1), b3 + hstepB, voffB); PG8_STAGE(PG8_SA(1, 0), a3, voffA);
            PG8_WAIT_V(8); PG8_WAIT_L(0); PG8_BAR; PG8_MMA(1, 0, At, B0); PG8_MMA(1, 1, At, B1); PG8_BAR; PG8_SCHED;
            if constexpr (Epi::HOOK_KT > 0) { if (t + 2 == Epi::HOOK_KT) { E.hook(acc, cur, wr, wc, fr, fq); PG8_WAIT_V(0); PG8_SCHED; } }
        }
        if constexpr (ALIGN_EPI) { if (wr == 0) PG8_BAR; }
        if constexpr (!Epi::AFTER_DRAIN) { E(acc, cur, wr, wc, fr, fq); }
        if (!has_next) break;
#pragma unroll
        for (int a = 0; a < 2; ++a)
#pragma unroll
            for (int b = 0; b < 2; ++b)
#pragma unroll
                for (int m = 0; m < 4; ++m)
#pragma unroll
                    for (int n = 0; n < 2; ++n) acc[a][b][m][n] = (f32x4){0.f, 0.f, 0.f, 0.f};
        cur = nxt; cA = nA; cB = nB; ++ui;
        if constexpr (ALIGN_EPI) { if (wr == 1) PG8_BAR; }
    }
    PG8_WAIT_V(0);
    if constexpr (!ALIGN_EPI) { if (wr == 0) PG8_BAR; }
    PG8_BAR;
    if constexpr (Epi::AFTER_DRAIN) { E.fused(acc, cur, wr, wc, fr, fq, wid, lane, lds); }
#undef PG8_SA
#undef PG8_SB
#undef PG8_STAGE
#undef PG8_LDA
#undef PG8_LDB
#undef PG8_MMA
#undef PG8_WAIT_V
#undef PG8_WAIT_L
#undef PG8_BAR
#undef PG8_SCHED
}
}
using pg8::Unit;
typedef f32x4 Acc[2][2][4][2];
#define EPI_ROW(u, ai, wr, m, fr) ((u).pm * 256 + (ai) * 128 + (wr) * 64 + (m) * 16 + (fr))
#define EPI_LC(bj, wc, fq) ((bj) * 128 + (wc) * 32 + (fq) * 8)

constexpr int CW_XC = 14600;
struct EpiIn {
    static constexpr bool AFTER_DRAIN = false; static constexpr int HOOK_KT = 0;
    bf16_t *U, *QP, *QR, *KV0, *SP, *SA; float* GN; const float* RC; const float* RS;
    __device__ __forceinline__ void rope8(f32x4& v0, f32x4& v1, int t, bool apply, int fq) const {
        f32x4 p0, p1;
#pragma unroll
        for (int e = 0; e < 4; ++e) { p0[e] = __shfl_xor(v0[e], 16); p1[e] = __shfl_xor(v1[e], 16); }
        if (apply) {
            const f32x4 c0 = *(const f32x4*)(RC + t * 8), c1 = *(const f32x4*)(RC + t * 8 + 4), s0 = *(const f32x4*)(RS + t * 8), s1 = *(const f32x4*)(RS + t * 8 + 4);
            const float sg = (fq & 1) ? 1.f : -1.f;
            v0 = v0 * c0 + (p0 * s0) * sg; v1 = v1 * c1 + (p1 * s1) * sg;
        }
    }
    __device__ __forceinline__ void operator()(const Acc& acc, const Unit& u, int wr, int wc, int fr, int fq) const {
        OPAQUE(fr); OPAQUE(fq);
        const int pn = u.pn; const bool ropel = ((wc & 1) == 0) && fq < 2;
#pragma unroll
        for (int ai = 0; ai < 2; ++ai)
#pragma unroll
            for (int m = 0; m < 4; ++m) {
                const int r = EPI_ROW(u, ai, wr, m, fr), t = r & (SEQ - 1);
#pragma unroll
                for (int bj = 0; bj < 2; ++bj) {
                    const int lc = EPI_LC(bj, wc, fq); f32x4 v0 = acc[ai][bj][m][0], v1 = acc[ai][bj][m][1];
                    if (pn < 2) { *(u32x4*)(U + (size_t)r * 512 + pn * 256 + lc) = pack8(v0, v1); }
                    else if (pn < 6) {
                        v0 = v0 * C2; v1 = v1 * C2; const size_t o = (size_t)r * 1024 + (pn - 2) * 256 + lc;
                        *(u32x4*)(QP + o) = pack8(v0, v1);
                        if ((wc & 1) == 0) rope8(v0, v1, t, ropel, fq);
                        *(u32x4*)(QR + o) = pack8(v0, v1);
                    } else if (pn < 12) {
                        const int ty = pn - 6; bf16_t* dst = KV0 + (size_t)ty * (size_t)(4u << 20);
                        if ((ty == 2 || ty == 4) && (wc & 1) == 0) rope8(v0, v1, t, ropel, fq);
                        *(u32x4*)(dst + (size_t)r * 256 + lc) = pack8(v0, v1);
                    } else if (pn < 20) {
                        bf16_t* dst = pn < 16 ? SP : SA; const int cb = ((pn - 12) & 3) * 256 + lc;
#pragma unroll
                        for (int e = 0; e < 4; ++e) { v0[e] = sigmoidf_(v0[e]); v1[e] = sigmoidf_(v1[e]); }
                        *(u32x4*)(dst + (size_t)r * 1024 + cb) = pack8(v0, v1);
                    } else if (lc < 48) {
#pragma unroll
                        for (int e = 0; e < 4; ++e) { v0[e] = sigmoidf_(v0[e]); v1[e] = sigmoidf_(v1[e]); }
                        *(f32x4*)(GN + (size_t)r * 48 + lc) = v0; *(f32x4*)(GN + (size_t)r * 48 + lc + 4) = v1;
                    }
                }
            }
    }
};
__device__ __forceinline__ float gelu_tanh(float x) { const float u = 0.7978845608028654f * (x + 0.044715f * x * x * x); const float e = __expf(2.f * u); return 0.5f * x * (1.f + (1.f - 2.f * __builtin_amdgcn_rcpf(e + 1.f))); }
struct EpiCmp {
    static constexpr bool AFTER_DRAIN = true; static constexpr int HOOK_KT = 0;
    bf16_t *HIDK, *HIDV; const float *PEBK, *PEBV; const bf16_t *W2K, *W2V; bf16_t *KCMP, *VCMP; unsigned char* wsb; int split;
    template <int AI> __device__ __forceinline__ void gelu_half(const Acc& acc, bf16_t* HID, const float* peb, int rbase, int wr, int wc, int fr, int fq) const {
#pragma unroll
        for (int bj = 0; bj < 2; ++bj) {
            const int lc = EPI_LC(bj, wc, fq); const f32x4 b0 = *(const f32x4*)(peb + lc), b1 = *(const f32x4*)(peb + lc + 4);
#pragma unroll
            for (int m = 0; m < 4; ++m) {
                const int r = rbase + wr * 64 + m * 16 + fr; f32x4 v0 = acc[AI][bj][m][0] + b0, v1 = acc[AI][bj][m][1] + b1;
#pragma unroll
                for (int e = 0; e < 4; ++e) { v0[e] = gelu_tanh(v0[e]); v1[e] = gelu_tanh(v1[e]); }
                *(u32x4*)(HID + (size_t)r * 256 + lc) = pack8(v0, v1);
            }
        }
    }
    __device__ __forceinline__ void fused(Acc& acc, const Unit& u, int wr, int wc, int fr, int fq, int wid, int lane, LAS unsigned char*) const {
        OPAQUE(fr); OPAQUE(fq);
        const int h = u.pn, which = u.pm >> 4, rt = u.pm & 15; bf16_t* HID = which ? HIDV : HIDK; const float* peb = which ? PEBV : PEBK;
        if (split) {
            float* slabs = (float*)(wsb + (u.pm < 16 ? WS_WM : WS_WD)) + (size_t)((u.pm & 15) * 2) * (128 * 256);
            unsigned* cnt = (unsigned*)(wsb + WS_CTL) + CW_XC + (u.pm * 2) * 16;
            float* mine = slabs + (size_t)h * (128 * 256); const float* theirs = slabs + (size_t)(h ^ 1) * (128 * 256);
#pragma unroll
            for (int bj = 0; bj < 2; ++bj)
#pragma unroll
                for (int m = 0; m < 4; ++m) { float* p = mine + (size_t)(wr * 64 + m * 16 + fr) * 256 + EPI_LC(bj, wc, fq);
                    asm volatile("global_store_dwordx4 %0, %1, off sc0 sc1" :: "v"(p), "v"(acc[1][bj][m][0]) : "memory");
                    asm volatile("global_store_dwordx4 %0, %1, off offset:16 sc0 sc1" :: "v"(p), "v"(acc[1][bj][m][1]) : "memory"); }
            asm volatile("s_waitcnt vmcnt(0)" ::: "memory");
            if (lane == 0) __hip_atomic_fetch_add(cnt + 16 * h, 1u, __ATOMIC_RELAXED, __HIP_MEMORY_SCOPE_AGENT);
            if (wid == 0) {
                unsigned sp = 0; while ((unsigned)__builtin_amdgcn_readfirstlane((int)__hip_atomic_load(cnt + 16 * (h ^ 1), __ATOMIC_RELAXED, __HIP_MEMORY_SCOPE_AGENT)) < 8u && ++sp < (1u << 22)) __builtin_amdgcn_s_sleep(2);
            }
            asm volatile("s_waitcnt vmcnt(0) lgkmcnt(0)" ::: "memory"); __builtin_amdgcn_s_barrier(); asm volatile("" ::: "memory");
            __builtin_amdgcn_fence(__ATOMIC_ACQUIRE, "agent");
#pragma unroll
            for (int bj = 0; bj < 2; ++bj)
#pragma unroll
                for (int m = 0; m < 4; ++m) { const float* p = theirs + (size_t)(wr * 64 + m * 16 + fr) * 256 + EPI_LC(bj, wc, fq); acc[0][bj][m][0] += *(const f32x4*)p; acc[0][bj][m][1] += *(const f32x4*)(p + 4); }
        }
        gelu_half<0>(acc, HID, peb, rt * 256 + (split ? h * 128 : 0), wr, wc, fr, fq);
        if (!split) gelu_half<1>(acc, HID, peb, rt * 256 + 128, wr, wc, fr, fq);
        asm volatile("s_waitcnt vmcnt(0)" ::: "memory"); __syncthreads();
        const bf16_t* W2 = which ? W2V : W2K; bf16_t* OUT = which ? VCMP : KCMP; const int r0 = rt * 256 + (split ? h * 128 + wid * 16 : wid * 32);
        f32x4 c2[2][4];
#pragma unroll
        for (int mt = 0; mt < 2; ++mt)
#pragma unroll
            for (int nt = 0; nt < 4; ++nt) c2[mt][nt] = (f32x4){0.f, 0.f, 0.f, 0.f};
        for (int k0 = 0; k0 < 256; k0 += 32) {
            bf16x8 a[2], b[4];
#pragma unroll
            for (int mt = 0; mt < 2; ++mt) a[mt] = *(const bf16x8*)(HID + (size_t)(r0 + (split ? 0 : 16 * mt) + fr) * 256 + k0 + 8 * fq);
#pragma unroll
            for (int nt = 0; nt < 4; ++nt) b[nt] = *(const bf16x8*)(W2 + (size_t)(16 * nt + fr) * 256 + k0 + 8 * fq);
#pragma unroll
            for (int mt = 0; mt < 2; ++mt)
#pragma unroll
                for (int nt = 0; nt < 4; ++nt) c2[mt][nt] = __builtin_amdgcn_mfma_f32_16x16x32_bf16(a[mt], b[nt], c2[mt][nt], 0, 0, 0);
        }
#pragma unroll
        for (int mt = 0; mt < 2; ++mt) {
            if (mt == 0 || !split) {
#pragma unroll
            for (int nt = 0; nt < 4; ++nt)
#pragma unroll
                for (int r = 0; r < 4; ++r) OUT[(size_t)(r0 + 16 * mt + 4 * fq + r) * 64 + 16 * nt + fr] = (bf16_t)f2bf(c2[mt][nt][r]);
            }
        }
    }
};
struct EpiMerged {
    static constexpr bool AFTER_DRAIN = false; static constexpr int HOOK_KT = 8;
    bf16_t* MG; const bf16_t* SP; const bf16_t* SA;
    __device__ __forceinline__ void hook(Acc& acc, const Unit& u, int wr, int wc, int fr, int fq) const {
        OPAQUE(fr); OPAQUE(fq);
#pragma unroll
        for (int ai = 0; ai < 2; ++ai)
#pragma unroll
            for (int m = 0; m < 4; ++m) {
                const int r = EPI_ROW(u, ai, wr, m, fr);
#pragma unroll
                for (int bj = 0; bj < 2; ++bj) {
                    const size_t o = (size_t)r * 1024 + u.pn * 256 + EPI_LC(bj, wc, fq);
                    const u32x4 wp = *(const u32x4*)(SP + o), wa = *(const u32x4*)(SA + o); f32x4 p0, p1, a0, a1; unpack8(wp, p0, p1); unpack8(wa, a0, a1);
#pragma unroll
                    for (int e = 0; e < 4; ++e) { acc[ai][bj][m][0][e] *= p0[e] * __builtin_amdgcn_rcpf(a0[e]); acc[ai][bj][m][1][e] *= p1[e] * __builtin_amdgcn_rcpf(a1[e]); }
                }
            }
    }
    __device__ __forceinline__ void operator()(const Acc& acc, const Unit& u, int wr, int wc, int fr, int fq) const {
        OPAQUE(fr); OPAQUE(fq);
#pragma unroll
        for (int ai = 0; ai < 2; ++ai)
#pragma unroll
            for (int m = 0; m < 4; ++m) {
                const int r = EPI_ROW(u, ai, wr, m, fr);
#pragma unroll
                for (int bj = 0; bj < 2; ++bj) {
                    const size_t o = (size_t)r * 1024 + u.pn * 256 + EPI_LC(bj, wc, fq);
                    const u32x4 wa = *(const u32x4*)(SA + o); f32x4 a0, a1; unpack8(wa, a0, a1);
                    *(u32x4*)(MG + o) = pack8(acc[ai][bj][m][0] * a0, acc[ai][bj][m][1] * a1);
                }
            }
    }
};
struct EpiX1 {
    static constexpr bool AFTER_DRAIN = false; static constexpr int HOOK_KT = 0;
    const float* x; float* X1; bf16_t* X1B; float* RSP;
    __device__ __forceinline__ void operator()(const Acc& acc, const Unit& u, int wr, int wc, int fr, int fq) const {
        OPAQUE(fr); OPAQUE(fq);
#pragma unroll
        for (int ai = 0; ai < 2; ++ai)
#pragma unroll
            for (int m = 0; m < 4; ++m) {
                const int r = EPI_ROW(u, ai, wr, m, fr); float s = 0.f;
#pragma unroll
                for (int bj = 0; bj < 2; ++bj) {
                    const size_t o = (size_t)r * 1024 + u.pn * 256 + EPI_LC(bj, wc, fq);
                    const f32x4 o0 = *(const f32x4*)(x + o) + acc[ai][bj][m][0], o1 = *(const f32x4*)(x + o + 4) + acc[ai][bj][m][1];
                    *(u32x4*)(X1B + o) = pack8(o0, o1);
                    s += (o0[0] * o0[0] + o0[1] * o0[1]) + (o0[2] * o0[2] + o0[3] * o0[3]) + (o1[0] * o1[0] + o1[1] * o1[1]) + (o1[2] * o1[2] + o1[3] * o1[3]);
                }
                s += __shfl_xor(s, 16); s += __shfl_xor(s, 32);
                if (fq == 0) RSP[(size_t)r * 16 + u.pn * 4 + wc] = s;
            }
    }
};
struct EpiAct {
    static constexpr bool AFTER_DRAIN = false; static constexpr int HOOK_KT = 0;
    bf16_t* ACT; const float* RSP;
    __device__ __forceinline__ void operator()(const Acc& acc, const Unit& u, int wr, int wc, int fr, int fq) const {
        OPAQUE(fr); OPAQUE(fq);
#pragma unroll
        for (int ai = 0; ai < 2; ++ai)
#pragma unroll
            for (int m = 0; m < 4; ++m) {
                const int r = EPI_ROW(u, ai, wr, m, fr); const f32x4* rp = (const f32x4*)(RSP + (size_t)r * 16);
                const f32x4 q0 = rp[0], q1 = rp[1], q2 = rp[2], q3 = rp[3];
                const float ss = ((q0[0] + q0[1]) + (q0[2] + q0[3])) + ((q1[0] + q1[1]) + (q1[2] + q1[3])) + ((q2[0] + q2[1]) + (q2[2] + q2[3])) + ((q3[0] + q3[1]) + (q3[2] + q3[3]));
                const float rstd = rsqrtf(ss * (1.f / DM) + RMS_EPS);
                f32x4 o[2];
#pragma unroll
                for (int n = 0; n < 2; ++n)
#pragma unroll
                    for (int e = 0; e < 4; ++e) { const float gg = acc[ai][0][m][n][e] * rstd, uu = acc[ai][1][m][n][e] * rstd; o[n][e] = gg * sigmoidf_(gg) * uu; }
                *(u32x4*)(ACT + (size_t)r * DFF + u.pn * 128 + wc * 32 + fq * 8) = pack8(o[0], o[1]);
            }
    }
};
struct EpiX2 {
    static constexpr bool AFTER_DRAIN = false; static constexpr int HOOK_KT = 0;
    float* X; const bf16_t* X1B;
    __device__ __forceinline__ void operator()(const Acc& acc, const Unit& u, int wr, int wc, int fr, int fq) const {
        OPAQUE(fr); OPAQUE(fq);
#pragma unroll
        for (int ai = 0; ai < 2; ++ai)
#pragma unroll
            for (int m = 0; m < 4; ++m) {
                const int r = EPI_ROW(u, ai, wr, m, fr);
#pragma unroll
                for (int bj = 0; bj < 2; ++bj) {
                    const size_t o = (size_t)r * 1024 + u.pn * 256 + EPI_LC(bj, wc, fq); float* p = X + o;
                    const u32x4 xw = *(const u32x4*)(X1B + o); f32x4 x0, x1v; unpack8(xw, x0, x1v);
                    *(f32x4*)p = x0 + acc[ai][bj][m][0]; *(f32x4*)(p + 4) = x1v + acc[ai][bj][m][1];
                }
            }
    }
};
struct EpiFinal {
    static constexpr bool AFTER_DRAIN = true; static constexpr int HOOK_KT = 0;
    float* X; const bf16_t* X1B; const float* nw; float* slots; unsigned* cnt;
    __device__ __forceinline__ void fused(Acc& acc, const Unit& u, int wr, int wc, int fr, int fq, int wid, int lane, LAS unsigned char* lds) const {
        OPAQUE(fr); OPAQUE(fq);
        LAS float* Pl = (LAS float*)lds;
        LAS float* Sr = (LAS float*)(lds + 4096);
#pragma unroll
        for (int ai = 0; ai < 2; ++ai)
#pragma unroll
            for (int m = 0; m < 4; ++m) {
                const int r = EPI_ROW(u, ai, wr, m, fr); float sq = 0.f;
#pragma unroll
                for (int bj = 0; bj < 2; ++bj) {
                    { const u32x4 xw = *(const u32x4*)(X1B + (size_t)r * 1024 + u.pn * 256 + EPI_LC(bj, wc, fq)); f32x4 x0, x1v; unpack8(xw, x0, x1v); acc[ai][bj][m][0] += x0; acc[ai][bj][m][1] += x1v; }
                    const f32x4 a = acc[ai][bj][m][0], b = acc[ai][bj][m][1];
                    sq += ((a[0] * a[0] + a[1] * a[1]) + (a[2] * a[2] + a[3] * a[3])) + ((b[0] * b[0] + b[1] * b[1]) + (b[2] * b[2] + b[3] * b[3]));
                }
                sq += __shfl_xor(sq, 16); sq += __shfl_xor(sq, 32);
                if (fq == 0) Pl[(ai * 128 + wr * 64 + m * 16 + fr) * 4 + wc] = sq;
            }
        asm volatile("s_waitcnt lgkmcnt(0)" ::: "memory"); __builtin_amdgcn_s_barrier(); asm volatile("" ::: "memory");
        const int row = wid * 32 + (lane & 31);
        if (lane < 32) { const f32x4 q4 = *(const LAS f32x4*)(Pl + row * 4);
            __hip_atomic_store(slots + (size_t)(u.pm * 256 + row) * 4 + u.pn, (q4[0] + q4[1]) + (q4[2] + q4[3]), __ATOMIC_RELAXED, __HIP_MEMORY_SCOPE_AGENT); }
        asm volatile("s_waitcnt vmcnt(0)" ::: "memory");
        if (lane == 0) __hip_atomic_fetch_add(cnt + 64 * u.pm, 1u, __ATOMIC_RELAXED, __HIP_MEMORY_SCOPE_AGENT);
        if (wid == 0) {
            unsigned sp = 0; while ((unsigned)__builtin_amdgcn_readfirstlane((int)__hip_atomic_load(cnt + 64 * u.pm, __ATOMIC_RELAXED, __HIP_MEMORY_SCOPE_AGENT)) < 32u && ++sp < (1u << 22)) __builtin_amdgcn_s_sleep(2);
            __builtin_amdgcn_fence(__ATOMIC_ACQUIRE, "agent");
        }
        asm volatile("s_waitcnt vmcnt(0) lgkmcnt(0)" ::: "memory"); __builtin_amdgcn_s_barrier(); asm volatile("" ::: "memory");
        if (lane < 32) { const float* sl = slots + (size_t)(u.pm * 256 + row) * 4; float t = 0.f;
#pragma unroll
            for (int k = 0; k < 4; ++k) t += __hip_atomic_load(sl + k, __ATOMIC_RELAXED, __HIP_MEMORY_SCOPE_AGENT);
            Sr[row] = rsqrtf(t * (1.f / DM) + RMS_EPS); }
        asm volatile("s_waitcnt lgkmcnt(0)" ::: "memory"); __builtin_amdgcn_s_barrier(); asm volatile("" ::: "memory");
#pragma unroll
        for (int bj = 0; bj < 2; ++bj) {
            const int c0 = u.pn * 256 + EPI_LC(bj, wc, fq); const f32x4 w0 = *(const f32x4*)(nw + c0), w1 = *(const f32x4*)(nw + c0 + 4);
#pragma unroll
            for (int ai = 0; ai < 2; ++ai)
#pragma unroll
                for (int m = 0; m < 4; ++m) {
                    const int rl = ai * 128 + wr * 64 + m * 16 + fr; const float rs = Sr[rl]; float* p = X + (size_t)(u.pm * 256 + rl) * 1024 + c0;
                    *(f32x4*)p = acc[ai][bj][m][0] * w0 * rs; *(f32x4*)(p + 4) = acc[ai][bj][m][1] * w1 * rs;
                }
        }
    }
};
struct CmpSched {
    const char *KC, *VC, *W1K, *W1V; int c, split;
    __device__ bool next(int i, Unit& u) const {
        if (i > 0 || c >= (split ? 64 : 32)) return false;
        const int un = split ? c >> 1 : c, hk = split ? c & 1 : 0;
        const int which = un >> 4, rt = un & 15, bg = rt >> 1, half = rt & 1, b = bg >> 2, g = bg & 3;
        u.pm = un; u.pn = hk; u.A = (which ? VC : KC) + ((size_t)(b * SEQ + 16 * 256 * half + 16 * hk + (hk ? 16 * 128 : 0)) * 256 + g * 64) * 2; u.B = (which ? W1V : W1K) + (size_t)hk * 2048; return true;
    }
};

struct SF_in { const float* W; __device__ __forceinline__ float operator()(int k, int n) const { const int r = incol_ref(n); return r < 0 ? 0.f : W[(size_t)k * NREF + r]; } };
struct SF_plain { const float* W; int ldn; __device__ __forceinline__ float operator()(int k, int n) const { return W[(size_t)k * ldn + n]; } };
struct SF_gu { const float *Wg, *Wu, *nw; __device__ __forceinline__ float operator()(int k, int n) const {
    const int tile = n >> 8, half = (n >> 7) & 1, j = n & 127, col = tile * 128 + j; const ptrdiff_t d = Wu - Wg; return nw[k] * Wg[(ptrdiff_t)half * d + (ptrdiff_t)k * DFF + col]; } };
__device__ __forceinline__ void p0_tile_out(int K, bf16_t* WT, LAS float* scr, int k0, int n0, int lane) {
    WSYNC();
    const int c = lane & 7;
#pragma unroll
    for (int j = 0; j < 4; ++j) { const int n = (lane >> 3) + 8 * j; const LAS float* s = scr + (8 * c) * 33 + n;
        u32x4 o; o.x = pk2(s[0 * 33], s[1 * 33]); o.y = pk2(s[2 * 33], s[3 * 33]); o.z = pk2(s[4 * 33], s[5 * 33]); o.w = pk2(s[6 * 33], s[7 * 33]);
        *(u32x4*)(WT + (size_t)(n0 + n) * K + k0 + 8 * c) = o; }
    WSYNC();
}
template <class SF> __device__ __forceinline__ void p0_transpose_item(const SF& sf, int K, int N, bf16_t* WT, LAS float* scr, int item, int lane) {
    const int nblk = N / 32, kb = item / nblk, nb = item % nblk, k0 = 64 * kb, n0 = 32 * nb;
    float v[32];
#pragma unroll
    for (int i = 0; i < 32; ++i) v[i] = sf(k0 + 2 * i + (lane >> 5), n0 + (lane & 31));
#pragma unroll
    for (int i = 0; i < 32; ++i) scr[(2 * i + (lane >> 5)) * 33 + (lane & 31)] = v[i];
    p0_tile_out(K, WT, scr, k0, n0, lane);
}
template <class SF> __device__ __forceinline__ void p0_transpose_item2(const SF& sf, int K, int N, bf16_t* WT, LAS float* scr, int item, int lane) {
    const int nblk = N / 32;
    const int kbA = item / nblk, nbA = item % nblk, kbB = (item + 1) / nblk, nbB = (item + 1) % nblk;
    float va[32], vb[32];
#pragma unroll
    for (int i = 0; i < 32; ++i) va[i] = sf(64 * kbA + 2 * i + (lane >> 5), 32 * nbA + (lane & 31));
#pragma unroll
    for (int i = 0; i < 32; ++i) vb[i] = sf(64 * kbB + 2 * i + (lane >> 5), 32 * nbB + (lane & 31));
#pragma unroll
    for (int i = 0; i < 32; ++i) scr[(2 * i + (lane >> 5)) * 33 + (lane & 31)] = va[i];
    p0_tile_out(K, WT, scr, 64 * kbA, 32 * nbA, lane);
#pragma unroll
    for (int i = 0; i < 32; ++i) scr[(2 * i + (lane >> 5)) * 33 + (lane & 31)] = vb[i];
    p0_tile_out(K, WT, scr, 64 * kbB, 32 * nbB, lane);
}
__device__ __forceinline__ void p0_fold_item(const float* pool_w, const float* pool_scale, const float* Wp, bf16_t* WT, int f, int wave, int lane) {
    const int k0 = 64 * (f >> 5), n0 = 32 * (f & 31) + 4 * wave, g = k0 >> 7;
    f32x4 acc = (f32x4){0.f, 0.f, 0.f, 0.f};
    const float* arow = pool_w + (size_t)(k0 + lane) * 128;
#pragma unroll 4
    for (int dp = 0; dp < 128; dp += 4) {
        const f32x4 a = *(const f32x4*)(arow + dp); const f32x4 sc = *(const f32x4*)(pool_scale + g * 128 + dp);
#pragma unroll
        for (int e = 0; e < 4; ++e) { const f32x4 w4 = *(const f32x4*)(Wp + (size_t)(g * 128 + dp + e) * 1024 + n0); acc += w4 * (a[e] * sc[e]); }
    }
#pragma unroll
    for (int j = 0; j < 4; ++j) WT[(size_t)(n0 + j) * 1536 + k0 + lane] = (bf16_t)f2bf(acc[j]);
}
__device__ __forceinline__ void p0_fold_item2(const float* pool_w, const float* pool_scale, const float* Wp, bf16_t* WT, int f, int lane) {
    const int g = f >> 5, kb = (f >> 2) & 7, nb = f & 3, kk0 = g * 128 + kb * 16, n0 = nb * 256 + 4 * lane;
    f32x4 acc[16];
#pragma unroll
    for (int r = 0; r < 16; ++r) acc[r] = (f32x4){0.f, 0.f, 0.f, 0.f};
    const float* bp = Wp + (size_t)(g * 128) * 1024 + n0;
#pragma unroll 1
    for (int dp = 0; dp < 128; dp += 4) {
        const f32x4 sc = *(const f32x4*)(pool_scale + g * 128 + dp);
        f32x4 b[4];
#pragma unroll
        for (int e = 0; e < 4; ++e) b[e] = *(const f32x4*)(bp + (size_t)(dp + e) * 1024);
#pragma unroll
        for (int r = 0; r < 16; ++r) {
            const f32x4 a = *(const f32x4*)(pool_w + (size_t)(kk0 + r) * 128 + dp);
#pragma unroll
            for (int e = 0; e < 4; ++e) acc[r] += b[e] * (a[e] * sc[e]);
        }
    }
#pragma unroll
    for (int j = 0; j < 4; ++j) {
        u32x4 w0, w1;
        w0.x = pk2(acc[0][j], acc[1][j]); w0.y = pk2(acc[2][j], acc[3][j]); w0.z = pk2(acc[4][j], acc[5][j]); w0.w = pk2(acc[6][j], acc[7][j]);
        w1.x = pk2(acc[8][j], acc[9][j]); w1.y = pk2(acc[10][j], acc[11][j]); w1.z = pk2(acc[12][j], acc[13][j]); w1.w = pk2(acc[14][j], acc[15][j]);
        bf16_t* o = WT + (size_t)(n0 + j) * 1536 + kk0; *(u32x4*)o = w0; *(u32x4*)(o + 8) = w1;
    }
}
template <int PART> __device__ __forceinline__ void p0_prologue(KParams P, LAS unsigned char* lds, int gw, int NGW, int wave, int lane) {
    unsigned char* ws = P->ws;
    LAS float* scr = (LAS float*)(lds + wave * 16384);
    constexpr int I_IN = (1024 / 64) * (NIN / 32), I_W1 = (2048 / 64) * (256 / 32), I_W2 = (256 / 64) * (64 / 32), I_WM = (1024 / 64) * (1024 / 32), I_WO = (1024 / 64) * (1024 / 32),
                  I_GU = (1024 / 64) * (5632 / 32), I_WD = (2816 / 64) * (1024 / 32);
    if constexpr (PART == 1) {
        constexpr int NITEMS = I_WM + I_WO + I_WD;
        for (int f = gw >> 3; f < 256; f += NGW >> 3) p0_fold_item(P->pool_w, P->pool_scale, P->w_pp, (bf16_t*)(ws + WS_WM), f, wave, lane);
        for (int it = gw; it < NITEMS; it += NGW) {
            int r = it;
            if (r < I_WM) { p0_transpose_item(SF_plain{P->w_pa, 1024}, 1536, 1024, (bf16_t*)(ws + WS_WM) + 512, scr, r, lane); continue; } r -= I_WM;
            if (r < I_WO) { p0_transpose_item(SF_plain{P->w_out, 1024}, 1024, 1024, (bf16_t*)(ws + WS_WO), scr, r, lane); continue; } r -= I_WO;
            p0_transpose_item(SF_plain{P->w_d, 1024}, 2816, 1024, (bf16_t*)(ws + WS_WD), scr, r, lane);
        }
        return;
    }
    const int nGU = (NGW == 256 * NWAVES) ? 0 : I_GU;
    const int NITEMS = I_IN + 2 * I_W1 + 2 * I_W2 + nGU;
    for (int it = gw; it < NITEMS; it += NGW) {
        int r = it;
        if (r < nGU) { p0_transpose_item(SF_gu{P->w_g, P->w_u, P->norm2_w}, 1024, 5632, (bf16_t*)(ws + WS_WGU), scr, r, lane); continue; } r -= nGU;
        if (r < I_IN) { p0_transpose_item(SF_in{P->w_in}, 1024, NIN, (bf16_t*)(ws + WS_WIN), scr, r, lane); continue; } r -= I_IN;
        if (r < I_W1) { p0_transpose_item(SF_plain{P->w1_k, 256}, 2048, 256, (bf16_t*)(ws + WS_W1K), scr, r, lane); continue; } r -= I_W1;
        if (r < I_W1) { p0_transpose_item(SF_plain{P->w1_v, 256}, 2048, 256, (bf16_t*)(ws + WS_W1V), scr, r, lane); continue; } r -= I_W1;
        if (r < I_W2) { p0_transpose_item(SF_plain{P->w2_k, 64}, 256, 64, (bf16_t*)(ws + WS_W2K), scr, r, lane); continue; } r -= I_W2;
        p0_transpose_item(SF_plain{P->w2_v, 64}, 256, 64, (bf16_t*)(ws + WS_W2V), scr, r, lane);
    }
    for (int it = (gw & 31) ? 64 : (gw >> 5); it < 64; it += NGW >> 5) {
        const int which = it >> 5, c0 = (it & 31) * 8; const float* pe = which ? P->pe_v : P->pe_k; const float* w1 = which ? P->w1_v : P->w1_k; const float* b1 = which ? P->b1_v : P->b1_k;
        f32x4 s0 = (f32x4){0.f, 0.f, 0.f, 0.f}, s1 = s0;
#pragma unroll 8
        for (int j = 0; j < 32; ++j) { const int k = lane + 64 * j; const float p = pe[k]; s0 += *(const f32x4*)(w1 + (size_t)k * 256 + c0) * p; s1 += *(const f32x4*)(w1 + (size_t)k * 256 + c0 + 4) * p; }
#pragma unroll
        for (int e = 0; e < 4; ++e) { s0[e] = wave_sum(s0[e]); s1[e] = wave_sum(s1[e]); }
        if (lane == 0) { float* o = (float*)(ws + (which ? WS_PEBV : WS_PEBK)) + c0; *(f32x4*)o = s0 + *(const f32x4*)(b1 + c0); *(f32x4*)(o + 4) = s1 + *(const f32x4*)(b1 + c0 + 4); }
    }
    for (int it = gw; it < SEQ * 8 / 64; it += NGW) {
        const int idx = it * 64 + lane, i = idx & 7, t = idx >> 3;
        const float inv_freq = i == 0 ? 1.0f : i == 1 ? 0.193922758102417f : i == 2 ? 0.03760603070259094f : i == 3 ? 0.00729266507551074f : i == 4 ? 0.001414213445968926f : i == 5 ? 0.00027424818836152554f : i == 6 ? 5.318296462064609e-05f : 1.0313385246263351e-05f;
        const float ang = (float)t * inv_freq;
        ((float*)(ws + WS_RCOS))[idx] = cosf(ang); ((float*)(ws + WS_RSIN))[idx] = sinf(ang);
    }
    bf16_t* H = (bf16_t*)((char*)P->out + DO_H);
#pragma unroll 1
    for (int row = gw; row < T; row += NGW) {
        const f32x4* xr = (const f32x4*)(P->x + (size_t)row * DM) + lane; const f32x4* wr = (const f32x4*)P->norm1_w + lane;
        f32x4 v[4]; float s = 0.f;
#pragma unroll
        for (int j = 0; j < 4; ++j) { v[j] = xr[64 * j]; s += (v[j].x * v[j].x + v[j].y * v[j].y) + (v[j].z * v[j].z + v[j].w * v[j].w); }
        const float rstd = rsqrtf(wave_sum(s) * (1.f / DM) + RMS_EPS);
        u32x2* o = (u32x2*)(H + (size_t)row * DM) + lane;
#pragma unroll
        for (int j = 0; j < 4; ++j) { const f32x4 ww = wr[64 * j]; u32x2 p; p.x = pk2(v[j].x * rstd * ww.x, v[j].y * rstd * ww.y); p.y = pk2(v[j].z * rstd * ww.z, v[j].w * rstd * ww.w); o[64 * j] = p; }
    }
}
template <int W> __device__ __forceinline__ void pooled_item(const bf16_t* U, bf16_t* PA, int g, int rb, int lane) {
    const int row = rb * 4 + (lane >> 4), c0 = g * 128 + (lane & 15) * 8, t = row & (SEQ - 1), cnt = t + 1 < W ? t + 1 : W;
    u32x4 q[W];
#pragma unroll
    for (int i = 0; i < W; ++i) q[i] = *(const u32x4*)(U + (size_t)(row - (i < cnt ? i : 0)) * 512 + c0);
    f32x4 u0, u1; unpack8(q[0], u0, u1); f32x4 s0 = u0, s1 = u1;
#pragma unroll
    for (int i = 1; i < W; ++i) { f32x4 a, b; unpack8(q[i], a, b); if (i < cnt) { s0 += a; s1 += b; } }
    const float ic = 1.f / (float)cnt;
    *(u32x4*)(PA + (size_t)row * 1536 + c0) = pack8(s0 * ic - u0, s1 * ic - u1);
}
template <int W> __device__ __forceinline__ void pooled_load(const bf16_t* U, int g, int rb, int lane, u32x4 (&q)[W]) {
    const int row = rb * 4 + (lane >> 4), c0 = g * 128 + (lane & 15) * 8, t = row & (SEQ - 1), cnt = t + 1 < W ? t + 1 : W;
#pragma unroll
    for (int i = 0; i < W; ++i) q[i] = *(const u32x4*)(U + (size_t)(row - (i < cnt ? i : 0)) * 512 + c0);
}
template <int W> __device__ __forceinline__ void pooled_store(bf16_t* PA, int g, int rb, int lane, const u32x4 (&q)[W]) {
    const int row = rb * 4 + (lane >> 4), c0 = g * 128 + (lane & 15) * 8, t = row & (SEQ - 1), cnt = t + 1 < W ? t + 1 : W;
    f32x4 u0, u1; unpack8(q[0], u0, u1); f32x4 s0 = u0, s1 = u1;
#pragma unroll
    for (int i = 1; i < W; ++i) { f32x4 a, b; unpack8(q[i], a, b); if (i < cnt) { s0 += a; s1 += b; } }
    const float ic = 1.f / (float)cnt;
    *(u32x4*)(PA + (size_t)row * 1536 + c0) = pack8(s0 * ic - u0, s1 * ic - u1);
}
__device__ __forceinline__ void p2_pooled(const bf16_t* U, bf16_t* PA, int gw, int NGW, int lane) {
#pragma unroll 1
    for (int rb = gw; rb < T / 4; rb += NGW) {
        { u32x4 q16[16]; pooled_load<16>(U, 3, rb, lane, q16); pooled_store<16>(PA, 3, rb, lane, q16); }
        { u32x4 q2[2], q4[4], q8[8]; pooled_load<8>(U, 2, rb, lane, q8); pooled_load<4>(U, 1, rb, lane, q4); pooled_load<2>(U, 0, rb, lane, q2);
          pooled_store<2>(PA, 0, rb, lane, q2); pooled_store<4>(PA, 1, rb, lane, q4); pooled_store<8>(PA, 2, rb, lane, q8); }
    }
}

constexpr int CW_DQ = 14400;
constexpr int DQ_FOLD = 128, DQ_I_WM = (1024 / 64) * (1024 / 32), DQ_I_WO = DQ_I_WM, DQ_I_WD = (2816 / 64) * (1024 / 32), DQ_I_GU = (1024 / 64) * (5632 / 32), DQ_TR = (DQ_I_WM + DQ_I_WO + DQ_I_WD + DQ_I_GU) / 2, DQ_NT = DQ_FOLD + DQ_TR;
__device__ __forceinline__ void late_weights_queue(KParams P, LAS unsigned char* lds, int wave, int lane) {
    unsigned char* ws = P->ws; unsigned* ctl = (unsigned*)(ws + WS_CTL);
    LAS float* scr = (LAS float*)(lds + wave * 16384);
#pragma unroll 1
    for (;;) {
        unsigned tk = 0u;
        if (lane == 0) tk = __hip_atomic_fetch_add(ctl + CW_DQ, 1u, __ATOMIC_RELAXED, __HIP_MEMORY_SCOPE_AGENT);
        const int t = __builtin_amdgcn_readfirstlane((int)tk);
        if (t >= DQ_NT) break;
        if (t < DQ_FOLD) p0_fold_item2(P->pool_w, P->pool_scale, P->w_pp, (bf16_t*)(ws + WS_WM), t, lane);
        else {
            int r = (t - DQ_FOLD) * 2;
            if (r < DQ_I_GU) { p0_transpose_item2(SF_gu{P->w_g, P->w_u, P->norm2_w}, 1024, 5632, (bf16_t*)(ws + WS_WGU), scr, r, lane); continue; } r -= DQ_I_GU;
            if (r < DQ_I_WD) { p0_transpose_item2(SF_plain{P->w_d, 1024}, 2816, 1024, (bf16_t*)(ws + WS_WD), scr, r, lane); continue; } r -= DQ_I_WD;
            if (r < DQ_I_WM) { p0_transpose_item2(SF_plain{P->w_pa, 1024}, 1536, 1024, (bf16_t*)(ws + WS_WM) + 512, scr, r, lane); continue; } r -= DQ_I_WM;
            p0_transpose_item2(SF_plain{P->w_out, 1024}, 1024, 1024, (bf16_t*)(ws + WS_WO), scr, r, lane);
        }
    }
}

namespace nsa {
constexpr int NS = 4, SLOT = 16384, RING = NS * SLOT, WSCR = 8704;
constexpr float THR = 8.f;
typedef short v4i16_t __attribute__((ext_vector_type(4)));
__device__ __forceinline__ float xor1_add(float v) { return v + __builtin_bit_cast(float, __builtin_amdgcn_mov_dpp(__builtin_bit_cast(int, v), 0xB1, 0xF, 0xF, true)); }
__device__ __forceinline__ float xor2_add(float v) { return v + __builtin_bit_cast(float, __builtin_amdgcn_mov_dpp(__builtin_bit_cast(int, v), 0x4E, 0xF, 0xF, true)); }
__device__ __forceinline__ float gmax(float m) {
    auto a = __builtin_amdgcn_permlane16_swap(__float_as_uint(m), __float_as_uint(m), false, false); m = fmaxf(__uint_as_float(a[0]), __uint_as_float(a[1]));
    auto b = __builtin_amdgcn_permlane32_swap(__float_as_uint(m), __float_as_uint(m), false, false); return fmaxf(__uint_as_float(b[0]), __uint_as_float(b[1])); }
__device__ __forceinline__ float gsum(float m) {
    auto a = __builtin_amdgcn_permlane16_swap(__float_as_uint(m), __float_as_uint(m), false, false); m = __uint_as_float(a[0]) + __uint_as_float(a[1]);
    auto b = __builtin_amdgcn_permlane32_swap(__float_as_uint(m), __float_as_uint(m), false, false); return __uint_as_float(b[0]) + __uint_as_float(b[1]); }
struct Lane {
    int wave, lane, g, c; unsigned kbase, vbase; unsigned lds0;
    __device__ __forceinline__ void init(int tid, LAS unsigned char* lds) {
        lane = tid & 63; wave = __builtin_amdgcn_readfirstlane(tid >> 6); g = lane >> 4; c = lane & 15; lds0 = (unsigned)(size_t)lds;
        kbase = (unsigned)(c * 128 + ((g ^ (lane & 7)) << 4));
        const int q = (lane >> 2) & 3, p = lane & 3, rx = 4 * (g & 1) + q;
        vbase = (unsigned)((4 * g + q) * 128 + (((p >> 1) ^ rx) << 4) + (p & 1) * 8);
    }
};
struct Src { const char* k; const char* v; unsigned loff, tstride; };
__device__ __forceinline__ Src make_src(const bf16_t* K, const bf16_t* V, size_t row0, int stride_el, int col0, const Lane& L) {
    Src s; s.k = (const char*)(K + row0 * stride_el + col0); s.v = (const char*)(V + row0 * stride_el + col0);
    const int R = 8 * L.wave + (L.lane >> 3), ch = (L.lane & 7) ^ ((L.lane >> 3) & 7);
    s.loff = (unsigned)((R * stride_el + ch * 8) * 2); s.tstride = (unsigned)(64 * stride_el * 2); return s;
}
__device__ __forceinline__ void glds16(const void* gsrc, unsigned lds_dst) { unsigned keep;
    asm volatile("s_mov_b32 %0, m0\n\ts_mov_b32 m0, %2\n\ts_nop 0\n\tglobal_load_lds_dwordx4 %1, off\n\ts_mov_b32 m0, %0" : "=&s"(keep) : "v"(gsrc), "s"(lds_dst) : "memory"); }
__device__ __forceinline__ void issue(const Lane& L, const Src& S, int tile, int slot) {
    const char* gk = S.k + (size_t)tile * S.tstride + S.loff; const char* gv = S.v + (size_t)tile * S.tstride + S.loff;
    const unsigned d = (unsigned)__builtin_amdgcn_readfirstlane((int)(L.lds0 + slot * SLOT + L.wave * 1024));
    glds16(gk, d); glds16(gv, d + 8192);
}
struct Frags { unsigned k0, k1, v0, v1, v2, v3; };
typedef Frags TileAddr;
template <bool WITH_V> __device__ __forceinline__ void load_frags(const TileAddr& A, const Lane& L, Frags& F) { F = A; }
__device__ __forceinline__ void load_k(const Frags& F, const Lane& L, bf16x8 (&kf)[4][2]) {
#pragma unroll
    for (int mt = 0; mt < 4; ++mt) {
        kf[mt][0] = *(const LAS bf16x8*)((const LAS unsigned char*)(size_t)F.k0 + mt * 2048);
        kf[mt][1] = *(const LAS bf16x8*)((const LAS unsigned char*)(size_t)F.k1 + mt * 2048);
    }
}
__device__ __forceinline__ void load_vdt(unsigned va, bf16x8 (&vf)[2]) {
#pragma unroll
    for (int ks = 0; ks < 2; ++ks) {
        const v4i16_t lo = __builtin_amdgcn_ds_read_tr16_b64_v4i16((LAS v4i16_t*)((LAS unsigned char*)(size_t)va + ks * 4096));
        const v4i16_t hi = __builtin_amdgcn_ds_read_tr16_b64_v4i16((LAS v4i16_t*)((LAS unsigned char*)(size_t)va + ks * 4096 + 2048));
        vf[ks] = (bf16x8){lo[0], lo[1], lo[2], lo[3], hi[0], hi[1], hi[2], hi[3]};
    }
}
__device__ __forceinline__ void load_v(const Frags& F, const Lane& L, bf16x8 (&vf)[4][2]) { load_vdt(F.v0, vf[0]); load_vdt(F.v1, vf[1]); load_vdt(F.v2, vf[2]); load_vdt(F.v3, vf[3]); }
template <bool WITH_V, bool MASKED, class MaskFn>
__device__ __forceinline__ void visit_slow(const Frags& F, const Lane& L, const bf16x8 (&q)[2], f32x4 (&o)[4], float& mref, float& lsum, bool colsel, const MaskFn& valid) {
    const bool seen = mref != -INFINITY;
    const float c0 = colsel ? (seen ? -mref : 0.f) : -INFINITY;
    const f32x4 ci = (f32x4){c0, c0, c0, c0};
    f32x4 s[4];
    { bf16x8 kf[4][2]; load_k(F, L, kf);
#pragma unroll
    for (int mt = 0; mt < 4; ++mt) {
        s[mt] = __builtin_amdgcn_mfma_f32_16x16x32_bf16(kf[mt][0], q[0], ci, 0, 0, 0);
        s[mt] = __builtin_amdgcn_mfma_f32_16x16x32_bf16(kf[mt][1], q[1], s[mt], 0, 0, 0);
    } }
    __builtin_amdgcn_sched_barrier(0);
    bf16x8 vf[4][2]; if constexpr (WITH_V) load_v(F, L, vf);
    if constexpr (MASKED) {
#pragma unroll
        for (int mt = 0; mt < 4; ++mt)
#pragma unroll
            for (int r = 0; r < 4; ++r) if (!valid(16 * mt + 4 * L.g + r)) s[mt][r] = -INFINITY;
    }
    float mx = fmaxf(fmaxf(s[0][0], s[0][1]), fmaxf(s[0][2], s[0][3]));
#pragma unroll
    for (int mt = 1; mt < 4; ++mt) mx = fmaxf(mx, fmaxf(fmaxf(s[mt][0], s[mt][1]), fmaxf(s[mt][2], s[mt][3])));
    if (__any((mx > THR) || (!seen && mx > -INFINITY))) {
        const float mxr = gmax(mx);
        const float d = (mxr == -INFINITY) ? 0.f : (seen ? fmaxf(mxr, 0.f) : mxr);
        const float f = __builtin_amdgcn_exp2f(-d);
        if (mxr != -INFINITY) mref = (seen ? mref : 0.f) + d;
#pragma unroll
        for (int mt = 0; mt < 4; ++mt) s[mt] = s[mt] - d;
        lsum *= f;
        if constexpr (WITH_V) {
#pragma unroll
            for (int dt = 0; dt < 4; ++dt) o[dt] = o[dt] * f;
        }
    }
#pragma unroll
    for (int mt = 0; mt < 4; ++mt)
#pragma unroll
        for (int r = 0; r < 4; ++r) s[mt][r] = __builtin_amdgcn_exp2f(s[mt][r]);
    bf16x8 pf[2];
#pragma unroll
    for (int ks = 0; ks < 2; ++ks) { const u32x4 w = pack8(s[2 * ks], s[2 * ks + 1]); pf[ks] = __builtin_bit_cast(bf16x8, w); }
    { const f32x4 t4 = (s[0] + s[1]) + (s[2] + s[3]); lsum += (t4[0] + t4[1]) + (t4[2] + t4[3]); }
    if constexpr (WITH_V) {
#pragma unroll
        for (int dt = 0; dt < 4; ++dt)
#pragma unroll
            for (int ks = 0; ks < 2; ++ks) o[dt] = __builtin_amdgcn_mfma_f32_16x16x32_bf16(vf[dt][ks], pf[ks], o[dt], 0, 0, 0);
    }
}
template <bool MASKED, class MaskA, class MaskB>
__device__ __forceinline__ void visitB2(const Frags& F, const Lane& L, const bf16x8 (&qA)[2], const bf16x8 (&qB)[2], f32x4 (&oA)[4], f32x4 (&oB)[4], float msA, float msB, float invA, float invB,
                                        const MaskA& validA, const MaskB& validB, LAS float* impA, LAS float* impB, int jb) {
    const float cA = -msA, cB = -msB; const f32x4 ciA = (f32x4){cA, cA, cA, cA}, ciB = (f32x4){cB, cB, cB, cB};
    f32x4 sA[4], sB[4];
    { bf16x8 kf[4][2]; load_k(F, L, kf);
#pragma unroll
    for (int mt = 0; mt < 4; ++mt) {
        sA[mt] = __builtin_amdgcn_mfma_f32_16x16x32_bf16(kf[mt][0], qA[0], ciA, 0, 0, 0);
        sB[mt] = __builtin_amdgcn_mfma_f32_16x16x32_bf16(kf[mt][0], qB[0], ciB, 0, 0, 0);
        sA[mt] = __builtin_amdgcn_mfma_f32_16x16x32_bf16(kf[mt][1], qA[1], sA[mt], 0, 0, 0);
        sB[mt] = __builtin_amdgcn_mfma_f32_16x16x32_bf16(kf[mt][1], qB[1], sB[mt], 0, 0, 0);
    } }

    bf16x8 vf[4][2]; load_v(F, L, vf);
#pragma unroll
    for (int mt = 0; mt < 4; ++mt) {
#pragma unroll
        for (int r = 0; r < 4; ++r) {
            sA[mt][r] = (!MASKED || validA(16 * mt + 4 * L.g + r)) ? __builtin_amdgcn_exp2f(sA[mt][r]) * invA : 0.f;
            sB[mt][r] = (!MASKED || validB(16 * mt + 4 * L.g + r)) ? __builtin_amdgcn_exp2f(sB[mt][r]) * invB : 0.f;
        }
        float va = (sA[mt][0] + sA[mt][1]) + (sA[mt][2] + sA[mt][3]), va3 = sA[mt][3], vb = (sB[mt][0] + sB[mt][1]) + (sB[mt][2] + sB[mt][3]), vb3 = sB[mt][3];
        va = xor2_add(xor1_add(va)); va3 = xor2_add(xor1_add(va3)); vb = xor2_add(xor1_add(vb)); vb3 = xor2_add(xor1_add(vb3));
        if ((L.c & 3) == 0) { const int j = jb + 4 * mt + L.g;
            __hip_atomic_fetch_add(impA + j, va, __ATOMIC_RELAXED, __HIP_MEMORY_SCOPE_WORKGROUP); __hip_atomic_fetch_add(impB + j, vb, __ATOMIC_RELAXED, __HIP_MEMORY_SCOPE_WORKGROUP);
            if (j + 1 < 128) { __hip_atomic_fetch_add(impA + j + 1, va3, __ATOMIC_RELAXED, __HIP_MEMORY_SCOPE_WORKGROUP); __hip_atomic_fetch_add(impB + j + 1, vb3, __ATOMIC_RELAXED, __HIP_MEMORY_SCOPE_WORKGROUP); } }
    }
    bf16x8 pA[2], pB[2];
#pragma unroll
    for (int ks = 0; ks < 2; ++ks) { const u32x4 wa = pack8(sA[2 * ks], sA[2 * ks + 1]), wb = pack8(sB[2 * ks], sB[2 * ks + 1]); pA[ks] = __builtin_bit_cast(bf16x8, wa); pB[ks] = __builtin_bit_cast(bf16x8, wb); }
#pragma unroll
    for (int dt = 0; dt < 4; ++dt)
#pragma unroll
        for (int ks = 0; ks < 2; ++ks) { oA[dt] = __builtin_amdgcn_mfma_f32_16x16x32_bf16(vf[dt][ks], pA[ks], oA[dt], 0, 0, 0); oB[dt] = __builtin_amdgcn_mfma_f32_16x16x32_bf16(vf[dt][ks], pB[ks], oB[dt], 0, 0, 0); }
}
constexpr float PLIM = 1.8446744e19f;
template <bool WITH_V, bool MASKED, class MaskFn>
__device__ __forceinline__ void visit_fast(const Frags& F, const Lane& L, const bf16x8 (&q)[2], f32x4 (&o)[4], float mref, float& lsum, float& badv, bool colsel, const MaskFn& valid) {
    const float c0 = colsel ? -mref : -INFINITY;
    const f32x4 ci = (f32x4){c0, c0, c0, c0};
    f32x4 s[4];
    { bf16x8 kf[4][2]; load_k(F, L, kf);
#pragma unroll
    for (int mt = 0; mt < 4; ++mt) {
        s[mt] = __builtin_amdgcn_mfma_f32_16x16x32_bf16(kf[mt][0], q[0], ci, 0, 0, 0);
        s[mt] = __builtin_amdgcn_mfma_f32_16x16x32_bf16(kf[mt][1], q[1], s[mt], 0, 0, 0);
    } }

    bf16x8 vf[4][2]; if constexpr (WITH_V) load_v(F, L, vf);
#pragma unroll
    for (int mt = 0; mt < 4; ++mt)
#pragma unroll
        for (int r = 0; r < 4; ++r) { const float e = __builtin_amdgcn_exp2f(s[mt][r]); s[mt][r] = (!MASKED || valid(16 * mt + 4 * L.g + r)) ? e : 0.f; }
    float ps; { const f32x4 t4 = (s[0] + s[1]) + (s[2] + s[3]); ps = (t4[0] + t4[1]) + (t4[2] + t4[3]); }
    lsum += ps; badv = fmaxf(badv, ps);
    if constexpr (WITH_V) {
        bf16x8 pf[2];
#pragma unroll
        for (int ks = 0; ks < 2; ++ks) { const u32x4 w = pack8(s[2 * ks], s[2 * ks + 1]); pf[ks] = __builtin_bit_cast(bf16x8, w); }
#pragma unroll
        for (int dt = 0; dt < 4; ++dt)
#pragma unroll
            for (int ks = 0; ks < 2; ++ks) o[dt] = __builtin_amdgcn_mfma_f32_16x16x32_bf16(vf[dt][ks], pf[ks], o[dt], 0, 0, 0);
    }
}
template <bool MASKED, bool WITH_V = true, class MaskA, class MaskB>
__device__ __forceinline__ void visit_fast2(const Frags& F, const Lane& L, const bf16x8 (&qA)[2], const bf16x8 (&qB)[2], f32x4 (&oA)[4], f32x4 (&oB)[4], float mrefA, float mrefB,
                                            float& lsumA, float& lsumB, float& badv, bool colA, bool colB, const MaskA& validA, const MaskB& validB) {
    const float cA = colA ? -mrefA : -INFINITY, cB = colB ? -mrefB : -INFINITY;
    const f32x4 ciA = (f32x4){cA, cA, cA, cA}, ciB = (f32x4){cB, cB, cB, cB};
    f32x4 sA[4], sB[4];
    { bf16x8 kf[4][2]; load_k(F, L, kf);
#pragma unroll
    for (int mt = 0; mt < 4; ++mt) {
        sA[mt] = __builtin_amdgcn_mfma_f32_16x16x32_bf16(kf[mt][0], qA[0], ciA, 0, 0, 0);
        sB[mt] = __builtin_amdgcn_mfma_f32_16x16x32_bf16(kf[mt][0], qB[0], ciB, 0, 0, 0);
        sA[mt] = __builtin_amdgcn_mfma_f32_16x16x32_bf16(kf[mt][1], qA[1], sA[mt], 0, 0, 0);
        sB[mt] = __builtin_amdgcn_mfma_f32_16x16x32_bf16(kf[mt][1], qB[1], sB[mt], 0, 0, 0);
    } }
    bf16x8 vf[4][2]; if constexpr (WITH_V) load_v(F, L, vf);
#pragma unroll
    for (int mt = 0; mt < 4; ++mt)
#pragma unroll
        for (int r = 0; r < 4; ++r) {
            const float ea = __builtin_amdgcn_exp2f(sA[mt][r]), eb = __builtin_amdgcn_exp2f(sB[mt][r]);
            sA[mt][r] = (!MASKED || validA(16 * mt + 4 * L.g + r)) ? ea : 0.f; sB[mt][r] = (!MASKED || validB(16 * mt + 4 * L.g + r)) ? eb : 0.f;
        }
    { const f32x4 t4 = (sA[0] + sA[1]) + (sA[2] + sA[3]); const float ps = (t4[0] + t4[1]) + (t4[2] + t4[3]); lsumA += ps; badv = fmaxf(badv, ps); }
    { const f32x4 t4 = (sB[0] + sB[1]) + (sB[2] + sB[3]); const float ps = (t4[0] + t4[1]) + (t4[2] + t4[3]); lsumB += ps; badv = fmaxf(badv, ps); }
    if constexpr (!WITH_V) return;
    bf16x8 pA[2], pB[2];
#pragma unroll
    for (int ks = 0; ks < 2; ++ks) { const u32x4 wa = pack8(sA[2 * ks], sA[2 * ks + 1]), wb = pack8(sB[2 * ks], sB[2 * ks + 1]); pA[ks] = __builtin_bit_cast(bf16x8, wa); pB[ks] = __builtin_bit_cast(bf16x8, wb); }
#pragma unroll
    for (int dt = 0; dt < 4; ++dt)
#pragma unroll
        for (int ks = 0; ks < 2; ++ks) { oA[dt] = __builtin_amdgcn_mfma_f32_16x16x32_bf16(vf[dt][ks], pA[ks], oA[dt], 0, 0, 0); oB[dt] = __builtin_amdgcn_mfma_f32_16x16x32_bf16(vf[dt][ks], pB[ks], oB[dt], 0, 0, 0); }
}
template <bool WITH_V, class MaskFn>
__device__ __forceinline__ void visit_init(const Frags& F, const Lane& L, const bf16x8 (&q)[2], f32x4 (&o)[4], float& mref, float& lsum, float& badv, bool colsel, const MaskFn& valid) {
    const bool seen = mref != -INFINITY;
    const float c0 = colsel ? (seen ? -mref : 0.f) : -INFINITY;
    const f32x4 ci = (f32x4){c0, c0, c0, c0};
    f32x4 s[4];
    { bf16x8 kf[4][2]; load_k(F, L, kf);
#pragma unroll
    for (int mt = 0; mt < 4; ++mt) {
        s[mt] = __builtin_amdgcn_mfma_f32_16x16x32_bf16(kf[mt][0], q[0], ci, 0, 0, 0);
        s[mt] = __builtin_amdgcn_mfma_f32_16x16x32_bf16(kf[mt][1], q[1], s[mt], 0, 0, 0);
    } }

    bf16x8 vf[4][2]; if constexpr (WITH_V) load_v(F, L, vf);
#pragma unroll
    for (int mt = 0; mt < 4; ++mt)
#pragma unroll
        for (int r = 0; r < 4; ++r) if (!valid(16 * mt + 4 * L.g + r)) s[mt][r] = -INFINITY;
    float mx = fmaxf(fmaxf(s[0][0], s[0][1]), fmaxf(s[0][2], s[0][3]));
#pragma unroll
    for (int mt = 1; mt < 4; ++mt) mx = fmaxf(mx, fmaxf(fmaxf(s[mt][0], s[mt][1]), fmaxf(s[mt][2], s[mt][3])));
    const float mxr = gmax(mx);
    const float d = (!seen && mxr != -INFINITY) ? mxr : 0.f;
    if (!seen && mxr != -INFINITY) mref = mxr;
#pragma unroll
    for (int mt = 0; mt < 4; ++mt)
#pragma unroll
        for (int r = 0; r < 4; ++r) s[mt][r] = __builtin_amdgcn_exp2f(s[mt][r] - d);
    float ps; { const f32x4 t4 = (s[0] + s[1]) + (s[2] + s[3]); ps = (t4[0] + t4[1]) + (t4[2] + t4[3]); }
    lsum += ps; badv = fmaxf(badv, ps);
    if constexpr (WITH_V) {
        bf16x8 pf[2];
#pragma unroll
        for (int ks = 0; ks < 2; ++ks) { const u32x4 w = pack8(s[2 * ks], s[2 * ks + 1]); pf[ks] = __builtin_bit_cast(bf16x8, w); }
#pragma unroll
        for (int dt = 0; dt < 4; ++dt)
#pragma unroll
            for (int ks = 0; ks < 2; ++ks) o[dt] = __builtin_amdgcn_mfma_f32_16x16x32_bf16(vf[dt][ks], pf[ks], o[dt], 0, 0, 0);
    }
}
template <bool MASKED, class MaskFn>
__device__ __forceinline__ void visitB(const Frags& F, const Lane& L, const bf16x8 (&q)[2], f32x4 (&o)[4], float ms, float inv_l, const MaskFn& valid, LAS float* imp_row, int jb) {
    const float c0 = -ms; const f32x4 ci = (f32x4){c0, c0, c0, c0};
    f32x4 s[4];
    { bf16x8 kf[4][2]; load_k(F, L, kf);
#pragma unroll
    for (int mt = 0; mt < 4; ++mt) {
        s[mt] = __builtin_amdgcn_mfma_f32_16x16x32_bf16(kf[mt][0], q[0], ci, 0, 0, 0);
        s[mt] = __builtin_amdgcn_mfma_f32_16x16x32_bf16(kf[mt][1], q[1], s[mt], 0, 0, 0);
    } }

    bf16x8 vf[4][2]; load_v(F, L, vf);
#pragma unroll
    for (int mt = 0; mt < 4; ++mt) {
#pragma unroll
        for (int r = 0; r < 4; ++r) s[mt][r] = (!MASKED || valid(16 * mt + 4 * L.g + r)) ? __builtin_amdgcn_exp2f(s[mt][r]) * inv_l : 0.f;
        float val = (s[mt][0] + s[mt][1]) + (s[mt][2] + s[mt][3]), v3 = s[mt][3];
        val = xor2_add(xor1_add(val)); v3 = xor2_add(xor1_add(v3));
        if ((L.c & 3) == 0) { const int j = jb + 4 * mt + L.g; __hip_atomic_fetch_add(imp_row + j, val, __ATOMIC_RELAXED, __HIP_MEMORY_SCOPE_WORKGROUP);
            if (j + 1 < 128) __hip_atomic_fetch_add(imp_row + j + 1, v3, __ATOMIC_RELAXED, __HIP_MEMORY_SCOPE_WORKGROUP); }
    }
    bf16x8 pf[2];
#pragma unroll
    for (int ks = 0; ks < 2; ++ks) { const u32x4 w = pack8(s[2 * ks], s[2 * ks + 1]); pf[ks] = __builtin_bit_cast(bf16x8, w); }
#pragma unroll
    for (int dt = 0; dt < 4; ++dt)
#pragma unroll
        for (int ks = 0; ks < 2; ++ks) o[dt] = __builtin_amdgcn_mfma_f32_16x16x32_bf16(vf[dt][ks], pf[ks], o[dt], 0, 0, 0);
}
struct HiMask { int hi; __device__ __forceinline__ bool operator()(int key) const { return key <= hi; } };
struct RangeMask { int lo, hi; __device__ __forceinline__ bool operator()(int key) const { return key >= lo && key <= hi; } };
struct LoMask { int lo; __device__ __forceinline__ bool operator()(int key) const { return key >= lo; } };
struct NoMask { __device__ __forceinline__ bool operator()(int) const { return true; } };
__device__ __forceinline__ unsigned ctr_load(LAS unsigned* p) { return (unsigned)__builtin_amdgcn_readfirstlane((int)__hip_atomic_load(p, __ATOMIC_RELAXED, __HIP_MEMORY_SCOPE_WORKGROUP)); }
template <class Body>
__device__ __forceinline__ void stream(LAS unsigned char* lds, const Lane& L, const Src& S, int tile0, int NT, const Body& body) {
    LAS unsigned* ready = (LAS unsigned*)(lds + MISC_OFF + 64);
    LAS unsigned* done = ready + NS;
    __builtin_amdgcn_s_barrier();
    if (L.wave == 0 && L.lane < 2 * NS) ready[L.lane] = 0u;
    asm volatile("s_waitcnt lgkmcnt(0)" ::: "memory");
    __builtin_amdgcn_s_barrier();
    asm volatile("" ::: "memory");
    int issued = 0, published = 0;
    TileAddr A; A.k0 = L.lds0 + L.kbase; A.k1 = L.lds0 + (L.kbase ^ 64u); A.v0 = L.lds0 + 8192u + L.vbase; A.v1 = L.lds0 + 8192u + (L.vbase ^ 32u); A.v2 = L.lds0 + 8192u + (L.vbase ^ 64u); A.v3 = L.lds0 + 8192u + (L.vbase ^ 96u);
    for (int i = 0; i < NT; ++i) {
        asm volatile("s_waitcnt vmcnt(0)" ::: "memory");
        for (; published < issued; ++published) if (L.lane == 0) __hip_atomic_fetch_add(ready + (published & (NS - 1)), 1u, __ATOMIC_RELAXED, __HIP_MEMORY_SCOPE_WORKGROUP);
        for (;;) {
            if (issued >= NT || issued >= i + NS) break;
            const bool must = issued <= i;
            if (issued >= NS) {
                const unsigned want = 8u * (unsigned)(issued / NS);
                if (ctr_load(done + (issued & (NS - 1))) < want) { if (!must) break; while (ctr_load(done + (issued & (NS - 1))) < want) __builtin_amdgcn_s_sleep(1); }
            }
            issue(L, S, tile0 + issued, issued & (NS - 1)); ++issued;
            if (must) { asm volatile("s_waitcnt vmcnt(0)" ::: "memory"); for (; published < issued; ++published) if (L.lane == 0) __hip_atomic_fetch_add(ready + (published & (NS - 1)), 1u, __ATOMIC_RELAXED, __HIP_MEMORY_SCOPE_WORKGROUP); }
        }
        { const unsigned want = 8u * (unsigned)(i / NS + 1); LAS unsigned* rp = ready + (i & (NS - 1)); while (ctr_load(rp) < want) __builtin_amdgcn_s_sleep(1); }
        asm volatile("" ::: "memory");
        body(i, A);
        { const unsigned d = ((i + 1) & (NS - 1)) ? (unsigned)SLOT : (unsigned)(-(NS - 1) * SLOT); A.k0 += d; A.k1 += d; A.v0 += d; A.v1 += d; A.v2 += d; A.v3 += d; }
        asm volatile("s_waitcnt lgkmcnt(0)" ::: "memory");
        if (L.lane == 0) __hip_atomic_fetch_add(done + (i & (NS - 1)), 1u, __ATOMIC_RELAXED, __HIP_MEMORY_SCOPE_WORKGROUP);
    }
    asm volatile("s_waitcnt vmcnt(0) lgkmcnt(0)" ::: "memory");
}
struct Tensors { unsigned char* ws;
    __device__ __forceinline__ const bf16_t* QP_() const { return (const bf16_t*)(ws + WS_QP); }   __device__ __forceinline__ const bf16_t* QR_() const { return (const bf16_t*)(ws + WS_QR); }
    __device__ __forceinline__ const bf16_t* KCMP_() const { return (const bf16_t*)(ws + WS_KCMP); } __device__ __forceinline__ const bf16_t* VCMP_() const { return (const bf16_t*)(ws + WS_VCMP); }
    __device__ __forceinline__ const bf16_t* KS_() const { return (const bf16_t*)(ws + WS_KS); }   __device__ __forceinline__ const bf16_t* VS_() const { return (const bf16_t*)(ws + WS_VS); }
    __device__ __forceinline__ const bf16_t* KW_() const { return (const bf16_t*)(ws + WS_KW); }   __device__ __forceinline__ const bf16_t* VW_() const { return (const bf16_t*)(ws + WS_VW); }
    __device__ __forceinline__ const float* GN_() const { return (const float*)(ws + WS_GN); }     __device__ __forceinline__ bf16_t* PA_() const { return (bf16_t*)(ws + WS_PA); }
};
__device__ __forceinline__ void unit(LAS unsigned char* lds, const Tensors& X, int b, int gk, int u, int wave_s) {
    const int t0 = 128 * u;
    bf16x8 q[4][2]; f32x4 o[4][4]; float m[4], l[4]; float badv;
#define NSA_STAGE() Lane L; { const int ln_ = lane_id(); L.init(ln_ + 64 * wave_s, lds); } \
    const int tw0 = t0 + 16 * L.wave, tl = L.c >> 2; (void)tl; \
    LAS unsigned char* wscr = lds + RING + L.wave * WSCR; (void)wscr; \
    LAS float* impw = (LAS float*)wscr; (void)impw;                   \
    LAS unsigned* bmask = (LAS unsigned*)(wscr + 8192); (void)bmask;     \
    const int qrow32 = (b * SEQ + tw0 + (L.c >> 2)) * 1024 + (gk * 4 + (L.c & 3)) * 64 + 8 * L.g; (void)qrow32;        \
    const LAS float* gate = (const LAS float*)(lds + GATE_OFF + L.wave * 768) + (L.c >> 2) * 12 + (L.c & 3) * 3; (void)gate;     \
    LAS unsigned char* park = wscr + ((size_t)L.c * 64 + 4 * L.g) * 2; (void)park
#define NSA_LOADQ_ISSUE(Qp) do { int qo_ = qrow32; OPAQUE(qo_); const bf16_t* qp_ = (Qp) + (size_t)qo_; _Pragma("unroll") for (int rt = 0; rt < 4; ++rt) _Pragma("unroll") for (int dk = 0; dk < 2; ++dk) q[rt][dk] = *(const bf16x8*)(qp_ + rt * 4096 + 32 * dk); } while (0)
#define NSA_LOADQ_USE() do { _Pragma("unroll") for (int rt = 0; rt < 4; ++rt) _Pragma("unroll") for (int dk = 0; dk < 2; ++dk) asm volatile("" : "+v"(q[rt][dk])); } while (0)
#define NSA_LOADQ(Qp) do { NSA_LOADQ_ISSUE(Qp); NSA_LOADQ_USE(); } while (0)
#define NSA_BAD() (__any(!(badv <= PLIM)))
#define NSA_RESET() do { float z_ = 0.f; OPAQUE(z_); badv = z_; _Pragma("unroll") for (int rt = 0; rt < 4; ++rt) { m[rt] = -INFINITY; l[rt] = z_; _Pragma("unroll") for (int dt = 0; dt < 4; ++dt) o[rt][dt] = (f32x4){z_, z_, z_, z_}; } } while (0)
    {
        NSA_STAGE();
        { float z_ = 0.f; OPAQUE(z_); const f32x4 z4 = (f32x4){z_, z_, z_, z_};
#pragma unroll
        for (int i = 0; i < 8; ++i) *(LAS f32x4*)(impw + (i * 64 + L.lane) * 4) = z4; }
        {
            const float* gsrc = X.GN_() + (size_t)(b * SEQ + tw0) * 48 + gk * 12; LAS float* gdst = (LAS float*)(lds + GATE_OFF + L.wave * 768);
            float gv[3];
#pragma unroll
            for (int k3 = 0; k3 < 3; ++k3) { const int idx = L.lane + 64 * k3; gv[k3] = gsrc[(idx / 12) * 48 + idx % 12]; }
            NSA_LOADQ(X.QP_());
#pragma unroll
            for (int k3 = 0; k3 < 3; ++k3) gdst[L.lane + 64 * k3] = gv[k3];
        }
        NSA_RESET();
        const int nct = ((8 * u + 6) >> 6) + 1;
        const Src S = make_src(X.KCMP_(), X.VCMP_(), (size_t)(b * 4 + gk) * NCP, 64, 0, L);
        stream(lds, L, S, 0, nct, [&](int i, const TileAddr& Ks) {
            const int nb = 64 * i;
            if (tw0 + 15 >= 31 && nb <= ((tw0 + 15 - 31) >> 4)) {
                Frags F; load_frags<false>(Ks, L, F);
#pragma unroll
                for (int pr = 0; pr < 2; ++pr) {
                    const int rA = 2 * pr, rB = rA + 1, twA = tw0 + 4 * rA, twB = twA + 4;
                    const bool nA = twA + 3 >= 31 && nb <= ((twA + 3 - 31) >> 4), nB = twB + 3 >= 31 && nb <= ((twB + 3 - 31) >> 4);
                    const bool inter = twA >= 31 && nb + 63 <= ((twA - 31) >> 4);
                    const int tA = twA + tl, tB = twB + tl;
                    const HiMask hA{(tA >= 31 ? ((tA - 31) >> 4) : -1) - nb}, hB{(tB >= 31 ? ((tB - 31) >> 4) : -1) - nb};
                    (void)inter;
                    if (i == 0) { if (nA) visit_init<false>(F, L, q[rA], o[rA], m[rA], l[rA], badv, true, hA); if (nB) visit_init<false>(F, L, q[rB], o[rB], m[rB], l[rB], badv, true, hB); }
                    else if (nA && nB) visit_fast2<true, false>(F, L, q[rA], q[rB], o[rA], o[rB], m[rA], m[rB], l[rA], l[rB], badv, true, true, hA, hB);
                    else { if (nA) visit_fast<false, true>(F, L, q[rA], o[rA], m[rA], l[rA], badv, true, hA); if (nB) visit_fast<false, true>(F, L, q[rB], o[rB], m[rB], l[rB], badv, true, hB); }
                }
            }
        });
        if (NSA_BAD()) {
            NSA_RESET();
            stream(lds, L, S, 0, nct, [&](int i, const TileAddr& Ks) {
                const int nb = 64 * i;
                if (tw0 + 15 >= 31 && nb <= ((tw0 + 15 - 31) >> 4)) {
                    Frags F; load_frags<false>(Ks, L, F);
#pragma unroll
                    for (int rt = 0; rt < 4; ++rt) {
                        const int twA = tw0 + 4 * rt, tA = twA + tl;
                        if (twA + 3 >= 31 && nb <= ((twA + 3 - 31) >> 4)) visit_slow<false, true>(F, L, q[rt], o[rt], m[rt], l[rt], true, HiMask{(tA >= 31 ? ((tA - 31) >> 4) : -1) - nb});
                    }
                }
            });
        }
        float inv[4], msf[4];
#pragma unroll
        for (int rt = 0; rt < 4; ++rt) { const float lt = gsum(l[rt]); inv[rt] = lt > 0.f ? __builtin_amdgcn_rcpf(lt) : 0.f; msf[rt] = (m[rt] == -INFINITY) ? 0.f : m[rt]; }
        NSA_RESET();
        stream(lds, L, S, 0, nct, [&](int i, const TileAddr& Ks) {
            const int nb = 64 * i;
            if (tw0 + 15 >= 31 && nb <= ((tw0 + 15 - 31) >> 4)) {
                Frags F; load_frags<true>(Ks, L, F);
#pragma unroll
                for (int pr = 0; pr < 2; ++pr) {
                    const int rA = 2 * pr, rB = rA + 1, twA = tw0 + 4 * rA, twB = twA + 4;
                    const bool nA = twA + 3 >= 31 && nb <= ((twA + 3 - 31) >> 4), nB = twB + 3 >= 31 && nb <= ((twB + 3 - 31) >> 4);
                    const bool inter = twA >= 31 && nb + 63 <= ((twA - 31) >> 4);
                    const int tA = twA + tl, tB = twB + tl;
                    const HiMask hA{(tA >= 31 ? ((tA - 31) >> 4) : -1) - nb}, hB{(tB >= 31 ? ((tB - 31) >> 4) : -1) - nb};
                    LAS float* iA = impw + (4 * rA + tl) * 128; LAS float* iB = impw + (4 * rB + tl) * 128;
                    (void)inter;
                    if (nA && nB) visitB2<true>(F, L, q[rA], q[rB], o[rA], o[rB], msf[rA], msf[rB], inv[rA], inv[rB], hA, hB, iA, iB, 16 * i);
                    else { if (nA) visitB<true>(F, L, q[rA], o[rA], msf[rA], inv[rA], hA, iA, 16 * i);
                           if (nB) visitB<true>(F, L, q[rB], o[rB], msf[rB], inv[rB], hB, iB, 16 * i); }
                }
            }
        });
    }
    asm volatile("s_waitcnt lgkmcnt(0)" ::: "memory");
    {
        NSA_STAGE();
        NSA_LOADQ_ISSUE(X.QR_());
        unsigned bm0 = 0u, bm1 = 0u;
        const int jt = tw0 >> 6;
        if (jt <= 15) { bm0 = (L.lane <= jt) ? 0xffffu : 0u; }
        else {
            const int tau = L.lane >> 2, part = L.lane & 3;
            unsigned A[32];
            { const LAS f32x4* src = (const LAS f32x4*)(impw + tau * 128 + part * 32);
#pragma unroll
              for (int i4 = 0; i4 < 8; ++i4) { const f32x4 v = src[i4];
#pragma unroll
                for (int e = 0; e < 4; ++e) { const int j = part * 32 + 4 * i4 + e; A[4 * i4 + e] = (j >= 1 && j <= jt - 2) ? (0x80000000u | __float_as_uint(v[e])) : 0u; } } }
#define TSTEP(J, M) _Pragma("unroll") for (int r = 0; r < 32; ++r) if (!(r & (J))) { const unsigned t_ = ((A[r] >> (J)) ^ A[r + (J)]) & (M); A[r + (J)] ^= t_; A[r] ^= t_ << (J); }
            TSTEP(16, 0x0000FFFFu) TSTEP(8, 0x00FF00FFu) TSTEP(4, 0x0F0F0F0Fu) TSTEP(2, 0x33333333u) TSTEP(1, 0x55555555u)
#undef TSTEP
#define QSUM(x) do { x += __builtin_amdgcn_mov_dpp(x, 0xB1, 0xF, 0xF, true); x += __builtin_amdgcn_mov_dpp(x, 0x4E, 0xF, 0xF, true); } while (0)
            unsigned cand = 0xffffffffu, gt = 0u; int G = 0;
#pragma unroll
            for (int bit = 31; bit >= 0; --bit) {
                const unsigned ones = cand & A[bit];
                int c1 = __builtin_popcount(ones); QSUM(c1);
                const bool take = G + c1 >= 13;
                gt |= take ? 0u : ones; cand = take ? ones : (cand ^ ones); G += take ? 0 : c1;
            }
            int eq = __builtin_popcount(cand);
            const int e0 = __builtin_amdgcn_mov_dpp(eq, 0x00, 0xF, 0xF, true), e1 = __builtin_amdgcn_mov_dpp(eq, 0x55, 0xF, 0xF, true), e2 = __builtin_amdgcn_mov_dpp(eq, 0xAA, 0xF, 0xF, true);
            const int rem = (13 - G) - ((part > 0 ? e0 : 0) + (part > 1 ? e1 : 0) + (part > 2 ? e2 : 0));
            unsigned W = gt, tq = cand;
#pragma unroll
            for (int n = 0; n < 13; ++n) { const unsigned low = (rem > n) ? (tq & (0u - tq)) : 0u; W |= low; tq ^= low; }
            { const int d0 = 0 - 32 * part, d1 = jt - 32 * part, d2 = jt - 1 - 32 * part;
              W |= ((unsigned)d0 < 32u ? 1u << d0 : 0u) | ((unsigned)d1 < 32u ? 1u << d1 : 0u) | ((unsigned)d2 < 32u ? 1u << d2 : 0u); }
#undef QSUM
            LAS unsigned* Wt = (LAS unsigned*)impw;
            asm volatile("s_waitcnt lgkmcnt(0)" ::: "memory");
            Wt[L.lane] = W;
            asm volatile("s_waitcnt lgkmcnt(0)" ::: "memory");
            const int hp = L.lane >> 5, sh = L.lane & 31;
#pragma unroll
            for (int t2 = 0; t2 < 16; ++t2) { const unsigned w0 = Wt[t2 * 4 + hp], w1 = Wt[t2 * 4 + 2 + hp]; bm0 |= ((w0 >> sh) & 1u) << t2; bm1 |= ((w1 >> sh) & 1u) << t2; }
        }
        bmask[L.lane] = bm0; bmask[64 + L.lane] = bm1;
    }
    asm volatile("s_waitcnt lgkmcnt(0)" ::: "memory");
    {
        NSA_STAGE();
#pragma unroll
        for (int rt = 0; rt < 4; ++rt) {
            const float gc = gate[rt * 48];
#pragma unroll
            for (int dt = 0; dt < 4; ++dt) { const f32x4 v = o[rt][dt] * gc; u32x2 w; w.x = cvt_pk_bf16(v[0], v[1]); w.y = cvt_pk_bf16(v[2], v[3]); *(LAS u32x2*)(park + rt * 2048 + dt * 32) = w; }
        }
    }
    {
        NSA_STAGE();
        NSA_LOADQ_USE();
        const int kt_lo = (2 * u - 8) > 0 ? (2 * u - 8) : 0, kt_hi = 2 * u + 1;
        const Src S = make_src(X.KW_(), X.VW_(), (size_t)b * SEQ, 256, gk * 64, L);
        SUBREP(32) { NSA_RESET();
        stream(lds, L, S, kt_lo, kt_hi - kt_lo + 1, [&](int i, const TileAddr& Ks) {
            const int kbase = 64 * (kt_lo + i);
            if (kbase <= tw0 + 15 && kbase + 63 >= tw0 - 511) {
                Frags F; load_frags<true>(Ks, L, F);
#pragma unroll
                for (int pr = 0; pr < 2; ++pr) {
                    const int rA = 2 * pr, rB = rA + 1, twA = tw0 + 4 * rA, twB = twA + 4;
                    const bool nA = kbase <= twA + 3 && kbase + 63 >= twA - 511, nB = kbase <= twB + 3 && kbase + 63 >= twB - 511;
                    const bool inter = kbase + 63 <= twA && kbase >= twB + 3 - 511;
                    const int tA = twA + tl, tB = twB + tl;
                    const bool init = kbase <= (twB + 3 - 511 > 0 ? twB + 3 - 511 : 0);
                    if (init) { if (nA) visit_init<true>(F, L, q[rA], o[rA], m[rA], l[rA], badv, true, RangeMask{tA - 511 - kbase, tA - kbase}); if (nB) visit_init<true>(F, L, q[rB], o[rB], m[rB], l[rB], badv, true, RangeMask{tB - 511 - kbase, tB - kbase}); }
                    else if (nA && nB) { if (inter) visit_fast2<false>(F, L, q[rA], q[rB], o[rA], o[rB], m[rA], m[rB], l[rA], l[rB], badv, true, true, NoMask{}, NoMask{});
                                         else visit_fast2<true>(F, L, q[rA], q[rB], o[rA], o[rB], m[rA], m[rB], l[rA], l[rB], badv, true, true, HiMask{tA - kbase}, HiMask{tB - kbase}); }
                    else if (inter) { if (nA) visit_fast<true, false>(F, L, q[rA], o[rA], m[rA], l[rA], badv, true, NoMask{}); if (nB) visit_fast<true, false>(F, L, q[rB], o[rB], m[rB], l[rB], badv, true, NoMask{}); }
                    else { if (nA) visit_fast<true, true>(F, L, q[rA], o[rA], m[rA], l[rA], badv, true, HiMask{tA - kbase}); if (nB) visit_fast<true, true>(F, L, q[rB], o[rB], m[rB], l[rB], badv, true, HiMask{tB - kbase}); }
                }
            }
        });
        if (NSA_BAD()) {
            NSA_RESET();
            stream(lds, L, S, kt_lo, kt_hi - kt_lo + 1, [&](int i, const TileAddr& Ks) {
                const int kbase = 64 * (kt_lo + i);
                if (kbase <= tw0 + 15 && kbase + 63 >= tw0 - 511) {
                    Frags F; load_frags<true>(Ks, L, F);
#pragma unroll
                    for (int rt = 0; rt < 4; ++rt) {
                        const int twA = tw0 + 4 * rt, tA = twA + tl;
                        if (kbase <= twA + 3 && kbase + 63 >= twA - 511) visit_slow<true, true>(F, L, q[rt], o[rt], m[rt], l[rt], true, RangeMask{tA - 511 - kbase, tA - kbase});
                    }
                }
            });
        }
        }
    }
    {
        NSA_STAGE();
#pragma unroll
        for (int rt = 0; rt < 4; ++rt) {
            const float sc = gate[rt * 48 + 2] * __builtin_amdgcn_rcpf(gsum(l[rt]));
#pragma unroll
            for (int dt = 0; dt < 4; ++dt) {
                LAS u32x2* pp = (LAS u32x2*)(park + rt * 2048 + dt * 32); const u32x2 pw = *pp; const f32x4 v = o[rt][dt] * sc; u32x2 w;
                w.x = cvt_pk_bf16(v[0] + __builtin_bit_cast(float, pw.x << 16), v[1] + __builtin_bit_cast(float, pw.x & 0xffff0000u));
                w.y = cvt_pk_bf16(v[2] + __builtin_bit_cast(float, pw.y << 16), v[3] + __builtin_bit_cast(float, pw.y & 0xffff0000u));
                *pp = w;
            }
        }
    }
    {
        NSA_STAGE();
        const Src S = make_src(X.KS_(), X.VS_(), (size_t)b * SEQ, 256, gk * 64, L);
        if (MK_PROBE == 34) stream(lds, L, S, 0, 2 * u + 2, [&](int j, const TileAddr& Ks) { const unsigned bm = (unsigned)__builtin_amdgcn_readfirstlane((int)bmask[j]); asm volatile("" :: "s"(bm), "v"(Ks.k0)); });
        SUBREP(33) { NSA_RESET();
        unsigned bmv = bmask[0];
        stream(lds, L, S, 0, 2 * u + 2, [&](int j, const TileAddr& Ks) {
            const unsigned bm = (unsigned)__builtin_amdgcn_readfirstlane((int)bmv);
            bmv = bmask[j + 1];
            const int kbase = 64 * j; const bool j0 = (j == 0);
            if (bm & 0xffffu) {
                Frags F; load_frags<true>(Ks, L, F);
#pragma unroll
                for (int pr = 0; pr < 2; ++pr) {
                    const int rA = 2 * pr, rB = rA + 1, twA = tw0 + 4 * rA, twB = twA + 4;
                    const bool nA = (bm >> (4 * rA)) & 15u, nB = (bm >> (4 * rB)) & 15u;
                    const bool inter = kbase + 63 <= twA;
                    const bool sA = (bm >> (4 * rA + tl)) & 1u, sB = (bm >> (4 * rB + tl)) & 1u;
                    const HiMask hA{twA + tl - kbase}, hB{twB + tl - kbase};
                    if (j0) { if (nA) visit_init<true>(F, L, q[rA], o[rA], m[rA], l[rA], badv, sA, hA); if (nB) visit_init<true>(F, L, q[rB], o[rB], m[rB], l[rB], badv, sB, hB); }
                    else if (nA && nB && inter) visit_fast2<false>(F, L, q[rA], q[rB], o[rA], o[rB], m[rA], m[rB], l[rA], l[rB], badv, sA, sB, hA, hB);
                    else if (inter) { if (nA) visit_fast<true, false>(F, L, q[rA], o[rA], m[rA], l[rA], badv, sA, hA); if (nB) visit_fast<true, false>(F, L, q[rB], o[rB], m[rB], l[rB], badv, sB, hB); }
                    else { if (nA) visit_fast<true, true>(F, L, q[rA], o[rA], m[rA], l[rA], badv, sA, hA); if (nB) visit_fast<true, true>(F, L, q[rB], o[rB], m[rB], l[rB], badv, sB, hB); }
                }
            }
        });
        if (NSA_BAD()) {
            NSA_RESET();
            stream(lds, L, S, 0, 2 * u + 2, [&](int j, const TileAddr& Ks) {
                const unsigned bm = (unsigned)__builtin_amdgcn_readfirstlane((int)bmask[j]);
                const int kbase = 64 * j;
                if (bm & 0xffffu) {
                    Frags F; load_frags<true>(Ks, L, F);
#pragma unroll
                    for (int rt = 0; rt < 4; ++rt) {
                        const int twA = tw0 + 4 * rt;
                        if ((bm >> (4 * rt)) & 15u) visit_slow<true, true>(F, L, q[rt], o[rt], m[rt], l[rt], (bool)((bm >> (4 * rt + tl)) & 1u), HiMask{twA + tl - kbase});
                    }
                }
            });
        }
        }
    }
    {
        NSA_STAGE();
#pragma unroll
        for (int rt = 0; rt < 4; ++rt) {
            const float sc = gate[rt * 48 + 1] * __builtin_amdgcn_rcpf(gsum(l[rt]));
            int oo_ = (b * SEQ + tw0 + 4 * rt + tl) * 1536 + 512 + (gk * 4 + (L.c & 3)) * 64 + 4 * L.g; OPAQUE(oo_); bf16_t* orow = X.PA_() + (size_t)oo_;
#pragma unroll
            for (int dt = 0; dt < 4; ++dt) {
                const u32x2 pw = *(LAS u32x2*)(park + rt * 2048 + dt * 32); const f32x4 v = o[rt][dt] * sc; u32x2 w;
                w.x = cvt_pk_bf16(v[0] + __builtin_bit_cast(float, pw.x << 16), v[1] + __builtin_bit_cast(float, pw.x & 0xffff0000u));
                w.y = cvt_pk_bf16(v[2] + __builtin_bit_cast(float, pw.y << 16), v[3] + __builtin_bit_cast(float, pw.y & 0xffff0000u));
                *(u32x2*)(orow + 16 * dt) = w;
            }
        }
    }
    asm volatile("s_waitcnt vmcnt(0) lgkmcnt(0)" ::: "memory");
#undef NSA_LOADQ
#undef NSA_LOADQ_ISSUE
#undef NSA_LOADQ_USE
#undef NSA_RESET
#undef NSA_BAD
#undef NSA_STAGE
}
}

#define XB_TMO      128
#define XB_XCNT(j)  (256  + 64 * (j))
#define XB_XSUB(j)  (1280 + 64 * (j))
#define XB_XGEN(j)  (2304 + 64 * (j))
#define XB_TOP      3328
#define XB_TOPGEN   3392
#define XCD_BAR_WORDS 3456
#define XB_SPIN_CAP (1u << 18)
constexpr int CW_FN = 10240;
constexpr int CW_BAR = 4096;
constexpr size_t CTL_ZERO_BYTES = 65536;
__device__ __forceinline__ unsigned xb_ld(unsigned* p)              { return __hip_atomic_load(p, __ATOMIC_RELAXED, __HIP_MEMORY_SCOPE_AGENT); }
__device__ __forceinline__ unsigned xb_add(unsigned* p, unsigned v) { return __hip_atomic_fetch_add(p, v, __ATOMIC_RELAXED, __HIP_MEMORY_SCOPE_AGENT); }
__device__ __forceinline__ unsigned xb_xcc_id() { return (unsigned)__builtin_amdgcn_s_getreg((3 << 11) | 20) & 0xFu; }
#define XB_SPIN(cond, bar) do { unsigned _sp = 0; while (cond) { __builtin_amdgcn_s_sleep(1); \
    if ((++_sp & 255u) == 0u) { if (xb_ld(&(bar)[XB_TMO])) break; if (_sp > XB_SPIN_CAP) { atomicAdd(&(bar)[XB_TMO], 1u); break; } } } } while (0)
struct XcdBarrier { unsigned* bar; unsigned x; volatile LAS unsigned* st; int wave; };
__device__ __forceinline__ XcdBarrier xcd_barrier_post(unsigned* bar, volatile LAS unsigned* st, int wave) {
    XcdBarrier b; b.bar = bar; b.x = xb_xcc_id(); b.st = st; b.wave = wave;
    if (wave == 0 && lane_id() == 0) (void)xb_add(&bar[XB_XCNT(b.x)], 1u);
    return b;
}
__device__ __forceinline__ void xcd_barrier_complete(unsigned* bar, unsigned x, unsigned& nloc, unsigned& nx) {
    const unsigned G = gridDim.x * gridDim.y * gridDim.z;
    unsigned sum, cnt, mine, sp = 0u;
    for (;;) {
        sum = 0u; cnt = 0u; mine = 0u;
#pragma unroll
        for (unsigned j = 0; j < 16; ++j) { const unsigned c = xb_ld(&bar[XB_XCNT(j)]); sum += c; cnt += (c > 0u) ? 1u : 0u; mine = (j == x) ? c : mine; }
        if (sum == G) break;
        __builtin_amdgcn_s_sleep(1);
        if ((++sp & 255u) == 0u) { if (xb_ld(&bar[XB_TMO])) break; if (sp > XB_SPIN_CAP) { atomicAdd(&bar[XB_TMO], 1u); break; } }
    }
    nloc = mine > 0u ? mine : 1u; nx = cnt > 0u ? cnt : 1u;
}
__device__ __forceinline__ void xcd_barrier(const XcdBarrier& b) {
    asm volatile("s_waitcnt vmcnt(0)" ::: "memory");
    __syncthreads();
    if (b.wave == 0 && lane_id() == 0) {
        unsigned* bar = b.bar;
        __builtin_amdgcn_s_waitcnt(0);
        unsigned nloc = b.st[0], nx = b.st[1];
        if (nloc == 0u) { xcd_barrier_complete(bar, b.x, nloc, nx); b.st[0] = nloc; b.st[1] = nx; }
        const unsigned old = xb_add(&bar[XB_XSUB(b.x)], 1u);
        const unsigned gen = old / nloc;
        if (old + 1u == (gen + 1u) * nloc) {
            __builtin_amdgcn_fence(__ATOMIC_RELEASE, "agent");
            asm volatile("s_waitcnt vmcnt(0)" ::: "memory");
            const unsigned og = xb_add(&bar[XB_TOP], 1u);
            const unsigned tg = og / nx;
            if (og + 1u == (tg + 1u) * nx) xb_add(&bar[XB_TOPGEN], 1u);
            else XB_SPIN(xb_ld(&bar[XB_TOPGEN]) == tg, bar);
            __builtin_amdgcn_fence(__ATOMIC_ACQUIRE, "agent");
            xb_add(&bar[XB_XGEN(b.x)], 1u);
            asm volatile("s_waitcnt vmcnt(0)" ::: "memory");
        } else {
            XB_SPIN(xb_ld(&bar[XB_XGEN(b.x)]) == gen, bar);
            __builtin_amdgcn_fence(__ATOMIC_ACQUIRE, "agent");
            asm volatile("s_waitcnt vmcnt(0)" ::: "memory");
        }
    }
    __syncthreads();
}

#ifndef MK_COOP
#define MK_COOP 1
#endif
constexpr int N_PHASES = 9;
#define REP(k) for (int rep_ = 0; rep_ < ((MK_PROBE) == (k) ? 2 : 1); ++rep_)
__device__ __forceinline__ KParams kparams() { KParams p = (KParams)__builtin_amdgcn_kernarg_segment_ptr(); asm volatile("" : "+s"(p)); return p; }
__global__ void __launch_bounds__(NTHREADS, 2) mk_fwd(Params Parg) {
    (void)Parg;
    extern __shared__ __attribute__((aligned(16))) unsigned char lds_raw[];
    LAS unsigned char* lds = (LAS unsigned char*)lds_raw;
    const int wave_k = __builtin_amdgcn_readfirstlane((int)(threadIdx.x >> 6));
    const int G = gridDim.x, bx = blockIdx.x;
    const int vcu = (G % 8 == 0) ? (bx % 8) * (G / 8) + bx / 8 : bx;
    const int NGW = G * NWAVES;
#define PHASE_IDS() int tid = TID_(wave_k); asm volatile("" : "+v"(tid)); const int lane = tid & 63, wave = __builtin_amdgcn_readfirstlane(tid >> 6), gw = vcu * NWAVES + wave; (void)lane; (void)gw
#define ws (kparams()->ws)
#define dout ((char*)kparams()->out)
    const int ph_lo = kparams()->ph_lo, ph_hi = kparams()->ph_hi;
#define WSP(T_, off) ((T_*)(ws + (off)))
#if MK_COOP
#ifndef MK_CG_SYNC
#define MK_CG_SYNC 0
#endif
#if MK_CG_SYNC
#define GRID_SYNC() cg::this_grid().sync()
#else
    volatile LAS unsigned* MISC = (volatile LAS unsigned*)(lds + MISC_OFF);
    if (wave_k == 0 && lane_id() < 32) MISC[lane_id()] = 0u;
    __syncthreads();
    const XcdBarrier xbar = xcd_barrier_post((unsigned*)(ws + WS_CTL) + CW_BAR, MISC + 8, wave_k);
#define GRID_SYNC() xcd_barrier(xbar)
#endif
#else
#define GRID_SYNC() do {} while (0)
#endif
#define IN(k) (ph_lo <= (k) && (k) < ph_hi)
#define SEAM(k) do { if (IN(k) && IN((k) + 1)) GRID_SYNC(); } while (0)
#define H ((bf16_t*)(dout + DO_H))
#define SP ((bf16_t*)(dout + DO_SP))
#define X1 ((float*)dout)

    if (IN(0)) REP(0) { PHASE_IDS(); p0_prologue<0>(kparams(), lds, gw, NGW, wave, lane); }
    SEAM(0);
    if (IN(1)) REP(1) {
        pg8::Gemm g{1024 * 2, 1024 * 2, 128, 128, 16}; pg8::StdSched S; S.init(H, WSP(bf16_t, WS_WIN), T, 5120, 2048, 2048, G, bx);
        EpiIn E{WSP(bf16_t, WS_U), WSP(bf16_t, WS_QP), WSP(bf16_t, WS_QR), WSP(bf16_t, WS_KC), SP, WSP(bf16_t, WS_SA),
                WSP(float, WS_GN), WSP(float, WS_RCOS), WSP(float, WS_RSIN)};
        pg8::gemm_phase<EpiIn, pg8::StdSched, true>(lds, g, S, E, wave_k);
    }
    SEAM(1);
    if (IN(2)) REP(2) {
        const int ncmp = (G == 256) ? 64 : 32;
        if (bx >= ncmp) {
            { PHASE_IDS(); (void)gw; p2_pooled(WSP(bf16_t, WS_U), WSP(bf16_t, WS_PA), (bx - ncmp) * NWAVES + wave, (G - ncmp) * NWAVES, lane); }
            PHASE_IDS(); (void)gw;
            const int fr = lane & 15, fq = lane >> 4; const bf16_t* Wg = WSP(bf16_t, WS_WIN) + (size_t)5120 * 1024; float* GNp = WSP(float, WS_GN);
#pragma unroll 1
            for (int it = (((bx - ncmp) * NWAVES + wave) % 3) ? T / 32 : ((bx - ncmp) * NWAVES + wave) / 3; it < T / 32; it += ((G - ncmp) * NWAVES + 2) / 3) {
                const int r0 = 32 * it; f32x4 c2[2][3];
#pragma unroll
                for (int mt = 0; mt < 2; ++mt)
#pragma unroll
                    for (int nt = 0; nt < 3; ++nt) c2[mt][nt] = (f32x4){0.f, 0.f, 0.f, 0.f};
#pragma unroll 4
                for (int k0 = 0; k0 < 1024; k0 += 32) {
                    bf16x8 a[2], b[3];
#pragma unroll
                    for (int mt = 0; mt < 2; ++mt) a[mt] = *(const bf16x8*)(H + (size_t)(r0 + 16 * mt + fr) * 1024 + k0 + 8 * fq);
#pragma unroll
                    for (int nt = 0; nt < 3; ++nt) b[nt] = *(const bf16x8*)(Wg + (size_t)(16 * nt + fr) * 1024 + k0 + 8 * fq);
#pragma unroll
                    for (int mt = 0; mt < 2; ++mt)
#pragma unroll
                        for (int nt = 0; nt < 3; ++nt) c2[mt][nt] = __builtin_amdgcn_mfma_f32_16x16x32_bf16(a[mt], b[nt], c2[mt][nt], 0, 0, 0);
                }
#pragma unroll
                for (int mt = 0; mt < 2; ++mt)
#pragma unroll
                    for (int nt = 0; nt < 3; ++nt)
#pragma unroll
                        for (int r = 0; r < 4; ++r) GNp[(size_t)(r0 + 16 * mt + 4 * fq + r) * 48 + 16 * nt + fr] = sigmoidf_(c2[mt][nt][r] + 0.f);
            }
            if (G != 256) p0_prologue<1>(kparams(), lds, (bx - ncmp) * NWAVES + wave, (G - ncmp) * NWAVES, wave, lane);
        }
        __syncthreads();
        const int split = (G == 256) ? 1 : 0;
        pg8::Gemm g{4096 * 2, 2048 * 2, 512, 128, split ? 16 : 32, (split && (bx & 1)) ? -128 * 4096 * 2 : 0};
        CmpSched S{(const char*)WSP(bf16_t, WS_KC), (const char*)WSP(bf16_t, WS_VC), (const char*)WSP(bf16_t, WS_W1K), (const char*)WSP(bf16_t, WS_W1V), bx, split};
        EpiCmp E{WSP(bf16_t, WS_HIDK), WSP(bf16_t, WS_HIDV), WSP(float, WS_PEBK), WSP(float, WS_PEBV), WSP(bf16_t, WS_W2K), WSP(bf16_t, WS_W2V), WSP(bf16_t, WS_KCMP), WSP(bf16_t, WS_VCMP), ws, split};
        pg8::gemm_phase<EpiCmp, CmpSched, false>(lds, g, S, E, wave_k);
    }
    SEAM(2);
    if (IN(3)) REP(3) {
        const nsa::Tensors X{ws};
        const int wave_s = wave_k;
#pragma unroll 1
        for (int uu = vcu; uu < 256; uu += G) { const int bg = uu >> 5, i = uu & 31;
#pragma unroll 1
            for (int hh = 0; hh < 2; ++hh) nsa::unit(lds, X, bg >> 2, bg & 3, hh ? 63 - i : i, wave_s); }
        if (G == 256) {
            __syncthreads();
            PHASE_IDS(); (void)gw;
            late_weights_queue(kparams(), lds, wave, lane);
        }
    }
    SEAM(3);
    if (IN(4)) REP(4) {
        pg8::Gemm g{1536 * 2, 1536 * 2, 128, 128, 24}; pg8::StdSched S; S.init(WSP(bf16_t, WS_PA), WSP(bf16_t, WS_WM), T, 1024, 3072, 3072, G, bx);
        EpiMerged E{WSP(bf16_t, WS_MG), SP, WSP(bf16_t, WS_SA)};
        pg8::gemm_phase<EpiMerged, pg8::StdSched, false>(lds, g, S, E, wave_k);
    }
    SEAM(4);
    if (IN(5)) REP(5) {
        pg8::Gemm g{1024 * 2, 1024 * 2, 128, 128, 16}; pg8::StdSched S; S.init(WSP(bf16_t, WS_MG), WSP(bf16_t, WS_WO), T, 1024, 2048, 2048, G, bx);
        EpiX1 E{kparams()->x, X1, WSP(bf16_t, WS_X1B), WSP(float, WS_RS1)};
        pg8::gemm_phase<EpiX1, pg8::StdSched, false>(lds, g, S, E, wave_k);
    }
    SEAM(5);
    if (IN(6)) REP(6) {
        pg8::Gemm g{1024 * 2, 1024 * 2, 128, 128, 16}; pg8::StdSched S; S.init(WSP(bf16_t, WS_X1B), WSP(bf16_t, WS_WGU), T, 5632, 2048, 2048, G, bx);
        EpiAct E{WSP(bf16_t, WS_ACT), WSP(float, WS_RS1)};
        pg8::gemm_phase<EpiAct, pg8::StdSched, true>(lds, g, S, E, wave_k);
    }
    SEAM(6);
    if (IN(7)) {
        pg8::Gemm g{DFF * 2, DFF * 2, 128, 128, DFF / 64}; pg8::StdSched S; S.init(WSP(bf16_t, WS_ACT), WSP(bf16_t, WS_WD), T, 1024, DFF * 2, DFF * 2, G, bx);
        if (G == 256) {
            EpiFinal E{X1, WSP(bf16_t, WS_X1B), kparams()->normf_w, WSP(float, WS_SEL), (unsigned*)(ws + WS_CTL) + CW_FN};
            pg8::gemm_phase<EpiFinal, pg8::StdSched, false>(lds, g, S, E, wave_k);
        } else {
            EpiX2 E{X1, WSP(bf16_t, WS_X1B)};
            pg8::gemm_phase<EpiX2, pg8::StdSched, false>(lds, g, S, E, wave_k);
        }
    }
    if (G != 256) {
    SEAM(7);
    if (IN(8)) {
        PHASE_IDS();
        for (int row = gw; row < T; row += NGW) {
            f32x4* xr = (f32x4*)(X1 + (size_t)row * DM) + lane; const f32x4* wr = (const f32x4*)kparams()->normf_w + lane;
            f32x4 v[4]; float s = 0.f;
#pragma unroll
            for (int j = 0; j < 4; ++j) { v[j] = xr[64 * j]; s += (v[j].x * v[j].x + v[j].y * v[j].y) + (v[j].z * v[j].z + v[j].w * v[j].w); }
            const float rstd = rsqrtf(wave_sum(s) * (1.f / DM) + RMS_EPS);
#pragma unroll
            for (int j = 0; j < 4; ++j) { const f32x4 ww = wr[64 * j]; xr[64 * j] = (f32x4){v[j].x * rstd * ww.x, v[j].y * rstd * ww.y, v[j].z * rstd * ww.z, v[j].w * rstd * ww.w}; }
        }
    }
    }
#undef WSP
#undef ws
#undef dout
#undef H
#undef SP
#undef X1
}

extern "C" void kernel_launch(void* const* d_in, const int* in_sizes, int n_in, void* d_out, int out_size, void* d_ws, size_t ws_size, hipStream_t stream) {
    static int grid = 0;
    if (grid == 0) {
        if (n_in != 21 || ws_size < WS_END || out_size != T * DM) { fprintf(stderr, "kernel_launch: unexpected shapes n_in %d ws %zu out %d\n", n_in, ws_size, out_size); grid = -1; return; }
        int dev = 0, cus = 0, per_cu = 0;
        if (hipGetDevice(&dev) != hipSuccess || hipDeviceGetAttribute(&cus, hipDeviceAttributeMultiprocessorCount, dev) != hipSuccess) { grid = -1; return; }
        if (hipFuncSetAttribute((const void*)mk_fwd, hipFuncAttributeMaxDynamicSharedMemorySize, LDS_BYTES) != hipSuccess) { fprintf(stderr, "kernel_launch: hipFuncSetAttribute failed\n"); grid = -1; return; }
        if (hipOccupancyMaxActiveBlocksPerMultiprocessor(&per_cu, (const void*)mk_fwd, NTHREADS, LDS_BYTES) != hipSuccess || per_cu < 1) { fprintf(stderr, "kernel_launch: occupancy query says %d\n", per_cu); (void)hipGetLastError(); per_cu = 1; }
        grid = cus;
    }
    if (grid < 0) return;
    Params p{};
    const float** pin = (const float**)&p;
    for (int i = 0; i < 21; ++i) pin[i] = (const float*)d_in[i];
    p.out = (float*)d_out; p.ws = (unsigned char*)d_ws;
#if MK_COOP
    p.ph_lo = 0; p.ph_hi = N_PHASES;
    if (hipMemsetAsync((char*)d_ws + WS_CTL, 0, CTL_ZERO_BYTES, stream) != hipSuccess) { fprintf(stderr, "kernel_launch: memset failed\n"); return; }
    void* args[] = {&p};
    hipError_t e = hipLaunchCooperativeKernel((const void*)mk_fwd, dim3(grid), dim3(NTHREADS), args, LDS_BYTES, stream);
    if (e != hipSuccess) fprintf(stderr, "kernel_launch: cooperative launch failed: %s (grid %d)\n", hipGetErrorString(e), grid);
#else
    for (int ph = 0; ph < N_PHASES; ++ph) { p.ph_lo = ph; p.ph_hi = ph + 1; hipLaunchKernelGGL(mk_fwd, dim3(grid), dim3(NTHREADS), LDS_BYTES, stream, p); }
#endif
}
```

```cpp
#include <hip/hip_runtime.h>
#include <hip/hip_cooperative_groups.h>
#include <cstdint>
#include <cstdio>
namespace cg = cooperative_groups;
#ifndef MK_PROBE
#define MK_PROBE -1
#endif
#define SUBREP(k) for (int srep_ = 0; srep_ < ((MK_PROBE) == (k) ? 2 : 1); ++srep_)

#define LAS __attribute__((address_space(3)))
typedef unsigned short bf16_t;
typedef short bf16x8 __attribute__((ext_vector_type(8)));
typedef float f32x4 __attribute__((ext_vector_type(4)));
typedef unsigned u32x4 __attribute__((ext_vector_type(4)));
typedef unsigned u32x2 __attribute__((ext_vector_type(2)));

constexpr int BATCH = 2, SEQ = 8192, T = BATCH * SEQ, DM = 1024;
constexpr int NREF = 5168, NIN = 5376;
constexpr int DFF = 2816;
constexpr int NCP = 512;
constexpr float RMS_EPS = 1e-6f;
constexpr float C2 = 0.125f * 1.4426950408889634f;
constexpr int NWAVES = 8, NTHREADS = 512;

constexpr size_t MiB = 1u << 20;
constexpr size_t WS_CTL = 0;
constexpr size_t WS_PEBK = 1 * MiB, WS_PEBV = 1 * MiB + 4096, WS_RCOS = 1 * MiB + 65536, WS_RSIN = WS_RCOS + 262144;
constexpr size_t WS_RS1 = 2 * MiB;
constexpr size_t WS_SEL = 3 * MiB;
constexpr size_t WS_KCMP = 4 * MiB, WS_VCMP = 4 * MiB + 512 * 1024;
constexpr size_t WS_W2K = 5 * MiB, WS_W2V = 5 * MiB + 65536;
constexpr size_t WS_W1K = 6 * MiB, WS_W1V = 7 * MiB;
constexpr size_t WS_WIN = 8 * MiB;
constexpr size_t WS_WM = 19 * MiB;
constexpr size_t WS_WO = 22 * MiB;
constexpr size_t WS_WGU = 24 * MiB;
constexpr size_t WS_WD = 35 * MiB;
constexpr size_t WS_GN = 41 * MiB;
constexpr size_t WS_U = 44 * MiB;
constexpr size_t WS_QP = 60 * MiB;
constexpr size_t WS_MG = 60 * MiB;
constexpr size_t WS_KC = 92 * MiB, WS_VC = 100 * MiB, WS_KS = 108 * MiB, WS_VS = 116 * MiB, WS_KW = 124 * MiB, WS_VW = 132 * MiB;
constexpr size_t WS_SA = 140 * MiB;
constexpr size_t WS_PA = 172 * MiB;
constexpr size_t WS_QR = 220 * MiB;
constexpr size_t WS_X1B = 220 * MiB;
constexpr size_t WS_HIDK = 252 * MiB, WS_HIDV = 254 * MiB;
constexpr size_t WS_ACT = 44 * MiB;
constexpr size_t WS_END = 256 * MiB;
constexpr size_t DO_H = 0, DO_SP = 32 * MiB;

constexpr int RING_BYTES = 131072;
constexpr int MISC_OFF = 147456 - 256;
constexpr int GATE_OFF = 147456;
constexpr int LDS_BYTES = 147456 + 8 * 768;

__device__ __forceinline__ unsigned f2bf(float f) { unsigned u = __builtin_bit_cast(unsigned, f); return (u + 0x7fffu + ((u >> 16) & 1u)) >> 16; }
__device__ __forceinline__ float bf2f(unsigned b) { return __builtin_bit_cast(float, (b & 0xffffu) << 16); }
__device__ __forceinline__ unsigned pk2(float lo, float hi) { return f2bf(lo) | (f2bf(hi) << 16); }
typedef float f32x2_t __attribute__((ext_vector_type(2))); typedef __bf16 bf16x2_t __attribute__((ext_vector_type(2)));
__device__ __forceinline__ unsigned cvt_pk_bf16(float lo, float hi) { f32x2_t v = {lo, hi}; bf16x2_t b = __builtin_convertvector(v, bf16x2_t); return __builtin_bit_cast(unsigned, b); }
__device__ __forceinline__ u32x4 pack8(const f32x4& a, const f32x4& b) { u32x4 w; w.x = cvt_pk_bf16(a[0], a[1]); w.y = cvt_pk_bf16(a[2], a[3]); w.z = cvt_pk_bf16(b[0], b[1]); w.w = cvt_pk_bf16(b[2], b[3]); return w; }
__device__ __forceinline__ void unpack8(const u32x4& w, f32x4& a, f32x4& b) {
    a[0] = __builtin_bit_cast(float, w.x << 16); a[1] = __builtin_bit_cast(float, w.x & 0xffff0000u); a[2] = __builtin_bit_cast(float, w.y << 16); a[3] = __builtin_bit_cast(float, w.y & 0xffff0000u);
    b[0] = __builtin_bit_cast(float, w.z << 16); b[1] = __builtin_bit_cast(float, w.z & 0xffff0000u); b[2] = __builtin_bit_cast(float, w.w << 16); b[3] = __builtin_bit_cast(float, w.w & 0xffff0000u); }
__device__ __forceinline__ float sigmoidf_(float v) { return __builtin_amdgcn_rcpf(1.f + __expf(-v)); }
__device__ __forceinline__ float wave_sum(float v) {
#pragma unroll
    for (int o = 1; o < 64; o <<= 1) v += __shfl_xor(v, o);
    return v;
}
__device__ __forceinline__ float wave_max(float v) {
#pragma unroll
    for (int o = 1; o < 64; o <<= 1) v = fmaxf(v, __shfl_xor(v, o));
    return v;
}
#define WSYNC() asm volatile("s_waitcnt lgkmcnt(0)" ::: "memory")
__device__ __forceinline__ int lane_id() { int r; asm volatile("v_mbcnt_lo_u32_b32 %0, -1, 0\n\tv_mbcnt_hi_u32_b32 %0, -1, %0" : "=v"(r)); return r; }
#define TID_(wv) (64 * (wv) + lane_id())
#define OPAQUE(x) asm volatile("" : "+v"(x))
__host__ __device__ __forceinline__ int incol_ref(int c) {
    if (c < 3072) return c;
    if (c < 4096) return 3120 + (c - 3072);
    if (c < 5120) return 4144 + (c - 4096);
    if (c < 5168) return 3072 + (c - 5120);
    return -1;
}

struct Params {
    const float *x, *norm1_w, *w_in, *pool_w, *pool_scale, *pe_k, *w1_k, *b1_k, *w2_k, *pe_v, *w1_v, *b1_v, *w2_v, *w_pp, *w_pa, *w_out, *norm2_w, *w_g, *w_u, *w_d, *normf_w;
    float* out; unsigned char* ws;
    int ph_lo, ph_hi;
};

typedef const __attribute__((address_space(4))) Params* KParams;
namespace pg8 {
constexpr int BM = 256, BK = 64, HALF = 128, HTB = HALF * BK * 2, STAGE_BYTES = 8 * HTB, NXCD = 8, WGM = 8;
__host__ __device__ __forceinline__ int lds_byte(int r, int c) { const int st = (r >> 4) * 2 + (c >> 5), rr = r & 15, cc = c & 31, ob = rr * 64 + cc * 2; return st * 1024 + (ob ^ (((ob >> 9) & 1) << 5)); }
__host__ __device__ __forceinline__ void stage_rc(int b, int& R, int& C) { const int st = b / 1024, sb = b % 1024, swz = sb ^ (((sb >> 9) & 1) << 5); R = (st >> 1) * 16 + swz / 64; C = (st & 1) * 32 + (swz % 64) / 2; }
__host__ __device__ __forceinline__ int perm32(int rho) { const int n = rho >> 4, i = rho & 15; return 8 * (i >> 2) + 4 * n + (i & 3); }

struct Unit { int pm, pn; const char* A; const char* B; };
struct Gemm { int lda, ldb, ksA, ksB, nt, hsA; };

struct StaticOrder {
    int nM, nN, nwg, G, c;
    __device__ void init(int M, int N, int G_, int c_) { nM = M / BM; nN = N / BM; nwg = nM * nN; G = G_; c = c_; }
    __device__ bool next(int i, int& pm, int& pn) const {
        const long L = (long)i * G + c; if (L >= nwg) return false;
        int wgid = (int)L; { const int q = nwg / NXCD, r = nwg % NXCD, xcd = wgid % NXCD, off = wgid / NXCD; wgid = (xcd < r ? xcd * (q + 1) : r * (q + 1) + (xcd - r) * q) + off; }
        const int nig = WGM * nN, gid = wgid / nig, fm = gid * WGM, gsz = (nM - fm) < WGM ? (nM - fm) : WGM;
        pm = fm + ((wgid % nig) % gsz); pn = (wgid % nig) / gsz; return true;
    }
};
struct StdSched {
    StaticOrder so; const char* A; const char* B; size_t tA, tB;
    __device__ void init(const void* A_, const void* B_, int M, int N, int lda_bytes, int ldb_bytes, int G, int c) { so.init(M, N, G, c); A = (const char*)A_; B = (const char*)B_; tA = (size_t)256 * lda_bytes; tB = (size_t)256 * ldb_bytes; }
    __device__ bool next(int i, Unit& u) const { if (!so.next(i, u.pm, u.pn)) return false; u.A = A + u.pm * tA; u.B = B + u.pn * tB; return true; }
};

template <class Epi, class Sched, bool ALIGN_EPI>
__device__ __forceinline__ void gemm_phase(LAS unsigned char* lds, const Gemm g, const Sched& S, const Epi& E, int wave_k) {
    int tid = TID_(wave_k); asm volatile("" : "+v"(tid));
    const int wid = __builtin_amdgcn_readfirstlane(tid >> 6), lane = tid & 63, wr = wid >> 2, wc = wid & 3, fr = lane & 15, fq = lane >> 4;
    const int nt = g.nt;
    unsigned voffA[2], voffB[2];
#pragma unroll
    for (int i = 0; i < 2; ++i) { int R, C; stage_rc(tid * 16 + i * 8192, R, C); const int Rb = (R & ~31) + perm32(R & 31);
        voffA[i] = (unsigned)(R * g.lda + C * 2); voffB[i] = (unsigned)(Rb * g.ldb + C * 2); }
    const size_t kstepA = (size_t)g.ksA, kstepB = (size_t)g.ksB;
    const ptrdiff_t hstepA = g.hsA ? (ptrdiff_t)g.hsA : (ptrdiff_t)HALF * g.lda; const size_t hstepB = (size_t)HALF * g.ldb;
    const unsigned ldsw = (unsigned)wid * 1024u;
    const int aoff = lds_byte(wr * 64 + fr, fq * 8), boff = lds_byte(wc * 32 + fr, fq * 8);
#define PG8_SA(b, h) (((b) * 2 + (h)) * HTB)
#define PG8_SB(b, h) ((4 + (b) * 2 + (h)) * HTB)
#define PG8_STAGE(bufoff, gbase, voff) do { _Pragma("unroll") for (int _i = 0; _i < 2; ++_i) \
        __builtin_amdgcn_global_load_lds((const unsigned*)((const char*)(gbase) + (voff)[_i]), (LAS unsigned*)(lds + (bufoff) + ldsw + _i * 8192), 16, 0, 0); } while (0)
#define PG8_LDA(dst, b, h) do { _Pragma("unroll") for (int m = 0; m < 4; ++m) _Pragma("unroll") for (int k = 0; k < 2; ++k) dst[m][k] = *(const LAS bf16x8*)(lds + PG8_SA(b, h) + aoff + m * 2048 + k * 1024); } while (0)
#define PG8_LDB(dst, b, h) do { _Pragma("unroll") for (int n = 0; n < 2; ++n) _Pragma("unroll") for (int k = 0; k < 2; ++k) dst[n][k] = *(const LAS bf16x8*)(lds + PG8_SB(b, h) + boff + n * 2048 + k * 1024); } while (0)
#define PG8_MMA(ai, bj, At, Bt) do { __builtin_amdgcn_s_setprio(1); _Pragma("unroll") for (int m = 0; m < 4; ++m) _Pragma("unroll") for (int n = 0; n < 2; ++n) _Pragma("unroll") for (int k = 0; k < 2; ++k) \
        acc[ai][bj][m][n] = __builtin_amdgcn_mfma_f32_16x16x32_bf16(Bt[n][k], At[m][k], acc[ai][bj][m][n], 0, 0, 0); __builtin_amdgcn_s_setprio(0); } while (0)
#define PG8_WAIT_V(n) asm volatile("s_waitcnt vmcnt(" #n ")" ::: "memory")
#define PG8_WAIT_L(n) asm volatile("s_waitcnt lgkmcnt(" #n ")" ::: "memory")
#define PG8_BAR __builtin_amdgcn_s_barrier()
#define PG8_SCHED __builtin_amdgcn_sched_barrier(0)
    Unit cur, nxt; int ui = 0;
    if (!S.next(0, cur)) return;
    f32x4 acc[2][2][4][2];
#pragma unroll
    for (int a = 0; a < 2; ++a)
#pragma unroll
        for (int b = 0; b < 2; ++b)
#pragma unroll
            for (int m = 0; m < 4; ++m)
#pragma unroll
                for (int n = 0; n < 2; ++n) acc[a][b][m][n] = (f32x4){0.f, 0.f, 0.f, 0.f};
    bf16x8 At[4][2], B0[2][2], B1[2][2];
    const char* cA = cur.A; const char* cB = cur.B;
    PG8_STAGE(PG8_SB(0, 0), cB, voffB); PG8_STAGE(PG8_SB(0, 1), cB + hstepB, voffB); PG8_STAGE(PG8_SA(0, 0), cA, voffA); PG8_STAGE(PG8_SA(0, 1), cA + hstepA, voffA);
    if (wr == 1) PG8_BAR;
    PG8_WAIT_V(2); PG8_BAR;
    PG8_STAGE(PG8_SB(1, 0), cB + kstepB, voffB); PG8_STAGE(PG8_SA(1, 0), cA + kstepA, voffA); PG8_STAGE(PG8_SB(1, 1), cB + hstepB + kstepB, voffB);
    PG8_WAIT_V(6); PG8_BAR;
    for (;;) {
        const bool has_next = S.next(ui + 1, nxt);
        const char* nA = has_next ? nxt.A : cA; const char* nB = has_next ? nxt.B : cB;
        for (int t = 0; t < nt; t += 2) {
            const bool last = (t == nt - 2);
            const char* a1 = cA + (size_t)(t + 1) * kstepA;
            const char* a2 = last ? nA : cA + (size_t)(t + 2) * kstepA; const char* b2 = last ? nB : cB + (size_t)(t + 2) * kstepB;
            const char* a3 = a2 + kstepA; const char* b3 = b2 + kstepB;
            PG8_LDB(B0, 0, 0); PG8_LDB(B1, 0, 1); PG8_SCHED; PG8_LDA(At, 0, 0); PG8_STAGE(PG8_SA(1, 1), a1 + hstepA, voffA);
            PG8_WAIT_V(8); PG8_WAIT_L(0); PG8_BAR; PG8_MMA(0, 0, At, B0); PG8_MMA(0, 1, At, B1); PG8_BAR; PG8_SCHED;
            PG8_LDA(At, 0, 1); PG8_STAGE(PG8_SB(0, 0), b2, voffB); PG8_STAGE(PG8_SB(0, 1), b2 + hstepB, voffB); PG8_STAGE(PG8_SA(0, 0), a2, voffA);
            PG8_WAIT_V(8); PG8_WAIT_L(0); PG8_BAR; PG8_MMA(1, 0, At, B0); PG8_MMA(1, 1, At, B1); PG8_BAR; PG8_SCHED;
            PG8_LDB(B0, 1, 0); PG8_LDB(B1, 1, 1); PG8_SCHED; PG8_LDA(At, 1, 0); PG8_STAGE(PG8_SA(0, 1), a2 + hstepA, voffA);
            PG8_WAIT_V(8); PG8_WAIT_L(0); PG8_BAR; PG8_MMA(0, 0, At, B0); PG8_MMA(0, 1, At, B1); PG8_BAR; PG8_SCHED;
            PG8_LDA(At, 1, 1); PG8_STAGE(PG8_SB(1, 0), b3, voffB); PG8_STAGE(PG8_SB(1, 1), b3 + hstepB, voffB); PG8_STAGE(PG8_SA(1, 0), a3, voffA);
            PG8_WAIT_V(8); PG8_WAIT_L(0); PG8_BAR; PG8_MMA(1, 0, At, B0); PG8_MMA(1, 1, At, B1); PG8_BAR; PG8_SCHED;
            if constexpr (Epi::HOOK_KT > 0) { if (t + 2 == Epi::HOOK_KT) { E.hook(acc, cur, wr, wc, fr, fq); PG8_WAIT_V(0); PG8_SCHED; } }
        }
        if constexpr (ALIGN_EPI) { if (wr == 0) PG8_BAR; }
        if constexpr (!Epi::AFTER_DRAIN) { E(acc, cur, wr, wc, fr, fq); }
        if (!has_next) break;
#pragma unroll
        for (int a = 0; a < 2; ++a)
#pragma unroll
            for (int b = 0; b < 2; ++b)
#pragma unroll
                for (int m = 0; m < 4; ++m)
#pragma unroll
                    for (int n = 0; n < 2; ++n) acc[a][b][m][n] = (f32x4){0.f, 0.f, 0.f, 0.f};
        cur = nxt; cA = nA; cB = nB; ++ui;
        if constexpr (ALIGN_EPI) { if (wr == 1) PG8_BAR; }
    }
    PG8_WAIT_V(0);
    if constexpr (!ALIGN_EPI) { if (wr == 0) PG8_BAR; }
    PG8_BAR;
    if constexpr (Epi::AFTER_DRAIN) { E.fused(acc, cur, wr, wc, fr, fq, wid, lane, lds); }
#undef PG8_SA
#undef PG8_SB
#undef PG8_STAGE
#undef PG8_LDA
#undef PG8_LDB
#undef PG8_MMA
#undef PG8_WAIT_V
#undef PG8_WAIT_L
#undef PG8_BAR
#undef PG8_SCHED
}
}
using pg8::Unit;
typedef f32x4 Acc[2][2][4][2];
#define EPI_ROW(u, ai, wr, m, fr) ((u).pm * 256 + (ai) * 128 + (wr) * 64 + (m) * 16 + (fr))
#define EPI_LC(bj, wc, fq) ((bj) * 128 + (wc) * 32 + (fq) * 8)

constexpr int CW_XC = 14600;
struct EpiIn {
    static constexpr bool AFTER_DRAIN = false; static constexpr int HOOK_KT = 0;
    bf16_t *U, *QP, *QR, *KV0, *SP, *SA; float* GN; const float* RC; const float* RS;
    __device__ __forceinline__ void rope8(f32x4& v0, f32x4& v1, int t, bool apply, int fq) const {
        f32x4 p0, p1;
#pragma unroll
        for (int e = 0; e < 4; ++e) { p0[e] = __shfl_xor(v0[e], 16); p1[e] = __shfl_xor(v1[e], 16); }
        if (apply) {
            const f32x4 c0 = *(const f32x4*)(RC + t * 8), c1 = *(const f32x4*)(RC + t * 8 + 4), s0 = *(const f32x4*)(RS + t * 8), s1 = *(const f32x4*)(RS + t * 8 + 4);
            const float sg = (fq & 1) ? 1.f : -1.f;
            v0 = v0 * c0 + (p0 * s0) * sg; v1 = v1 * c1 + (p1 * s1) * sg;
        }
    }
    __device__ __forceinline__ void operator()(const Acc& acc, const Unit& u, int wr, int wc, int fr, int fq) const {
        OPAQUE(fr); OPAQUE(fq);
        const int pn = u.pn; const bool ropel = ((wc & 1) == 0) && fq < 2;
#pragma unroll
        for (int ai = 0; ai < 2; ++ai)
#pragma unroll
            for (int m = 0; m < 4; ++m) {
                const int r = EPI_ROW(u, ai, wr, m, fr), t = r & (SEQ - 1);
#pragma unroll
                for (int bj = 0; bj < 2; ++bj) {
                    const int lc = EPI_LC(bj, wc, fq); f32x4 v0 = acc[ai][bj][m][0], v1 = acc[ai][bj][m][1];
                    if (pn < 2) { *(u32x4*)(U + (size_t)r * 512 + pn * 256 + lc) = pack8(v0, v1); }
                    else if (pn < 6) {
                        v0 = v0 * C2; v1 = v1 * C2; const size_t o = (size_t)r * 1024 + (pn - 2) * 256 + lc;
                        *(u32x4*)(QP + o) = pack8(v0, v1);
                        if ((wc & 1) == 0) rope8(v0, v1, t, ropel, fq);
                        *(u32x4*)(QR + o) = pack8(v0, v1);
                    } else if (pn < 12) {
                        const int ty = pn - 6; bf16_t* dst = KV0 + (size_t)ty * (size_t)(4u << 20);
                        if ((ty == 2 || ty == 4) && (wc & 1) == 0) rope8(v0, v1, t, ropel, fq);
                        *(u32x4*)(dst + (size_t)r * 256 + lc) = pack8(v0, v1);
                    } else if (pn < 20) {
                        bf16_t* dst = pn < 16 ? SP : SA; const int cb = ((pn - 12) & 3) * 256 + lc;
#pragma unroll
                        for (int e = 0; e < 4; ++e) { v0[e] = sigmoidf_(v0[e]); v1[e] = sigmoidf_(v1[e]); }
                        *(u32x4*)(dst + (size_t)r * 1024 + cb) = pack8(v0, v1);
                    } else if (lc < 48) {
#pragma unroll
                        for (int e = 0; e < 4; ++e) { v0[e] = sigmoidf_(v0[e]); v1[e] = sigmoidf_(v1[e]); }
                        *(f32x4*)(GN + (size_t)r * 48 + lc) = v0; *(f32x4*)(GN + (size_t)r * 48 + lc + 4) = v1;
                    }
                }
            }
    }
};
__device__ __forceinline__ float gelu_tanh(float x) { const float u = 0.7978845608028654f * (x + 0.044715f * x * x * x); const float e = __expf(2.f * u); return 0.5f * x * (1.f + (1.f - 2.f * __builtin_amdgcn_rcpf(e + 1.f))); }
struct EpiCmp {
    static constexpr bool AFTER_DRAIN = true; static constexpr int HOOK_KT = 0;
    bf16_t *HIDK, *HIDV; const float *PEBK, *PEBV; const bf16_t *W2K, *W2V; bf16_t *KCMP, *VCMP; unsigned char* wsb; int split;
    template <int AI> __device__ __forceinline__ void gelu_half(const Acc& acc, bf16_t* HID, const float* peb, int rbase, int wr, int wc, int fr, int fq) const {
#pragma unroll
        for (int bj = 0; bj < 2; ++bj) {
            const int lc = EPI_LC(bj, wc, fq); const f32x4 b0 = *(const f32x4*)(peb + lc), b1 = *(const f32x4*)(peb + lc + 4);
#pragma unroll
            for (int m = 0; m < 4; ++m) {
                const int r = rbase + wr * 64 + m * 16 + fr; f32x4 v0 = acc[AI][bj][m][0] + b0, v1 = acc[AI][bj][m][1] + b1;
#pragma unroll
                for (int e = 0; e < 4; ++e) { v0[e] = gelu_tanh(v0[e]); v1[e] = gelu_tanh(v1[e]); }
                *(u32x4*)(HID + (size_t)r * 256 + lc) = pack8(v0, v1);
            }
        }
    }
    __device__ __forceinline__ void fused(Acc& acc, const Unit& u, int wr, int wc, int fr, int fq, int wid, int lane, LAS unsigned char* lds) const {
        OPAQUE(fr); OPAQUE(fq);
        const int h = u.pn, which = u.pm >> 4, rt = u.pm & 15; bf16_t* HID = which ? HIDV : HIDK; const float* peb = which ? PEBV : PEBK;
        if (split) {
            float* slabs = (float*)(wsb + (u.pm < 16 ? WS_WM : WS_WD)) + (size_t)((u.pm & 15) * 2) * (128 * 256);
            unsigned* cnt = (unsigned*)(wsb + WS_CTL) + CW_XC + (u.pm * 2) * 16;
            float* mine = slabs + (size_t)h * (128 * 256); const float* theirs = slabs + (size_t)(h ^ 1) * (128 * 256);
#pragma unroll
            for (int bj = 0; bj < 2; ++bj)
#pragma unroll
                for (int m = 0; m < 4; ++m) { float* p = mine + (size_t)(wr * 64 + m * 16 + fr) * 256 + EPI_LC(bj, wc, fq);
                    asm volatile("global_store_dwordx4 %0, %1, off sc0 sc1" :: "v"(p), "v"(acc[1][bj][m][0]) : "memory");
                    asm volatile("global_store_dwordx4 %0, %1, off offset:16 sc0 sc1" :: "v"(p), "v"(acc[1][bj][m][1]) : "memory"); }
            asm volatile("s_waitcnt vmcnt(0)" ::: "memory");
            if (lane == 0) __hip_atomic_fetch_add(cnt + 16 * h, 1u, __ATOMIC_RELAXED, __HIP_MEMORY_SCOPE_AGENT);
            if (wid == 0) {
                unsigned sp = 0; while ((unsigned)__builtin_amdgcn_readfirstlane((int)__hip_atomic_load(cnt + 16 * (h ^ 1), __ATOMIC_RELAXED, __HIP_MEMORY_SCOPE_AGENT)) < 8u && ++sp < (1u << 22)) __builtin_amdgcn_s_sleep(2);
            }
            asm volatile("s_waitcnt vmcnt(0) lgkmcnt(0)" ::: "memory"); __builtin_amdgcn_s_barrier(); asm volatile("" ::: "memory");
            __builtin_amdgcn_fence(__ATOMIC_ACQUIRE, "agent");
#pragma unroll
            for (int bj = 0; bj < 2; ++bj)
#pragma unroll
                for (int m = 0; m < 4; ++m) { const float* p = theirs + (size_t)(wr * 64 + m * 16 + fr) * 256 + EPI_LC(bj, wc, fq); acc[0][bj][m][0] += *(const f32x4*)p; acc[0][bj][m][1] += *(const f32x4*)(p + 4); }
        }
        const bf16_t* W2 = which ? W2V : W2K; bf16_t* OUT = which ? VCMP : KCMP; const int r0 = rt * 256 + (split ? h * 128 + wid * 16 : wid * 32);
        if (split) {
            bf16x8 b[8][4];
#pragma unroll
            for (int ks = 0; ks < 8; ++ks)
#pragma unroll
                for (int nt = 0; nt < 4; ++nt) b[ks][nt] = *(const bf16x8*)(W2 + (size_t)(16 * nt + fr) * 256 + 32 * ks + 8 * fq);
            LAS bf16_t* HL = (LAS bf16_t*)lds;
#pragma unroll
            for (int bj = 0; bj < 2; ++bj) {
                const int lc = EPI_LC(bj, wc, fq); const f32x4 b0 = *(const f32x4*)(peb + lc), b1 = *(const f32x4*)(peb + lc + 4);
#pragma unroll
                for (int m = 0; m < 4; ++m) {
                    f32x4 v0 = acc[0][bj][m][0] + b0, v1 = acc[0][bj][m][1] + b1;
#pragma unroll
                    for (int e = 0; e < 4; ++e) { v0[e] = gelu_tanh(v0[e]); v1[e] = gelu_tanh(v1[e]); }
                    *(LAS u32x4*)(HL + (wr * 64 + m * 16 + fr) * 264 + lc) = pack8(v0, v1);
                }
            }
            asm volatile("s_waitcnt lgkmcnt(0)" ::: "memory"); __builtin_amdgcn_s_barrier(); asm volatile("" ::: "memory");
            f32x4 c2[4];
#pragma unroll
            for (int nt = 0; nt < 4; ++nt) c2[nt] = (f32x4){0.f, 0.f, 0.f, 0.f};
#pragma unroll
            for (int ks = 0; ks < 8; ++ks) {
                const bf16x8 a = *(const LAS bf16x8*)(HL + (wid * 16 + fr) * 264 + 32 * ks + 8 * fq);
#pragma unroll
                for (int nt = 0; nt < 4; ++nt) c2[nt] = __builtin_amdgcn_mfma_f32_16x16x32_bf16(a, b[ks][nt], c2[nt], 0, 0, 0);
            }
#pragma unroll
            for (int nt = 0; nt < 4; ++nt)
#pragma unroll
                for (int r = 0; r < 4; ++r) OUT[(size_t)(r0 + 4 * fq + r) * 64 + 16 * nt + fr] = (bf16_t)f2bf(c2[nt][r]);
            return;
        }
        gelu_half<0>(acc, HID, peb, rt * 256, wr, wc, fr, fq);
        gelu_half<1>(acc, HID, peb, rt * 256 + 128, wr, wc, fr, fq);
        asm volatile("s_waitcnt vmcnt(0)" ::: "memory"); __syncthreads();
        f32x4 c2[2][4];
#pragma unroll
        for (int mt = 0; mt < 2; ++mt)
#pragma unroll
            for (int nt = 0; nt < 4; ++nt) c2[mt][nt] = (f32x4){0.f, 0.f, 0.f, 0.f};
        for (int k0 = 0; k0 < 256; k0 += 32) {
            bf16x8 a[2], b[4];
#pragma unroll
            for (int mt = 0; mt < 2; ++mt) a[mt] = *(const bf16x8*)(HID + (size_t)(r0 + (split ? 0 : 16 * mt) + fr) * 256 + k0 + 8 * fq);
#pragma unroll
            for (int nt = 0; nt < 4; ++nt) b[nt] = *(const bf16x8*)(W2 + (size_t)(16 * nt + fr) * 256 + k0 + 8 * fq);
#pragma unroll
            for (int mt = 0; mt < 2; ++mt)
#pragma unroll
                for (int nt = 0; nt < 4; ++nt) c2[mt][nt] = __builtin_amdgcn_mfma_f32_16x16x32_bf16(a[mt], b[nt], c2[mt][nt], 0, 0, 0);
        }
#pragma unroll
        for (int mt = 0; mt < 2; ++mt) {
            if (mt == 0 || !split) {
#pragma unroll
            for (int nt = 0; nt < 4; ++nt)
#pragma unroll
                for (int r = 0; r < 4; ++r) OUT[(size_t)(r0 + 16 * mt + 4 * fq + r) * 64 + 16 * nt + fr] = (bf16_t)f2bf(c2[mt][nt][r]);
            }
        }
    }
};
struct EpiMerged {
    static constexpr bool AFTER_DRAIN = false; static constexpr int HOOK_KT = 8;
    bf16_t* MG; const bf16_t* SP; const bf16_t* SA;
    __device__ __forceinline__ void hook(Acc& acc, const Unit& u, int wr, int wc, int fr, int fq) const {
        OPAQUE(fr); OPAQUE(fq);
#pragma unroll
        for (int ai = 0; ai < 2; ++ai)
#pragma unroll
            for (int m = 0; m < 4; ++m) {
                const int r = EPI_ROW(u, ai, wr, m, fr);
#pragma unroll
                for (int bj = 0; bj < 2; ++bj) {
                    const size_t o = (size_t)r * 1024 + u.pn * 256 + EPI_LC(bj, wc, fq);
                    const u32x4 wp = *(const u32x4*)(SP + o), wa = *(const u32x4*)(SA + o); f32x4 p0, p1, a0, a1; unpack8(wp, p0, p1); unpack8(wa, a0, a1);
#pragma unroll
                    for (int e = 0; e < 4; ++e) { acc[ai][bj][m][0][e] *= p0[e] * __builtin_amdgcn_rcpf(a0[e]); acc[ai][bj][m][1][e] *= p1[e] * __builtin_amdgcn_rcpf(a1[e]); }
                }
            }
    }
    __device__ __forceinline__ void operator()(const Acc& acc, const Unit& u, int wr, int wc, int fr, int fq) const {
        OPAQUE(fr); OPAQUE(fq);
        u32x4 wa[2][4][2];
#pragma unroll
        for (int ai = 0; ai < 2; ++ai)
#pragma unroll
            for (int m = 0; m < 4; ++m)
#pragma unroll
                for (int bj = 0; bj < 2; ++bj) wa[ai][m][bj] = *(const u32x4*)(SA + (size_t)EPI_ROW(u, ai, wr, m, fr) * 1024 + u.pn * 256 + EPI_LC(bj, wc, fq));
#pragma unroll
        for (int ai = 0; ai < 2; ++ai)
#pragma unroll
            for (int m = 0; m < 4; ++m) {
                const int r = EPI_ROW(u, ai, wr, m, fr);
#pragma unroll
                for (int bj = 0; bj < 2; ++bj) {
                    const size_t o = (size_t)r * 1024 + u.pn * 256 + EPI_LC(bj, wc, fq);
                    f32x4 a0, a1; unpack8(wa[ai][m][bj], a0, a1);
                    *(u32x4*)(MG + o) = pack8(acc[ai][bj][m][0] * a0, acc[ai][bj][m][1] * a1);
                }
            }
    }
};
struct EpiX1 {
    static constexpr bool AFTER_DRAIN = false; static constexpr int HOOK_KT = 0; static constexpr bool ACC_INIT = false;
    const float* x; float* X1; bf16_t* X1B; float* RSP;
    __device__ __forceinline__ void operator()(const Acc& acc, const Unit& u, int wr, int wc, int fr, int fq) const {
        OPAQUE(fr); OPAQUE(fq);
#pragma unroll
        for (int ai = 0; ai < 2; ++ai) {
            f32x4 xv[4][2][2];
#pragma unroll
            for (int m = 0; m < 4; ++m)
#pragma unroll
                for (int bj = 0; bj < 2; ++bj) { const float* xp = x + (size_t)EPI_ROW(u, ai, wr, m, fr) * 1024 + u.pn * 256 + EPI_LC(bj, wc, fq); xv[m][bj][0] = *(const f32x4*)xp; xv[m][bj][1] = *(const f32x4*)(xp + 4); }
#pragma unroll
            for (int m = 0; m < 4; ++m) {
                const int r = EPI_ROW(u, ai, wr, m, fr); float s = 0.f;
#pragma unroll
                for (int bj = 0; bj < 2; ++bj) {
                    const size_t o = (size_t)r * 1024 + u.pn * 256 + EPI_LC(bj, wc, fq);
                    const f32x4 o0 = xv[m][bj][0] + acc[ai][bj][m][0], o1 = xv[m][bj][1] + acc[ai][bj][m][1];
                    *(u32x4*)(X1B + o) = pack8(o0, o1);
                    s += (o0[0] * o0[0] + o0[1] * o0[1]) + (o0[2] * o0[2] + o0[3] * o0[3]) + (o1[0] * o1[0] + o1[1] * o1[1]) + (o1[2] * o1[2] + o1[3] * o1[3]);
                }
                s += __shfl_xor(s, 16); s += __shfl_xor(s, 32);
                if (fq == 0) RSP[(size_t)r * 16 + u.pn * 4 + wc] = s;
            }
        }
    }
};
struct EpiAct {
    static constexpr bool AFTER_DRAIN = false; static constexpr int HOOK_KT = 0;
    bf16_t* ACT; const float* RSP;
    __device__ __forceinline__ void operator()(const Acc& acc, const Unit& u, int wr, int wc, int fr, int fq) const {
        OPAQUE(fr); OPAQUE(fq);
#pragma unroll
        for (int ai = 0; ai < 2; ++ai)
#pragma unroll
            for (int m = 0; m < 4; ++m) {
                const int r = EPI_ROW(u, ai, wr, m, fr); const f32x4* rp = (const f32x4*)(RSP + (size_t)r * 16);
                const f32x4 q0 = rp[0], q1 = rp[1], q2 = rp[2], q3 = rp[3];
                const float ss = ((q0[0] + q0[1]) + (q0[2] + q0[3])) + ((q1[0] + q1[1]) + (q1[2] + q1[3])) + ((q2[0] + q2[1]) + (q2[2] + q2[3])) + ((q3[0] + q3[1]) + (q3[2] + q3[3]));
                const float rstd = rsqrtf(ss * (1.f / DM) + RMS_EPS);
                f32x4 o[2];
#pragma unroll
                for (int n = 0; n < 2; ++n)
#pragma unroll
                    for (int e = 0; e < 4; ++e) { const float gg = acc[ai][0][m][n][e] * rstd, uu = acc[ai][1][m][n][e] * rstd; o[n][e] = gg * sigmoidf_(gg) * uu; }
                *(u32x4*)(ACT + (size_t)r * DFF + u.pn * 128 + wc * 32 + fq * 8) = pack8(o[0], o[1]);
            }
    }
};
struct EpiX2 {
    static constexpr bool AFTER_DRAIN = false; static constexpr int HOOK_KT = 0;
    float* X; const bf16_t* X1B;
    __device__ __forceinline__ void operator()(const Acc& acc, const Unit& u, int wr, int wc, int fr, int fq) const {
        OPAQUE(fr); OPAQUE(fq);
#pragma unroll
        for (int ai = 0; ai < 2; ++ai)
#pragma unroll
            for (int m = 0; m < 4; ++m) {
                const int r = EPI_ROW(u, ai, wr, m, fr);
#pragma unroll
                for (int bj = 0; bj < 2; ++bj) {
                    const size_t o = (size_t)r * 1024 + u.pn * 256 + EPI_LC(bj, wc, fq); float* p = X + o;
                    const u32x4 xw = *(const u32x4*)(X1B + o); f32x4 x0, x1v; unpack8(xw, x0, x1v);
                    *(f32x4*)p = x0 + acc[ai][bj][m][0]; *(f32x4*)(p + 4) = x1v + acc[ai][bj][m][1];
                }
            }
    }
};
struct EpiFinal {
    static constexpr bool AFTER_DRAIN = true; static constexpr int HOOK_KT = 0;
    float* X; const bf16_t* X1B; const float* nw; float* slots; unsigned* cnt;
    __device__ __forceinline__ void fused(Acc& acc, const Unit& u, int wr, int wc, int fr, int fq, int wid, int lane, LAS unsigned char* lds) const {
        OPAQUE(fr); OPAQUE(fq);
        LAS float* Pl = (LAS float*)lds;
        LAS float* Sr = (LAS float*)(lds + 4096);
#pragma unroll
        for (int ai = 0; ai < 2; ++ai)
#pragma unroll
            for (int m = 0; m < 4; ++m) {
                const int r = EPI_ROW(u, ai, wr, m, fr); float sq = 0.f;
#pragma unroll
                for (int bj = 0; bj < 2; ++bj) {
                    { const u32x4 xw = *(const u32x4*)(X1B + (size_t)r * 1024 + u.pn * 256 + EPI_LC(bj, wc, fq)); f32x4 x0, x1v; unpack8(xw, x0, x1v); acc[ai][bj][m][0] += x0; acc[ai][bj][m][1] += x1v; }
                    const f32x4 a = acc[ai][bj][m][0], b = acc[ai][bj][m][1];
                    sq += ((a[0] * a[0] + a[1] * a[1]) + (a[2] * a[2] + a[3] * a[3])) + ((b[0] * b[0] + b[1] * b[1]) + (b[2] * b[2] + b[3] * b[3]));
                }
                sq += __shfl_xor(sq, 16); sq += __shfl_xor(sq, 32);
                if (fq == 0) Pl[(ai * 128 + wr * 64 + m * 16 + fr) * 4 + wc] = sq;
            }
        asm volatile("s_waitcnt lgkmcnt(0)" ::: "memory"); __builtin_amdgcn_s_barrier(); asm volatile("" ::: "memory");
        const int row = wid * 32 + (lane & 31);
        if (lane < 32) { const f32x4 q4 = *(const LAS f32x4*)(Pl + row * 4);
            __hip_atomic_store(slots + (size_t)(u.pm * 256 + row) * 4 + u.pn, (q4[0] + q4[1]) + (q4[2] + q4[3]), __ATOMIC_RELAXED, __HIP_MEMORY_SCOPE_AGENT); }
        asm volatile("s_waitcnt vmcnt(0)" ::: "memory");
        if (lane == 0) __hip_atomic_fetch_add(cnt + 64 * u.pm, 1u, __ATOMIC_RELAXED, __HIP_MEMORY_SCOPE_AGENT);
        if (wid == 0) {
            unsigned sp = 0; while ((unsigned)__builtin_amdgcn_readfirstlane((int)__hip_atomic_load(cnt + 64 * u.pm, __ATOMIC_RELAXED, __HIP_MEMORY_SCOPE_AGENT)) < 32u && ++sp < (1u << 22)) __builtin_amdgcn_s_sleep(2);
            __builtin_amdgcn_fence(__ATOMIC_ACQUIRE, "agent");
        }
        asm volatile("s_waitcnt vmcnt(0) lgkmcnt(0)" ::: "memory"); __builtin_amdgcn_s_barrier(); asm volatile("" ::: "memory");
        if (lane < 32) { const float* sl = slots + (size_t)(u.pm * 256 + row) * 4; float t = 0.f;
#pragma unroll
            for (int k = 0; k < 4; ++k) t += __hip_atomic_load(sl + k, __ATOMIC_RELAXED, __HIP_MEMORY_SCOPE_AGENT);
            Sr[row] = rsqrtf(t * (1.f / DM) + RMS_EPS); }
        asm volatile("s_waitcnt lgkmcnt(0)" ::: "memory"); __builtin_amdgcn_s_barrier(); asm volatile("" ::: "memory");
#pragma unroll
        for (int bj = 0; bj < 2; ++bj) {
            const int c0 = u.pn * 256 + EPI_LC(bj, wc, fq); const f32x4 w0 = *(const f32x4*)(nw + c0), w1 = *(const f32x4*)(nw + c0 + 4);
#pragma unroll
            for (int ai = 0; ai < 2; ++ai)
#pragma unroll
                for (int m = 0; m < 4; ++m) {
                    const int rl = ai * 128 + wr * 64 + m * 16 + fr; const float rs = Sr[rl]; float* p = X + (size_t)(u.pm * 256 + rl) * 1024 + c0;
                    *(f32x4*)p = acc[ai][bj][m][0] * w0 * rs; *(f32x4*)(p + 4) = acc[ai][bj][m][1] * w1 * rs;
                }
        }
    }
};
struct CmpSched {
    const char *KC, *VC, *W1K, *W1V; int c, split;
    __device__ bool next(int i, Unit& u) const {
        if (i > 0 || c >= (split ? 64 : 32)) return false;
        const int un = split ? c >> 1 : c, hk = split ? c & 1 : 0;
        const int which = un >> 4, rt = un & 15, bg = rt >> 1, half = rt & 1, b = bg >> 2, g = bg & 3;
        u.pm = un; u.pn = hk; u.A = (which ? VC : KC) + ((size_t)(b * SEQ + 16 * 256 * half + 16 * hk + (hk ? 16 * 128 : 0)) * 256 + g * 64) * 2; u.B = (which ? W1V : W1K) + (size_t)hk * 2048; return true;
    }
};

struct SF_in { const float* W; __device__ __forceinline__ float operator()(int k, int n) const { const int r = incol_ref(n); return r < 0 ? 0.f : W[(size_t)k * NREF + r]; } };
struct SF_plain { const float* W; int ldn; __device__ __forceinline__ float operator()(int k, int n) const { return W[(size_t)k * ldn + n]; } };
struct SF_gu { const float *Wg, *Wu, *nw; __device__ __forceinline__ float operator()(int k, int n) const {
    const int tile = n >> 8, half = (n >> 7) & 1, j = n & 127, col = tile * 128 + j; const ptrdiff_t d = Wu - Wg; return nw[k] * Wg[(ptrdiff_t)half * d + (ptrdiff_t)k * DFF + col]; } };
__device__ __forceinline__ void p0_tile_out(int K, bf16_t* WT, LAS float* scr, int k0, int n0, int lane) {
    WSYNC();
    const int c = lane & 7;
#pragma unroll
    for (int j = 0; j < 4; ++j) { const int n = (lane >> 3) + 8 * j; const LAS float* s = scr + (8 * c) * 33 + n;
        u32x4 o; o.x = pk2(s[0 * 33], s[1 * 33]); o.y = pk2(s[2 * 33], s[3 * 33]); o.z = pk2(s[4 * 33], s[5 * 33]); o.w = pk2(s[6 * 33], s[7 * 33]);
        *(u32x4*)(WT + (size_t)(n0 + n) * K + k0 + 8 * c) = o; }
    WSYNC();
}
template <class SF> __device__ __forceinline__ void p0_transpose_item(const SF& sf, int K, int N, bf16_t* WT, LAS float* scr, int item, int lane) {
    const int nblk = N / 32, kb = item / nblk, nb = item % nblk, k0 = 64 * kb, n0 = 32 * nb;
    float v[32];
#pragma unroll
    for (int i = 0; i < 32; ++i) v[i] = sf(k0 + 2 * i + (lane >> 5), n0 + (lane & 31));
#pragma unroll
    for (int i = 0; i < 32; ++i) scr[(2 * i + (lane >> 5)) * 33 + (lane & 31)] = v[i];
    p0_tile_out(K, WT, scr, k0, n0, lane);
}
template <class SF> __device__ __forceinline__ void p0_transpose_item2(const SF& sf, int K, int N, bf16_t* WT, LAS float* scr, int item, int lane) {
    const int nblk = N / 32;
    const int kbA = item / nblk, nbA = item % nblk, kbB = (item + 1) / nblk, nbB = (item + 1) % nblk;
    float va[32], vb[32];
#pragma unroll
    for (int i = 0; i < 32; ++i) va[i] = sf(64 * kbA + 2 * i + (lane >> 5), 32 * nbA + (lane & 31));
#pragma unroll
    for (int i = 0; i < 32; ++i) vb[i] = sf(64 * kbB + 2 * i + (lane >> 5), 32 * nbB + (lane & 31));
#pragma unroll
    for (int i = 0; i < 32; ++i) scr[(2 * i + (lane >> 5)) * 33 + (lane & 31)] = va[i];
    p0_tile_out(K, WT, scr, 64 * kbA, 32 * nbA, lane);
#pragma unroll
    for (int i = 0; i < 32; ++i) scr[(2 * i + (lane >> 5)) * 33 + (lane & 31)] = vb[i];
    p0_tile_out(K, WT, scr, 64 * kbB, 32 * nbB, lane);
}
__device__ __forceinline__ void p0_fold_item(const float* pool_w, const float* pool_scale, const float* Wp, bf16_t* WT, int f, int wave, int lane) {
    const int k0 = 64 * (f >> 5), n0 = 32 * (f & 31) + 4 * wave, g = k0 >> 7;
    f32x4 acc = (f32x4){0.f, 0.f, 0.f, 0.f};
    const float* arow = pool_w + (size_t)(k0 + lane) * 128;
#pragma unroll 4
    for (int dp = 0; dp < 128; dp += 4) {
        const f32x4 a = *(const f32x4*)(arow + dp); const f32x4 sc = *(const f32x4*)(pool_scale + g * 128 + dp);
#pragma unroll
        for (int e = 0; e < 4; ++e) { const f32x4 w4 = *(const f32x4*)(Wp + (size_t)(g * 128 + dp + e) * 1024 + n0); acc += w4 * (a[e] * sc[e]); }
    }
#pragma unroll
    for (int j = 0; j < 4; ++j) WT[(size_t)(n0 + j) * 1536 + k0 + lane] = (bf16_t)f2bf(acc[j]);
}
__device__ __forceinline__ void p0_fold_item2(const float* pool_w, const float* pool_scale, const float* Wp, bf16_t* WT, int f, int lane) {
    const int g = f >> 5, kb = (f >> 2) & 7, nb = f & 3, kk0 = g * 128 + kb * 16, n0 = nb * 256 + 4 * lane;
    f32x4 acc[16];
#pragma unroll
    for (int r = 0; r < 16; ++r) acc[r] = (f32x4){0.f, 0.f, 0.f, 0.f};
    const float* bp = Wp + (size_t)(g * 128) * 1024 + n0;
#pragma unroll 1
    for (int dp = 0; dp < 128; dp += 4) {
        const f32x4 sc = *(const f32x4*)(pool_scale + g * 128 + dp);
        f32x4 b[4];
#pragma unroll
        for (int e = 0; e < 4; ++e) b[e] = *(const f32x4*)(bp + (size_t)(dp + e) * 1024);
#pragma unroll
        for (int r = 0; r < 16; ++r) {
            const f32x4 a = *(const f32x4*)(pool_w + (size_t)(kk0 + r) * 128 + dp);
#pragma unroll
            for (int e = 0; e < 4; ++e) acc[r] += b[e] * (a[e] * sc[e]);
        }
    }
#pragma unroll
    for (int j = 0; j < 4; ++j) {
        u32x4 w0, w1;
        w0.x = pk2(acc[0][j], acc[1][j]); w0.y = pk2(acc[2][j], acc[3][j]); w0.z = pk2(acc[4][j], acc[5][j]); w0.w = pk2(acc[6][j], acc[7][j]);
        w1.x = pk2(acc[8][j], acc[9][j]); w1.y = pk2(acc[10][j], acc[11][j]); w1.z = pk2(acc[12][j], acc[13][j]); w1.w = pk2(acc[14][j], acc[15][j]);
        bf16_t* o = WT + (size_t)(n0 + j) * 1536 + kk0; *(u32x4*)o = w0; *(u32x4*)(o + 8) = w1;
    }
}
template <int PART> __device__ __forceinline__ void p0_prologue(KParams P, LAS unsigned char* lds, int gw, int NGW, int wave, int lane) {
    unsigned char* ws = P->ws;
    LAS float* scr = (LAS float*)(lds + wave * 16384);
    constexpr int I_IN = (1024 / 64) * (NIN / 32), I_W1 = (2048 / 64) * (256 / 32), I_W2 = (256 / 64) * (64 / 32), I_WM = (1024 / 64) * (1024 / 32), I_WO = (1024 / 64) * (1024 / 32),
                  I_GU = (1024 / 64) * (5632 / 32), I_WD = (2816 / 64) * (1024 / 32);
    if constexpr (PART == 1) {
        constexpr int NITEMS = I_WM + I_WO + I_WD;
        for (int f = gw >> 3; f < 256; f += NGW >> 3) p0_fold_item(P->pool_w, P->pool_scale, P->w_pp, (bf16_t*)(ws + WS_WM), f, wave, lane);
        for (int it = gw; it < NITEMS; it += NGW) {
            int r = it;
            if (r < I_WM) { p0_transpose_item(SF_plain{P->w_pa, 1024}, 1536, 1024, (bf16_t*)(ws + WS_WM) + 512, scr, r, lane); continue; } r -= I_WM;
            if (r < I_WO) { p0_transpose_item(SF_plain{P->w_out, 1024}, 1024, 1024, (bf16_t*)(ws + WS_WO), scr, r, lane); continue; } r -= I_WO;
            p0_transpose_item(SF_plain{P->w_d, 1024}, 2816, 1024, (bf16_t*)(ws + WS_WD), scr, r, lane);
        }
        return;
    }
    const int nGU = (NGW == 256 * NWAVES) ? 0 : I_GU;
    const int NITEMS = I_IN + 2 * I_W1 + 2 * I_W2 + nGU;
    for (int it = gw; it < NITEMS; it += NGW) {
        int r = it;
        if (r < nGU) { p0_transpose_item(SF_gu{P->w_g, P->w_u, P->norm2_w}, 1024, 5632, (bf16_t*)(ws + WS_WGU), scr, r, lane); continue; } r -= nGU;
        if (r < I_IN) { p0_transpose_item(SF_in{P->w_in}, 1024, NIN, (bf16_t*)(ws + WS_WIN), scr, r, lane); continue; } r -= I_IN;
        if (r < I_W1) { p0_transpose_item(SF_plain{P->w1_k, 256}, 2048, 256, (bf16_t*)(ws + WS_W1K), scr, r, lane); continue; } r -= I_W1;
        if (r < I_W1) { p0_transpose_item(SF_plain{P->w1_v, 256}, 2048, 256, (bf16_t*)(ws + WS_W1V), scr, r, lane); continue; } r -= I_W1;
        if (r < I_W2) { p0_transpose_item(SF_plain{P->w2_k, 64}, 256, 64, (bf16_t*)(ws + WS_W2K), scr, r, lane); continue; } r -= I_W2;
        p0_transpose_item(SF_plain{P->w2_v, 64}, 256, 64, (bf16_t*)(ws + WS_W2V), scr, r, lane);
    }
    for (int it = (gw & 31) ? 64 : (gw >> 5); it < 64; it += NGW >> 5) {
        const int which = it >> 5, c0 = (it & 31) * 8; const float* pe = which ? P->pe_v : P->pe_k; const float* w1 = which ? P->w1_v : P->w1_k; const float* b1 = which ? P->b1_v : P->b1_k;
        f32x4 s0 = (f32x4){0.f, 0.f, 0.f, 0.f}, s1 = s0;
#pragma unroll 8
        for (int j = 0; j < 32; ++j) { const int k = lane + 64 * j; const float p = pe[k]; s0 += *(const f32x4*)(w1 + (size_t)k * 256 + c0) * p; s1 += *(const f32x4*)(w1 + (size_t)k * 256 + c0 + 4) * p; }
#pragma unroll
        for (int e = 0; e < 4; ++e) { s0[e] = wave_sum(s0[e]); s1[e] = wave_sum(s1[e]); }
        if (lane == 0) { float* o = (float*)(ws + (which ? WS_PEBV : WS_PEBK)) + c0; *(f32x4*)o = s0 + *(const f32x4*)(b1 + c0); *(f32x4*)(o + 4) = s1 + *(const f32x4*)(b1 + c0 + 4); }
    }
    for (int it = gw; it < SEQ * 8 / 64; it += NGW) {
        const int idx = it * 64 + lane, i = idx & 7, t = idx >> 3;
        const float inv_freq = i == 0 ? 1.0f : i == 1 ? 0.193922758102417f : i == 2 ? 0.03760603070259094f : i == 3 ? 0.00729266507551074f : i == 4 ? 0.001414213445968926f : i == 5 ? 0.00027424818836152554f : i == 6 ? 5.318296462064609e-05f : 1.0313385246263351e-05f;
        const float ang = (float)t * inv_freq;
        ((float*)(ws + WS_RCOS))[idx] = cosf(ang); ((float*)(ws + WS_RSIN))[idx] = sinf(ang);
    }
    bf16_t* H = (bf16_t*)((char*)P->out + DO_H);
#pragma unroll 1
    for (int row = gw; row < T; row += NGW) {
        const f32x4* xr = (const f32x4*)(P->x + (size_t)row * DM) + lane; const f32x4* wr = (const f32x4*)P->norm1_w + lane;
        f32x4 v[4]; float s = 0.f;
#pragma unroll
        for (int j = 0; j < 4; ++j) { v[j] = xr[64 * j]; s += (v[j].x * v[j].x + v[j].y * v[j].y) + (v[j].z * v[j].z + v[j].w * v[j].w); }
        const float rstd = rsqrtf(wave_sum(s) * (1.f / DM) + RMS_EPS);
        u32x2* o = (u32x2*)(H + (size_t)row * DM) + lane;
#pragma unroll
        for (int j = 0; j < 4; ++j) { const f32x4 ww = wr[64 * j]; u32x2 p; p.x = pk2(v[j].x * rstd * ww.x, v[j].y * rstd * ww.y); p.y = pk2(v[j].z * rstd * ww.z, v[j].w * rstd * ww.w); o[64 * j] = p; }
    }
}
template <int W> __device__ __forceinline__ void pooled_item(const bf16_t* U, bf16_t* PA, int g, int rb, int lane) {
    const int row = rb * 4 + (lane >> 4), c0 = g * 128 + (lane & 15) * 8, t = row & (SEQ - 1), cnt = t + 1 < W ? t + 1 : W;
    u32x4 q[W];
#pragma unroll
    for (int i = 0; i < W; ++i) q[i] = *(const u32x4*)(U + (size_t)(row - (i < cnt ? i : 0)) * 512 + c0);
    f32x4 u0, u1; unpack8(q[0], u0, u1); f32x4 s0 = u0, s1 = u1;
#pragma unroll
    for (int i = 1; i < W; ++i) { f32x4 a, b; unpack8(q[i], a, b); if (i < cnt) { s0 += a; s1 += b; } }
    const float ic = 1.f / (float)cnt;
    *(u32x4*)(PA + (size_t)row * 1536 + c0) = pack8(s0 * ic - u0, s1 * ic - u1);
}
template <int W> __device__ __forceinline__ void pooled_load(const bf16_t* U, int g, int rb, int lane, u32x4 (&q)[W]) {
    const int row = rb * 4 + (lane >> 4), c0 = g * 128 + (lane & 15) * 8, t = row & (SEQ - 1), cnt = t + 1 < W ? t + 1 : W;
#pragma unroll
    for (int i = 0; i < W; ++i) q[i] = *(const u32x4*)(U + (size_t)(row - (i < cnt ? i : 0)) * 512 + c0);
}
template <int W> __device__ __forceinline__ void pooled_store(bf16_t* PA, int g, int rb, int lane, const u32x4 (&q)[W]) {
    const int row = rb * 4 + (lane >> 4), c0 = g * 128 + (lane & 15) * 8, t = row & (SEQ - 1), cnt = t + 1 < W ? t + 1 : W;
    f32x4 u0, u1; unpack8(q[0], u0, u1); f32x4 s0 = u0, s1 = u1;
#pragma unroll
    for (int i = 1; i < W; ++i) { f32x4 a, b; unpack8(q[i], a, b); if (i < cnt) { s0 += a; s1 += b; } }
    const float ic = 1.f / (float)cnt;
    *(u32x4*)(PA + (size_t)row * 1536 + c0) = pack8(s0 * ic - u0, s1 * ic - u1);
}
__device__ __forceinline__ void p2_pooled(const bf16_t* U, bf16_t* PA, int gw, int NGW, int lane) {
#pragma unroll 1
    for (int rb = gw; rb < T / 4; rb += NGW) {
        { u32x4 q16[16]; pooled_load<16>(U, 3, rb, lane, q16); pooled_store<16>(PA, 3, rb, lane, q16); }
        { u32x4 q2[2], q4[4], q8[8]; pooled_load<8>(U, 2, rb, lane, q8); pooled_load<4>(U, 1, rb, lane, q4); pooled_load<2>(U, 0, rb, lane, q2);
          pooled_store<2>(PA, 0, rb, lane, q2); pooled_store<4>(PA, 1, rb, lane, q4); pooled_store<8>(PA, 2, rb, lane, q8); }
    }
}

constexpr int CW_DQ = 14400;
constexpr int DQ_FOLD = 128, DQ_I_WM = (1024 / 64) * (1024 / 32), DQ_I_WO = DQ_I_WM, DQ_I_WD = (2816 / 64) * (1024 / 32), DQ_I_GU = (1024 / 64) * (5632 / 32), DQ_TR = (DQ_I_WM + DQ_I_WO + DQ_I_WD + DQ_I_GU) / 2, DQ_NT = DQ_FOLD + DQ_TR;
__device__ __forceinline__ void late_weights_queue(KParams P, LAS unsigned char* lds, int wave, int lane) {
    unsigned char* ws = P->ws; unsigned* ctl = (unsigned*)(ws + WS_CTL);
    LAS float* scr = (LAS float*)(lds + wave * 16384);
#pragma unroll 1
    for (;;) {
        unsigned tk = 0u;
        if (lane == 0) tk = __hip_atomic_fetch_add(ctl + CW_DQ, 1u, __ATOMIC_RELAXED, __HIP_MEMORY_SCOPE_AGENT);
        const int t = __builtin_amdgcn_readfirstlane((int)tk);
        if (t >= DQ_NT) break;
        if (t < DQ_FOLD) p0_fold_item2(P->pool_w, P->pool_scale, P->w_pp, (bf16_t*)(ws + WS_WM), t, lane);
        else {
            int r = (t - DQ_FOLD) * 2;
            if (r < DQ_I_GU) { p0_transpose_item2(SF_gu{P->w_g, P->w_u, P->norm2_w}, 1024, 5632, (bf16_t*)(ws + WS_WGU), scr, r, lane); continue; } r -= DQ_I_GU;
            if (r < DQ_I_WD) { p0_transpose_item2(SF_plain{P->w_d, 1024}, 2816, 1024, (bf16_t*)(ws + WS_WD), scr, r, lane); continue; } r -= DQ_I_WD;
            if (r < DQ_I_WM) { p0_transpose_item2(SF_plain{P->w_pa, 1024}, 1536, 1024, (bf16_t*)(ws + WS_WM) + 512, scr, r, lane); continue; } r -= DQ_I_WM;
            p0_transpose_item2(SF_plain{P->w_out, 1024}, 1024, 1024, (bf16_t*)(ws + WS_WO), scr, r, lane);
        }
    }
}

namespace nsa {
constexpr int NS = 4, SLOT = 16384, RING = NS * SLOT, WSCR = 8704;
constexpr float THR = 8.f;
typedef short v4i16_t __attribute__((ext_vector_type(4)));
__device__ __forceinline__ float xor1_add(float v) { return v + __builtin_bit_cast(float, __builtin_amdgcn_mov_dpp(__builtin_bit_cast(int, v), 0xB1, 0xF, 0xF, true)); }
__device__ __forceinline__ float xor2_add(float v) { return v + __builtin_bit_cast(float, __builtin_amdgcn_mov_dpp(__builtin_bit_cast(int, v), 0x4E, 0xF, 0xF, true)); }
__device__ __forceinline__ float gmax(float m) {
    auto a = __builtin_amdgcn_permlane16_swap(__float_as_uint(m), __float_as_uint(m), false, false); m = fmaxf(__uint_as_float(a[0]), __uint_as_float(a[1]));
    auto b = __builtin_amdgcn_permlane32_swap(__float_as_uint(m), __float_as_uint(m), false, false); return fmaxf(__uint_as_float(b[0]), __uint_as_float(b[1])); }
__device__ __forceinline__ float gsum(float m) {
    auto a = __builtin_amdgcn_permlane16_swap(__float_as_uint(m), __float_as_uint(m), false, false); m = __uint_as_float(a[0]) + __uint_as_float(a[1]);
    auto b = __builtin_amdgcn_permlane32_swap(__float_as_uint(m), __float_as_uint(m), false, false); return __uint_as_float(b[0]) + __uint_as_float(b[1]); }
struct Lane {
    int wave, lane, g, c; unsigned kbase, vbase; unsigned lds0;
    __device__ __forceinline__ void init(int tid, LAS unsigned char* lds) {
        lane = tid & 63; wave = __builtin_amdgcn_readfirstlane(tid >> 6); g = lane >> 4; c = lane & 15; lds0 = (unsigned)(size_t)lds;
        kbase = (unsigned)(c * 128 + ((g ^ (lane & 7)) << 4));
        const int q = (lane >> 2) & 3, p = lane & 3, rx = 4 * (g & 1) + q;
        vbase = (unsigned)((4 * g + q) * 128 + (((p >> 1) ^ rx) << 4) + (p & 1) * 8);
    }
};
struct Src { const char* k; const char* v; unsigned loff, tstride; };
__device__ __forceinline__ Src make_src(const bf16_t* K, const bf16_t* V, size_t row0, int stride_el, int col0, const Lane& L) {
    Src s; s.k = (const char*)(K + row0 * stride_el + col0); s.v = (const char*)(V + row0 * stride_el + col0);
    const int R = 8 * L.wave + (L.lane >> 3), ch = (L.lane & 7) ^ ((L.lane >> 3) & 7);
    s.loff = (unsigned)((R * stride_el + ch * 8) * 2); s.tstride = (unsigned)(64 * stride_el * 2); return s;
}
__device__ __forceinline__ void glds16(const void* gsrc, unsigned lds_dst) { unsigned keep;
    asm volatile("s_mov_b32 %0, m0\n\ts_mov_b32 m0, %2\n\ts_nop 0\n\tglobal_load_lds_dwordx4 %1, off\n\ts_mov_b32 m0, %0" : "=&s"(keep) : "v"(gsrc), "s"(lds_dst) : "memory"); }
__device__ __forceinline__ void issue(const Lane& L, const Src& S, int tile, int slot) {
    const char* gk = S.k + (size_t)tile * S.tstride + S.loff; const char* gv = S.v + (size_t)tile * S.tstride + S.loff;
    const unsigned d = (unsigned)__builtin_amdgcn_readfirstlane((int)(L.lds0 + slot * SLOT + L.wave * 1024));
    glds16(gk, d); glds16(gv, d + 8192);
}
struct Frags { unsigned k0, k1, v0, v1, v2, v3; };
typedef Frags TileAddr;
template <bool WITH_V> __device__ __forceinline__ void load_frags(const TileAddr& A, const Lane& L, Frags& F) { F = A; }
__device__ __forceinline__ void load_k(const Frags& F, const Lane& L, bf16x8 (&kf)[4][2]) {
#pragma unroll
    for (int mt = 0; mt < 4; ++mt) {
        kf[mt][0] = *(const LAS bf16x8*)((const LAS unsigned char*)(size_t)F.k0 + mt * 2048);
        kf[mt][1] = *(const LAS bf16x8*)((const LAS unsigned char*)(size_t)F.k1 + mt * 2048);
    }
}
__device__ __forceinline__ void load_vdt(unsigned va, bf16x8 (&vf)[2]) {
#pragma unroll
    for (int ks = 0; ks < 2; ++ks) {
        const v4i16_t lo = __builtin_amdgcn_ds_read_tr16_b64_v4i16((LAS v4i16_t*)((LAS unsigned char*)(size_t)va + ks * 4096));
        const v4i16_t hi = __builtin_amdgcn_ds_read_tr16_b64_v4i16((LAS v4i16_t*)((LAS unsigned char*)(size_t)va + ks * 4096 + 2048));
        vf[ks] = (bf16x8){lo[0], lo[1], lo[2], lo[3], hi[0], hi[1], hi[2], hi[3]};
    }
}
__device__ __forceinline__ void load_v(const Frags& F, const Lane& L, bf16x8 (&vf)[4][2]) { load_vdt(F.v0, vf[0]); load_vdt(F.v1, vf[1]); load_vdt(F.v2, vf[2]); load_vdt(F.v3, vf[3]); }
template <bool WITH_V, bool MASKED, class MaskFn>
__device__ __forceinline__ void visit_slow(const Frags& F, const Lane& L, const bf16x8 (&q)[2], f32x4 (&o)[4], float& mref, float& lsum, bool colsel, const MaskFn& valid) {
    const bool seen = mref != -INFINITY;
    const float c0 = colsel ? (seen ? -mref : 0.f) : -INFINITY;
    const f32x4 ci = (f32x4){c0, c0, c0, c0};
    f32x4 s[4];
    { bf16x8 kf[4][2]; load_k(F, L, kf);
#pragma unroll
    for (int mt = 0; mt < 4; ++mt) {
        s[mt] = __builtin_amdgcn_mfma_f32_16x16x32_bf16(kf[mt][0], q[0], ci, 0, 0, 0);
        s[mt] = __builtin_amdgcn_mfma_f32_16x16x32_bf16(kf[mt][1], q[1], s[mt], 0, 0, 0);
    } }
    __builtin_amdgcn_sched_barrier(0);
    bf16x8 vf[4][2]; if constexpr (WITH_V) load_v(F, L, vf);
    if constexpr (MASKED) {
#pragma unroll
        for (int mt = 0; mt < 4; ++mt)
#pragma unroll
            for (int r = 0; r < 4; ++r) if (!valid(16 * mt + 4 * L.g + r)) s[mt][r] = -INFINITY;
    }
    float mx = fmaxf(fmaxf(s[0][0], s[0][1]), fmaxf(s[0][2], s[0][3]));
#pragma unroll
    for (int mt = 1; mt < 4; ++mt) mx = fmaxf(mx, fmaxf(fmaxf(s[mt][0], s[mt][1]), fmaxf(s[mt][2], s[mt][3])));
    if (__any((mx > THR) || (!seen && mx > -INFINITY))) {
        const float mxr = gmax(mx);
        const float d = (mxr == -INFINITY) ? 0.f : (seen ? fmaxf(mxr, 0.f) : mxr);
        const float f = __builtin_amdgcn_exp2f(-d);
        if (mxr != -INFINITY) mref = (seen ? mref : 0.f) + d;
#pragma unroll
        for (int mt = 0; mt < 4; ++mt) s[mt] = s[mt] - d;
        lsum *= f;
        if constexpr (WITH_V) {
#pragma unroll
            for (int dt = 0; dt < 4; ++dt) o[dt] = o[dt] * f;
        }
    }
#pragma unroll
    for (int mt = 0; mt < 4; ++mt)
#pragma unroll
        for (int r = 0; r < 4; ++r) s[mt][r] = __builtin_amdgcn_exp2f(s[mt][r]);
    bf16x8 pf[2];
#pragma unroll
    for (int ks = 0; ks < 2; ++ks) { const u32x4 w = pack8(s[2 * ks], s[2 * ks + 1]); pf[ks] = __builtin_bit_cast(bf16x8, w); }
    { const f32x4 t4 = (s[0] + s[1]) + (s[2] + s[3]); lsum += (t4[0] + t4[1]) + (t4[2] + t4[3]); }
    if constexpr (WITH_V) {
#pragma unroll
        for (int dt = 0; dt < 4; ++dt)
#pragma unroll
            for (int ks = 0; ks < 2; ++ks) o[dt] = __builtin_amdgcn_mfma_f32_16x16x32_bf16(vf[dt][ks], pf[ks], o[dt], 0, 0, 0);
    }
}
template <bool MASKED, class MaskA, class MaskB>
__device__ __forceinline__ void visitB2(const Frags& F, const Lane& L, const bf16x8 (&qA)[2], const bf16x8 (&qB)[2], f32x4 (&oA)[4], f32x4 (&oB)[4], float msA, float msB, float invA, float invB,
                                        const MaskA& validA, const MaskB& validB, LAS float* impA, LAS float* impB, int jb) {
    const float cA = -msA, cB = -msB; const f32x4 ciA = (f32x4){cA, cA, cA, cA}, ciB = (f32x4){cB, cB, cB, cB};
    f32x4 sA[4], sB[4];
    { bf16x8 kf[4][2]; load_k(F, L, kf);
#pragma unroll
    for (int mt = 0; mt < 4; ++mt) {
        sA[mt] = __builtin_amdgcn_mfma_f32_16x16x32_bf16(kf[mt][0], qA[0], ciA, 0, 0, 0);
        sB[mt] = __builtin_amdgcn_mfma_f32_16x16x32_bf16(kf[mt][0], qB[0], ciB, 0, 0, 0);
        sA[mt] = __builtin_amdgcn_mfma_f32_16x16x32_bf16(kf[mt][1], qA[1], sA[mt], 0, 0, 0);
        sB[mt] = __builtin_amdgcn_mfma_f32_16x16x32_bf16(kf[mt][1], qB[1], sB[mt], 0, 0, 0);
    } }

    bf16x8 vf[4][2]; load_v(F, L, vf);
#pragma unroll
    for (int mt = 0; mt < 4; ++mt) {
#pragma unroll
        for (int r = 0; r < 4; ++r) {
            sA[mt][r] = (!MASKED || validA(16 * mt + 4 * L.g + r)) ? __builtin_amdgcn_exp2f(sA[mt][r]) * invA : 0.f;
            sB[mt][r] = (!MASKED || validB(16 * mt + 4 * L.g + r)) ? __builtin_amdgcn_exp2f(sB[mt][r]) * invB : 0.f;
        }
        float va = (sA[mt][0] + sA[mt][1]) + (sA[mt][2] + sA[mt][3]), va3 = sA[mt][3], vb = (sB[mt][0] + sB[mt][1]) + (sB[mt][2] + sB[mt][3]), vb3 = sB[mt][3];
        va = xor2_add(xor1_add(va)); va3 = xor2_add(xor1_add(va3)); vb = xor2_add(xor1_add(vb)); vb3 = xor2_add(xor1_add(vb3));
        if ((L.c & 3) == 0) { const int j = jb + 4 * mt + L.g;
            __hip_atomic_fetch_add(impA + j, va, __ATOMIC_RELAXED, __HIP_MEMORY_SCOPE_WORKGROUP); __hip_atomic_fetch_add(impB + j, vb, __ATOMIC_RELAXED, __HIP_MEMORY_SCOPE_WORKGROUP);
            if (j + 1 < 128) { __hip_atomic_fetch_add(impA + j + 1, va3, __ATOMIC_RELAXED, __HIP_MEMORY_SCOPE_WORKGROUP); __hip_atomic_fetch_add(impB + j + 1, vb3, __ATOMIC_RELAXED, __HIP_MEMORY_SCOPE_WORKGROUP); } }
    }
    bf16x8 pA[2], pB[2];
#pragma unroll
    for (int ks = 0; ks < 2; ++ks) { const u32x4 wa = pack8(sA[2 * ks], sA[2 * ks + 1]), wb = pack8(sB[2 * ks], sB[2 * ks + 1]); pA[ks] = __builtin_bit_cast(bf16x8, wa); pB[ks] = __builtin_bit_cast(bf16x8, wb); }
#pragma unroll
    for (int dt = 0; dt < 4; ++dt)
#pragma unroll
        for (int ks = 0; ks < 2; ++ks) { oA[dt] = __builtin_amdgcn_mfma_f32_16x16x32_bf16(vf[dt][ks], pA[ks], oA[dt], 0, 0, 0); oB[dt] = __builtin_amdgcn_mfma_f32_16x16x32_bf16(vf[dt][ks], pB[ks], oB[dt], 0, 0, 0); }
}
constexpr float PLIM = 1.8446744e19f;
template <bool WITH_V, bool MASKED, class MaskFn>
__device__ __forceinline__ void visit_fast(const Frags& F, const Lane& L, const bf16x8 (&q)[2], f32x4 (&o)[4], float mref, float& lsum, float& badv, bool colsel, const MaskFn& valid) {
    const float c0 = colsel ? -mref : -INFINITY;
    const f32x4 ci = (f32x4){c0, c0, c0, c0};
    f32x4 s[4];
    { bf16x8 kf[4][2]; load_k(F, L, kf);
#pragma unroll
    for (int mt = 0; mt < 4; ++mt) {
        s[mt] = __builtin_amdgcn_mfma_f32_16x16x32_bf16(kf[mt][0], q[0], ci, 0, 0, 0);
        s[mt] = __builtin_amdgcn_mfma_f32_16x16x32_bf16(kf[mt][1], q[1], s[mt], 0, 0, 0);
    } }

    bf16x8 vf[4][2]; if constexpr (WITH_V) load_v(F, L, vf);
#pragma unroll
    for (int mt = 0; mt < 4; ++mt)
#pragma unroll
        for (int r = 0; r < 4; ++r) { const float e = __builtin_amdgcn_exp2f(s[mt][r]); s[mt][r] = (!MASKED || valid(16 * mt + 4 * L.g + r)) ? e : 0.f; }
    float ps; { const f32x4 t4 = (s[0] + s[1]) + (s[2] + s[3]); ps = (t4[0] + t4[1]) + (t4[2] + t4[3]); }
    lsum += ps; badv = fmaxf(badv, ps);
    if constexpr (WITH_V) {
        bf16x8 pf[2];
#pragma unroll
        for (int ks = 0; ks < 2; ++ks) { const u32x4 w = pack8(s[2 * ks], s[2 * ks + 1]); pf[ks] = __builtin_bit_cast(bf16x8, w); }
#pragma unroll
        for (int dt = 0; dt < 4; ++dt)
#pragma unroll
            for (int ks = 0; ks < 2; ++ks) o[dt] = __builtin_amdgcn_mfma_f32_16x16x32_bf16(vf[dt][ks], pf[ks], o[dt], 0, 0, 0);
    }
}
template <bool MASKED, bool WITH_V = true, class MaskA, class MaskB>
__device__ __forceinline__ void visit_fast2(const Frags& F, const Lane& L, const bf16x8 (&qA)[2], const bf16x8 (&qB)[2], f32x4 (&oA)[4], f32x4 (&oB)[4], float mrefA, float mrefB,
                                            float& lsumA, float& lsumB, float& badv, bool colA, bool colB, const MaskA& validA, const MaskB& validB) {
    const float cA = colA ? -mrefA : -INFINITY, cB = colB ? -mrefB : -INFINITY;
    const f32x4 ciA = (f32x4){cA, cA, cA, cA}, ciB = (f32x4){cB, cB, cB, cB};
    f32x4 sA[4], sB[4];
    { bf16x8 kf[4][2]; load_k(F, L, kf);
#pragma unroll
    for (int mt = 0; mt < 4; ++mt) {
        sA[mt] = __builtin_amdgcn_mfma_f32_16x16x32_bf16(kf[mt][0], qA[0], ciA, 0, 0, 0);
        sB[mt] = __builtin_amdgcn_mfma_f32_16x16x32_bf16(kf[mt][0], qB[0], ciB, 0, 0, 0);
        sA[mt] = __builtin_amdgcn_mfma_f32_16x16x32_bf16(kf[mt][1], qA[1], sA[mt], 0, 0, 0);
        sB[mt] = __builtin_amdgcn_mfma_f32_16x16x32_bf16(kf[mt][1], qB[1], sB[mt], 0, 0, 0);
    } }
    bf16x8 vf[4][2]; if constexpr (WITH_V) load_v(F, L, vf);
#pragma unroll
    for (int mt = 0; mt < 4; ++mt)
#pragma unroll
        for (int r = 0; r < 4; ++r) {
            const float ea = __builtin_amdgcn_exp2f(sA[mt][r]), eb = __builtin_amdgcn_exp2f(sB[mt][r]);
            sA[mt][r] = (!MASKED || validA(16 * mt + 4 * L.g + r)) ? ea : 0.f; sB[mt][r] = (!MASKED || validB(16 * mt + 4 * L.g + r)) ? eb : 0.f;
        }
    { const f32x4 t4 = (sA[0] + sA[1]) + (sA[2] + sA[3]); const float ps = (t4[0] + t4[1]) + (t4[2] + t4[3]); lsumA += ps; badv = fmaxf(badv, ps); }
    { const f32x4 t4 = (sB[0] + sB[1]) + (sB[2] + sB[3]); const float ps = (t4[0] + t4[1]) + (t4[2] + t4[3]); lsumB += ps; badv = fmaxf(badv, ps); }
    if constexpr (!WITH_V) return;
    bf16x8 pA[2], pB[2];
#pragma unroll
    for (int ks = 0; ks < 2; ++ks) { const u32x4 wa = pack8(sA[2 * ks], sA[2 * ks + 1]), wb = pack8(sB[2 * ks], sB[2 * ks + 1]); pA[ks] = __builtin_bit_cast(bf16x8, wa); pB[ks] = __builtin_bit_cast(bf16x8, wb); }
#pragma unroll
    for (int dt = 0; dt < 4; ++dt)
#pragma unroll
        for (int ks = 0; ks < 2; ++ks) { oA[dt] = __builtin_amdgcn_mfma_f32_16x16x32_bf16(vf[dt][ks], pA[ks], oA[dt], 0, 0, 0); oB[dt] = __builtin_amdgcn_mfma_f32_16x16x32_bf16(vf[dt][ks], pB[ks], oB[dt], 0, 0, 0); }
}
template <bool WITH_V, class MaskFn>
__device__ __forceinline__ void visit_init(const Frags& F, const Lane& L, const bf16x8 (&q)[2], f32x4 (&o)[4], float& mref, float& lsum, float& badv, bool colsel, const MaskFn& valid) {
    const bool seen = mref != -INFINITY;
    const float c0 = colsel ? (seen ? -mref : 0.f) : -INFINITY;
    const f32x4 ci = (f32x4){c0, c0, c0, c0};
    f32x4 s[4];
    { bf16x8 kf[4][2]; load_k(F, L, kf);
#pragma unroll
    for (int mt = 0; mt < 4; ++mt) {
        s[mt] = __builtin_amdgcn_mfma_f32_16x16x32_bf16(kf[mt][0], q[0], ci, 0, 0, 0);
        s[mt] = __builtin_amdgcn_mfma_f32_16x16x32_bf16(kf[mt][1], q[1], s[mt], 0, 0, 0);
    } }

    bf16x8 vf[4][2]; if constexpr (WITH_V) load_v(F, L, vf);
#pragma unroll
    for (int mt = 0; mt < 4; ++mt)
#pragma unroll
        for (int r = 0; r < 4; ++r) if (!valid(16 * mt + 4 * L.g + r)) s[mt][r] = -INFINITY;
    float mx = fmaxf(fmaxf(s[0][0], s[0][1]), fmaxf(s[0][2], s[0][3]));
#pragma unroll
    for (int mt = 1; mt < 4; ++mt) mx = fmaxf(mx, fmaxf(fmaxf(s[mt][0], s[mt][1]), fmaxf(s[mt][2], s[mt][3])));
    const float mxr = gmax(mx);
    const float d = (!seen && mxr != -INFINITY) ? mxr : 0.f;
    if (!seen && mxr != -INFINITY) mref = mxr;
#pragma unroll
    for (int mt = 0; mt < 4; ++mt)
#pragma unroll
        for (int r = 0; r < 4; ++r) s[mt][r] = __builtin_amdgcn_exp2f(s[mt][r] - d);
    float ps; { const f32x4 t4 = (s[0] + s[1]) + (s[2] + s[3]); ps = (t4[0] + t4[1]) + (t4[2] + t4[3]); }
    lsum += ps; badv = fmaxf(badv, ps);
    if constexpr (WITH_V) {
        bf16x8 pf[2];
#pragma unroll
        for (int ks = 0; ks < 2; ++ks) { const u32x4 w = pack8(s[2 * ks], s[2 * ks + 1]); pf[ks] = __builtin_bit_cast(bf16x8, w); }
#pragma unroll
        for (int dt = 0; dt < 4; ++dt)
#pragma unroll
            for (int ks = 0; ks < 2; ++ks) o[dt] = __builtin_amdgcn_mfma_f32_16x16x32_bf16(vf[dt][ks], pf[ks], o[dt], 0, 0, 0);
    }
}
template <bool MASKED, class MaskFn>
__device__ __forceinline__ void visitB(const Frags& F, const Lane& L, const bf16x8 (&q)[2], f32x4 (&o)[4], float ms, float inv_l, const MaskFn& valid, LAS float* imp_row, int jb) {
    const float c0 = -ms; const f32x4 ci = (f32x4){c0, c0, c0, c0};
    f32x4 s[4];
    { bf16x8 kf[4][2]; load_k(F, L, kf);
#pragma unroll
    for (int mt = 0; mt < 4; ++mt) {
        s[mt] = __builtin_amdgcn_mfma_f32_16x16x32_bf16(kf[mt][0], q[0], ci, 0, 0, 0);
        s[mt] = __builtin_amdgcn_mfma_f32_16x16x32_bf16(kf[mt][1], q[1], s[mt], 0, 0, 0);
    } }

    bf16x8 vf[4][2]; load_v(F, L, vf);
#pragma unroll
    for (int mt = 0; mt < 4; ++mt) {
#pragma unroll
        for (int r = 0; r < 4; ++r) s[mt][r] = (!MASKED || valid(16 * mt + 4 * L.g + r)) ? __builtin_amdgcn_exp2f(s[mt][r]) * inv_l : 0.f;
        float val = (s[mt][0] + s[mt][1]) + (s[mt][2] + s[mt][3]), v3 = s[mt][3];
        val = xor2_add(xor1_add(val)); v3 = xor2_add(xor1_add(v3));
        if ((L.c & 3) == 0) { const int j = jb + 4 * mt + L.g; __hip_atomic_fetch_add(imp_row + j, val, __ATOMIC_RELAXED, __HIP_MEMORY_SCOPE_WORKGROUP);
            if (j + 1 < 128) __hip_atomic_fetch_add(imp_row + j + 1, v3, __ATOMIC_RELAXED, __HIP_MEMORY_SCOPE_WORKGROUP); }
    }
    bf16x8 pf[2];
#pragma unroll
    for (int ks = 0; ks < 2; ++ks) { const u32x4 w = pack8(s[2 * ks], s[2 * ks + 1]); pf[ks] = __builtin_bit_cast(bf16x8, w); }
#pragma unroll
    for (int dt = 0; dt < 4; ++dt)
#pragma unroll
        for (int ks = 0; ks < 2; ++ks) o[dt] = __builtin_amdgcn_mfma_f32_16x16x32_bf16(vf[dt][ks], pf[ks], o[dt], 0, 0, 0);
}
struct HiMask { int hi; __device__ __forceinline__ bool operator()(int key) const { return key <= hi; } };
struct RangeMask { int lo, hi; __device__ __forceinline__ bool operator()(int key) const { return key >= lo && key <= hi; } };
struct LoMask { int lo; __device__ __forceinline__ bool operator()(int key) const { return key >= lo; } };
struct NoMask { __device__ __forceinline__ bool operator()(int) const { return true; } };
__device__ __forceinline__ unsigned ctr_load(LAS unsigned* p) { return (unsigned)__builtin_amdgcn_readfirstlane((int)__hip_atomic_load(p, __ATOMIC_RELAXED, __HIP_MEMORY_SCOPE_WORKGROUP)); }
template <class Body>
__device__ __forceinline__ void stream(LAS unsigned char* lds, const Lane& L, const Src& S, int tile0, int NT, const Body& body) {
    LAS unsigned* ready = (LAS unsigned*)(lds + MISC_OFF + 64);
    LAS unsigned* done = ready + NS;
    __builtin_amdgcn_s_barrier();
    if (L.wave == 0 && L.lane < 2 * NS) ready[L.lane] = 0u;
    asm volatile("s_waitcnt lgkmcnt(0)" ::: "memory");
    __builtin_amdgcn_s_barrier();
    asm volatile("" ::: "memory");
    int issued = 0, published = 0;
    TileAddr A; A.k0 = L.lds0 + L.kbase; A.k1 = L.lds0 + (L.kbase ^ 64u); A.v0 = L.lds0 + 8192u + L.vbase; A.v1 = L.lds0 + 8192u + (L.vbase ^ 32u); A.v2 = L.lds0 + 8192u + (L.vbase ^ 64u); A.v3 = L.lds0 + 8192u + (L.vbase ^ 96u);
    for (int i = 0; i < NT; ++i) {
        asm volatile("s_waitcnt vmcnt(0)" ::: "memory");
        for (; published < issued; ++published) if (L.lane == 0) __hip_atomic_fetch_add(ready + (published & (NS - 1)), 1u, __ATOMIC_RELAXED, __HIP_MEMORY_SCOPE_WORKGROUP);
        for (;;) {
            if (issued >= NT || issued >= i + NS) break;
            const bool must = issued <= i;
            if (issued >= NS) {
                const unsigned want = 8u * (unsigned)(issued / NS);
                if (ctr_load(done + (issued & (NS - 1))) < want) { if (!must) break; while (ctr_load(done + (issued & (NS - 1))) < want) __builtin_amdgcn_s_sleep(1); }
            }
            issue(L, S, tile0 + issued, issued & (NS - 1)); ++issued;
            if (must) { asm volatile("s_waitcnt vmcnt(0)" ::: "memory"); for (; published < issued; ++published) if (L.lane == 0) __hip_atomic_fetch_add(ready + (published & (NS - 1)), 1u, __ATOMIC_RELAXED, __HIP_MEMORY_SCOPE_WORKGROUP); }
        }
        { const unsigned want = 8u * (unsigned)(i / NS + 1); LAS unsigned* rp = ready + (i & (NS - 1)); while (ctr_load(rp) < want) __builtin_amdgcn_s_sleep(1); }
        asm volatile("" ::: "memory");
        body(i, A);
        { const unsigned d = ((i + 1) & (NS - 1)) ? (unsigned)SLOT : (unsigned)(-(NS - 1) * SLOT); A.k0 += d; A.k1 += d; A.v0 += d; A.v1 += d; A.v2 += d; A.v3 += d; }
        asm volatile("s_waitcnt lgkmcnt(0)" ::: "memory");
        if (L.lane == 0) __hip_atomic_fetch_add(done + (i & (NS - 1)), 1u, __ATOMIC_RELAXED, __HIP_MEMORY_SCOPE_WORKGROUP);
    }
    asm volatile("s_waitcnt vmcnt(0) lgkmcnt(0)" ::: "memory");
}
struct Tensors { unsigned char* ws;
    __device__ __forceinline__ const bf16_t* QP_() const { return (const bf16_t*)(ws + WS_QP); }   __device__ __forceinline__ const bf16_t* QR_() const { return (const bf16_t*)(ws + WS_QR); }
    __device__ __forceinline__ const bf16_t* KCMP_() const { return (const bf16_t*)(ws + WS_KCMP); } __device__ __forceinline__ const bf16_t* VCMP_() const { return (const bf16_t*)(ws + WS_VCMP); }
    __device__ __forceinline__ const bf16_t* KS_() const { return (const bf16_t*)(ws + WS_KS); }   __device__ __forceinline__ const bf16_t* VS_() const { return (const bf16_t*)(ws + WS_VS); }
    __device__ __forceinline__ const bf16_t* KW_() const { return (const bf16_t*)(ws + WS_KW); }   __device__ __forceinline__ const bf16_t* VW_() const { return (const bf16_t*)(ws + WS_VW); }
    __device__ __forceinline__ const float* GN_() const { return (const float*)(ws + WS_GN); }     __device__ __forceinline__ bf16_t* PA_() const { return (bf16_t*)(ws + WS_PA); }
};
__device__ __forceinline__ void unit(LAS unsigned char* lds, const Tensors& X, int b, int gk, int u, int wave_s) {
    const int t0 = 128 * u;
    bf16x8 q[4][2]; f32x4 o[4][4]; float m[4], l[4]; float badv;
#define NSA_STAGE() Lane L; { const int ln_ = lane_id(); L.init(ln_ + 64 * wave_s, lds); } \
    const int tw0 = t0 + 16 * L.wave, tl = L.c >> 2; (void)tl; \
    LAS unsigned char* wscr = lds + RING + L.wave * WSCR; (void)wscr; \
    LAS float* impw = (LAS float*)wscr; (void)impw;                   \
    LAS unsigned* bmask = (LAS unsigned*)(wscr + 8192); (void)bmask;     \
    const int qrow32 = (b * SEQ + tw0 + (L.c >> 2)) * 1024 + (gk * 4 + (L.c & 3)) * 64 + 8 * L.g; (void)qrow32;        \
    const LAS float* gate = (const LAS float*)(lds + GATE_OFF + L.wave * 768) + (L.c >> 2) * 12 + (L.c & 3) * 3; (void)gate;     \
    LAS unsigned char* park = wscr + ((size_t)L.c * 64 + 4 * L.g) * 2; (void)park
#define NSA_LOADQ_ISSUE(Qp) do { int qo_ = qrow32; OPAQUE(qo_); const bf16_t* qp_ = (Qp) + (size_t)qo_; _Pragma("unroll") for (int rt = 0; rt < 4; ++rt) _Pragma("unroll") for (int dk = 0; dk < 2; ++dk) q[rt][dk] = *(const bf16x8*)(qp_ + rt * 4096 + 32 * dk); } while (0)
#define NSA_LOADQ_USE() do { _Pragma("unroll") for (int rt = 0; rt < 4; ++rt) _Pragma("unroll") for (int dk = 0; dk < 2; ++dk) asm volatile("" : "+v"(q[rt][dk])); } while (0)
#define NSA_LOADQ(Qp) do { NSA_LOADQ_ISSUE(Qp); NSA_LOADQ_USE(); } while (0)
#define NSA_BAD() (__any(!(badv <= PLIM)))
#define NSA_RESET() do { float z_ = 0.f; OPAQUE(z_); badv = z_; _Pragma("unroll") for (int rt = 0; rt < 4; ++rt) { m[rt] = -INFINITY; l[rt] = z_; _Pragma("unroll") for (int dt = 0; dt < 4; ++dt) o[rt][dt] = (f32x4){z_, z_, z_, z_}; } } while (0)
    {
        NSA_STAGE();
        { float z_ = 0.f; OPAQUE(z_); const f32x4 z4 = (f32x4){z_, z_, z_, z_};
#pragma unroll
        for (int i = 0; i < 8; ++i) *(LAS f32x4*)(impw + (i * 64 + L.lane) * 4) = z4; }
        {
            const float* gsrc = X.GN_() + (size_t)(b * SEQ + tw0) * 48 + gk * 12; LAS float* gdst = (LAS float*)(lds + GATE_OFF + L.wave * 768);
            float gv[3];
#pragma unroll
            for (int k3 = 0; k3 < 3; ++k3) { const int idx = L.lane + 64 * k3; gv[k3] = gsrc[(idx / 12) * 48 + idx % 12]; }
            NSA_LOADQ(X.QP_());
#pragma unroll
            for (int k3 = 0; k3 < 3; ++k3) gdst[L.lane + 64 * k3] = gv[k3];
        }
        NSA_RESET();
        const int nct = ((8 * u + 6) >> 6) + 1;
        const Src S = make_src(X.KCMP_(), X.VCMP_(), (size_t)(b * 4 + gk) * NCP, 64, 0, L);
        stream(lds, L, S, 0, nct, [&](int i, const TileAddr& Ks) {
            const int nb = 64 * i;
            if (tw0 + 15 >= 31 && nb <= ((tw0 + 15 - 31) >> 4)) {
                Frags F; load_frags<false>(Ks, L, F);
#pragma unroll
                for (int pr = 0; pr < 2; ++pr) {
                    const int rA = 2 * pr, rB = rA + 1, twA = tw0 + 4 * rA, twB = twA + 4;
                    const bool nA = twA + 3 >= 31 && nb <= ((twA + 3 - 31) >> 4), nB = twB + 3 >= 31 && nb <= ((twB + 3 - 31) >> 4);
                    const bool inter = twA >= 31 && nb + 63 <= ((twA - 31) >> 4);
                    const int tA = twA + tl, tB = twB + tl;
                    const HiMask hA{(tA >= 31 ? ((tA - 31) >> 4) : -1) - nb}, hB{(tB >= 31 ? ((tB - 31) >> 4) : -1) - nb};
                    (void)inter;
                    if (i == 0) { if (nA) visit_init<false>(F, L, q[rA], o[rA], m[rA], l[rA], badv, true, hA); if (nB) visit_init<false>(F, L, q[rB], o[rB], m[rB], l[rB], badv, true, hB); }
                    else if (nA && nB) visit_fast2<true, false>(F, L, q[rA], q[rB], o[rA], o[rB], m[rA], m[rB], l[rA], l[rB], badv, true, true, hA, hB);
                    else { if (nA) visit_fast<false, true>(F, L, q[rA], o[rA], m[rA], l[rA], badv, true, hA); if (nB) visit_fast<false, true>(F, L, q[rB], o[rB], m[rB], l[rB], badv, true, hB); }
                }
            }
        });
        if (NSA_BAD()) {
            NSA_RESET();
            stream(lds, L, S, 0, nct, [&](int i, const TileAddr& Ks) {
                const int nb = 64 * i;
                if (tw0 + 15 >= 31 && nb <= ((tw0 + 15 - 31) >> 4)) {
                    Frags F; load_frags<false>(Ks, L, F);
#pragma unroll
                    for (int rt = 0; rt < 4; ++rt) {
                        const int twA = tw0 + 4 * rt, tA = twA + tl;
                        if (twA + 3 >= 31 && nb <= ((twA + 3 - 31) >> 4)) visit_slow<false, true>(F, L, q[rt], o[rt], m[rt], l[rt], true, HiMask{(tA >= 31 ? ((tA - 31) >> 4) : -1) - nb});
                    }
                }
            });
        }
        float inv[4], msf[4];
#pragma unroll
        for (int rt = 0; rt < 4; ++rt) { const float lt = gsum(l[rt]); inv[rt] = lt > 0.f ? __builtin_amdgcn_rcpf(lt) : 0.f; msf[rt] = (m[rt] == -INFINITY) ? 0.f : m[rt]; }
        NSA_RESET();
        stream(lds, L, S, 0, nct, [&](int i, const TileAddr& Ks) {
            const int nb = 64 * i;
            if (tw0 + 15 >= 31 && nb <= ((tw0 + 15 - 31) >> 4)) {
                Frags F; load_frags<true>(Ks, L, F);
#pragma unroll
                for (int pr = 0; pr < 2; ++pr) {
                    const int rA = 2 * pr, rB = rA + 1, twA = tw0 + 4 * rA, twB = twA + 4;
                    const bool nA = twA + 3 >= 31 && nb <= ((twA + 3 - 31) >> 4), nB = twB + 3 >= 31 && nb <= ((twB + 3 - 31) >> 4);
                    const bool inter = twA >= 31 && nb + 63 <= ((twA - 31) >> 4);
                    const int tA = twA + tl, tB = twB + tl;
                    const HiMask hA{(tA >= 31 ? ((tA - 31) >> 4) : -1) - nb}, hB{(tB >= 31 ? ((tB - 31) >> 4) : -1) - nb};
                    LAS float* iA = impw + (4 * rA + tl) * 128; LAS float* iB = impw + (4 * rB + tl) * 128;
                    (void)inter;
                    if (nA && nB) visitB2<true>(F, L, q[rA], q[rB], o[rA], o[rB], msf[rA], msf[rB], inv[rA], inv[rB], hA, hB, iA, iB, 16 * i);
                    else { if (nA) visitB<true>(F, L, q[rA], o[rA], msf[rA], inv[rA], hA, iA, 16 * i);
                           if (nB) visitB<true>(F, L, q[rB], o[rB], msf[rB], inv[rB], hB, iB, 16 * i); }
                }
            }
        });
    }
    asm volatile("s_waitcnt lgkmcnt(0)" ::: "memory");
    {
        NSA_STAGE();
        NSA_LOADQ_ISSUE(X.QR_());
        unsigned bm0 = 0u, bm1 = 0u;
        const int jt = tw0 >> 6;
        if (jt <= 15) { bm0 = (L.lane <= jt) ? 0xffffu : 0u; }
        else {
            const int tau = L.lane >> 2, part = L.lane & 3;
            unsigned A[32];
            { const LAS f32x4* src = (const LAS f32x4*)(impw + tau * 128 + part * 32);
#pragma unroll
              for (int i4 = 0; i4 < 8; ++i4) { const f32x4 v = src[i4];
#pragma unroll
                for (int e = 0; e < 4; ++e) { const int j = part * 32 + 4 * i4 + e; A[4 * i4 + e] = (j >= 1 && j <= jt - 2) ? (0x80000000u | __float_as_uint(v[e])) : 0u; } } }
#define TSTEP(J, M) _Pragma("unroll") for (int r = 0; r < 32; ++r) if (!(r & (J))) { const unsigned t_ = ((A[r] >> (J)) ^ A[r + (J)]) & (M); A[r + (J)] ^= t_; A[r] ^= t_ << (J); }
            TSTEP(16, 0x0000FFFFu) TSTEP(8, 0x00FF00FFu) TSTEP(4, 0x0F0F0F0Fu) TSTEP(2, 0x33333333u) TSTEP(1, 0x55555555u)
#undef TSTEP
#define QSUM(x) do { x += __builtin_amdgcn_mov_dpp(x, 0xB1, 0xF, 0xF, true); x += __builtin_amdgcn_mov_dpp(x, 0x4E, 0xF, 0xF, true); } while (0)
            unsigned cand = 0xffffffffu, gt = 0u; int G = 0;
#pragma unroll
            for (int bit = 31; bit >= 0; --bit) {
                const unsigned ones = cand & A[bit];
                int c1 = __builtin_popcount(ones); QSUM(c1);
                const bool take = G + c1 >= 13;
                gt |= take ? 0u : ones; cand = take ? ones : (cand ^ ones); G += take ? 0 : c1;
            }
            int eq = __builtin_popcount(cand);
            const int e0 = __builtin_amdgcn_mov_dpp(eq, 0x00, 0xF, 0xF, true), e1 = __builtin_amdgcn_mov_dpp(eq, 0x55, 0xF, 0xF, true), e2 = __builtin_amdgcn_mov_dpp(eq, 0xAA, 0xF, 0xF, true);
            const int rem = (13 - G) - ((part > 0 ? e0 : 0) + (part > 1 ? e1 : 0) + (part > 2 ? e2 : 0));
            unsigned W = gt, tq = cand;
#pragma unroll
            for (int n = 0; n < 13; ++n) { const unsigned low = (rem > n) ? (tq & (0u - tq)) : 0u; W |= low; tq ^= low; }
            { const int d0 = 0 - 32 * part, d1 = jt - 32 * part, d2 = jt - 1 - 32 * part;
              W |= ((unsigned)d0 < 32u ? 1u << d0 : 0u) | ((unsigned)d1 < 32u ? 1u << d1 : 0u) | ((unsigned)d2 < 32u ? 1u << d2 : 0u); }
#undef QSUM
            LAS unsigned* Wt = (LAS unsigned*)impw;
            asm volatile("s_waitcnt lgkmcnt(0)" ::: "memory");
            Wt[L.lane] = W;
            asm volatile("s_waitcnt lgkmcnt(0)" ::: "memory");
            const int hp = L.lane >> 5, sh = L.lane & 31;
#pragma unroll
            for (int t2 = 0; t2 < 16; ++t2) { const unsigned w0 = Wt[t2 * 4 + hp], w1 = Wt[t2 * 4 + 2 + hp]; bm0 |= ((w0 >> sh) & 1u) << t2; bm1 |= ((w1 >> sh) & 1u) << t2; }
        }
        bmask[L.lane] = bm0; bmask[64 + L.lane] = bm1;
    }
    asm volatile("s_waitcnt lgkmcnt(0)" ::: "memory");
    {
        NSA_STAGE();
#pragma unroll
        for (int rt = 0; rt < 4; ++rt) {
            const float gc = gate[rt * 48];
#pragma unroll
            for (int dt = 0; dt < 4; ++dt) { const f32x4 v = o[rt][dt] * gc; u32x2 w; w.x = cvt_pk_bf16(v[0], v[1]); w.y = cvt_pk_bf16(v[2], v[3]); *(LAS u32x2*)(park + rt * 2048 + dt * 32) = w; }
        }
    }
    {
        NSA_STAGE();
        NSA_LOADQ_USE();
        const int kt_lo = (2 * u - 8) > 0 ? (2 * u - 8) : 0, kt_hi = 2 * u + 1;
        const Src S = make_src(X.KW_(), X.VW_(), (size_t)b * SEQ, 256, gk * 64, L);
        SUBREP(32) { NSA_RESET();
        stream(lds, L, S, kt_lo, kt_hi - kt_lo + 1, [&](int i, const TileAddr& Ks) {
            const int kbase = 64 * (kt_lo + i);
            if (kbase <= tw0 + 15 && kbase + 63 >= tw0 - 511) {
                Frags F; load_frags<true>(Ks, L, F);
#pragma unroll
                for (int pr = 0; pr < 2; ++pr) {
                    const int rA = 2 * pr, rB = rA + 1, twA = tw0 + 4 * rA, twB = twA + 4;
                    const bool nA = kbase <= twA + 3 && kbase + 63 >= twA - 511, nB = kbase <= twB + 3 && kbase + 63 >= twB - 511;
                    const bool inter = kbase + 63 <= twA && kbase >= twB + 3 - 511;
                    const int tA = twA + tl, tB = twB + tl;
                    const bool init = kbase <= (twB + 3 - 511 > 0 ? twB + 3 - 511 : 0);
                    if (init) { if (nA) visit_init<true>(F, L, q[rA], o[rA], m[rA], l[rA], badv, true, RangeMask{tA - 511 - kbase, tA - kbase}); if (nB) visit_init<true>(F, L, q[rB], o[rB], m[rB], l[rB], badv, true, RangeMask{tB - 511 - kbase, tB - kbase}); }
                    else if (nA && nB) { if (inter) visit_fast2<false>(F, L, q[rA], q[rB], o[rA], o[rB], m[rA], m[rB], l[rA], l[rB], badv, true, true, NoMask{}, NoMask{});
                                         else visit_fast2<true>(F, L, q[rA], q[rB], o[rA], o[rB], m[rA], m[rB], l[rA], l[rB], badv, true, true, HiMask{tA - kbase}, HiMask{tB - kbase}); }
                    else if (inter) { if (nA) visit_fast<true, false>(F, L, q[rA], o[rA], m[rA], l[rA], badv, true, NoMask{}); if (nB) visit_fast<true, false>(F, L, q[rB], o[rB], m[rB], l[rB], badv, true, NoMask{}); }
                    else { if (nA) visit_fast<true, true>(F, L, q[rA], o[rA], m[rA], l[rA], badv, true, HiMask{tA - kbase}); if (nB) visit_fast<true, true>(F, L, q[rB], o[rB], m[rB], l[rB], badv, true, HiMask{tB - kbase}); }
                }
            }
        });
        if (NSA_BAD()) {
            NSA_RESET();
            stream(lds, L, S, kt_lo, kt_hi - kt_lo + 1, [&](int i, const TileAddr& Ks) {
                const int kbase = 64 * (kt_lo + i);
                if (kbase <= tw0 + 15 && kbase + 63 >= tw0 - 511) {
                    Frags F; load_frags<true>(Ks, L, F);
#pragma unroll
                    for (int rt = 0; rt < 4; ++rt) {
                        const int twA = tw0 + 4 * rt, tA = twA + tl;
                        if (kbase <= twA + 3 && kbase + 63 >= twA - 511) visit_slow<true, true>(F, L, q[rt], o[rt], m[rt], l[rt], true, RangeMask{tA - 511 - kbase, tA - kbase});
                    }
                }
            });
        }
        }
    }
    {
        NSA_STAGE();
#pragma unroll
        for (int rt = 0; rt < 4; ++rt) {
            const float sc = gate[rt * 48 + 2] * __builtin_amdgcn_rcpf(gsum(l[rt]));
#pragma unroll
            for (int dt = 0; dt < 4; ++dt) {
                LAS u32x2* pp = (LAS u32x2*)(park + rt * 2048 + dt * 32); const u32x2 pw = *pp; const f32x4 v = o[rt][dt] * sc; u32x2 w;
                w.x = cvt_pk_bf16(v[0] + __builtin_bit_cast(float, pw.x << 16), v[1] + __builtin_bit_cast(float, pw.x & 0xffff0000u));
                w.y = cvt_pk_bf16(v[2] + __builtin_bit_cast(float, pw.y << 16), v[3] + __builtin_bit_cast(float, pw.y & 0xffff0000u));
                *pp = w;
            }
        }
    }
    {
        NSA_STAGE();
        const Src S = make_src(X.KS_(), X.VS_(), (size_t)b * SEQ, 256, gk * 64, L);
        if (MK_PROBE == 34) stream(lds, L, S, 0, 2 * u + 2, [&](int j, const TileAddr& Ks) { const unsigned bm = (unsigned)__builtin_amdgcn_readfirstlane((int)bmask[j]); asm volatile("" :: "s"(bm), "v"(Ks.k0)); });
        SUBREP(33) { NSA_RESET();
        unsigned bmv = bmask[0];
        stream(lds, L, S, 0, 2 * u + 2, [&](int j, const TileAddr& Ks) {
            const unsigned bm = (unsigned)__builtin_amdgcn_readfirstlane((int)bmv);
            bmv = bmask[j + 1];
            const int kbase = 64 * j; const bool j0 = (j == 0);
            if (bm & 0xffffu) {
                Frags F; load_frags<true>(Ks, L, F);
#pragma unroll
                for (int pr = 0; pr < 2; ++pr) {
                    const int rA = 2 * pr, rB = rA + 1, twA = tw0 + 4 * rA, twB = twA + 4;
                    const bool nA = (bm >> (4 * rA)) & 15u, nB = (bm >> (4 * rB)) & 15u;
                    const bool inter = kbase + 63 <= twA;
                    const bool sA = (bm >> (4 * rA + tl)) & 1u, sB = (bm >> (4 * rB + tl)) & 1u;
                    const HiMask hA{twA + tl - kbase}, hB{twB + tl - kbase};
                    if (j0) { if (nA) visit_init<true>(F, L, q[rA], o[rA], m[rA], l[rA], badv, sA, hA); if (nB) visit_init<true>(F, L, q[rB], o[rB], m[rB], l[rB], badv, sB, hB); }
                    else if (nA && nB && inter) visit_fast2<false>(F, L, q[rA], q[rB], o[rA], o[rB], m[rA], m[rB], l[rA], l[rB], badv, sA, sB, hA, hB);
                    else if (inter) { if (nA) visit_fast<true, false>(F, L, q[rA], o[rA], m[rA], l[rA], badv, sA, hA); if (nB) visit_fast<true, false>(F, L, q[rB], o[rB], m[rB], l[rB], badv, sB, hB); }
                    else { if (nA) visit_fast<true, true>(F, L, q[rA], o[rA], m[rA], l[rA], badv, sA, hA); if (nB) visit_fast<true, true>(F, L, q[rB], o[rB], m[rB], l[rB], badv, sB, hB); }
                }
            }
        });
        if (NSA_BAD()) {
            NSA_RESET();
            stream(lds, L, S, 0, 2 * u + 2, [&](int j, const TileAddr& Ks) {
                const unsigned bm = (unsigned)__builtin_amdgcn_readfirstlane((int)bmask[j]);
                const int kbase = 64 * j;
                if (bm & 0xffffu) {
                    Frags F; load_frags<true>(Ks, L, F);
#pragma unroll
                    for (int rt = 0; rt < 4; ++rt) {
                        const int twA = tw0 + 4 * rt;
                        if ((bm >> (4 * rt)) & 15u) visit_slow<true, true>(F, L, q[rt], o[rt], m[rt], l[rt], (bool)((bm >> (4 * rt + tl)) & 1u), HiMask{twA + tl - kbase});
                    }
                }
            });
        }
        }
    }
    {
        NSA_STAGE();
#pragma unroll
        for (int rt = 0; rt < 4; ++rt) {
            const float sc = gate[rt * 48 + 1] * __builtin_amdgcn_rcpf(gsum(l[rt]));
            int oo_ = (b * SEQ + tw0 + 4 * rt + tl) * 1536 + 512 + (gk * 4 + (L.c & 3)) * 64 + 4 * L.g; OPAQUE(oo_); bf16_t* orow = X.PA_() + (size_t)oo_;
#pragma unroll
            for (int dt = 0; dt < 4; ++dt) {
                const u32x2 pw = *(LAS u32x2*)(park + rt * 2048 + dt * 32); const f32x4 v = o[rt][dt] * sc; u32x2 w;
                w.x = cvt_pk_bf16(v[0] + __builtin_bit_cast(float, pw.x << 16), v[1] + __builtin_bit_cast(float, pw.x & 0xffff0000u));
                w.y = cvt_pk_bf16(v[2] + __builtin_bit_cast(float, pw.y << 16), v[3] + __builtin_bit_cast(float, pw.y & 0xffff0000u));
                *(u32x2*)(orow + 16 * dt) = w;
            }
        }
    }
    asm volatile("s_waitcnt vmcnt(0) lgkmcnt(0)" ::: "memory");
#undef NSA_LOADQ
#undef NSA_LOADQ_ISSUE
#undef NSA_LOADQ_USE
#undef NSA_RESET
#undef NSA_BAD
#undef NSA_STAGE
}
}

#define XB_TMO      128
#define XB_XCNT(j)  (256  + 64 * (j))
#define XB_XSUB(j)  (1280 + 64 * (j))
#define XB_XGEN(j)  (2304 + 64 * (j))
#define XB_TOP      3328
#define XB_TOPGEN   3392
#define XCD_BAR_WORDS 3456
#define XB_SPIN_CAP (1u << 18)
constexpr int CW_FN = 10240;
constexpr int CW_BAR = 4096;
constexpr size_t CTL_ZERO_BYTES = 65536;
__device__ __forceinline__ unsigned xb_ld(unsigned* p)              { return __hip_atomic_load(p, __ATOMIC_RELAXED, __HIP_MEMORY_SCOPE_AGENT); }
__device__ __forceinline__ unsigned xb_add(unsigned* p, unsigned v) { return __hip_atomic_fetch_add(p, v, __ATOMIC_RELAXED, __HIP_MEMORY_SCOPE_AGENT); }
__device__ __forceinline__ unsigned xb_xcc_id() { return (unsigned)__builtin_amdgcn_s_getreg((3 << 11) | 20) & 0xFu; }
#define XB_SPIN(cond, bar) do { unsigned _sp = 0; while (cond) { __builtin_amdgcn_s_sleep(1); \
    if ((++_sp & 255u) == 0u) { if (xb_ld(&(bar)[XB_TMO])) break; if (_sp > XB_SPIN_CAP) { atomicAdd(&(bar)[XB_TMO], 1u); break; } } } } while (0)
struct XcdBarrier { unsigned* bar; unsigned x; volatile LAS unsigned* st; int wave; };
__device__ __forceinline__ XcdBarrier xcd_barrier_post(unsigned* bar, volatile LAS unsigned* st, int wave) {
    XcdBarrier b; b.bar = bar; b.x = xb_xcc_id(); b.st = st; b.wave = wave;
    if (wave == 0 && lane_id() == 0) (void)xb_add(&bar[XB_XCNT(b.x)], 1u);
    return b;
}
__device__ __forceinline__ void xcd_barrier_complete(unsigned* bar, unsigned x, unsigned& nloc, unsigned& nx) {
    const unsigned G = gridDim.x * gridDim.y * gridDim.z;
    unsigned sum, cnt, mine, sp = 0u;
    for (;;) {
        sum = 0u; cnt = 0u; mine = 0u;
#pragma unroll
        for (unsigned j = 0; j < 16; ++j) { const unsigned c = xb_ld(&bar[XB_XCNT(j)]); sum += c; cnt += (c > 0u) ? 1u : 0u; mine = (j == x) ? c : mine; }
        if (sum == G) break;
        __builtin_amdgcn_s_sleep(1);
        if ((++sp & 255u) == 0u) { if (xb_ld(&bar[XB_TMO])) break; if (sp > XB_SPIN_CAP) { atomicAdd(&bar[XB_TMO], 1u); break; } }
    }
    nloc = mine > 0u ? mine : 1u; nx = cnt > 0u ? cnt : 1u;
}
__device__ __forceinline__ void xcd_barrier(const XcdBarrier& b) {
    asm volatile("s_waitcnt vmcnt(0)" ::: "memory");
    __syncthreads();
    if (b.wave == 0 && lane_id() == 0) {
        unsigned* bar = b.bar;
        __builtin_amdgcn_s_waitcnt(0);
        unsigned nloc = b.st[0], nx = b.st[1];
        if (nloc == 0u) { xcd_barrier_complete(bar, b.x, nloc, nx); b.st[0] = nloc; b.st[1] = nx; }
        const unsigned old = xb_add(&bar[XB_XSUB(b.x)], 1u);
        const unsigned gen = old / nloc;
        if (old + 1u == (gen + 1u) * nloc) {
            __builtin_amdgcn_fence(__ATOMIC_RELEASE, "agent");
            asm volatile("s_waitcnt vmcnt(0)" ::: "memory");
            const unsigned og = xb_add(&bar[XB_TOP], 1u);
            const unsigned tg = og / nx;
            if (og + 1u == (tg + 1u) * nx) xb_add(&bar[XB_TOPGEN], 1u);
            else XB_SPIN(xb_ld(&bar[XB_TOPGEN]) == tg, bar);
            __builtin_amdgcn_fence(__ATOMIC_ACQUIRE, "agent");
            xb_add(&bar[XB_XGEN(b.x)], 1u);
            asm volatile("s_waitcnt vmcnt(0)" ::: "memory");
        } else {
            XB_SPIN(xb_ld(&bar[XB_XGEN(b.x)]) == gen, bar);
            __builtin_amdgcn_fence(__ATOMIC_ACQUIRE, "agent");
            asm volatile("s_waitcnt vmcnt(0)" ::: "memory");
        }
    }
    __syncthreads();
}

#ifndef MK_COOP
#define MK_COOP 1
#endif
constexpr int N_PHASES = 9;
#define REP(k) for (int rep_ = 0; rep_ < ((MK_PROBE) == (k) ? 2 : 1); ++rep_)
__device__ __forceinline__ KParams kparams() { KParams p = (KParams)__builtin_amdgcn_kernarg_segment_ptr(); asm volatile("" : "+s"(p)); return p; }
__global__ void __launch_bounds__(NTHREADS, 2) mk_fwd(Params Parg) {
    (void)Parg;
    extern __shared__ __attribute__((aligned(16))) unsigned char lds_raw[];
    LAS unsigned char* lds = (LAS unsigned char*)lds_raw;
    const int wave_k = __builtin_amdgcn_readfirstlane((int)(threadIdx.x >> 6));
    const int G = gridDim.x, bx = blockIdx.x;
    const int vcu = (G % 8 == 0) ? (bx % 8) * (G / 8) + bx / 8 : bx;
    const int NGW = G * NWAVES;
#define PHASE_IDS() int tid = TID_(wave_k); asm volatile("" : "+v"(tid)); const int lane = tid & 63, wave = __builtin_amdgcn_readfirstlane(tid >> 6), gw = vcu * NWAVES + wave; (void)lane; (void)gw
#define ws (kparams()->ws)
#define dout ((char*)kparams()->out)
    const int ph_lo = kparams()->ph_lo, ph_hi = kparams()->ph_hi;
#define WSP(T_, off) ((T_*)(ws + (off)))
#if MK_COOP
#ifndef MK_CG_SYNC
#define MK_CG_SYNC 0
#endif
#if MK_CG_SYNC
#define GRID_SYNC() cg::this_grid().sync()
#else
    volatile LAS unsigned* MISC = (volatile LAS unsigned*)(lds + MISC_OFF);
    if (wave_k == 0 && lane_id() < 32) MISC[lane_id()] = 0u;
    __syncthreads();
    const XcdBarrier xbar = xcd_barrier_post((unsigned*)(ws + WS_CTL) + CW_BAR, MISC + 8, wave_k);
#define GRID_SYNC() xcd_barrier(xbar)
#endif
#else
#define GRID_SYNC() do {} while (0)
#endif
#define IN(k) (ph_lo <= (k) && (k) < ph_hi)
#define SEAM(k) do { if (IN(k) && IN((k) + 1)) GRID_SYNC(); } while (0)
#define H ((bf16_t*)(dout + DO_H))
#define SP ((bf16_t*)(dout + DO_SP))
#define X1 ((float*)dout)

    if (IN(0)) REP(0) { PHASE_IDS(); p0_prologue<0>(kparams(), lds, gw, NGW, wave, lane); }
    SEAM(0);
    if (IN(1)) REP(1) {
        pg8::Gemm g{1024 * 2, 1024 * 2, 128, 128, 16}; pg8::StdSched S; S.init(H, WSP(bf16_t, WS_WIN), T, 5120, 2048, 2048, G, bx);
        EpiIn E{WSP(bf16_t, WS_U), WSP(bf16_t, WS_QP), WSP(bf16_t, WS_QR), WSP(bf16_t, WS_KC), SP, WSP(bf16_t, WS_SA),
                WSP(float, WS_GN), WSP(float, WS_RCOS), WSP(float, WS_RSIN)};
        pg8::gemm_phase<EpiIn, pg8::StdSched, true>(lds, g, S, E, wave_k);
    }
    SEAM(1);
    if (IN(2)) REP(2) {
        const int ncmp = (G == 256) ? 64 : 32;
        if (bx >= ncmp) {
            { PHASE_IDS(); (void)gw; p2_pooled(WSP(bf16_t, WS_U), WSP(bf16_t, WS_PA), (bx - ncmp) * NWAVES + wave, (G - ncmp) * NWAVES, lane); }
            PHASE_IDS(); (void)gw;
            const int fr = lane & 15, fq = lane >> 4; const bf16_t* Wg = WSP(bf16_t, WS_WIN) + (size_t)5120 * 1024; float* GNp = WSP(float, WS_GN);
#pragma unroll 1
            for (int it = (((bx - ncmp) * NWAVES + wave) % 3) ? T / 32 : ((bx - ncmp) * NWAVES + wave) / 3; it < T / 32; it += ((G - ncmp) * NWAVES + 2) / 3) {
                const int r0 = 32 * it; f32x4 c2[2][3];
#pragma unroll
                for (int mt = 0; mt < 2; ++mt)
#pragma unroll
                    for (int nt = 0; nt < 3; ++nt) c2[mt][nt] = (f32x4){0.f, 0.f, 0.f, 0.f};
#pragma unroll 4
                for (int k0 = 0; k0 < 1024; k0 += 32) {
                    bf16x8 a[2], b[3];
#pragma unroll
                    for (int mt = 0; mt < 2; ++mt) a[mt] = *(const bf16x8*)(H + (size_t)(r0 + 16 * mt + fr) * 1024 + k0 + 8 * fq);
#pragma unroll
                    for (int nt = 0; nt < 3; ++nt) b[nt] = *(const bf16x8*)(Wg + (size_t)(16 * nt + fr) * 1024 + k0 + 8 * fq);
#pragma unroll
                    for (int mt = 0; mt < 2; ++mt)
#pragma unroll
                        for (int nt = 0; nt < 3; ++nt) c2[mt][nt] = __builtin_amdgcn_mfma_f32_16x16x32_bf16(a[mt], b[nt], c2[mt][nt], 0, 0, 0);
                }
#pragma unroll
                for (int mt = 0; mt < 2; ++mt)
#pragma unroll
                    for (int nt = 0; nt < 3; ++nt)
#pragma unroll
                        for (int r = 0; r < 4; ++r) GNp[(size_t)(r0 + 16 * mt + 4 * fq + r) * 48 + 16 * nt + fr] = sigmoidf_(c2[mt][nt][r] + 0.f);
            }
            if (G != 256) p0_prologue<1>(kparams(), lds, (bx - ncmp) * NWAVES + wave, (G - ncmp) * NWAVES, wave, lane);
        }
        __syncthreads();
        const int split = (G == 256) ? 1 : 0;
        pg8::Gemm g{4096 * 2, 2048 * 2, 512, 128, split ? 16 : 32, (split && (bx & 1)) ? -128 * 4096 * 2 : 0};
        CmpSched S{(const char*)WSP(bf16_t, WS_KC), (const char*)WSP(bf16_t, WS_VC), (const char*)WSP(bf16_t, WS_W1K), (const char*)WSP(bf16_t, WS_W1V), bx, split};
        EpiCmp E{WSP(bf16_t, WS_HIDK), WSP(bf16_t, WS_HIDV), WSP(float, WS_PEBK), WSP(float, WS_PEBV), WSP(bf16_t, WS_W2K), WSP(bf16_t, WS_W2V), WSP(bf16_t, WS_KCMP), WSP(bf16_t, WS_VCMP), ws, split};
        pg8::gemm_phase<EpiCmp, CmpSched, false>(lds, g, S, E, wave_k);
    }
    SEAM(2);
    if (IN(3)) REP(3) {
        const nsa::Tensors X{ws};
        const int wave_s = wave_k;
#pragma unroll 1
        for (int uu = vcu; uu < 256; uu += G) { const int bg = uu >> 5, i = uu & 31;
#pragma unroll 1
            for (int hh = 0; hh < 2; ++hh) nsa::unit(lds, X, bg >> 2, bg & 3, hh ? 63 - i : i, wave_s); }
        if (G == 256) {
            __syncthreads();
            PHASE_IDS(); (void)gw;
            late_weights_queue(kparams(), lds, wave, lane);
        }
    }
    SEAM(3);
    if (IN(4)) REP(4) {
        pg8::Gemm g{1536 * 2, 1536 * 2, 128, 128, 24}; pg8::StdSched S; S.init(WSP(bf16_t, WS_PA), WSP(bf16_t, WS_WM), T, 1024, 3072, 3072, G, bx);
        EpiMerged E{WSP(bf16_t, WS_MG), SP, WSP(bf16_t, WS_SA)};
        pg8::gemm_phase<EpiMerged, pg8::StdSched, false>(lds, g, S, E, wave_k);
    }
    SEAM(4);
    if (IN(5)) REP(5) {
        pg8::Gemm g{1024 * 2, 1024 * 2, 128, 128, 16}; pg8::StdSched S; S.init(WSP(bf16_t, WS_MG), WSP(bf16_t, WS_WO), T, 1024, 2048, 2048, G, bx);
        EpiX1 E{kparams()->x, X1, WSP(bf16_t, WS_X1B), WSP(float, WS_RS1)};
        pg8::gemm_phase<EpiX1, pg8::StdSched, false>(lds, g, S, E, wave_k);
    }
    SEAM(5);
    if (IN(6)) REP(6) {
        pg8::Gemm g{1024 * 2, 1024 * 2, 128, 128, 16}; pg8::StdSched S; S.init(WSP(bf16_t, WS_X1B), WSP(bf16_t, WS_WGU), T, 5632, 2048, 2048, G, bx);
        EpiAct E{WSP(bf16_t, WS_ACT), WSP(float, WS_RS1)};
        pg8::gemm_phase<EpiAct, pg8::StdSched, true>(lds, g, S, E, wave_k);
    }
    SEAM(6);
    if (IN(7)) {
        pg8::Gemm g{DFF * 2, DFF * 2, 128, 128, DFF / 64}; pg8::StdSched S; S.init(WSP(bf16_t, WS_ACT), WSP(bf16_t, WS_WD), T, 1024, DFF * 2, DFF * 2, G, bx);
        if (G == 256) {
            EpiFinal E{X1, WSP(bf16_t, WS_X1B), kparams()->normf_w, WSP(float, WS_SEL), (unsigned*)(ws + WS_CTL) + CW_FN};
            pg8::gemm_phase<EpiFinal, pg8::StdSched, false>(lds, g, S, E, wave_k);
        } else {
            EpiX2 E{X1, WSP(bf16_t, WS_X1B)};
            pg8::gemm_phase<EpiX2, pg8::StdSched, false>(lds, g, S, E, wave_k);
        }
    }
    if (G != 256) {
    SEAM(7);
    if (IN(8)) {
        PHASE_IDS();
        for (int row = gw; row < T; row += NGW) {
            f32x4* xr = (f32x4*)(X1 + (size_t)row * DM) + lane; const f32x4* wr = (const f32x4*)kparams()->normf_w + lane;
            f32x4 v[4]; float s = 0.f;
#pragma unroll
            for (int j = 0; j < 4; ++j) { v[j] = xr[64 * j]; s += (v[j].x * v[j].x + v[j].y * v[j].y) + (v[j].z * v[j].z + v[j].w * v[j].w); }
            const float rstd = rsqrtf(wave_sum(s) * (1.f / DM) + RMS_EPS);
#pragma unroll
            for (int j = 0; j < 4; ++j) { const f32x4 ww = wr[64 * j]; xr[64 * j] = (f32x4){v[j].x * rstd * ww.x, v[j].y * rstd * ww.y, v[j].z * rstd * ww.z, v[j].w * rstd * ww.w}; }
        }
    }
    }
#undef WSP
#undef ws
#undef dout
#undef H
#undef SP
#undef X1
}

extern "C" void kernel_launch(void* const* d_in, const int* in_sizes, int n_in, void* d_out, int out_size, void* d_ws, size_t ws_size, hipStream_t stream) {
    static int grid = 0;
    if (grid == 0) {
        if (n_in != 21 || ws_size < WS_END || out_size != T * DM) { fprintf(stderr, "kernel_launch: unexpected shapes n_in %d ws %zu out %d\n", n_in, ws_size, out_size); grid = -1; return; }
        int dev = 0, cus = 0, per_cu = 0;
        if (hipGetDevice(&dev) != hipSuccess || hipDeviceGetAttribute(&cus, hipDeviceAttributeMultiprocessorCount, dev) != hipSuccess) { grid = -1; return; }
        if (hipFuncSetAttribute((const void*)mk_fwd, hipFuncAttributeMaxDynamicSharedMemorySize, LDS_BYTES) != hipSuccess) { fprintf(stderr, "kernel_launch: hipFuncSetAttribute failed\n"); grid = -1; return; }
        if (hipOccupancyMaxActiveBlocksPerMultiprocessor(&per_cu, (const void*)mk_fwd, NTHREADS, LDS_BYTES) != hipSuccess || per_cu < 1) { fprintf(stderr, "kernel_launch: occupancy query says %d\n", per_cu); (void)hipGetLastError(); per_cu = 1; }
        grid = cus;
    }
    if (grid < 0) return;
    Params p{};
    const float** pin = (const float**)&p;
    for (int i = 0; i < 21; ++i) pin[i] = (const float*)d_in[i];
    p.out = (float*)d_out; p.ws = (unsigned char*)d_ws;
#if MK_COOP
    p.ph_lo = 0; p.ph_hi = N_PHASES;
    if (hipMemsetAsync((char*)d_ws + WS_CTL, 0, CTL_ZERO_BYTES, stream) != hipSuccess) { fprintf(stderr, "kernel_launch: memset failed\n"); return; }
    void* args[] = {&p};
    hipError_t e = hipLaunchCooperativeKernel((const void*)mk_fwd, dim3(grid), dim3(NTHREADS), args, LDS_BYTES, stream);
    if (e != hipSuccess) fprintf(stderr, "kernel_launch: cooperative launch failed: %s (grid %d)\n", hipGetErrorString(e), grid);
#else
    for (int ph = 0; ph < N_PHASES; ++ph) { p.ph_lo = ph; p.ph_hi = ph + 1; hipLaunchKernelGGL(mk_fwd, dim3(grid), dim3(NTHREADS), LDS_BYTES, stream, p); }
#endif
}
```
